# Optimizing an MI355X kernel written in HIP

```python
import math
import jax, jax.numpy as jnp
from jax import lax
import numpy as np

D_MODEL = 1024
BATCH = 8
SEQ = 2048
DEPTH = 2

CHUNK = 64
N_META = 16
Q_BLOCK = 128
ROPE_THETA = 500000.0
EPS = 1e-6
N_BRANCH = 3

SB_HEADS = D_MODEL // 128
SB_HEAD_DIM = 64
SB_WIDTH = SB_HEADS * SB_HEAD_DIM

MLA_HEADS = D_MODEL // 128
MLA_NOPE = 64
MLA_ROPE = 32
MLA_V = 64
MLA_Q_RANK = 3 * D_MODEL // 8
MLA_KV_RANK = D_MODEL // 4
MLA_WIDTH = MLA_HEADS * MLA_V

DIFF_HEADS = D_MODEL // 256
DIFF_HEAD_DIM = 64
DIFF_V_DIM = 2 * DIFF_HEAD_DIM
DIFF_WIDTH = DIFF_HEADS * DIFF_V_DIM
ROT_DIM = DIFF_HEAD_DIM // 4

IN_SIZES = (
    SB_WIDTH, SB_WIDTH, SB_WIDTH, SB_WIDTH,
    MLA_Q_RANK, MLA_KV_RANK, MLA_ROPE, MLA_WIDTH,
    2 * DIFF_HEADS * DIFF_HEAD_DIM, 2 * DIFF_HEADS * DIFF_HEAD_DIM,
    DIFF_HEADS * DIFF_V_DIM, DIFF_WIDTH,
    N_BRANCH * D_MODEL,
)
IN_COLS = sum(IN_SIZES)

kernel_name = "hybrid_stickbreak_mla_diffattn_gated_merge"


def _rmsnorm(x, g):
    x32 = x.astype(jnp.float32)
    y = x32 * lax.rsqrt(jnp.mean(x32 * x32, axis=-1, keepdims=True) + EPS)
    return y.astype(x.dtype) * g


def _rope_tables(n_pos, dim):
    inv_freq = ROPE_THETA ** (-jnp.arange(0, dim, 2, dtype=jnp.float32) / dim)
    ang = jnp.arange(n_pos, dtype=jnp.float32)[:, None] * inv_freq[None, :]
    return jnp.cos(ang), jnp.sin(ang)


def _rope(x, cos, sin):
    half = x.shape[-1] // 2
    x32 = x.astype(jnp.float32)
    x1, x2 = x32[..., :half], x32[..., half:]
    out = jnp.concatenate([x1 * cos - x2 * sin, x2 * cos + x1 * sin], axis=-1)
    return out.astype(x.dtype)


def _partial_rope(x, cos, sin):
    return jnp.concatenate([_rope(x[..., :ROT_DIM], cos, sin), x[..., ROT_DIM:]], axis=-1)


def _heads(t, n_heads):
    b, l, w = t.shape
    return t.reshape(b, l, n_heads, w // n_heads).transpose(0, 2, 1, 3)


def _merge_heads(t):
    b, h, l, d = t.shape
    return t.transpose(0, 2, 1, 3).reshape(b, l, h * d)


def _sweep(block_fn, n_blocks):
    return jnp.concatenate([block_fn(i) for i in range(n_blocks)], axis=2)


def _chunk_mask(chunk_ids, q0, k_end):
    qc = chunk_ids[q0:q0 + Q_BLOCK]
    kc = chunk_ids[:k_end]
    return kc[None, :] <= qc[:, None]


def _masked_softmax(s, mask):
    return jax.nn.softmax(jnp.where(mask, s, -jnp.inf), axis=-1)


def _layer(x, layer_idx, pos, chunk_ids, cos_d, sin_d, cos_m, sin_m,
           norm_g, w_in, b_gate, mla_cq_g, mla_ckv_g, mla_w_uq, mla_w_ukv,
           diff_lambda, diff_norm_g, w_o_sb, w_o_mla, w_o_diff, w_out):
    B, L, D = x.shape
    n_blocks = L // Q_BLOCK
    h = _rmsnorm(x, norm_g)
    proj = h @ w_in
    offsets = []
    acc = 0
    for s in IN_SIZES[:-1]:
        acc += s
        offsets.append(acc)
    (sb_q, sb_k, sb_v, sb_z, mla_cq, mla_ckv, mla_kr, mla_z,
     d_q, d_k, d_v, d_z, gate_logits) = jnp.split(proj, offsets, axis=-1)

    q_a, k_a, v_a = _heads(sb_q, SB_HEADS), _heads(sb_k, SB_HEADS), _heads(sb_v, SB_HEADS)
    scale_a = 1.0 / math.sqrt(SB_HEAD_DIM)

    def sb_block(i):
        q0 = i * Q_BLOCK
        k_end = q0 + Q_BLOCK
        z = jnp.einsum('bhqd,bhkd->bhqk', q_a[:, :, q0:k_end], k_a[:, :, :k_end]).astype(jnp.float32) * scale_a
        valid = pos[:k_end][None, :] < pos[q0:k_end][:, None]
        log_keep = jnp.where(valid, -jax.nn.softplus(z), 0.0)
        after = lax.cumsum(log_keep, axis=3, reverse=True) - log_keep
        w = jnp.where(valid, jnp.exp(jax.nn.log_sigmoid(z) + after), 0.0)
        return jnp.einsum('bhqk,bhkd->bhqd', w.astype(v_a.dtype), v_a[:, :, :k_end])

    o_sb = _merge_heads(_sweep(sb_block, n_blocks))

    q_b = _heads(_rmsnorm(mla_cq, mla_cq_g) @ mla_w_uq, MLA_HEADS)
    q_b = jnp.concatenate([q_b[..., :MLA_NOPE], _rope(q_b[..., MLA_NOPE:], cos_m, sin_m)], axis=-1)
    kv_b = _heads(_rmsnorm(mla_ckv, mla_ckv_g) @ mla_w_ukv, MLA_HEADS)
    k_rope = _rope(mla_kr, cos_m, sin_m)
    k_b = jnp.concatenate([kv_b[..., :MLA_NOPE],
                           jnp.broadcast_to(k_rope[:, None], (B, MLA_HEADS, L, MLA_ROPE))], axis=-1)
    v_b = kv_b[..., MLA_NOPE:]
    scale_b = 1.0 / math.sqrt(MLA_NOPE + MLA_ROPE)

    def mla_block(i):
        q0 = i * Q_BLOCK
        k_end = min(q0 + Q_BLOCK + CHUNK, L)
        s = jnp.einsum('bhqd,bhkd->bhqk', q_b[:, :, q0:q0 + Q_BLOCK], k_b[:, :, :k_end]).astype(jnp.float32) * scale_b
        p = _masked_softmax(s, _chunk_mask(chunk_ids, q0, k_end))
        return jnp.einsum('bhqk,bhkd->bhqd', p.astype(v_b.dtype), v_b[:, :, :k_end])

    o_mla = _merge_heads(_sweep(mla_block, n_blocks))

    q_c = _partial_rope(d_q.reshape(B, L, DIFF_HEADS, 2, DIFF_HEAD_DIM).transpose(0, 2, 3, 1, 4), cos_d, sin_d)
    k_c = _partial_rope(d_k.reshape(B, L, DIFF_HEADS, 2, DIFF_HEAD_DIM).transpose(0, 2, 3, 1, 4), cos_d, sin_d)
    v_c = _heads(d_v, DIFF_HEADS)
    lam_init = 0.8 - 0.6 * math.exp(-0.3 * layer_idx)
    lam32 = diff_lambda.astype(jnp.float32)
    lam = (jnp.exp(jnp.sum(lam32[0] * lam32[1])) - jnp.exp(jnp.sum(lam32[2] * lam32[3])) + lam_init)
    scale_c = 1.0 / math.sqrt(DIFF_HEAD_DIM)

    def diff_block(i):
        q0 = i * Q_BLOCK
        k_end = min(q0 + Q_BLOCK + CHUNK, L)
        s = jnp.einsum('bhmqd,bhmkd->bhmqk', q_c[:, :, :, q0:q0 + Q_BLOCK], k_c[:, :, :, :k_end]).astype(jnp.float32) * scale_c
        p = _masked_softmax(s, _chunk_mask(chunk_ids, q0, k_end))
        w = p[:, :, 0] - lam * p[:, :, 1]
        return jnp.einsum('bhqk,bhkd->bhqd', w.astype(v_c.dtype), v_c[:, :, :k_end])

    o_c = _sweep(diff_block, n_blocks)
    o_diff = _merge_heads(_rmsnorm(o_c, diff_norm_g) * (1.0 - lam_init))

    y_sb = (o_sb * jax.nn.silu(sb_z)) @ w_o_sb
    y_mla = (o_mla * jax.nn.silu(mla_z)) @ w_o_mla
    y_diff = (o_diff * jax.nn.silu(d_z)) @ w_o_diff
    g = jax.nn.sigmoid(gate_logits + b_gate).reshape(B, L, N_BRANCH, D)
    merged = g[:, :, 0] * y_sb + g[:, :, 1] * y_mla + g[:, :, 2] * y_diff
    return x + merged @ w_out


def setup_inputs(seed: int = 0) -> dict:
    key = jax.random.key(seed)
    ks = jax.random.split(key, 18)

    def nrm(k, shape, fan_in):
        return jax.random.normal(k, shape, jnp.float32) * fan_in ** -0.5

    def gain(k, shape):
        return 1.0 + 0.05 * jax.random.normal(k, shape, jnp.float32)

    return {
        "x": jax.random.normal(ks[0], (BATCH, SEQ, D_MODEL), jnp.float32),
        "meta_tokens": jax.random.normal(ks[1], (N_META, D_MODEL), jnp.float32),
        "norm_g": gain(ks[2], (DEPTH, D_MODEL)),
        "w_in": nrm(ks[3], (DEPTH, D_MODEL, IN_COLS), D_MODEL),
        "b_gate": 0.01 * jax.random.normal(ks[4], (DEPTH, N_BRANCH * D_MODEL), jnp.float32),
        "mla_cq_g": gain(ks[5], (DEPTH, MLA_Q_RANK)),
        "mla_ckv_g": gain(ks[6], (DEPTH, MLA_KV_RANK)),
        "mla_w_uq": nrm(ks[7], (DEPTH, MLA_Q_RANK, MLA_HEADS * (MLA_NOPE + MLA_ROPE)), MLA_Q_RANK),
        "mla_w_ukv": nrm(ks[8], (DEPTH, MLA_KV_RANK, MLA_HEADS * (MLA_NOPE + MLA_V)), MLA_KV_RANK),
        "diff_lambda": 0.1 * jax.random.normal(ks[9], (DEPTH, 4, DIFF_HEAD_DIM), jnp.float32),
        "diff_norm_g": gain(ks[10], (DEPTH, DIFF_V_DIM)),
        "w_o_sb": nrm(ks[11], (DEPTH, SB_WIDTH, D_MODEL), SB_WIDTH),
        "w_o_mla": nrm(ks[12], (DEPTH, MLA_WIDTH, D_MODEL), MLA_WIDTH),
        "w_o_diff": nrm(ks[13], (DEPTH, DIFF_WIDTH, D_MODEL), DIFF_WIDTH),
        "w_out": nrm(ks[14], (DEPTH, D_MODEL, D_MODEL), D_MODEL),
        "final_g": gain(ks[15], (D_MODEL,)),
    }


def reference(x, meta_tokens, norm_g, w_in, b_gate, mla_cq_g, mla_ckv_g, mla_w_uq, mla_w_ukv,
              diff_lambda, diff_norm_g, w_o_sb, w_o_mla, w_o_diff, w_out, final_g):
    B, S, D = x.shape
    L = S + N_META
    L_pad = -(-L // Q_BLOCK) * Q_BLOCK
    meta = jnp.broadcast_to(meta_tokens.astype(x.dtype)[None], (B, N_META, D))
    h = jnp.concatenate([meta, x, jnp.zeros((B, L_pad - L, D), x.dtype)], axis=1)
    pos = jnp.arange(L_pad)
    chunk_ids = jnp.where(pos < N_META, 0, (pos - N_META) // CHUNK + 1)
    cos_d, sin_d = _rope_tables(L_pad, ROT_DIM)
    cos_m, sin_m = _rope_tables(L_pad, MLA_ROPE)
    for l in range(DEPTH):
        h = _layer(h, l, pos, chunk_ids, cos_d, sin_d, cos_m, sin_m,
                   norm_g[l], w_in[l], b_gate[l], mla_cq_g[l], mla_ckv_g[l], mla_w_uq[l], mla_w_ukv[l],
                   diff_lambda[l], diff_norm_g[l], w_o_sb[l], w_o_mla[l], w_o_diff[l], w_out[l])
    h = _rmsnorm(h, final_g)
    return h[:, N_META:N_META + S]
```

```cpp
#ifndef HOST_EMU
#include <hip/hip_runtime.h>
#endif
#include <cstdio>
#include <cstdint>
#include <cmath>
#include <cstring>

#ifndef CFG_B
#define CFG_B 8
#endif
#ifndef CFG_S
#define CFG_S 2048
#endif
#ifndef CFG_D
#define CFG_D 1024
#endif

typedef unsigned short bf16_t;

namespace cfg {
constexpr int NB = CFG_B, SEQ = CFG_S, D = CFG_D, DEPTH = 2;
constexpr int NMETA = 16, LEAD = 48, TB = LEAD + NMETA + SEQ, R = NB * TB, NPOS = NMETA + SEQ;
constexpr int W = D / 2;
constexpr int NH = D / 128;
constexpr int NHD = D / 256;
constexpr int QR = 3 * D / 8, KVR = D / 4, QBW = NH * 96;
constexpr int INC = 4 * W + QR + KVR + 32 + W + 4 * W + 3 * D;
constexpr int C_SBQ = 0, C_SBK = W, C_SBV = 2 * W, C_SBZ = 3 * W, C_CQ = 4 * W, C_CKV = C_CQ + QR, C_KR = C_CKV + KVR, C_MZ = C_KR + 32,
              C_DQ = C_MZ + W, C_DK = C_DQ + W, C_DV = C_DK + W, C_DZ = C_DV + W, C_G = C_DZ + W;
static_assert(C_G + 3 * D == INC, "w_in columns");
constexpr int V1_SBQ = 0, V1_SBK = W, V1_CQ = 2 * W, V1_CKV = V1_CQ + QR, V1_KR = V1_CKV + KVR, V1_DQ = V1_KR + 32, V1_DK = V1_DQ + W, V1_END = V1_DK + W;
constexpr int N1 = (V1_END + 255) / 256 * 256;
constexpr int N3 = 3 * W + 3 * D;
constexpr int NSX = D / 32, NSQ = QR / 32, NSK = KVR / 32;
constexpr float EPS = 1e-6f, LOG2E = 1.4426950408889634f;
constexpr int GP = D / 256;
}
using namespace cfg;

constexpr size_t MiB = size_t(1) << 20;
constexpr size_t al256(size_t x) { return (x + 255) & ~size_t(255); }
constexpr size_t SZ_W = (size_t)R * W * 2, SZ_D2 = (size_t)R * D * 2, SZ_X = (size_t)R * D * 4, SZ_CQ = (size_t)R * QR * 2, SZ_CKV = (size_t)R * KVR * 2,
                 SZ_KR = (size_t)R * 32 * 2, SZ_QB = (size_t)R * QBW * 2, SZ_GP = (size_t)R * 256 * 2;
constexpr size_t WB_W1 = (size_t)N1 * D * 2, WB_WV = (size_t)2 * W * D * 2, WB_W3 = (size_t)N3 * D * 2, WB_UQ = (size_t)QBW * QR * 2, WB_UK = (size_t)W * KVR * 2,
                 WB_UV = WB_UK, WB_WO = (size_t)3 * D * W * 2, WB_OUT = (size_t)D * D * 2;
constexpr size_t WL_W1 = 0, WL_WV = WL_W1 + WB_W1, WL_W3 = WL_WV + WB_WV, WL_UQ = WL_W3 + WB_W3, WL_UK = WL_UQ + WB_UQ, WL_UV = WL_UK + WB_UK, WL_WO = WL_UV + WB_UV,
                 WL_OUT = WL_WO + WB_WO, WL_BYTES = al256(WL_OUT + WB_OUT);
constexpr bool STDCFG = (NB == 8 && SEQ == 2048 && D == 1024);
#if defined(HOST_EMU)
constexpr bool HANDMAP = false;
#else
constexpr bool HANDMAP = STDCFG;
#endif
constexpr size_t O_CTL = 0, O_TAB = 1 * MiB, O_LAM = O_TAB + 768 * 1024, O_SSX = 2 * MiB, O_SSQ = O_SSX + al256((size_t)R * NSX * 4), O_SSK = O_SSQ + al256((size_t)R * NSQ * 4),
                 O_WTS = al256(O_SSK + (size_t)R * NSK * 4 + MiB) / MiB * MiB;
constexpr size_t O_X = HANDMAP ? 52 * MiB : al256(O_WTS + 2 * WL_BYTES);
static_assert(O_WTS + 2 * WL_BYTES <= O_X, "weights overrun X");
constexpr size_t O_A = O_X + al256(SZ_X);
constexpr size_t Q_QSB = O_A, Q_QD = Q_QSB + al256(SZ_W), Q_OMLA = Q_QD + al256(SZ_W), Q_KSB = Q_OMLA + al256(SZ_W), Q_VSBT = Q_KSB + al256(SZ_W), Q_KD = Q_VSBT + al256(SZ_W),
                 Q_VDT = Q_KD + al256(SZ_W), Q_VBT = Q_VDT + al256(SZ_W), Q_KR = Q_VBT + al256(SZ_W), Q_CKV = Q_KR + al256(SZ_KR), Q_XB2 = Q_CKV + al256(SZ_CKV), Q_G0 = Q_XB2 + al256(SZ_D2),
                 Q_GPC = Q_G0 + al256(SZ_D2), Q_XB = Q_GPC + 2 * GP * al256(SZ_GP), Q_QB = Q_XB + al256(SZ_D2), Q_CQ = Q_QB + al256(SZ_QB), Q_KNOPE = Q_CQ + al256(SZ_CQ), Q_END = Q_KNOPE + al256(SZ_W);
constexpr size_t WS_NEED = HANDMAP ? 256 * MiB : Q_END;

struct Params {
    const float *x, *meta, *norm_g, *w_in, *b_gate, *cq_g, *ckv_g, *w_uq, *w_ukv, *dlam, *dnorm_g, *w_osb, *w_omla, *w_odiff, *w_out, *final_g;
    float* out;
    float *X, *ssx, *ssq, *ssk, *cosm, *sinm, *cosd, *sind, *lamv;
    char* WTS;
    bf16_t *XB, *XB2, *QSB, *KSB, *VSBT, *QD, *KD, *VDT, *CQ, *CKV, *KR, *QB, *KNOPE, *VBT, *OMLA, *G0, *GPW, *GPO;
    unsigned* ctl;
};

static Params make_params(void* const* d_in, void* d_out, void* d_ws) {
    Params p{};
    const float* const* in = (const float* const*)d_in;
    p.x = in[0]; p.meta = in[1]; p.norm_g = in[2]; p.w_in = in[3]; p.b_gate = in[4]; p.cq_g = in[5]; p.ckv_g = in[6]; p.w_uq = in[7]; p.w_ukv = in[8]; p.dlam = in[9];
    p.dnorm_g = in[10]; p.w_osb = in[11]; p.w_omla = in[12]; p.w_odiff = in[13]; p.w_out = in[14]; p.final_g = in[15];
    p.out = (float*)d_out;
    char* ws = (char*)d_ws; char* ob = (char*)d_out;
    p.ctl = (unsigned*)(ws + O_CTL);
    p.cosm = (float*)(ws + O_TAB); p.sinm = p.cosm + NPOS * 16; p.cosd = p.sinm + NPOS * 16; p.sind = p.cosd + NPOS * 8; p.lamv = (float*)(ws + O_LAM);
    p.ssx = (float*)(ws + O_SSX); p.ssq = (float*)(ws + O_SSQ); p.ssk = (float*)(ws + O_SSK);
    p.WTS = ws + O_WTS;
    p.X = (float*)(ws + O_X);
    if (HANDMAP) {
        auto A = [&](double mib) { return (bf16_t*)(ws + (size_t)(mib * 1048576.0)); };
        auto Bq = [&](double mib) { return (bf16_t*)(ob + (size_t)(mib * 1048576.0)); };
        p.QSB = A(118); p.QD = A(134.5); p.OMLA = A(151); p.CKV = A(151); p.KSB = A(167.5); p.VSBT = A(184); p.KD = A(200.5); p.VDT = A(217); p.VBT = A(233.5); p.KR = A(250);
        p.XB2 = A(167.5); p.G0 = A(200.5);
        p.XB = Bq(0); p.QB = Bq(0); p.CQ = Bq(33); p.KNOPE = Bq(45.5);
        p.GPW = A(233.5); p.GPO = Bq(0);
    } else {
        auto A = [&](size_t off) { return (bf16_t*)(ws + off); };
        p.QSB = A(Q_QSB); p.QD = A(Q_QD); p.OMLA = A(Q_OMLA); p.CKV = A(Q_CKV); p.KSB = A(Q_KSB); p.VSBT = A(Q_VSBT); p.KD = A(Q_KD); p.VDT = A(Q_VDT); p.VBT = A(Q_VBT); p.KR = A(Q_KR);
        p.XB2 = A(Q_XB2); p.G0 = A(Q_G0); p.XB = A(Q_XB); p.QB = A(Q_QB); p.CQ = A(Q_CQ); p.KNOPE = A(Q_KNOPE);
        p.GPW = A(Q_GPC); p.GPO = A(Q_GPC);
    }
    return p;
}
static_assert(!STDCFG || (SZ_W == (size_t)(16.5 * 1048576) && SZ_D2 == 33 * MiB && SZ_GP == (size_t)(8.25 * 1048576) && SZ_QB == (size_t)(24.75 * 1048576) && SZ_CQ <= (size_t)(12.5 * 1048576) &&
              SZ_KR <= (size_t)(1.1 * 1048576) && SZ_X == 66 * MiB && GP == 4), "hand map sizes");

#ifdef HOST_EMU
#define DEVFN inline
#define HDFN inline
#else
#define DEVFN __device__ __forceinline__
#define HDFN __host__ __device__ __forceinline__
#endif
DEVFN float bf2f(bf16_t h) { unsigned u = (unsigned)h << 16; float f; memcpy(&f, &u, 4); return f; }
DEVFN bf16_t f2bf(float f) { unsigned u; memcpy(&u, &f, 4); return (bf16_t)((u + 0x7fffu + ((u >> 16) & 1u)) >> 16); }
struct alignas(16) U4 { unsigned x, y, z, w; };
DEVFN void ld8(const bf16_t* p, float* o) {
    const U4 v = *(const U4*)p; const unsigned u[4] = {v.x, v.y, v.z, v.w};
#pragma unroll
    for (int i = 0; i < 4; ++i) { unsigned lo = u[i] << 16, hi = u[i] & 0xffff0000u; memcpy(&o[2 * i], &lo, 4); memcpy(&o[2 * i + 1], &hi, 4); }
}
DEVFN float rsq(float x) { return 1.0f / sqrtf(x); }
DEVFN float rstd_slots(const float* s, int row, int ns, float invn) { float t = 0.f; for (int i = 0; i < ns; ++i) t += s[(size_t)row * ns + i]; return rsq(t * invn + EPS); }
DEVFN int sperm(int r) { return (r & ~12) | ((r & 4) << 1) | ((r & 8) >> 1); }
constexpr int NPW = HANDMAP ? 2 : 2 * GP;
DEVFN bf16_t* gptr(const Params& p, int b, int row, int c) {
    if (b == 0) return p.G0 + (size_t)row * D + c;
    const int j = (b - 1) * GP + (c >> 8); bf16_t* base = j < NPW ? p.GPW + (size_t)j * (al256(SZ_GP) / 2) : p.GPO + (size_t)(j - NPW) * (al256(SZ_GP) / 2);
    return base + (size_t)row * 256 + (c & 255);
}
HDFN bf16_t* wptr(const Params& p, int l, size_t off) { return (bf16_t*)(p.WTS + (size_t)l * WL_BYTES + off); }
DEVFN float silu_f(float z) { return z / (1.f + expf(-z)); }
DEVFN float sigm_f(float z) { return 1.f / (1.f + expf(-z)); }
struct alignas(8) U2 { unsigned x, y; };
#ifdef HOST_EMU
DEVFN unsigned pk2(float lo, float hi) { return (unsigned)f2bf(lo) | ((unsigned)f2bf(hi) << 16); }
#else
typedef float f32x2_t __attribute__((ext_vector_type(2))); typedef __bf16 bf16x2_t __attribute__((ext_vector_type(2)));
DEVFN unsigned pk2(float lo, float hi) { f32x2_t v = {lo, hi}; bf16x2_t b = __builtin_convertvector(v, bf16x2_t); return __builtin_bit_cast(unsigned, b); }
#endif
DEVFN void st4(bf16_t* p, float a, float b, float c, float d) { U2 v; v.x = pk2(a, b); v.y = pk2(c, d); *(U2*)p = v; }
DEVFN void st2(bf16_t* p, float a, float b) { *(unsigned*)p = pk2(a, b); }
DEVFN void ld4(const bf16_t* p, float* o) { const U2 v = *(const U2*)p; unsigned t; t = v.x << 16; memcpy(&o[0], &t, 4); t = v.x & 0xffff0000u; memcpy(&o[1], &t, 4); t = v.y << 16; memcpy(&o[2], &t, 4); t = v.y & 0xffff0000u; memcpy(&o[3], &t, 4); }

DEVFN int rotmap(int c, int half) { const int g = c >> 2, e = c & 3; return e < 2 ? 2 * g + e : half + 2 * g + (e - 2); }
DEVFN int src_w1(int n) {
    if (n < V1_SBK) return C_SBQ + n;
    if (n < V1_CQ) return C_SBK + (n - V1_SBK);
    if (n < V1_CKV) return C_CQ + (n - V1_CQ);
    if (n < V1_KR) return C_CKV + (n - V1_CKV);
    if (n < V1_DQ) return C_KR + rotmap(n - V1_KR, 16);
    if (n < V1_DK) { const int c = n - V1_DQ, cc = c & 63; return C_DQ + (c & ~63) + (cc < 16 ? rotmap(cc, 8) : cc); }
    if (n < V1_END) { const int c = n - V1_DK, cc = c & 63; return C_DK + (c & ~63) + (cc < 16 ? rotmap(cc, 8) : cc); }
    return -1;
}
DEVFN int src_wv(int n) { return n < W ? C_SBV + n : C_DV + (n - W); }
DEVFN int src_w3(int n) { return n < W ? C_SBZ + n : n < 2 * W ? C_MZ + (n - W) : n < 3 * W ? C_DZ + (n - 2 * W) : C_G + (n - 3 * W); }
DEVFN int src_uq(int n) { const int h = n / 96, cc = n % 96; return h * 96 + (cc < 64 ? cc : 64 + rotmap(cc - 64, 16)); }
DEVFN int src_uk(int n) { return (n >> 6) * 128 + (n & 63); }
DEVFN int src_uv(int n) { return (n >> 6) * 128 + 64 + (n & 63); }

#ifdef HOST_EMU
#define SHFL_XOR(v, m) (v)
#else
#define SHFL_XOR(v, m) __shfl_xor((v), (m))
#endif
DEVFN float quad_sum(float s) { s += SHFL_XOR(s, 16); s += SHFL_XOR(s, 32); return s; }
struct F1 {
    const Params& p; int aux;
    DEVFN bool swapped(int tag) const { return tag == 1; }
    DEVFN float scale(int tag, int idx) const { return rstd_slots(p.ssx, idx, NSX, 1.0f / D); }
    DEVFN float operator()(int tag, int row, int vc, const float* a, const float* sc) const {
        if (tag == 1) { bf16_t* o = (row < W ? p.VSBT + (size_t)row * R : p.VDT + (size_t)(row - W) * R) + ((vc & ~15) | sperm(vc & 15)); st4(o, a[0] * sc[0], a[1] * sc[1], a[2] * sc[2], a[3] * sc[3]); return 0.f; }
        const float rs = sc[0]; const float v0 = a[0] * rs, v1 = a[1] * rs, v2 = a[2] * rs, v3 = a[3] * rs;
        const int t = row % TB; const int pos = t >= LEAD ? t - LEAD : 0;
        if (vc < V1_SBK) { st4(p.QSB + (size_t)row * W + vc, v0 * (0.125f * LOG2E), v1 * (0.125f * LOG2E), v2 * (0.125f * LOG2E), v3 * (0.125f * LOG2E)); }
        else if (vc < V1_CQ) { st4(p.KSB + (size_t)row * W + (vc - V1_SBK), v0, v1, v2, v3); }
        else if (vc < V1_CKV) { st4(p.CQ + (size_t)row * QR + (vc - V1_CQ), v0, v1, v2, v3); return (v0 * v0 + v1 * v1) + (v2 * v2 + v3 * v3); }
        else if (vc < V1_KR) { st4(p.CKV + (size_t)row * KVR + (vc - V1_CKV), v0, v1, v2, v3); return (v0 * v0 + v1 * v1) + (v2 * v2 + v3 * v3); }
        else if (vc < V1_DQ) { const int g = (vc - V1_KR) >> 2; const float c0 = p.cosm[pos * 16 + 2 * g], c1 = p.cosm[pos * 16 + 2 * g + 1], s0 = p.sinm[pos * 16 + 2 * g], s1 = p.sinm[pos * 16 + 2 * g + 1];
            bf16_t* o = p.KR + (size_t)row * 32; st2(o + 2 * g, v0 * c0 - v2 * s0, v1 * c1 - v3 * s1); st2(o + 16 + 2 * g, v2 * c0 + v0 * s0, v3 * c1 + v1 * s1); }
        else if (vc < V1_END) { const bool isq = vc < V1_DK; const int c = vc - (isq ? V1_DQ : V1_DK), cc = c & 63; const float sc2 = isq ? 0.125f * LOG2E : 1.0f;
            bf16_t* o = (isq ? p.QD : p.KD) + (size_t)row * W + (c & ~63);
            if (cc < 16) { const int g = cc >> 2; const float c0 = p.cosd[pos * 8 + 2 * g], c1 = p.cosd[pos * 8 + 2 * g + 1], s0 = p.sind[pos * 8 + 2 * g], s1 = p.sind[pos * 8 + 2 * g + 1];
                st2(o + 2 * g, (v0 * c0 - v2 * s0) * sc2, (v1 * c1 - v3 * s1) * sc2); st2(o + 8 + 2 * g, (v2 * c0 + v0 * s0) * sc2, (v3 * c1 + v1 * s1) * sc2); }
            else st4(o + cc, v0 * sc2, v1 * sc2, v2 * sc2, v3 * sc2); }
        return 0.f;
    }
    DEVFN void rowslot(int tag, int row, int vc0, int fq, float part) const {
        if (tag != 0 || vc0 < V1_CQ || vc0 >= V1_KR) return;
        const float s = quad_sum(part);
        if (fq == 0) { if (vc0 < V1_CKV) p.ssq[(size_t)row * NSQ + ((vc0 - V1_CQ) >> 5)] = s; else p.ssk[(size_t)row * NSK + ((vc0 - V1_CKV) >> 5)] = s; }
    }
};
struct FUQ {
    const Params& p; int aux;
    DEVFN bool swapped(int) const { return false; }
    DEVFN float scale(int, int idx) const { return rstd_slots(p.ssq, idx, NSQ, 1.0f / QR) * (LOG2E * 0.10206207261596577f); }
    DEVFN float operator()(int, int row, int vc, const float* a, const float* sc) const {
        const float rs = sc[0]; const float v0 = a[0] * rs, v1 = a[1] * rs, v2 = a[2] * rs, v3 = a[3] * rs;
        const int t = row % TB; const int pos = t >= LEAD ? t - LEAD : 0;
        const int h = vc / 96, cc = vc % 96; bf16_t* o = p.QB + (size_t)row * QBW + h * 96;
        if (cc < 64) st4(o + cc, v0, v1, v2, v3);
        else { const int g = (cc - 64) >> 2; const float c0 = p.cosm[pos * 16 + 2 * g], c1 = p.cosm[pos * 16 + 2 * g + 1], s0 = p.sinm[pos * 16 + 2 * g], s1 = p.sinm[pos * 16 + 2 * g + 1];
            st2(o + 64 + 2 * g, v0 * c0 - v2 * s0, v1 * c1 - v3 * s1); st2(o + 80 + 2 * g, v2 * c0 + v0 * s0, v3 * c1 + v1 * s1); }
        return 0.f;
    }
    DEVFN void rowslot(int, int, int, int, float) const {}
};
struct FUK {
    const Params& p; int aux;
    DEVFN bool swapped(int tag) const { return tag == 1; }
    DEVFN float scale(int, int idx) const { return rstd_slots(p.ssk, idx, NSK, 1.0f / KVR); }
    DEVFN float operator()(int tag, int row, int vc, const float* a, const float* sc) const {
        if (tag == 1) st4(p.VBT + (size_t)row * R + ((vc & ~15) | sperm(vc & 15)), a[0] * sc[0], a[1] * sc[1], a[2] * sc[2], a[3] * sc[3]);
        else st4(p.KNOPE + (size_t)row * W + vc, a[0] * sc[0], a[1] * sc[0], a[2] * sc[0], a[3] * sc[0]);
        return 0.f;
    }
    DEVFN void rowslot(int, int, int, int, float) const {}
};
struct F3 {
    const Params& p; int layer;
    DEVFN bool swapped(int) const { return false; }
    DEVFN float scale(int, int idx) const { return rstd_slots(p.ssx, idx, NSX, 1.0f / D); }
    DEVFN float operator()(int, int row, int vc, const float* a, const float* sc) const {
        const float rs = sc[0];
        if (vc < 3 * W) { bf16_t* o = (vc < W ? p.QSB : vc < 2 * W ? p.OMLA : p.QD) + (size_t)row * W + (vc % W); float ov[4]; ld4(o, ov);
            st4(o, ov[0] * silu_f(a[0] * rs), ov[1] * silu_f(a[1] * rs), ov[2] * silu_f(a[2] * rs), ov[3] * silu_f(a[3] * rs)); }
        else { const int c = vc - 3 * W, b = c / D, cc = c % D; const float* bg = p.b_gate + (size_t)layer * 3 * D + c;
            st4(gptr(p, b, row, cc), sigm_f(a[0] * rs + bg[0]), sigm_f(a[1] * rs + bg[1]), sigm_f(a[2] * rs + bg[2]), sigm_f(a[3] * rs + bg[3])); }
        return 0.f;
    }
    DEVFN void rowslot(int, int, int, int, float) const {}
};
struct F4 {
    const Params& p; int aux;
    DEVFN bool swapped(int) const { return false; }
    DEVFN float scale(int, int) const { return 1.f; }
    DEVFN float operator()(int tag, int row, int c, const float* a, const float*) const {
        float g[4], m[4] = {0.f, 0.f, 0.f, 0.f}; ld4(gptr(p, tag & 3, row, c), g); bf16_t* mp = p.G0 + (size_t)row * D + c; if (tag >> 2) ld4(mp, m);
        st4(mp, m[0] + g[0] * a[0], m[1] + g[1] * a[1], m[2] + g[2] * a[2], m[3] + g[3] * a[3]); return 0.f;
    }
    DEVFN void rowslot(int, int, int, int, float) const {}
};
struct F5 {
    const Params& p; int last;
    DEVFN bool swapped(int) const { return false; }
    DEVFN float scale(int, int) const { return 1.f; }
    DEVFN float operator()(int, int row, int c, const float* a, const float*) const {
        float* x = p.X + (size_t)row * D + c; const float v0 = x[0] + a[0], v1 = x[1] + a[1], v2 = x[2] + a[2], v3 = x[3] + a[3];
        x[0] = v0; x[1] = v1; x[2] = v2; x[3] = v3; if (!last) st4(p.XB + (size_t)row * D + c, v0, v1, v2, v3);
        return (v0 * v0 + v1 * v1) + (v2 * v2 + v3 * v3);
    }
    DEVFN void rowslot(int, int row, int vc0, int fq, float part) const { const float s = quad_sum(part); if (fq == 0) p.ssx[(size_t)row * NSX + (vc0 >> 5)] = s; }
};

#ifdef HOST_EMU
struct dim3e { unsigned x, y, z; };
static dim3e threadIdx, blockIdx, blockDim, gridDim;
#define GLOBAL static
#define LB64
#define LAUNCH(kern, nblk, nthr, ...) do { gridDim.x = (unsigned)(nblk); blockDim.x = (unsigned)(nthr); for (unsigned b_ = 0; b_ < gridDim.x; ++b_) for (unsigned t_ = 0; t_ < blockDim.x; ++t_) { blockIdx.x = b_; threadIdx.x = t_; kern(__VA_ARGS__); } } while (0)
#else
#define GLOBAL __global__
#define LB64 __launch_bounds__(64)
#define LAUNCH(kern, nblk, nthr, ...) kern<<<dim3((unsigned)(nblk)), dim3((unsigned)(nthr)), 0, stream>>>(__VA_ARGS__)
#endif
#define GTID ((long)blockIdx.x * blockDim.x + threadIdx.x)

template <int MAP> GLOBAL void k_prep_w(bf16_t* dst, int N, int K, const float* src, int src_ld, const float* rowscale) {
    const long i = GTID; if (i >= (long)N * K) return;
    const int n = (int)(i % N), k = (int)(i / N);
    int s;
    if (MAP == 0) s = src_w1(n); else if (MAP == 1) s = src_wv(n); else if (MAP == 2) s = src_w3(n); else if (MAP == 3) s = src_uq(n); else if (MAP == 4) s = src_uk(n); else if (MAP == 5) s = src_uv(n); else s = n;
    float v = 0.f; if (s >= 0) v = src[(size_t)k * src_ld + s] * (rowscale ? rowscale[k] : 1.f);
    dst[(size_t)n * K + k] = f2bf(v);
}
GLOBAL void k_tables(Params p) {
    const long i = GTID;
    if (i < NPOS * 16) { const int pos = (int)(i / 16), j = (int)(i % 16); const float inv = (float)pow(500000.0, -(double)(2 * j) / 32.0); const float ang = (float)pos * inv;
        p.cosm[i] = (float)cos((double)ang); p.sinm[i] = (float)sin((double)ang); }
    if (i < NPOS * 8) { const int pos = (int)(i / 8), j = (int)(i % 8); const float inv = (float)pow(500000.0, -(double)(2 * j) / 16.0); const float ang = (float)pos * inv;
        p.cosd[i] = (float)cos((double)ang); p.sind[i] = (float)sin((double)ang); }
    if (i < DEPTH) { const float* lm = p.dlam + i * 4 * 64; float s0 = 0.f, s1 = 0.f; for (int d = 0; d < 64; ++d) { s0 += lm[d] * lm[64 + d]; s1 += lm[128 + d] * lm[192 + d]; }
        p.lamv[i] = expf(s0) - expf(s1) + (0.8f - 0.6f * expf(-0.3f * (float)i)); }
}
GLOBAL void k_init_x(Params p) {
    const long i = GTID; if (i >= (long)R * D) return;
    const int row = (int)(i / D), c = (int)(i % D), b = row / TB, t = row % TB;
    const float v = t < LEAD ? 0.f : t < LEAD + NMETA ? p.meta[(t - LEAD) * D + c] : p.x[((size_t)b * SEQ + (t - LEAD - NMETA)) * D + c];
    p.X[i] = v; p.XB[i] = f2bf(v);
}
GLOBAL void k_x2bf(Params p) { const long i = GTID; if (i >= (long)R * D) return; p.XB2[i] = f2bf(p.X[i]); }
GLOBAL void k_ssq_f32(const float* X, int n, float* slots, int ns) {
    const long row = GTID; if (row >= R) return; float s = 0.f; for (int c = 0; c < n; ++c) { const float v = X[(size_t)row * n + c]; s += v * v; }
    slots[row * ns] = s; for (int i = 1; i < ns; ++i) slots[row * ns + i] = 0.f;
}
GLOBAL void k_ssq_bf(const bf16_t* X, int n, float* slots, int ns) {
    const long row = GTID; if (row >= R) return; float s = 0.f; for (int c = 0; c < n; ++c) { const float v = bf2f(X[(size_t)row * n + c]); s += v * v; }
    slots[row * ns] = s; for (int i = 1; i < ns; ++i) slots[row * ns + i] = 0.f;
}
GLOBAL void k_final(Params p) {
    const long i = GTID; if (i >= (long)NB * SEQ) return;
    const int b = (int)(i / SEQ), s = (int)(i % SEQ); const float* x = p.X + ((size_t)b * TB + LEAD + NMETA + s) * D; float ss = 0.f;
    for (int c = 0; c < D; ++c) ss += x[c] * x[c];
    const float rs = rsq(ss / D + EPS); float* o = p.out + (size_t)i * D;
    for (int c = 0; c < D; ++c) o[c] = x[c] * rs * p.final_g[c];
}

template <class Epi> GLOBAL void k_gemm(const bf16_t* A, int lda, const bf16_t* Bt, int ldb, int M, int N, int K, Params pp, int aux, int tag) {
    const Epi epi{pp, aux};
    const long idx = GTID; const int n4 = N / 4; if (idx >= (long)M * n4) return;
    const int m = (int)(idx / n4), n0 = (int)(idx % n4) * 4;
    float acc[4] = {0.f, 0.f, 0.f, 0.f};
    const bf16_t* a = A + (size_t)m * lda; const bf16_t* b0 = Bt + (size_t)n0 * ldb;
    for (int k = 0; k < K; k += 8) {
        float av[8]; ld8(a + k, av);
#pragma unroll
        for (int i = 0; i < 4; ++i) { float bv[8]; ld8(b0 + (size_t)i * ldb + k, bv); float s = 0.f;
#pragma unroll
            for (int j = 0; j < 8; ++j) s += av[j] * bv[j];
            acc[i] += s; }
    }
    float sc[4]; if (epi.swapped(tag)) { for (int i = 0; i < 4; ++i) sc[i] = epi.scale(tag, n0 + i); } else sc[0] = epi.scale(tag, m);
    epi(tag, m, n0, acc, sc);
}

GLOBAL void LB64 k_attn_sb(Params p) {
    const long i = GTID; if (i >= (long)NB * NH * TB) return;
    const int t = (int)(i % TB), h = (int)((i / TB) % NH), b = (int)(i / ((long)TB * NH));
    const size_t row = (size_t)b * TB + t; bf16_t* qo = p.QSB + row * W + h * 64;
    float q[64], o[64];
#pragma unroll
    for (int d = 0; d < 64; ++d) { q[d] = bf2f(qo[d]); o[d] = 0.f; }
    if (t >= LEAD) {
        float carry = 0.f;
        for (int j = t - 1; j >= LEAD; --j) {
            const size_t kr = (size_t)b * TB + j; const bf16_t* k = p.KSB + kr * W + h * 64; float z = 0.f;
#pragma unroll
            for (int d = 0; d < 64; ++d) z += q[d] * bf2f(k[d]);
            const float sp = fmaxf(z, 0.f) + log2f(1.f + exp2f(-fabsf(z)));
            const float w = exp2f((z - sp) + carry); carry -= sp;
            const bf16_t* vt = p.VSBT + (size_t)(h * 64) * R + ((kr & ~(size_t)15) | sperm((int)(kr & 15)));
#pragma unroll
            for (int d = 0; d < 64; ++d) o[d] += w * bf2f(vt[(size_t)d * R]);
        }
    }
#pragma unroll
    for (int d = 0; d < 64; ++d) qo[d] = f2bf(o[d]);
}
GLOBAL void LB64 k_attn_mla(Params p) {
    const long i = GTID; if (i >= (long)NB * NH * TB) return;
    const int t = (int)(i % TB), h = (int)((i / TB) % NH), b = (int)(i / ((long)TB * NH));
    const size_t row = (size_t)b * TB + t; const bf16_t* qp = p.QB + row * QBW + h * 96;
    float o[64]; float m = -INFINITY, l = 0.f;
#pragma unroll
    for (int d = 0; d < 64; ++d) o[d] = 0.f;
    if (t >= LEAD) {
        const int kend = (t / 64 + 1) * 64 < TB ? (t / 64 + 1) * 64 : TB;
        for (int j = LEAD; j < kend; ++j) {
            const size_t kr = (size_t)b * TB + j; const bf16_t* kn = p.KNOPE + kr * W + h * 64; const bf16_t* kq = p.KR + kr * 32; float s = 0.f;
            for (int d = 0; d < 64; ++d) s += bf2f(qp[d]) * bf2f(kn[d]);
            for (int d = 0; d < 32; ++d) s += bf2f(qp[64 + d]) * bf2f(kq[d]);
            const float mn = fmaxf(m, s), f = exp2f(m - mn), w = exp2f(s - mn); m = mn; l = l * f + w;
            const bf16_t* vt = p.VBT + (size_t)(h * 64) * R + ((kr & ~(size_t)15) | sperm((int)(kr & 15)));
#pragma unroll
            for (int d = 0; d < 64; ++d) o[d] = o[d] * f + w * bf2f(vt[(size_t)d * R]);
        }
    }
    const float il = l > 0.f ? 1.f / l : 0.f; bf16_t* op = p.OMLA + row * W + h * 64;
#pragma unroll
    for (int d = 0; d < 64; ++d) op[d] = f2bf(o[d] * il);
}
GLOBAL void LB64 k_attn_diff(Params p, int layer) {
    const long i = GTID; if (i >= (long)NB * NHD * TB) return;
    const int t = (int)(i % TB), h = (int)((i / TB) % NHD), b = (int)(i / ((long)TB * NHD));
    const size_t row = (size_t)b * TB + t; bf16_t* qo = p.QD + row * W + h * 128;
    const float lam = p.lamv[layer], lam_init = 0.8f - 0.6f * expf(-0.3f * (float)layer);
    float o[128];
#pragma unroll
    for (int d = 0; d < 128; ++d) o[d] = 0.f;
    if (t >= LEAD) {
        const int kend = (t / 64 + 1) * 64 < TB ? (t / 64 + 1) * 64 : TB;
        float m0 = -INFINITY, l0 = 0.f, m1 = -INFINITY, l1 = 0.f;
        for (int j = LEAD; j < kend; ++j) { const bf16_t* k = p.KD + ((size_t)b * TB + j) * W + h * 128; float s0 = 0.f, s1 = 0.f;
            for (int d = 0; d < 64; ++d) { s0 += bf2f(qo[d]) * bf2f(k[d]); s1 += bf2f(qo[64 + d]) * bf2f(k[64 + d]); }
            float mn = fmaxf(m0, s0); l0 = l0 * exp2f(m0 - mn) + exp2f(s0 - mn); m0 = mn; mn = fmaxf(m1, s1); l1 = l1 * exp2f(m1 - mn) + exp2f(s1 - mn); m1 = mn; }
        const float i0 = 1.f / l0, i1 = lam / l1;
        for (int j = LEAD; j < kend; ++j) { const size_t kr = (size_t)b * TB + j; const bf16_t* k = p.KD + kr * W + h * 128; float s0 = 0.f, s1 = 0.f;
            for (int d = 0; d < 64; ++d) { s0 += bf2f(qo[d]) * bf2f(k[d]); s1 += bf2f(qo[64 + d]) * bf2f(k[64 + d]); }
            const float w = exp2f(s0 - m0) * i0 - exp2f(s1 - m1) * i1;
            const bf16_t* vt = p.VDT + (size_t)(h * 128) * R + ((kr & ~(size_t)15) | sperm((int)(kr & 15)));
#pragma unroll
            for (int d = 0; d < 128; ++d) o[d] += w * bf2f(vt[(size_t)d * R]);
        }
    }
    float ss = 0.f;
#pragma unroll
    for (int d = 0; d < 128; ++d) ss += o[d] * o[d];
    const float rs = rsq(ss * (1.f / 128.f) + EPS) * (1.f - lam_init); const float* g = p.dnorm_g + (size_t)layer * 128;
#pragma unroll
    for (int d = 0; d < 128; ++d) qo[d] = f2bf(o[d] * rs * g[d]);
}


#ifndef HOST_EMU
namespace pg8 {
#define PG8_LAS __attribute__((address_space(3)))
typedef short bf16x8 __attribute__((ext_vector_type(8)));
typedef float f32x4 __attribute__((ext_vector_type(4)));
typedef unsigned u32x4 __attribute__((ext_vector_type(4)));
constexpr int BM = 256, BK = 64, HALF = 128, HTB = HALF * BK * 2  , STAGE_BYTES = 8 * HTB, NXCD = 8, WGM = 8;
__host__ __device__ __forceinline__ int lds_byte(int r, int c) { const int st = (r >> 4) * 2 + (c >> 5), rr = r & 15, cc = c & 31, ob = rr * 64 + cc * 2; return st * 1024 + (ob ^ (((ob >> 9) & 1) << 5)); }
__host__ __device__ __forceinline__ void stage_rc(int b, int& R, int& C) { const int st = b / 1024, sb = b % 1024, swz = sb ^ (((sb >> 9) & 1) << 5); R = (st >> 1) * 16 + swz / 64; C = (st & 1) * 32 + (swz % 64) / 2; }
__host__ __device__ __forceinline__ int perm32(int rho) { const int n = rho >> 4, i = rho & 15; return 8 * (i >> 2) + 4 * n + (i & 3); }
struct Unit { int pm, pn, tag; const char* A; const char* B; };
struct Gemm { int K, lda, ldb; };
__device__ __forceinline__ void order_map(int L, int nM, int nN, int& pm, int& pn) {
    const int nwg = nM * nN; int wgid = L; { const int q = nwg / NXCD, r = nwg % NXCD, xcd = wgid % NXCD, off = wgid / NXCD; wgid = (xcd < r ? xcd * (q + 1) : r * (q + 1) + (xcd - r) * q) + off; }
    const int nig = WGM * nN, gid = wgid / nig, fm = gid * WGM, gsz = (nM - fm) < WGM ? (nM - fm) : WGM;
    pm = fm + ((wgid % nig) % gsz); pn = (wgid % nig) / gsz;
}
template <class F> struct EpiAd {
    static constexpr bool PERM = true, AFTER_DRAIN = false;
    F f;
    __device__ __forceinline__ void operator()(const f32x4 (&acc)[2][2][4][2], const Unit& u, int wr, int wc, int fr, int fq, PG8_LAS unsigned char* scr, int tid) const {
        PG8_LAS float* rs = (PG8_LAS float*)scr;
        const bool sw = f.swapped(u.tag);
        if (tid < 256) rs[tid] = f.scale(u.tag, (sw ? u.pn : u.pm) * BM + tid);
        asm volatile("s_waitcnt lgkmcnt(0)" ::: "memory"); __builtin_amdgcn_s_barrier(); asm volatile("" ::: "memory");
#pragma unroll
        for (int ai = 0; ai < 2; ++ai)
#pragma unroll
            for (int m = 0; m < 4; ++m) { int rl = ai * HALF + wr * 64 + m * 16 + fr; asm volatile("" : "+v"(rl)); const int row = u.pm * BM + rl;
#pragma unroll
                for (int bj = 0; bj < 2; ++bj) { float part = 0.f;
#pragma unroll
                    for (int n = 0; n < 2; ++n) { const int cl = bj * HALF + wc * 32 + 8 * fq + 4 * n; const f32x4 v = acc[ai][bj][m][n]; const float a4[4] = {v[0], v[1], v[2], v[3]};
                        float sc[4]; if (sw) { sc[0] = rs[cl]; sc[1] = rs[cl + 1]; sc[2] = rs[cl + 2]; sc[3] = rs[cl + 3]; } else { sc[0] = rs[rl]; sc[1] = sc[2] = sc[3] = 0.f; }
                        part += f(u.tag, row, u.pn * BM + cl, a4, sc); }
                    f.rowslot(u.tag, row, u.pn * BM + bj * HALF + wc * 32, fq, part); asm volatile("" ::: "memory"); } }
    }
};
template <class Epi, class Sched, bool ALIGN_EPI = false, bool SP2 = false>
__device__ __forceinline__ void gemm_phase(PG8_LAS unsigned char* lds, const Gemm g, const Sched& S, const Epi& E) {
    int tid_ = threadIdx.x; asm volatile("" : "+v"(tid_));
    const int tid = tid_, wid = __builtin_amdgcn_readfirstlane(tid >> 6), lane = tid & 63, wr = wid >> 2, wc = wid & 3, fr = lane & 15, fq = lane >> 4;
    const int K = g.K, nt = K / BK, lda = g.lda, ldb = g.ldb;
    unsigned voffA[2], voffB[2];
#pragma unroll
    for (int i = 0; i < 2; ++i) { int R, C; stage_rc(tid * 16 + i * 8192, R, C); const int Rb = Epi::PERM ? ((R & ~31) + perm32(R & 31)) : R;
        voffA[i] = (unsigned)(R * lda + C) * 2u; voffB[i] = (unsigned)(Rb * ldb + C) * 2u; }
    const size_t kstep = (size_t)(BK * 2);
    const size_t hstepA = (size_t)HALF * lda * 2, hstepB = (size_t)HALF * ldb * 2;
    const size_t tstepA = 2 * hstepA, tstepB = 2 * hstepB;
    const unsigned ldsw = (unsigned)wid * 1024u;
    const int aoff = lds_byte(wr * 64 + fr, fq * 8), boff = lds_byte(wc * 32 + fr, fq * 8);
#define PG8_SA(b, h) (((b) * 2 + (h)) * HTB)
#define PG8_SB(b, h) ((4 + (b) * 2 + (h)) * HTB)
#define PG8_STAGE(bufoff, gbase, voff) do { _Pragma("unroll") for (int _i = 0; _i < 2; ++_i) \
        __builtin_amdgcn_global_load_lds((const unsigned*)((const char*)(gbase) + (voff)[_i]), (PG8_LAS unsigned*)(lds + (bufoff) + ldsw + _i * 8192), 16, 0, 0); } while (0)
#define PG8_LDA(dst, b, h) do { _Pragma("unroll") for (int m = 0; m < 4; ++m) _Pragma("unroll") for (int k = 0; k < 2; ++k) dst[m][k] = *(const PG8_LAS bf16x8*)(lds + PG8_SA(b, h) + aoff + m * 2048 + k * 1024); } while (0)
#define PG8_LDB(dst, b, h) do { _Pragma("unroll") for (int n = 0; n < 2; ++n) _Pragma("unroll") for (int k = 0; k < 2; ++k) dst[n][k] = *(const PG8_LAS bf16x8*)(lds + PG8_SB(b, h) + boff + n * 2048 + k * 1024); } while (0)
#define PG8_MMA(ai, bj, At, Bt) do { __builtin_amdgcn_s_setprio(1); _Pragma("unroll") for (int m = 0; m < 4; ++m) _Pragma("unroll") for (int n = 0; n < 2; ++n) _Pragma("unroll") for (int k = 0; k < 2; ++k) \
        acc[ai][bj][m][n] = __builtin_amdgcn_mfma_f32_16x16x32_bf16(Bt[n][k], At[m][k], acc[ai][bj][m][n], 0, 0, 0); __builtin_amdgcn_s_setprio(0); } while (0)
#define PG8_WAIT_V(n) asm volatile("s_waitcnt vmcnt(" #n ")" ::: "memory")
#define PG8_WAIT_L(n) asm volatile("s_waitcnt lgkmcnt(" #n ")" ::: "memory")
#define PG8_BAR __builtin_amdgcn_s_barrier()
#define PG8_SCHED __builtin_amdgcn_sched_barrier(0)
    Unit cur, nxt; int ui = 0;
    if (!S.next(0, cur)) return;
    f32x4 acc[2][2][4][2];
#pragma unroll
    for (int a = 0; a < 2; ++a)
#pragma unroll
        for (int b = 0; b < 2; ++b)
#pragma unroll
            for (int m = 0; m < 4; ++m)
#pragma unroll
                for (int n = 0; n < 2; ++n) acc[a][b][m][n] = (f32x4){0.f, 0.f, 0.f, 0.f};
    bf16x8 At[4][2], B0[2][2], B1[2][2];
    const char* cA = cur.A + (size_t)cur.pm * tstepA; const char* cB = cur.B + (size_t)cur.pn * tstepB;
    S.a_ready(cur);
    if constexpr (SP2) {
        PG8_STAGE(PG8_SB(0, 0), cB, voffB); PG8_STAGE(PG8_SB(0, 1), cB + hstepB, voffB); PG8_STAGE(PG8_SA(0, 0), cA, voffA); PG8_STAGE(PG8_SA(0, 1), cA + hstepA, voffA);
        if (wr == 1) PG8_BAR;
        PG8_WAIT_V(2); PG8_BAR;
        PG8_STAGE(PG8_SB(1, 0), cB + kstep, voffB); PG8_STAGE(PG8_SA(1, 0), cA + kstep, voffA); PG8_STAGE(PG8_SB(1, 1), cB + hstepB + kstep, voffB);
        PG8_WAIT_V(6); PG8_BAR;
    } else {
        PG8_STAGE(PG8_SB(0, 0), cB, voffB); PG8_STAGE(PG8_SA(0, 0), cA, voffA); PG8_STAGE(PG8_SB(0, 1), cB + hstepB, voffB); PG8_STAGE(PG8_SA(0, 1), cA + hstepA, voffA);
        if (wr == 1) PG8_BAR;
        PG8_WAIT_V(4); PG8_BAR;
        PG8_STAGE(PG8_SB(1, 0), cB + kstep, voffB); PG8_STAGE(PG8_SA(1, 0), cA + kstep, voffA); PG8_STAGE(PG8_SB(1, 1), cB + hstepB + kstep, voffB);
        PG8_WAIT_V(6); PG8_BAR;
    }
    for (;;) {
        const bool has_next = S.next(ui + 1, nxt);
        const char* nA = has_next ? nxt.A + (size_t)nxt.pm * tstepA : cA; const char* nB = has_next ? nxt.B + (size_t)nxt.pn * tstepB : cB;
#pragma nounroll
        for (int t = 0; t < nt; t += 2) {
            const bool last = (t == nt - 2);
            const char* a1 = cA + (size_t)(t + 1) * kstep;
            const char* a2 = last ? nA : cA + (size_t)(t + 2) * kstep; const char* b2 = last ? nB : cB + (size_t)(t + 2) * kstep;
            const char* a3 = a2 + kstep; const char* b3 = b2 + kstep;
            if (last && has_next) S.a_ready(nxt);
            if constexpr (SP2) {
            PG8_LDB(B0, 0, 0); PG8_LDB(B1, 0, 1); PG8_SCHED; PG8_LDA(At, 0, 0); PG8_STAGE(PG8_SA(1, 1), a1 + hstepA, voffA);
            PG8_WAIT_V(8); PG8_WAIT_L(0); PG8_BAR; PG8_MMA(0, 0, At, B0); PG8_MMA(0, 1, At, B1); PG8_BAR; PG8_SCHED;
            PG8_LDA(At, 0, 1); PG8_STAGE(PG8_SB(0, 0), b2, voffB); PG8_STAGE(PG8_SB(0, 1), b2 + hstepB, voffB); PG8_STAGE(PG8_SA(0, 0), a2, voffA);
            PG8_WAIT_V(8); PG8_WAIT_L(0); PG8_BAR; PG8_MMA(1, 0, At, B0); PG8_MMA(1, 1, At, B1); PG8_BAR; PG8_SCHED;
            PG8_LDB(B0, 1, 0); PG8_LDB(B1, 1, 1); PG8_SCHED; PG8_LDA(At, 1, 0); PG8_STAGE(PG8_SA(0, 1), a2 + hstepA, voffA);
            PG8_WAIT_V(8); PG8_WAIT_L(0); PG8_BAR; PG8_MMA(0, 0, At, B0); PG8_MMA(0, 1, At, B1); PG8_BAR; PG8_SCHED;
            PG8_LDA(At, 1, 1); PG8_STAGE(PG8_SB(1, 0), b3, voffB); PG8_STAGE(PG8_SB(1, 1), b3 + hstepB, voffB); PG8_STAGE(PG8_SA(1, 0), a3, voffA);
            PG8_WAIT_V(8); PG8_WAIT_L(0); PG8_BAR; PG8_MMA(1, 0, At, B0); PG8_MMA(1, 1, At, B1); PG8_BAR; PG8_SCHED;
            } else {
            PG8_LDB(B0, 0, 0); PG8_SCHED; PG8_LDA(At, 0, 0); PG8_STAGE(PG8_SA(1, 1), a1 + hstepA, voffA);
            PG8_WAIT_L(8); PG8_BAR; PG8_WAIT_L(0); PG8_MMA(0, 0, At, B0); PG8_BAR; PG8_SCHED;
            PG8_LDB(B1, 0, 1); PG8_STAGE(PG8_SB(0, 0), b2, voffB);
            PG8_BAR; PG8_WAIT_L(0); PG8_MMA(0, 1, At, B1); PG8_BAR;
            PG8_LDA(At, 0, 1); PG8_STAGE(PG8_SA(0, 0), a2, voffA);
            PG8_BAR; PG8_WAIT_L(0); PG8_MMA(1, 0, At, B0); PG8_BAR; PG8_SCHED;
            PG8_STAGE(PG8_SB(0, 1), b2 + hstepB, voffB);
            PG8_WAIT_V(6); PG8_BAR; PG8_MMA(1, 1, At, B1); PG8_BAR;
            PG8_LDB(B0, 1, 0); PG8_SCHED; PG8_LDA(At, 1, 0); PG8_STAGE(PG8_SA(0, 1), a2 + hstepA, voffA);
            PG8_WAIT_L(8); PG8_BAR; PG8_WAIT_L(0); PG8_MMA(0, 0, At, B0); PG8_BAR; PG8_SCHED;
            PG8_LDB(B1, 1, 1); PG8_STAGE(PG8_SB(1, 0), b3, voffB);
            PG8_BAR; PG8_WAIT_L(0); PG8_MMA(0, 1, At, B1); PG8_BAR;
            PG8_LDA(At, 1, 1); PG8_STAGE(PG8_SA(1, 0), a3, voffA);
            PG8_BAR; PG8_WAIT_L(0); PG8_MMA(1, 0, At, B0); PG8_BAR; PG8_SCHED;
            PG8_STAGE(PG8_SB(1, 1), b3 + hstepB, voffB);
            PG8_WAIT_V(6); PG8_BAR; PG8_MMA(1, 1, At, B1); PG8_BAR;
            }
        }
        if constexpr (ALIGN_EPI) { if (wr == 0) PG8_BAR; }
        if constexpr (!Epi::AFTER_DRAIN) { E(acc, cur, wr, wc, fr, fq, lds + STAGE_BYTES, tid); S.done(cur); }
        if (!has_next) break;
#pragma unroll
        for (int a = 0; a < 2; ++a)
#pragma unroll
            for (int b = 0; b < 2; ++b)
#pragma unroll
                for (int m = 0; m < 4; ++m)
#pragma unroll
                    for (int n = 0; n < 2; ++n) acc[a][b][m][n] = (f32x4){0.f, 0.f, 0.f, 0.f};
        cur = nxt; cA = nA; cB = nB; ++ui;
        if constexpr (ALIGN_EPI) { if (wr == 1) PG8_BAR; }
    }
    PG8_WAIT_V(0);
    if constexpr (!ALIGN_EPI) { if (wr == 0) PG8_BAR; }
    PG8_BAR;
    if constexpr (Epi::AFTER_DRAIN) { E.fused(acc, cur, wr, wc, fr, fq, lds, wid, lane); S.done(cur); }
#undef PG8_SA
#undef PG8_SB
#undef PG8_STAGE
#undef PG8_LDA
#undef PG8_LDB
#undef PG8_MMA
#undef PG8_WAIT_V
#undef PG8_WAIT_L
#undef PG8_BAR
#undef PG8_SCHED
}

}

struct SchedGrid {
    int nM, nN, G, c, tag; const char* A; const char* B;
    __device__ __forceinline__ bool next(int i, pg8::Unit& u) const { const long L = (long)i * G + c; if (L >= (long)nM * nN) return false; pg8::order_map((int)L, nM, nN, u.pm, u.pn); u.tag = tag; u.A = A; u.B = B; return true; }
    __device__ __forceinline__ void a_ready(const pg8::Unit&) const {}
    __device__ __forceinline__ void done(const pg8::Unit&) const {}
};
struct SchedTwo {
    int nM0, nN0, nM1, nN1, G, c; const char *A0, *B0, *A1, *B1;
    __device__ __forceinline__ bool next(int i, pg8::Unit& u) const { long L = (long)i * G + c; const long n0 = (long)nM0 * nN0;
        if (L < n0) { pg8::order_map((int)L, nM0, nN0, u.pm, u.pn); u.tag = 0; u.A = A0; u.B = B0; return true; }
        L -= n0; if (L >= (long)nM1 * nN1) return false; pg8::order_map((int)L, nM1, nN1, u.pm, u.pn); u.tag = 1; u.A = A1; u.B = B1; return true; }
    __device__ __forceinline__ void a_ready(const pg8::Unit&) const {}
    __device__ __forceinline__ void done(const pg8::Unit&) const {}
};
struct SchedP4 {
    int nM, nN, G, c; const char* A0; size_t astride; const char* B0; size_t bstride;
    __device__ __forceinline__ bool next(int i, pg8::Unit& u) const { const int j = i % 3, b = (2 * j) % 3; const long L = (long)(i / 3) * G + c; if (L >= (long)nM * nN) return false;
        pg8::order_map((int)L, nM, nN, u.pm, u.pn); u.tag = b + (j > 0 ? 4 : 0); u.A = A0 + (size_t)j * astride; u.B = B0 + (size_t)b * bstride; return true; }
    __device__ __forceinline__ void a_ready(const pg8::Unit&) const {}
    __device__ __forceinline__ void done(const pg8::Unit&) const {}
};
constexpr int LDS_SCR = pg8::STAGE_BYTES, LDS_BYTES = 147456;
#define LASP __attribute__((address_space(3)))
enum { PK_P1 = 0, PK_P2 = 1, PK_P3 = 2, PK_P3B = 3, PK_P4 = 4, PK_P5 = 5 };
__device__ __forceinline__ void gemm_part(const Params& p, LASP unsigned char* lds, int kind, int l, int G, int c) {
    constexpr int nR = R / 256;
    if (kind == PK_P1) {
        SchedTwo S{nR, N1 / 256, 2 * W / 256, nR, G, c, (const char*)p.XB, (const char*)wptr(p, l, WL_W1), (const char*)wptr(p, l, WL_WV), (const char*)p.XB};
        pg8::EpiAd<F1> E{F1{p, 0}}; pg8::gemm_phase<pg8::EpiAd<F1>, SchedTwo, true, true>(lds, pg8::Gemm{D, D, D}, S, E);
    } else if (kind == PK_P2) {
        { SchedGrid S{nR, QBW / 256, G, c, 0, (const char*)p.CQ, (const char*)wptr(p, l, WL_UQ)};
          pg8::EpiAd<FUQ> E{FUQ{p, 0}}; pg8::gemm_phase<pg8::EpiAd<FUQ>, SchedGrid, true, true>(lds, pg8::Gemm{QR, QR, QR}, S, E); }
        { SchedTwo S{nR, W / 256, W / 256, nR, G, c, (const char*)p.CKV, (const char*)wptr(p, l, WL_UK), (const char*)wptr(p, l, WL_UV), (const char*)p.CKV};
          pg8::EpiAd<FUK> E{FUK{p, 0}}; pg8::gemm_phase<pg8::EpiAd<FUK>, SchedTwo, true, true>(lds, pg8::Gemm{KVR, KVR, KVR}, S, E); }
    } else if (kind == PK_P3B) {
        SchedGrid S{nR, N3 / 256, G, c, 0, (const char*)p.XB2, (const char*)wptr(p, l, WL_W3)};
        pg8::EpiAd<F3> E{F3{p, l}}; pg8::gemm_phase<pg8::EpiAd<F3>, SchedGrid, true, true>(lds, pg8::Gemm{D, D, D}, S, E);
    } else if (kind == PK_P4) {
        SchedP4 S{nR, D / 256, G, c, (const char*)p.QSB, (size_t)((const char*)p.QD - (const char*)p.QSB), (const char*)wptr(p, l, WL_WO), (size_t)D * W * 2};
        pg8::EpiAd<F4> E{F4{p, 0}}; pg8::gemm_phase<pg8::EpiAd<F4>, SchedP4, true, true>(lds, pg8::Gemm{W, W, W}, S, E);
    } else if (kind == PK_P5) {
        SchedGrid S{nR, D / 256, G, c, 0, (const char*)p.G0, (const char*)wptr(p, l, WL_OUT)};
        pg8::EpiAd<F5> E{F5{p, l == DEPTH - 1 ? 1 : 0}}; pg8::gemm_phase<pg8::EpiAd<F5>, SchedGrid, true, true>(lds, pg8::Gemm{D, D, D}, S, E);
    }
}
template <int KIND> __global__ void __launch_bounds__(512, 2) k_gemm_fast(Params p, int l) {
    extern __shared__ __attribute__((aligned(16))) unsigned char lds_raw[];
    gemm_part(p, (LASP unsigned char*)lds_raw, KIND, l, (int)gridDim.x, (int)blockIdx.x);
}
template __global__ void k_gemm_fast<PK_P1>(Params, int);
template __global__ void k_gemm_fast<PK_P2>(Params, int);
template __global__ void k_gemm_fast<PK_P3B>(Params, int);
template __global__ void k_gemm_fast<PK_P4>(Params, int);
template __global__ void k_gemm_fast<PK_P5>(Params, int);

namespace att {
typedef short bf16x8 __attribute__((ext_vector_type(8)));
typedef float f32x16 __attribute__((ext_vector_type(16)));
typedef unsigned u32x4v __attribute__((ext_vector_type(4)));
__device__ __forceinline__ int crow(int r, int h) { return (r & 3) + 8 * (r >> 2) + 4 * h; }
__device__ __forceinline__ bf16x8 ldg8(const bf16_t* p) { return *(const bf16x8*)p; }
__device__ __forceinline__ void halves(float x, float& lo, float& hi) { auto r = __builtin_amdgcn_permlane32_swap(__float_as_uint(x), __float_as_uint(x), false, false); lo = __uint_as_float(r[0]); hi = __uint_as_float(r[1]); }
__device__ __forceinline__ bf16x8 pack8(const f32x16& v, int b) { u32x4v w; w.x = pk2(v[b], v[b + 1]); w.y = pk2(v[b + 2], v[b + 3]); w.z = pk2(v[b + 4], v[b + 5]); w.w = pk2(v[b + 6], v[b + 7]); return __builtin_bit_cast(bf16x8, w); }
constexpr float SB_DEAD = -152.0f;
#define ATT_FENCE() asm volatile("" ::: "memory")
template <int NQB, int NKS, int NKSA, int NDB, bool SBM>
__device__ __forceinline__ void attn_wave(const bf16_t* qptr, int ldq, const bf16_t* kA, int ldkA, const bf16_t* kB, int ldkB, const bf16_t* vt, int c, int qoff,
                                          f32x16 (&o)[NDB][NQB], float (&mrun)[NQB], float (&lrun)[NQB]) {
    int lane_ = (int)__builtin_amdgcn_mbcnt_hi(~0u, __builtin_amdgcn_mbcnt_lo(~0u, 0u)); asm volatile("" : "+v"(lane_));
    const int lane = lane_, cl = lane & 31, h = lane >> 5;
    constexpr int NG = NKS;
    bf16x8 qf[NQB][NKS];
#pragma unroll
    for (int qb = 0; qb < NQB; ++qb)
#pragma unroll
        for (int ks = 0; ks < NKS; ++ks) qf[qb][ks] = ldg8(qptr + (size_t)(qoff + qb * 32 + cl) * ldq + 16 * ks + 8 * h);
#pragma unroll
    for (int qb = 0; qb < NQB; ++qb) { mrun[qb] = -INFINITY; lrun[qb] = 0.f;
#pragma unroll
        for (int d = 0; d < NDB; ++d)
#pragma unroll
            for (int r = 0; r < 16; ++r) o[d][qb][r] = 0.f; }
    float carry[NQB];
#pragma unroll
    for (int qb = 0; qb < NQB; ++qb) carry[qb] = 0.f;
#define ATT_LDK(dst, kt_, g_) do { _Pragma("unroll") for (int j_ = 0; j_ < 2; ++j_) { const int ks_ = (g_); const size_t kr_ = (size_t)((kt_) * 64 + j_ * 32 + cl); \
        dst[j_] = ks_ < NKSA ? ldg8(kA + kr_ * ldkA + 16 * ks_ + 8 * h) : ldg8(kB + kr_ * ldkB + 16 * (ks_ - NKSA) + 8 * h); } } while (0)
#define ATT_LDV(dst, kt_, j_) do { _Pragma("unroll") for (int d_ = 0; d_ < NDB; ++d_) dst[d_] = ldg8(vt + (size_t)(d_ * 32 + cl) * R + (kt_) * 64 + (j_) * 16 + 8 * h); } while (0)
    bf16x8 kf0[2], kf1[2], vf0[NDB], vf1[NDB];
    ATT_LDK(kf0, (SBM ? c : 0), 0); ATT_FENCE();
    for (int it = 0; it <= c; ++it) {
        const int kt = SBM ? c - it : it; const int ktn = it < c ? (SBM ? kt - 1 : kt + 1) : kt;
        f32x16 s[2][NQB];
#pragma unroll
        for (int kb = 0; kb < 2; ++kb)
#pragma unroll
            for (int qb = 0; qb < NQB; ++qb)
#pragma unroll
                for (int r = 0; r < 16; ++r) s[kb][qb][r] = 0.f;
#pragma unroll
        for (int g = 0; g < NG; ++g) {
            if (g + 1 < NG) { if (g & 1) ATT_LDK(kf0, kt, g + 1); else ATT_LDK(kf1, kt, g + 1); } else ATT_LDV(vf0, kt, 0);
            ATT_FENCE();
#pragma unroll
            for (int j = 0; j < 2; ++j)
#pragma unroll
                for (int qb = 0; qb < NQB; ++qb) s[j][qb] = __builtin_amdgcn_mfma_f32_32x32x16_bf16((g & 1) ? kf1[j] : kf0[j], qf[qb][g], s[j][qb], 0, 0, 0);
        }
        if (!SBM) {
            if (kt == 0) {
#pragma unroll
                for (int qb = 0; qb < NQB; ++qb) {
#pragma unroll
                    for (int r = 0; r < 16; ++r) s[0][qb][r] = -INFINITY;
#pragma unroll
                    for (int r = 0; r < 8; ++r) s[1][qb][r] = -INFINITY; } }
#pragma unroll
            for (int qb = 0; qb < NQB; ++qb) {
                float mx = s[0][qb][0];
#pragma unroll
                for (int r = 1; r < 16; ++r) mx = fmaxf(mx, s[0][qb][r]);
#pragma unroll
                for (int r = 0; r < 16; ++r) mx = fmaxf(mx, s[1][qb][r]);
                float m0, m1; halves(mx, m0, m1); const float mn = fmaxf(mrun[qb], fmaxf(m0, m1)); const float f = __builtin_amdgcn_exp2f(mrun[qb] - mn); mrun[qb] = mn;
                float ps = 0.f;
#pragma unroll
                for (int kb = 0; kb < 2; ++kb)
#pragma unroll
                    for (int r = 0; r < 16; ++r) { const float pv = __builtin_amdgcn_exp2f(s[kb][qb][r] - mn); s[kb][qb][r] = pv; ps += pv; }
                lrun[qb] = lrun[qb] * f + ps;
#pragma unroll
                for (int d = 0; d < NDB; ++d)
#pragma unroll
                    for (int r = 0; r < 16; ++r) o[d][qb][r] *= f;
            }
        } else {
#pragma unroll
            for (int qb = 0; qb < NQB; ++qb) {
                float run = carry[qb];
#pragma unroll
                for (int kb = 1; kb >= 0; --kb)
#pragma unroll
                    for (int rg = 3; rg >= 0; --rg) {
                        const bool lead = (kt == 0) && (kb == 0 || rg < 2);
                        float y[4], sp[4]; bool ok[4];
#pragma unroll
                        for (int e = 0; e < 4; ++e) { y[e] = s[kb][qb][4 * rg + e]; ok[e] = !lead && !(kt == c && (kb * 32 + 8 * rg + 4 * h + e >= qb * 32 + cl));
                            sp[e] = ok[e] ? fmaxf(y[e], 0.f) + __builtin_amdgcn_logf(1.0f + __builtin_amdgcn_exp2f(-fabsf(y[e]))) : 0.f; }
                        const float gs = -((sp[0] + sp[1]) + (sp[2] + sp[3])); float g0, g1; halves(gs, g0, g1);
                        const float t1 = run; run += g1; const float t0 = run; run += g0; float a = h ? t1 : t0;
#pragma unroll
                        for (int e = 3; e >= 0; --e) { const float w = ok[e] ? __builtin_amdgcn_exp2f((y[e] - sp[e]) + a) : 0.f; a -= sp[e]; s[kb][qb][4 * rg + e] = w; } }
                carry[qb] = run;
            }
        }
        ATT_FENCE();
#pragma unroll
        for (int j = 0; j < 4; ++j) {
            if (j + 1 < 4) { if (j & 1) ATT_LDV(vf0, kt, j + 1); else ATT_LDV(vf1, kt, j + 1); } else ATT_LDK(kf0, ktn, 0);
            ATT_FENCE();
            bf16x8 pf[NQB];
#pragma unroll
            for (int qb = 0; qb < NQB; ++qb) pf[qb] = pack8(s[j >> 1][qb], 8 * (j & 1));
#pragma unroll
            for (int d = 0; d < NDB; ++d)
#pragma unroll
                for (int qb = 0; qb < NQB; ++qb) o[d][qb] = __builtin_amdgcn_mfma_f32_32x32x16_bf16((j & 1) ? vf1[d] : vf0[d], pf[qb], o[d][qb], 0, 0, 0);
        }
        if (SBM) { bool dead = true;
#pragma unroll
            for (int qb = 0; qb < NQB; ++qb) dead = dead && (carry[qb] < SB_DEAD);
            if (__all(dead)) break; }
    }
#undef ATT_LDK
#undef ATT_LDV
}
template <int NQB, int NDB> __device__ __forceinline__ void store_ot(bf16_t* optr, int ldo, const f32x16 (&o)[NDB][NQB], const float (&sc)[NQB]) {
    int lane_ = (int)__builtin_amdgcn_mbcnt_hi(~0u, __builtin_amdgcn_mbcnt_lo(~0u, 0u)); asm volatile("" : "+v"(lane_)); const int lane = lane_, cl = lane & 31, h = lane >> 5;
#pragma unroll
    for (int qb = 0; qb < NQB; ++qb)
#pragma unroll
        for (int d = 0; d < NDB; ++d)
#pragma unroll
            for (int rg = 0; rg < 4; ++rg) st4(optr + (size_t)(qb * 32 + cl) * ldo + d * 32 + 8 * rg + 4 * h, o[d][qb][4 * rg] * sc[qb], o[d][qb][4 * rg + 1] * sc[qb], o[d][qb][4 * rg + 2] * sc[qb], o[d][qb][4 * rg + 3] * sc[qb]);
}
__device__ __forceinline__ void unit_sb(const Params& p, int wid, int b, int c) {
    const size_t r0 = (size_t)b * TB;
    f32x16 o[2][2]; float m[2], l[2];
    bf16_t* q = p.QSB + (r0 + c * 64) * W + wid * 64;
    attn_wave<2, 4, 4, 2, true>(q, W, p.KSB + r0 * W + wid * 64, W, nullptr, 0, p.VSBT + (size_t)(wid * 64) * R + r0, c, 0, o, m, l);
    const float one[2] = {1.f, 1.f}; store_ot<2, 2>(q, W, o, one);
}
__device__ __forceinline__ void unit_mla(const Params& p, int wid, int b, int c) {
    const size_t r0 = (size_t)b * TB;
    f32x16 o[2][2]; float m[2], l[2];
    attn_wave<2, 6, 4, 2, false>(p.QB + (r0 + c * 64) * QBW + wid * 96, QBW, p.KNOPE + r0 * W + wid * 64, W, p.KR + r0 * 32, 32, p.VBT + (size_t)(wid * 64) * R + r0, c, 0, o, m, l);
    float il[2];
#pragma unroll
    for (int qb = 0; qb < 2; ++qb) { float l0, l1; halves(l[qb], l0, l1); il[qb] = 1.0f / (l0 + l1); }
    store_ot<2, 2>(p.OMLA + (r0 + c * 64) * W + wid * 64, W, o, il);
}
__device__ __forceinline__ void unit_diff(const Params& p, int wid, int layer, int b, int c, int hp, LASP unsigned char* lds) {
    int lane_ = (int)__builtin_amdgcn_mbcnt_hi(~0u, __builtin_amdgcn_mbcnt_lo(~0u, 0u)); asm volatile("" : "+v"(lane_)); const int lane = lane_, g = wid >> 2, mp = (wid >> 1) & 1, qh = wid & 1, head = hp * 2 + g; const size_t r0 = (size_t)b * TB;
    f32x16 o[4][1]; float m[1], l[1];
    const bf16_t* q = p.QD + (r0 + c * 64) * W + head * 128 + mp * 64;
    attn_wave<1, 4, 4, 4, false>(q, W, p.KD + r0 * W + head * 128 + mp * 64, W, nullptr, 0, p.VDT + (size_t)(head * 128) * R + r0, c, qh * 32, o, m, l);
    float l0, l1; halves(l[0], l0, l1); const float il = 1.0f / (l0 + l1);
    { LASP float* reg = (LASP float*)(lds + wid * 16384); const int cl = lane & 31, h = lane >> 5;
#pragma unroll
      for (int d = 0; d < 4; ++d)
#pragma unroll
          for (int r = 0; r < 16; ++r) reg[cl * 128 + ((d * 32 + crow(r, h)) ^ cl)] = o[d][0][r] * il; }
    asm volatile("s_waitcnt lgkmcnt(0)" ::: "memory"); __builtin_amdgcn_s_barrier(); asm volatile("" ::: "memory");
    { const float lam = p.lamv[layer], lam_init = __uint_as_float(__builtin_amdgcn_readfirstlane(layer == 0 ? 0x3e4ccccdu : 0x3eb60549u));
      const LASP float* r0p = (const LASP float*)(lds + ((g * 2 + 0) * 2 + qh) * 16384); const LASP float* r1p = (const LASP float*)(lds + ((g * 2 + 1) * 2 + qh) * 16384);
      const int ql = mp * 16 + (lane >> 2), part = lane & 3; float v[32]; float ss = 0.f;
#pragma unroll
      for (int i = 0; i < 32; ++i) { const int ii = (i + 8 * part) & 31; const int a = ql * 128 + ((part * 32 + ii) ^ ql); v[i] = r0p[a] - lam * r1p[a]; ss += v[i] * v[i]; }
      ss += __shfl_xor(ss, 1); ss += __shfl_xor(ss, 2);
      const float rs = rsq(ss * (1.0f / 128.0f) + EPS) * (1.0f - lam_init); const float* gn = p.dnorm_g + (size_t)layer * 128 + part * 32;
      bf16_t* op = p.QD + (r0 + c * 64 + qh * 32 + ql) * W + head * 128 + part * 32;
#pragma unroll
      for (int i = 0; i < 32; i += 2) { const int ii = (i + 8 * part) & 31;
          st2(op + ii, v[i] * rs * gn[ii], v[i + 1] * rs * gn[ii + 1]); } }
}
enum { AK_P2 = 0, AK_P3 = 1 };
__device__ __forceinline__ void attn_part(const Params& p, LASP unsigned char* lds, int kind, int layer) {
    const int wid = __builtin_amdgcn_readfirstlane((int)threadIdx.x >> 6); const bool leader = threadIdx.x == 0;
    volatile LASP int* slot = (volatile LASP int*)(lds + LDS_SCR + 2048);
    unsigned* ctr = p.ctl + 1024 + 64 * (layer * 2 + kind);
    constexpr int NT = TB / 64;
    const int nitems = kind == AK_P2 ? NB * NT * (NHD / 2) + NB * NT : NB * NT;
    for (int n = 0;; ++n) {
        if (leader) slot[n & 1] = (int)atomicAdd(ctr, 1u);
        asm volatile("s_waitcnt vmcnt(0) lgkmcnt(0)" ::: "memory"); __builtin_amdgcn_s_barrier(); asm volatile("" ::: "memory");
        const int item = __builtin_amdgcn_readfirstlane(slot[n & 1]);
        if (item >= nitems) break;
        if (kind == AK_P2) {
            constexpr int ND = NB * (NHD / 2);
            if (item < ND * NT) { const int c = NT - 1 - item / ND, j = item % ND; unit_diff(p, wid, layer, j / (NHD / 2), c, j % (NHD / 2), lds); }
            else { const int j = item - ND * NT; unit_sb(p, wid, j % NB, NT - 1 - j / NB); }
        } else unit_mla(p, wid, item % NB, NT - 1 - item / NB);
    }
}
}
template <int KIND> __global__ void __launch_bounds__(512, 2) k_attn_fast(Params p, int l) {
    extern __shared__ __attribute__((aligned(16))) unsigned char lds_raw[];
    att::attn_part(p, (LASP unsigned char*)lds_raw, KIND, l);
}
template __global__ void k_attn_fast<att::AK_P2>(Params, int);
template __global__ void k_attn_fast<att::AK_P3>(Params, int);
#endif

#ifdef HOST_EMU
typedef int hipStream_t;
#endif
#define NBLK(n, t) (((long)(n) + (t) - 1) / (t))
#ifndef HOST_EMU
#define FASTG(KIND, layer) hipLaunchKernelGGL(k_gemm_fast<KIND>, dim3(grid), dim3(512), LDS_BYTES, stream, p, layer)
#endif
extern "C" void kernel_launch(void* const* d_in, const int* in_sizes, int n_in, void* d_out, int out_size, void* d_ws, size_t ws_size, hipStream_t stream) {
    if (n_in != 16 || in_sizes[0] != NB * SEQ * D || out_size != NB * SEQ * D || ws_size < WS_NEED) { fprintf(stderr, "kernel_launch: unexpected shapes / workspace (%d inputs, ws %zu, need %zu)\n", n_in, ws_size, (size_t)WS_NEED); return; }
    const Params p = make_params(d_in, d_out, d_ws);
    const int T = 256;
#ifndef HOST_EMU
    static int grid = 0;
    if (grid == 0) { int dev = 0, cus = 0; hipGetDevice(&dev); hipDeviceGetAttribute(&cus, hipDeviceAttributeMultiprocessorCount, dev); grid = cus > 0 ? cus : 256;
        (void)hipFuncSetAttribute((const void*)k_gemm_fast<PK_P1>, hipFuncAttributeMaxDynamicSharedMemorySize, LDS_BYTES); hipFuncSetAttribute((const void*)k_gemm_fast<PK_P2>, hipFuncAttributeMaxDynamicSharedMemorySize, LDS_BYTES);
        hipFuncSetAttribute((const void*)k_gemm_fast<PK_P3B>, hipFuncAttributeMaxDynamicSharedMemorySize, LDS_BYTES); hipFuncSetAttribute((const void*)k_gemm_fast<PK_P4>, hipFuncAttributeMaxDynamicSharedMemorySize, LDS_BYTES);
        hipFuncSetAttribute((const void*)k_gemm_fast<PK_P5>, hipFuncAttributeMaxDynamicSharedMemorySize, LDS_BYTES);
        hipFuncSetAttribute((const void*)k_attn_fast<att::AK_P2>, hipFuncAttributeMaxDynamicSharedMemorySize, LDS_BYTES); hipFuncSetAttribute((const void*)k_attn_fast<att::AK_P3>, hipFuncAttributeMaxDynamicSharedMemorySize, LDS_BYTES); }
    (void)hipMemsetAsync((char*)d_ws + O_CTL, 0, 65536, stream);
#endif
    LAUNCH(k_tables, NBLK(NPOS * 16, T), T, p);
    for (int l = 0; l < DEPTH; ++l) {
        LAUNCH(k_prep_w<0>, NBLK((long)N1 * D, T), T, wptr(p, l, WL_W1), N1, D, p.w_in + (size_t)l * D * INC, INC, p.norm_g + l * D);
        LAUNCH(k_prep_w<1>, NBLK((long)2 * W * D, T), T, wptr(p, l, WL_WV), 2 * W, D, p.w_in + (size_t)l * D * INC, INC, p.norm_g + l * D);
        LAUNCH(k_prep_w<2>, NBLK((long)N3 * D, T), T, wptr(p, l, WL_W3), N3, D, p.w_in + (size_t)l * D * INC, INC, p.norm_g + l * D);
        LAUNCH(k_prep_w<3>, NBLK((long)QBW * QR, T), T, wptr(p, l, WL_UQ), QBW, QR, p.w_uq + (size_t)l * QR * QBW, QBW, p.cq_g + l * QR);
        LAUNCH(k_prep_w<4>, NBLK((long)W * KVR, T), T, wptr(p, l, WL_UK), W, KVR, p.w_ukv + (size_t)l * KVR * NH * 128, NH * 128, p.ckv_g + l * KVR);
        LAUNCH(k_prep_w<5>, NBLK((long)W * KVR, T), T, wptr(p, l, WL_UV), W, KVR, p.w_ukv + (size_t)l * KVR * NH * 128, NH * 128, p.ckv_g + l * KVR);
        LAUNCH(k_prep_w<6>, NBLK((long)D * W, T), T, wptr(p, l, WL_WO), D, W, p.w_osb + (size_t)l * W * D, D, (const float*)nullptr);
        LAUNCH(k_prep_w<6>, NBLK((long)D * W, T), T, wptr(p, l, WL_WO) + (size_t)D * W, D, W, p.w_omla + (size_t)l * W * D, D, (const float*)nullptr);
        LAUNCH(k_prep_w<6>, NBLK((long)D * W, T), T, wptr(p, l, WL_WO) + (size_t)2 * D * W, D, W, p.w_odiff + (size_t)l * W * D, D, (const float*)nullptr);
        LAUNCH(k_prep_w<6>, NBLK((long)D * D, T), T, wptr(p, l, WL_OUT), D, D, p.w_out + (size_t)l * D * D, D, (const float*)nullptr);
    }
    LAUNCH(k_init_x, NBLK((long)R * D, T), T, p);
    LAUNCH(k_ssq_f32, NBLK(R, 64), 64, (const float*)p.X, D, p.ssx, NSX);
    for (int l = 0; l < DEPTH; ++l) {
        const int last = (l == DEPTH - 1) ? 1 : 0; (void)last;
#ifndef HOST_EMU
        FASTG(PK_P1, l);
        FASTG(PK_P2, l);
#else
        LAUNCH(k_gemm<F1>, NBLK((long)R * (V1_END / 4), T), T, (const bf16_t*)p.XB, D, (const bf16_t*)wptr(p, l, WL_W1), D, R, V1_END, D, p, 0, 0);
        LAUNCH(k_gemm<F1>, NBLK((long)2 * W * (R / 4), T), T, (const bf16_t*)wptr(p, l, WL_WV), D, (const bf16_t*)p.XB, D, 2 * W, R, D, p, 0, 1);
        LAUNCH(k_ssq_bf, NBLK(R, 64), 64, (const bf16_t*)p.CQ, QR, p.ssq, NSQ);
        LAUNCH(k_ssq_bf, NBLK(R, 64), 64, (const bf16_t*)p.CKV, KVR, p.ssk, NSK);
        LAUNCH(k_gemm<FUQ>, NBLK((long)R * (QBW / 4), T), T, (const bf16_t*)p.CQ, QR, (const bf16_t*)wptr(p, l, WL_UQ), QR, R, QBW, QR, p, 0, 0);
        LAUNCH(k_gemm<FUK>, NBLK((long)R * (W / 4), T), T, (const bf16_t*)p.CKV, KVR, (const bf16_t*)wptr(p, l, WL_UK), KVR, R, W, KVR, p, 0, 0);
        LAUNCH(k_gemm<FUK>, NBLK((long)W * (R / 4), T), T, (const bf16_t*)wptr(p, l, WL_UV), KVR, (const bf16_t*)p.CKV, KVR, W, R, KVR, p, 0, 1);
#endif
#ifndef HOST_EMU
        hipLaunchKernelGGL(k_attn_fast<att::AK_P2>, dim3(grid), dim3(512), LDS_BYTES, stream, p, l);
        hipLaunchKernelGGL(k_attn_fast<att::AK_P3>, dim3(grid), dim3(512), LDS_BYTES, stream, p, l);
#else
        LAUNCH(k_attn_sb, NBLK((long)NB * NH * TB, 64), 64, p);
        LAUNCH(k_attn_diff, NBLK((long)NB * NHD * TB, 64), 64, p, l);
        LAUNCH(k_attn_mla, NBLK((long)NB * NH * TB, 64), 64, p);
#endif
        LAUNCH(k_x2bf, NBLK((long)R * D, T), T, p);
#ifndef HOST_EMU
        FASTG(PK_P3B, l); FASTG(PK_P4, l); FASTG(PK_P5, l);
#else
        LAUNCH(k_gemm<F3>, NBLK((long)R * (N3 / 4), T), T, (const bf16_t*)p.XB2, D, (const bf16_t*)wptr(p, l, WL_W3), D, R, N3, D, p, l, 0);
        LAUNCH(k_gemm<F4>, NBLK((long)R * (D / 4), T), T, (const bf16_t*)p.QSB, W, (const bf16_t*)wptr(p, l, WL_WO), W, R, D, W, p, 0, 0);
        LAUNCH(k_gemm<F4>, NBLK((long)R * (D / 4), T), T, (const bf16_t*)p.OMLA, W, (const bf16_t*)(wptr(p, l, WL_WO) + (size_t)D * W), W, R, D, W, p, 0, 5);
        LAUNCH(k_gemm<F4>, NBLK((long)R * (D / 4), T), T, (const bf16_t*)p.QD, W, (const bf16_t*)(wptr(p, l, WL_WO) + (size_t)2 * D * W), W, R, D, W, p, 0, 6);
        LAUNCH(k_gemm<F5>, NBLK((long)R * (D / 4), T), T, (const bf16_t*)p.G0, D, (const bf16_t*)wptr(p, l, WL_OUT), D, R, D, D, p, last, 0);
        if (!last) LAUNCH(k_ssq_f32, NBLK(R, 64), 64, (const float*)p.X, D, p.ssx, NSX);
#endif
    }
    LAUNCH(k_final, NBLK((long)NB * SEQ, 64), 64, p);
}
```

```cpp
#ifndef HOST_EMU
#include <hip/hip_runtime.h>
#endif
#include <cstdio>
#include <cstdint>
#include <cmath>
#include <cstring>

#ifndef CFG_B
#define CFG_B 8
#endif
#ifndef CFG_S
#define CFG_S 2048
#endif
#ifndef CFG_D
#define CFG_D 1024
#endif

typedef unsigned short bf16_t;

namespace cfg {
constexpr int NB = CFG_B, SEQ = CFG_S, D = CFG_D, DEPTH = 2;
constexpr int NMETA = 16, LEAD = 48, TB = LEAD + NMETA + SEQ, R = NB * TB, NPOS = NMETA + SEQ;
constexpr int W = D / 2;
constexpr int NH = D / 128;
constexpr int NHD = D / 256;
constexpr int QR = 3 * D / 8, KVR = D / 4, QBW = NH * 96;
constexpr int INC = 4 * W + QR + KVR + 32 + W + 4 * W + 3 * D;
constexpr int C_SBQ = 0, C_SBK = W, C_SBV = 2 * W, C_SBZ = 3 * W, C_CQ = 4 * W, C_CKV = C_CQ + QR, C_KR = C_CKV + KVR, C_MZ = C_KR + 32,
              C_DQ = C_MZ + W, C_DK = C_DQ + W, C_DV = C_DK + W, C_DZ = C_DV + W, C_G = C_DZ + W;
static_assert(C_G + 3 * D == INC, "w_in columns");
constexpr int V1_SBQ = 0, V1_SBK = W, V1_CQ = 2 * W, V1_CKV = V1_CQ + QR, V1_KR = V1_CKV + KVR, V1_DQ = V1_KR + 32, V1_DK = V1_DQ + W, V1_END = V1_DK + W;
constexpr int N1 = (V1_END + 255) / 256 * 256;
constexpr int N3 = 3 * W + 3 * D;
constexpr int NSX = D / 32, NSQ = QR / 32, NSK = KVR / 32;
constexpr float EPS = 1e-6f, LOG2E = 1.4426950408889634f;
constexpr int GP = D / 256;
}
using namespace cfg;

constexpr size_t MiB = size_t(1) << 20;
constexpr size_t al256(size_t x) { return (x + 255) & ~size_t(255); }
constexpr size_t SZ_W = (size_t)R * W * 2, SZ_D2 = (size_t)R * D * 2, SZ_X = (size_t)R * D * 4, SZ_CQ = (size_t)R * QR * 2, SZ_CKV = (size_t)R * KVR * 2,
                 SZ_KR = (size_t)R * 32 * 2, SZ_QB = (size_t)R * QBW * 2, SZ_GP = (size_t)R * 256 * 2;
constexpr size_t WB_W1 = (size_t)N1 * D * 2, WB_WV = (size_t)2 * W * D * 2, WB_W3 = (size_t)N3 * D * 2, WB_UQ = (size_t)QBW * QR * 2, WB_UK = (size_t)W * KVR * 2,
                 WB_UV = WB_UK, WB_WO = (size_t)3 * D * W * 2, WB_OUT = (size_t)D * D * 2;
constexpr size_t WL_W1 = 0, WL_WV = WL_W1 + WB_W1, WL_W3 = WL_WV + WB_WV, WL_UQ = WL_W3 + WB_W3, WL_UK = WL_UQ + WB_UQ, WL_UV = WL_UK + WB_UK, WL_WO = WL_UV + WB_UV,
                 WL_OUT = WL_WO + WB_WO, WL_BYTES = al256(WL_OUT + WB_OUT);
constexpr bool STDCFG = (NB == 8 && SEQ == 2048 && D == 1024);
#if defined(HOST_EMU)
constexpr bool HANDMAP = false;
#else
constexpr bool HANDMAP = STDCFG;
#endif
constexpr size_t O_CTL = 0, O_TAB = 1 * MiB, O_LAM = O_TAB + 768 * 1024, O_SSX = 2 * MiB, O_SSQ = O_SSX + al256((size_t)R * NSX * 4), O_SSK = O_SSQ + al256((size_t)R * NSQ * 4),
                 O_WTS = al256(O_SSK + (size_t)R * NSK * 4 + MiB) / MiB * MiB;
constexpr size_t O_X = HANDMAP ? 52 * MiB : al256(O_WTS + 2 * WL_BYTES);
static_assert(O_WTS + 2 * WL_BYTES <= O_X, "weights overrun X");
constexpr size_t O_A = O_X + al256(SZ_X);
constexpr size_t Q_QSB = O_A, Q_QD = Q_QSB + al256(SZ_W), Q_OMLA = Q_QD + al256(SZ_W), Q_KSB = Q_OMLA + al256(SZ_W), Q_VSBT = Q_KSB + al256(SZ_W), Q_KD = Q_VSBT + al256(SZ_W),
                 Q_VDT = Q_KD + al256(SZ_W), Q_VBT = Q_VDT + al256(SZ_W), Q_KR = Q_VBT + al256(SZ_W), Q_CKV = Q_KR + al256(SZ_KR), Q_XB2 = Q_CKV + al256(SZ_CKV), Q_G0 = Q_XB2 + al256(SZ_D2),
                 Q_GPC = Q_G0 + al256(SZ_D2), Q_XB = Q_GPC + 2 * GP * al256(SZ_GP), Q_QB = Q_XB + al256(SZ_D2), Q_CQ = Q_QB + al256(SZ_QB), Q_KNOPE = Q_CQ + al256(SZ_CQ), Q_END = Q_KNOPE + al256(SZ_W);
constexpr size_t WS_NEED = HANDMAP ? 256 * MiB : Q_END;

struct Params {
    const float *x, *meta, *norm_g, *w_in, *b_gate, *cq_g, *ckv_g, *w_uq, *w_ukv, *dlam, *dnorm_g, *w_osb, *w_omla, *w_odiff, *w_out, *final_g;
    float* out;
    float *X, *ssx, *ssq, *ssk, *cosm, *sinm, *cosd, *sind, *lamv;
    char* WTS;
    bf16_t *XB, *XB2, *QSB, *KSB, *VSBT, *QD, *KD, *VDT, *CQ, *CKV, *KR, *QB, *KNOPE, *VBT, *OMLA, *G0, *GPW, *GPO;
    unsigned* ctl;
};

static Params make_params(void* const* d_in, void* d_out, void* d_ws) {
    Params p{};
    const float* const* in = (const float* const*)d_in;
    p.x = in[0]; p.meta = in[1]; p.norm_g = in[2]; p.w_in = in[3]; p.b_gate = in[4]; p.cq_g = in[5]; p.ckv_g = in[6]; p.w_uq = in[7]; p.w_ukv = in[8]; p.dlam = in[9];
    p.dnorm_g = in[10]; p.w_osb = in[11]; p.w_omla = in[12]; p.w_odiff = in[13]; p.w_out = in[14]; p.final_g = in[15];
    p.out = (float*)d_out;
    char* ws = (char*)d_ws; char* ob = (char*)d_out;
    p.ctl = (unsigned*)(ws + O_CTL);
    p.cosm = (float*)(ws + O_TAB); p.sinm = p.cosm + NPOS * 16; p.cosd = p.sinm + NPOS * 16; p.sind = p.cosd + NPOS * 8; p.lamv = (float*)(ws + O_LAM);
    p.ssx = (float*)(ws + O_SSX); p.ssq = (float*)(ws + O_SSQ); p.ssk = (float*)(ws + O_SSK);
    p.WTS = ws + O_WTS;
    p.X = (float*)(ws + O_X);
    if (HANDMAP) {
        auto A = [&](double mib) { return (bf16_t*)(ws + (size_t)(mib * 1048576.0)); };
        auto Bq = [&](double mib) { return (bf16_t*)(ob + (size_t)(mib * 1048576.0)); };
        p.QSB = A(118); p.QD = A(134.5); p.OMLA = A(151); p.CKV = A(151); p.KSB = A(167.5); p.VSBT = A(184); p.KD = A(200.5); p.VDT = A(217); p.VBT = A(233.5); p.KR = A(250);
        p.XB2 = A(167.5); p.G0 = A(200.5);
        p.XB = Bq(0); p.QB = Bq(0); p.CQ = Bq(33); p.KNOPE = Bq(45.5);
        p.GPW = A(233.5); p.GPO = Bq(0);
    } else {
        auto A = [&](size_t off) { return (bf16_t*)(ws + off); };
        p.QSB = A(Q_QSB); p.QD = A(Q_QD); p.OMLA = A(Q_OMLA); p.CKV = A(Q_CKV); p.KSB = A(Q_KSB); p.VSBT = A(Q_VSBT); p.KD = A(Q_KD); p.VDT = A(Q_VDT); p.VBT = A(Q_VBT); p.KR = A(Q_KR);
        p.XB2 = A(Q_XB2); p.G0 = A(Q_G0); p.XB = A(Q_XB); p.QB = A(Q_QB); p.CQ = A(Q_CQ); p.KNOPE = A(Q_KNOPE);
        p.GPW = A(Q_GPC); p.GPO = A(Q_GPC);
    }
    return p;
}
static_assert(!STDCFG || (SZ_W == (size_t)(16.5 * 1048576) && SZ_D2 == 33 * MiB && SZ_GP == (size_t)(8.25 * 1048576) && SZ_QB == (size_t)(24.75 * 1048576) && SZ_CQ <= (size_t)(12.5 * 1048576) &&
              SZ_KR <= (size_t)(1.1 * 1048576) && SZ_X == 66 * MiB && GP == 4), "hand map sizes");

#ifdef HOST_EMU
#define DEVFN inline
#define HDFN inline
#else
#define DEVFN __device__ __forceinline__
#define HDFN __host__ __device__ __forceinline__
#endif
#ifdef HOST_EMU
template <class T> DEVFN T* opq(T* p) { return p; }
#else
DEVFN int lane_id_v() { int l; asm volatile("v_mbcnt_lo_u32_b32 %0, -1, 0\n\tv_mbcnt_hi_u32_b32 %0, -1, %0" : "=v"(l)); return l; }
template <class T> DEVFN T* opq(T* p) { asm volatile("" : "+s"(p)); return p; }
#endif
DEVFN float bf2f(bf16_t h) { unsigned u = (unsigned)h << 16; float f; memcpy(&f, &u, 4); return f; }
DEVFN bf16_t f2bf(float f) { unsigned u; memcpy(&u, &f, 4); return (bf16_t)((u + 0x7fffu + ((u >> 16) & 1u)) >> 16); }
struct alignas(16) U4 { unsigned x, y, z, w; };
DEVFN void ld8(const bf16_t* p, float* o) {
    const U4 v = *(const U4*)p; const unsigned u[4] = {v.x, v.y, v.z, v.w};
#pragma unroll
    for (int i = 0; i < 4; ++i) { unsigned lo = u[i] << 16, hi = u[i] & 0xffff0000u; memcpy(&o[2 * i], &lo, 4); memcpy(&o[2 * i + 1], &hi, 4); }
}
DEVFN float rsq(float x) { return 1.0f / sqrtf(x); }
DEVFN float rstd_slots(const float* s, int row, int ns, float invn) { float t = 0.f; for (int i = 0; i < ns; ++i) t += s[(size_t)row * ns + i]; return rsq(t * invn + EPS); }
DEVFN int sperm(int r) { return (r & ~12) | ((r & 4) << 1) | ((r & 8) >> 1); }
constexpr int NPW = HANDMAP ? 2 : 2 * GP;
DEVFN bf16_t* gptr(const Params& p, int b, int row, int c) {
    bf16_t* const g0 = opq(p.G0); bf16_t* const gw = opq(p.GPW); bf16_t* const go = opq(p.GPO);
    if (b == 0) return g0 + (size_t)row * D + c;
    const int j = (b - 1) * GP + (c >> 8); bf16_t* base = j < NPW ? gw + (size_t)j * (al256(SZ_GP) / 2) : go + (size_t)(j - NPW) * (al256(SZ_GP) / 2);
    return base + (size_t)row * 256 + (c & 255);
}
HDFN bf16_t* wptr(const Params& p, int l, size_t off) { return (bf16_t*)(p.WTS + (size_t)l * WL_BYTES + off); }
DEVFN float silu_f(float z) { return z / (1.f + expf(-z)); }
DEVFN float sigm_f(float z) { return 1.f / (1.f + expf(-z)); }
struct alignas(8) U2 { unsigned x, y; };
#ifdef HOST_EMU
DEVFN unsigned pk2(float lo, float hi) { return (unsigned)f2bf(lo) | ((unsigned)f2bf(hi) << 16); }
#else
typedef float f32x2_t __attribute__((ext_vector_type(2))); typedef __bf16 bf16x2_t __attribute__((ext_vector_type(2)));
DEVFN unsigned pk2(float lo, float hi) { f32x2_t v = {lo, hi}; bf16x2_t b = __builtin_convertvector(v, bf16x2_t); return __builtin_bit_cast(unsigned, b); }
#endif
DEVFN void st4(bf16_t* p, float a, float b, float c, float d) { U2 v; v.x = pk2(a, b); v.y = pk2(c, d); *(U2*)p = v; }
DEVFN void st2(bf16_t* p, float a, float b) { *(unsigned*)p = pk2(a, b); }
DEVFN void ld4(const bf16_t* p, float* o) { const U2 v = *(const U2*)p; unsigned t; t = v.x << 16; memcpy(&o[0], &t, 4); t = v.x & 0xffff0000u; memcpy(&o[1], &t, 4); t = v.y << 16; memcpy(&o[2], &t, 4); t = v.y & 0xffff0000u; memcpy(&o[3], &t, 4); }

DEVFN int rotmap(int c, int half) { const int g = c >> 2, e = c & 3; return e < 2 ? 2 * g + e : half + 2 * g + (e - 2); }
DEVFN int src_w1(int n) {
    if (n < V1_SBK) return C_SBQ + n;
    if (n < V1_CQ) return C_SBK + (n - V1_SBK);
    if (n < V1_CKV) return C_CQ + (n - V1_CQ);
    if (n < V1_KR) return C_CKV + (n - V1_CKV);
    if (n < V1_DQ) return C_KR + rotmap(n - V1_KR, 16);
    if (n < V1_DK) { const int c = n - V1_DQ, cc = c & 63; return C_DQ + (c & ~63) + (cc < 16 ? rotmap(cc, 8) : cc); }
    if (n < V1_END) { const int c = n - V1_DK, cc = c & 63; return C_DK + (c & ~63) + (cc < 16 ? rotmap(cc, 8) : cc); }
    return -1;
}
DEVFN int src_wv(int n) { return n < W ? C_SBV + n : C_DV + (n - W); }
DEVFN int src_w3(int n) { return n < W ? C_SBZ + n : n < 2 * W ? C_MZ + (n - W) : n < 3 * W ? C_DZ + (n - 2 * W) : C_G + (n - 3 * W); }
DEVFN int src_uq(int n) { const int h = n / 96, cc = n % 96; return h * 96 + (cc < 64 ? cc : 64 + rotmap(cc - 64, 16)); }
DEVFN int src_uk(int n) { return (n >> 6) * 128 + (n & 63); }
DEVFN int src_uv(int n) { return (n >> 6) * 128 + 64 + (n & 63); }

#ifdef HOST_EMU
DEVFN float quad_sum(float s) { return s; }
#else
template <int CTRL> DEVFN float dpp_get(float s) { return __int_as_float(__builtin_amdgcn_update_dpp(0, __float_as_int(s), CTRL, 0xf, 0xf, true)); }
DEVFN float xor16_sum(float s) { auto r = __builtin_amdgcn_permlane16_swap(__float_as_uint(s), __float_as_uint(s), false, false); return __uint_as_float(r[0]) + __uint_as_float(r[1]); }
DEVFN float xor32_sum(float s) { auto r = __builtin_amdgcn_permlane32_swap(__float_as_uint(s), __float_as_uint(s), false, false); return __uint_as_float(r[0]) + __uint_as_float(r[1]); }
DEVFN float quad_sum(float s) { return xor32_sum(xor16_sum(s)); }
DEVFN float quad4_sum(float s) { s += dpp_get<0xB1>(s); s += dpp_get<0x4E>(s); return s; }
DEVFN float wave_sum(float s) { s = quad4_sum(s); s += dpp_get<0x124>(s); s += dpp_get<0x128>(s); return xor32_sum(xor16_sum(s)); }
#endif
struct F1 {
    const Params& p; int aux;
    DEVFN bool swapped(int tag) const { return tag == 1; }
    DEVFN float scale(int tag, int idx) const { return rstd_slots(p.ssx, idx, NSX, 1.0f / D); }
    DEVFN float operator()(int tag, int row, int vc, const float* a, const float* sc) const {
        if (tag == 1) { bf16_t* const vs = opq(p.VSBT); bf16_t* const vd = opq(p.VDT); bf16_t* o = (row < W ? vs + (size_t)row * R : vd + (size_t)(row - W) * R) + ((vc & ~15) | sperm(vc & 15)); st4(o, a[0] * sc[0], a[1] * sc[1], a[2] * sc[2], a[3] * sc[3]); return 0.f; }
        const float rs = sc[0]; const float v0 = a[0] * rs, v1 = a[1] * rs, v2 = a[2] * rs, v3 = a[3] * rs;
        const int t = row % TB; const int pos = t >= LEAD ? t - LEAD : 0;
        if (vc < V1_SBK) { st4(p.QSB + (size_t)row * W + vc, v0 * (0.125f * LOG2E), v1 * (0.125f * LOG2E), v2 * (0.125f * LOG2E), v3 * (0.125f * LOG2E)); }
        else if (vc < V1_CQ) { st4(p.KSB + (size_t)row * W + (vc - V1_SBK), v0, v1, v2, v3); }
        else if (vc < V1_CKV) { st4(p.CQ + (size_t)row * QR + (vc - V1_CQ), v0, v1, v2, v3); return (v0 * v0 + v1 * v1) + (v2 * v2 + v3 * v3); }
        else if (vc < V1_KR) { st4(p.CKV + (size_t)row * KVR + (vc - V1_CKV), v0, v1, v2, v3); return (v0 * v0 + v1 * v1) + (v2 * v2 + v3 * v3); }
        else if (vc < V1_DQ) { const int g = (vc - V1_KR) >> 2; const float c0 = p.cosm[pos * 16 + 2 * g], c1 = p.cosm[pos * 16 + 2 * g + 1], s0 = p.sinm[pos * 16 + 2 * g], s1 = p.sinm[pos * 16 + 2 * g + 1];
            bf16_t* o = p.KR + (size_t)row * 32; st2(o + 2 * g, v0 * c0 - v2 * s0, v1 * c1 - v3 * s1); st2(o + 16 + 2 * g, v2 * c0 + v0 * s0, v3 * c1 + v1 * s1); }
        else if (vc < V1_END) { const bool isq = vc < V1_DK; const int c = vc - (isq ? V1_DQ : V1_DK), cc = c & 63; const float sc2 = isq ? 0.125f * LOG2E : 1.0f;
            bf16_t* const qd = opq(p.QD); bf16_t* const kd = opq(p.KD); bf16_t* o = (isq ? qd : kd) + (size_t)row * W + (c & ~63);
            if (cc < 16) { const int g = cc >> 2; const float c0 = p.cosd[pos * 8 + 2 * g], c1 = p.cosd[pos * 8 + 2 * g + 1], s0 = p.sind[pos * 8 + 2 * g], s1 = p.sind[pos * 8 + 2 * g + 1];
                st2(o + 2 * g, (v0 * c0 - v2 * s0) * sc2, (v1 * c1 - v3 * s1) * sc2); st2(o + 8 + 2 * g, (v2 * c0 + v0 * s0) * sc2, (v3 * c1 + v1 * s1) * sc2); }
            else st4(o + cc, v0 * sc2, v1 * sc2, v2 * sc2, v3 * sc2); }
        return 0.f;
    }
    DEVFN void rowslot(int tag, int row, int vc0, int fq, float part) const {
        if (tag != 0 || vc0 < V1_CQ || vc0 >= V1_KR) return;
        const float s = quad_sum(part);
        if (fq == 0) { if (vc0 < V1_CKV) p.ssq[(size_t)row * NSQ + ((vc0 - V1_CQ) >> 5)] = s; else p.ssk[(size_t)row * NSK + ((vc0 - V1_CKV) >> 5)] = s; }
    }
};
struct FUQ {
    const Params& p; int aux;
    DEVFN bool swapped(int) const { return false; }
    DEVFN float scale(int, int idx) const { return rstd_slots(p.ssq, idx, NSQ, 1.0f / QR) * (LOG2E * 0.10206207261596577f); }
    DEVFN float operator()(int, int row, int vc, const float* a, const float* sc) const {
        const float rs = sc[0]; const float v0 = a[0] * rs, v1 = a[1] * rs, v2 = a[2] * rs, v3 = a[3] * rs;
        const int t = row % TB; const int pos = t >= LEAD ? t - LEAD : 0;
        const int h = vc / 96, cc = vc % 96; bf16_t* o = p.QB + (size_t)row * QBW + h * 96;
        if (cc < 64) st4(o + cc, v0, v1, v2, v3);
        else { const int g = (cc - 64) >> 2; const float c0 = p.cosm[pos * 16 + 2 * g], c1 = p.cosm[pos * 16 + 2 * g + 1], s0 = p.sinm[pos * 16 + 2 * g], s1 = p.sinm[pos * 16 + 2 * g + 1];
            st2(o + 64 + 2 * g, v0 * c0 - v2 * s0, v1 * c1 - v3 * s1); st2(o + 80 + 2 * g, v2 * c0 + v0 * s0, v3 * c1 + v1 * s1); }
        return 0.f;
    }
    DEVFN void rowslot(int, int, int, int, float) const {}
};
struct FUK {
    const Params& p; int aux;
    DEVFN bool swapped(int tag) const { return tag == 1; }
    DEVFN float scale(int, int idx) const { return rstd_slots(p.ssk, idx, NSK, 1.0f / KVR); }
    DEVFN float operator()(int tag, int row, int vc, const float* a, const float* sc) const {
        if (tag == 1) st4(p.VBT + (size_t)row * R + ((vc & ~15) | sperm(vc & 15)), a[0] * sc[0], a[1] * sc[1], a[2] * sc[2], a[3] * sc[3]);
        else st4(p.KNOPE + (size_t)row * W + vc, a[0] * sc[0], a[1] * sc[0], a[2] * sc[0], a[3] * sc[0]);
        return 0.f;
    }
    DEVFN void rowslot(int, int, int, int, float) const {}
};
struct F3 {
    const Params& p; int layer;
    DEVFN bool swapped(int) const { return false; }
    DEVFN float scale(int, int idx) const { return rstd_slots(p.ssx, idx, NSX, 1.0f / D); }
    DEVFN float operator()(int, int row, int vc, const float* a, const float* sc) const {
        const float rs = sc[0];
        if (vc < 3 * W) { bf16_t* const o0 = opq(p.QSB); bf16_t* const o1 = opq(p.OMLA); bf16_t* const o2 = opq(p.QD); bf16_t* o = (vc < W ? o0 : vc < 2 * W ? o1 : o2) + (size_t)row * W + (vc % W); float ov[4]; ld4(o, ov);
            st4(o, ov[0] * silu_f(a[0] * rs), ov[1] * silu_f(a[1] * rs), ov[2] * silu_f(a[2] * rs), ov[3] * silu_f(a[3] * rs)); }
        else { const int c = vc - 3 * W, b = c / D, cc = c % D; const float* bg = p.b_gate + (size_t)layer * 3 * D + c;
            st4(gptr(p, b, row, cc), sigm_f(a[0] * rs + bg[0]), sigm_f(a[1] * rs + bg[1]), sigm_f(a[2] * rs + bg[2]), sigm_f(a[3] * rs + bg[3])); }
        return 0.f;
    }
    DEVFN void rowslot(int, int, int, int, float) const {}
};
struct F4 {
    const Params& p; int aux;
    DEVFN bool swapped(int) const { return false; }
    DEVFN float scale(int, int) const { return 1.f; }
    DEVFN float operator()(int tag, int row, int c, const float* a, const float*) const {
        float g[4], m[4] = {0.f, 0.f, 0.f, 0.f}; ld4(gptr(p, tag & 3, row, c), g); bf16_t* mp = p.G0 + (size_t)row * D + c; if (tag >> 2) ld4(mp, m);
        st4(mp, m[0] + g[0] * a[0], m[1] + g[1] * a[1], m[2] + g[2] * a[2], m[3] + g[3] * a[3]); return 0.f;
    }
    DEVFN void rowslot(int, int, int, int, float) const {}
};
struct F5 {
    const Params& p; int last;
    DEVFN bool swapped(int) const { return false; }
    DEVFN float scale(int, int) const { return 1.f; }
    DEVFN float operator()(int, int row, int c, const float* a, const float*) const {
        float* x = p.X + (size_t)row * D + c; const float v0 = x[0] + a[0], v1 = x[1] + a[1], v2 = x[2] + a[2], v3 = x[3] + a[3];
        x[0] = v0; x[1] = v1; x[2] = v2; x[3] = v3; if (!last) st4(p.XB + (size_t)row * D + c, v0, v1, v2, v3);
        return (v0 * v0 + v1 * v1) + (v2 * v2 + v3 * v3);
    }
    DEVFN void rowslot(int, int row, int vc0, int fq, float part) const { const float s = quad_sum(part); if (fq == 0) p.ssx[(size_t)row * NSX + (vc0 >> 5)] = s; }
};

#ifdef HOST_EMU
struct dim3e { unsigned x, y, z; };
static dim3e threadIdx, blockIdx, blockDim, gridDim;
#define GLOBAL static
#define LB64
#define LAUNCH(kern, nblk, nthr, ...) do { gridDim.x = (unsigned)(nblk); blockDim.x = (unsigned)(nthr); for (unsigned b_ = 0; b_ < gridDim.x; ++b_) for (unsigned t_ = 0; t_ < blockDim.x; ++t_) { blockIdx.x = b_; threadIdx.x = t_; kern(__VA_ARGS__); } } while (0)
#else
#define GLOBAL __global__
#define LB64 __launch_bounds__(64)
#define LAUNCH(kern, nblk, nthr, ...) kern<<<dim3((unsigned)(nblk)), dim3((unsigned)(nthr)), 0, stream>>>(__VA_ARGS__)
#endif
#define GTID ((long)blockIdx.x * blockDim.x + threadIdx.x)

#ifdef HOST_EMU
template <int MAP> GLOBAL void k_prep_w(bf16_t* dst, int N, int K, const float* src, int src_ld, const float* rowscale) {
    const long i = GTID; if (i >= (long)N * K) return;
    const int n = (int)(i % N), k = (int)(i / N);
    int s;
    if (MAP == 0) s = src_w1(n); else if (MAP == 1) s = src_wv(n); else if (MAP == 2) s = src_w3(n); else if (MAP == 3) s = src_uq(n); else if (MAP == 4) s = src_uk(n); else if (MAP == 5) s = src_uv(n); else s = n;
    float v = 0.f; if (s >= 0) v = src[(size_t)k * src_ld + s] * (rowscale ? rowscale[k] : 1.f);
    dst[(size_t)n * K + k] = f2bf(v);
}
GLOBAL void k_tables(Params p) {
    const long i = GTID;
    if (i < NPOS * 16) { const int pos = (int)(i / 16), j = (int)(i % 16); const float inv = (float)pow(500000.0, -(double)(2 * j) / 32.0); const float ang = (float)pos * inv;
        p.cosm[i] = (float)cos((double)ang); p.sinm[i] = (float)sin((double)ang); }
    if (i < NPOS * 8) { const int pos = (int)(i / 8), j = (int)(i % 8); const float inv = (float)pow(500000.0, -(double)(2 * j) / 16.0); const float ang = (float)pos * inv;
        p.cosd[i] = (float)cos((double)ang); p.sind[i] = (float)sin((double)ang); }
    if (i < DEPTH) { const float* lm = p.dlam + i * 4 * 64; float s0 = 0.f, s1 = 0.f; for (int d = 0; d < 64; ++d) { s0 += lm[d] * lm[64 + d]; s1 += lm[128 + d] * lm[192 + d]; }
        p.lamv[i] = expf(s0) - expf(s1) + (0.8f - 0.6f * expf(-0.3f * (float)i)); }
}
GLOBAL void k_init_x(Params p) {
    const long i = GTID; if (i >= (long)R * D) return;
    const int row = (int)(i / D), c = (int)(i % D), b = row / TB, t = row % TB;
    const float v = t < LEAD ? 0.f : t < LEAD + NMETA ? p.meta[(t - LEAD) * D + c] : p.x[((size_t)b * SEQ + (t - LEAD - NMETA)) * D + c];
    p.X[i] = v; p.XB[i] = f2bf(v);
}
GLOBAL void k_x2bf(Params p) { const long i = GTID; if (i >= (long)R * D) return; p.XB2[i] = f2bf(p.X[i]); }
GLOBAL void k_ssq_f32(const float* X, int n, float* slots, int ns) {
    const long row = GTID; if (row >= R) return; float s = 0.f; for (int c = 0; c < n; ++c) { const float v = X[(size_t)row * n + c]; s += v * v; }
    slots[row * ns] = s; for (int i = 1; i < ns; ++i) slots[row * ns + i] = 0.f;
}
GLOBAL void k_ssq_bf(const bf16_t* X, int n, float* slots, int ns) {
    const long row = GTID; if (row >= R) return; float s = 0.f; for (int c = 0; c < n; ++c) { const float v = bf2f(X[(size_t)row * n + c]); s += v * v; }
    slots[row * ns] = s; for (int i = 1; i < ns; ++i) slots[row * ns + i] = 0.f;
}
GLOBAL void k_final(Params p) {
    const long i = GTID; if (i >= (long)NB * SEQ) return;
    const int b = (int)(i / SEQ), s = (int)(i % SEQ); const float* x = p.X + ((size_t)b * TB + LEAD + NMETA + s) * D; float ss = 0.f;
    for (int c = 0; c < D; ++c) ss += x[c] * x[c];
    const float rs = rsq(ss / D + EPS); float* o = p.out + (size_t)i * D;
    for (int c = 0; c < D; ++c) o[c] = x[c] * rs * p.final_g[c];
}

template <class Epi> GLOBAL void k_gemm(const bf16_t* A, int lda, const bf16_t* Bt, int ldb, int M, int N, int K, Params pp, int aux, int tag) {
    const Epi epi{pp, aux};
    const long idx = GTID; const int n4 = N / 4; if (idx >= (long)M * n4) return;
    const int m = (int)(idx / n4), n0 = (int)(idx % n4) * 4;
    float acc[4] = {0.f, 0.f, 0.f, 0.f};
    const bf16_t* a = A + (size_t)m * lda; const bf16_t* b0 = Bt + (size_t)n0 * ldb;
    for (int k = 0; k < K; k += 8) {
        float av[8]; ld8(a + k, av);
#pragma unroll
        for (int i = 0; i < 4; ++i) { float bv[8]; ld8(b0 + (size_t)i * ldb + k, bv); float s = 0.f;
#pragma unroll
            for (int j = 0; j < 8; ++j) s += av[j] * bv[j];
            acc[i] += s; }
    }
    float sc[4]; if (epi.swapped(tag)) { for (int i = 0; i < 4; ++i) sc[i] = epi.scale(tag, n0 + i); } else sc[0] = epi.scale(tag, m);
    epi(tag, m, n0, acc, sc);
}

GLOBAL void LB64 k_attn_sb(Params p) {
    const long i = GTID; if (i >= (long)NB * NH * TB) return;
    const int t = (int)(i % TB), h = (int)((i / TB) % NH), b = (int)(i / ((long)TB * NH));
    const size_t row = (size_t)b * TB + t; bf16_t* qo = p.QSB + row * W + h * 64;
    float q[64], o[64];
#pragma unroll
    for (int d = 0; d < 64; ++d) { q[d] = bf2f(qo[d]); o[d] = 0.f; }
    if (t >= LEAD) {
        float carry = 0.f;
        for (int j = t - 1; j >= LEAD; --j) {
            const size_t kr = (size_t)b * TB + j; const bf16_t* k = p.KSB + kr * W + h * 64; float z = 0.f;
#pragma unroll
            for (int d = 0; d < 64; ++d) z += q[d] * bf2f(k[d]);
            const float sp = fmaxf(z, 0.f) + log2f(1.f + exp2f(-fabsf(z)));
            const float w = exp2f((z - sp) + carry); carry -= sp;
            const bf16_t* vt = p.VSBT + (size_t)(h * 64) * R + ((kr & ~(size_t)15) | sperm((int)(kr & 15)));
#pragma unroll
            for (int d = 0; d < 64; ++d) o[d] += w * bf2f(vt[(size_t)d * R]);
        }
    }
#pragma unroll
    for (int d = 0; d < 64; ++d) qo[d] = f2bf(o[d]);
}
GLOBAL void LB64 k_attn_mla(Params p) {
    const long i = GTID; if (i >= (long)NB * NH * TB) return;
    const int t = (int)(i % TB), h = (int)((i / TB) % NH), b = (int)(i / ((long)TB * NH));
    const size_t row = (size_t)b * TB + t; const bf16_t* qp = p.QB + row * QBW + h * 96;
    float o[64]; float m = -INFINITY, l = 0.f;
#pragma unroll
    for (int d = 0; d < 64; ++d) o[d] = 0.f;
    if (t >= LEAD) {
        const int kend = (t / 64 + 1) * 64 < TB ? (t / 64 + 1) * 64 : TB;
        for (int j = LEAD; j < kend; ++j) {
            const size_t kr = (size_t)b * TB + j; const bf16_t* kn = p.KNOPE + kr * W + h * 64; const bf16_t* kq = p.KR + kr * 32; float s = 0.f;
            for (int d = 0; d < 64; ++d) s += bf2f(qp[d]) * bf2f(kn[d]);
            for (int d = 0; d < 32; ++d) s += bf2f(qp[64 + d]) * bf2f(kq[d]);
            const float mn = fmaxf(m, s), f = exp2f(m - mn), w = exp2f(s - mn); m = mn; l = l * f + w;
            const bf16_t* vt = p.VBT + (size_t)(h * 64) * R + ((kr & ~(size_t)15) | sperm((int)(kr & 15)));
#pragma unroll
            for (int d = 0; d < 64; ++d) o[d] = o[d] * f + w * bf2f(vt[(size_t)d * R]);
        }
    }
    const float il = l > 0.f ? 1.f / l : 0.f; bf16_t* op = p.OMLA + row * W + h * 64;
#pragma unroll
    for (int d = 0; d < 64; ++d) op[d] = f2bf(o[d] * il);
}
GLOBAL void LB64 k_attn_diff(Params p, int layer) {
    const long i = GTID; if (i >= (long)NB * NHD * TB) return;
    const int t = (int)(i % TB), h = (int)((i / TB) % NHD), b = (int)(i / ((long)TB * NHD));
    const size_t row = (size_t)b * TB + t; bf16_t* qo = p.QD + row * W + h * 128;
    const float lam = p.lamv[layer], lam_init = 0.8f - 0.6f * expf(-0.3f * (float)layer);
    float o[128];
#pragma unroll
    for (int d = 0; d < 128; ++d) o[d] = 0.f;
    if (t >= LEAD) {
        const int kend = (t / 64 + 1) * 64 < TB ? (t / 64 + 1) * 64 : TB;
        float m0 = -INFINITY, l0 = 0.f, m1 = -INFINITY, l1 = 0.f;
        for (int j = LEAD; j < kend; ++j) { const bf16_t* k = p.KD + ((size_t)b * TB + j) * W + h * 128; float s0 = 0.f, s1 = 0.f;
            for (int d = 0; d < 64; ++d) { s0 += bf2f(qo[d]) * bf2f(k[d]); s1 += bf2f(qo[64 + d]) * bf2f(k[64 + d]); }
            float mn = fmaxf(m0, s0); l0 = l0 * exp2f(m0 - mn) + exp2f(s0 - mn); m0 = mn; mn = fmaxf(m1, s1); l1 = l1 * exp2f(m1 - mn) + exp2f(s1 - mn); m1 = mn; }
        const float i0 = 1.f / l0, i1 = lam / l1;
        for (int j = LEAD; j < kend; ++j) { const size_t kr = (size_t)b * TB + j; const bf16_t* k = p.KD + kr * W + h * 128; float s0 = 0.f, s1 = 0.f;
            for (int d = 0; d < 64; ++d) { s0 += bf2f(qo[d]) * bf2f(k[d]); s1 += bf2f(qo[64 + d]) * bf2f(k[64 + d]); }
            const float w = exp2f(s0 - m0) * i0 - exp2f(s1 - m1) * i1;
            const bf16_t* vt = p.VDT + (size_t)(h * 128) * R + ((kr & ~(size_t)15) | sperm((int)(kr & 15)));
#pragma unroll
            for (int d = 0; d < 128; ++d) o[d] += w * bf2f(vt[(size_t)d * R]);
        }
    }
    float ss = 0.f;
#pragma unroll
    for (int d = 0; d < 128; ++d) ss += o[d] * o[d];
    const float rs = rsq(ss * (1.f / 128.f) + EPS) * (1.f - lam_init); const float* g = p.dnorm_g + (size_t)layer * 128;
#pragma unroll
    for (int d = 0; d < 128; ++d) qo[d] = f2bf(o[d] * rs * g[d]);
}


#endif
#ifndef HOST_EMU
namespace pg8 {
#define PG8_LAS __attribute__((address_space(3)))
typedef short bf16x8 __attribute__((ext_vector_type(8)));
typedef float f32x4 __attribute__((ext_vector_type(4)));
typedef unsigned u32x4 __attribute__((ext_vector_type(4)));
constexpr int BM = 256, BK = 64, HALF = 128, HTB = HALF * BK * 2  , STAGE_BYTES = 8 * HTB, NXCD = 8, WGM = 8;
__host__ __device__ __forceinline__ int lds_byte(int r, int c) { const int st = (r >> 4) * 2 + (c >> 5), rr = r & 15, cc = c & 31, ob = rr * 64 + cc * 2; return st * 1024 + (ob ^ (((ob >> 9) & 1) << 5)); }
__host__ __device__ __forceinline__ void stage_rc(int b, int& R, int& C) { const int st = b / 1024, sb = b % 1024, swz = sb ^ (((sb >> 9) & 1) << 5); R = (st >> 1) * 16 + swz / 64; C = (st & 1) * 32 + (swz % 64) / 2; }
__host__ __device__ __forceinline__ int perm32(int rho) { const int n = rho >> 4, i = rho & 15; return 8 * (i >> 2) + 4 * n + (i & 3); }
struct Unit { int pm, pn, tag; const char* A; const char* B; };
struct Gemm { int K, lda, ldb; };
__device__ __forceinline__ void order_map(int L, int nM, int nN, int& pm, int& pn) {
    const int nwg = nM * nN; int wgid = L; { const int q = nwg / NXCD, r = nwg % NXCD, xcd = wgid % NXCD, off = wgid / NXCD; wgid = (xcd < r ? xcd * (q + 1) : r * (q + 1) + (xcd - r) * q) + off; }
    const int nig = WGM * nN, gid = wgid / nig, fm = gid * WGM, gsz = (nM - fm) < WGM ? (nM - fm) : WGM;
    pm = fm + ((wgid % nig) % gsz); pn = (wgid % nig) / gsz;
}
template <class F> struct EpiAd {
    static constexpr bool PERM = true, AFTER_DRAIN = false;
    F f;
    __device__ __forceinline__ void operator()(const f32x4 (&acc)[2][2][4][2], const Unit& u, int wr, int wc, int fr, int fq, PG8_LAS unsigned char* scr, int tid) const {
        PG8_LAS float* rs = (PG8_LAS float*)scr;
        const bool sw = f.swapped(u.tag);
        if (tid < 256) rs[tid] = f.scale(u.tag, (sw ? u.pn : u.pm) * BM + tid);
        asm volatile("s_waitcnt lgkmcnt(0)" ::: "memory"); __builtin_amdgcn_s_barrier(); asm volatile("" ::: "memory");
#pragma unroll
        for (int ai = 0; ai < 2; ++ai)
#pragma unroll
            for (int m = 0; m < 4; ++m) { int rl = ai * HALF + wr * 64 + m * 16 + fr; asm volatile("" : "+v"(rl)); const int row = u.pm * BM + rl;
#pragma unroll
                for (int bj = 0; bj < 2; ++bj) { float part = 0.f;
#pragma unroll
                    for (int n = 0; n < 2; ++n) { const int cl = bj * HALF + wc * 32 + 8 * fq + 4 * n; const f32x4 v = acc[ai][bj][m][n]; const float a4[4] = {v[0], v[1], v[2], v[3]};
                        float sc[4]; if (sw) { sc[0] = rs[cl]; sc[1] = rs[cl + 1]; sc[2] = rs[cl + 2]; sc[3] = rs[cl + 3]; } else { sc[0] = rs[rl]; sc[1] = sc[2] = sc[3] = 0.f; }
                        part += f(u.tag, row, u.pn * BM + cl, a4, sc); }
                    f.rowslot(u.tag, row, u.pn * BM + bj * HALF + wc * 32, fq, part); asm volatile("" ::: "memory"); } }
    }
};
template <class Epi, class Sched, bool ALIGN_EPI = false, bool SP2 = false>
__device__ __forceinline__ void gemm_phase(PG8_LAS unsigned char* lds, const Gemm g, const Sched& S, const Epi& E, const int wid0  ) {
    int lane_ = lane_id_v();
    const int wid = wid0, lane = lane_, tid = wid * 64 + lane, wr = wid >> 2, wc = wid & 3, fr = lane & 15, fq = lane >> 4;
    const int K = g.K, nt = K / BK, lda = g.lda, ldb = g.ldb;
    unsigned voffA[2], voffB[2];
#pragma unroll
    for (int i = 0; i < 2; ++i) { int R, C; stage_rc(tid * 16 + i * 8192, R, C); const int Rb = Epi::PERM ? ((R & ~31) + perm32(R & 31)) : R;
        voffA[i] = (unsigned)(R * lda + C) * 2u; voffB[i] = (unsigned)(Rb * ldb + C) * 2u; }
    const size_t kstep = (size_t)(BK * 2);
    const size_t hstepA = (size_t)HALF * lda * 2, hstepB = (size_t)HALF * ldb * 2;
    const size_t tstepA = 2 * hstepA, tstepB = 2 * hstepB;
    const unsigned ldsw = (unsigned)wid * 1024u;
    const int aoff = lds_byte(wr * 64 + fr, fq * 8), boff = lds_byte(wc * 32 + fr, fq * 8);
#define PG8_SA(b, h) (((b) * 2 + (h)) * HTB)
#define PG8_SB(b, h) ((4 + (b) * 2 + (h)) * HTB)
#define PG8_STAGE(bufoff, gbase, voff) do { _Pragma("unroll") for (int _i = 0; _i < 2; ++_i) \
        __builtin_amdgcn_global_load_lds((const unsigned*)((const char*)(gbase) + (voff)[_i]), (PG8_LAS unsigned*)(lds + (bufoff) + ldsw + _i * 8192), 16, 0, 0); } while (0)
#define PG8_LDA(dst, b, h) do { _Pragma("unroll") for (int m = 0; m < 4; ++m) _Pragma("unroll") for (int k = 0; k < 2; ++k) dst[m][k] = *(const PG8_LAS bf16x8*)(lds + PG8_SA(b, h) + aoff + m * 2048 + k * 1024); } while (0)
#define PG8_LDB(dst, b, h) do { _Pragma("unroll") for (int n = 0; n < 2; ++n) _Pragma("unroll") for (int k = 0; k < 2; ++k) dst[n][k] = *(const PG8_LAS bf16x8*)(lds + PG8_SB(b, h) + boff + n * 2048 + k * 1024); } while (0)
#define PG8_MMA(ai, bj, At, Bt) do { __builtin_amdgcn_s_setprio(1); _Pragma("unroll") for (int m = 0; m < 4; ++m) _Pragma("unroll") for (int n = 0; n < 2; ++n) _Pragma("unroll") for (int k = 0; k < 2; ++k) \
        acc[ai][bj][m][n] = __builtin_amdgcn_mfma_f32_16x16x32_bf16(Bt[n][k], At[m][k], acc[ai][bj][m][n], 0, 0, 0); __builtin_amdgcn_s_setprio(0); } while (0)
#define PG8_WAIT_V(n) asm volatile("s_waitcnt vmcnt(" #n ")" ::: "memory")
#define PG8_WAIT_L(n) asm volatile("s_waitcnt lgkmcnt(" #n ")" ::: "memory")
#define PG8_BAR __builtin_amdgcn_s_barrier()
#define PG8_SCHED __builtin_amdgcn_sched_barrier(0)
    Unit cur, nxt; int ui = 0;
    if (!S.next(0, cur)) return;
    f32x4 acc[2][2][4][2];
#pragma unroll
    for (int a = 0; a < 2; ++a)
#pragma unroll
        for (int b = 0; b < 2; ++b)
#pragma unroll
            for (int m = 0; m < 4; ++m)
#pragma unroll
                for (int n = 0; n < 2; ++n) acc[a][b][m][n] = (f32x4){0.f, 0.f, 0.f, 0.f};
    bf16x8 At[4][2], B0[2][2], B1[2][2];
    const char* cA = cur.A + (size_t)cur.pm * tstepA; const char* cB = cur.B + (size_t)cur.pn * tstepB;
    S.a_ready(cur);
    if constexpr (SP2) {
        PG8_STAGE(PG8_SB(0, 0), cB, voffB); PG8_STAGE(PG8_SB(0, 1), cB + hstepB, voffB); PG8_STAGE(PG8_SA(0, 0), cA, voffA); PG8_STAGE(PG8_SA(0, 1), cA + hstepA, voffA);
        if (wr == 1) PG8_BAR;
        PG8_WAIT_V(2); PG8_BAR;
        PG8_STAGE(PG8_SB(1, 0), cB + kstep, voffB); PG8_STAGE(PG8_SA(1, 0), cA + kstep, voffA); PG8_STAGE(PG8_SB(1, 1), cB + hstepB + kstep, voffB);
        PG8_WAIT_V(6); PG8_BAR;
    } else {
        PG8_STAGE(PG8_SB(0, 0), cB, voffB); PG8_STAGE(PG8_SA(0, 0), cA, voffA); PG8_STAGE(PG8_SB(0, 1), cB + hstepB, voffB); PG8_STAGE(PG8_SA(0, 1), cA + hstepA, voffA);
        if (wr == 1) PG8_BAR;
        PG8_WAIT_V(4); PG8_BAR;
        PG8_STAGE(PG8_SB(1, 0), cB + kstep, voffB); PG8_STAGE(PG8_SA(1, 0), cA + kstep, voffA); PG8_STAGE(PG8_SB(1, 1), cB + hstepB + kstep, voffB);
        PG8_WAIT_V(6); PG8_BAR;
    }
    for (;;) {
        const bool has_next = S.next(ui + 1, nxt);
        const char* nA = has_next ? nxt.A + (size_t)nxt.pm * tstepA : cA; const char* nB = has_next ? nxt.B + (size_t)nxt.pn * tstepB : cB;
#pragma nounroll
        for (int t = 0; t < nt; t += 2) {
            const bool last = (t == nt - 2);
            const char* a1 = cA + (size_t)(t + 1) * kstep;
            const char* a2 = last ? nA : cA + (size_t)(t + 2) * kstep; const char* b2 = last ? nB : cB + (size_t)(t + 2) * kstep;
            const char* a3 = a2 + kstep; const char* b3 = b2 + kstep;
            if (last && has_next) S.a_ready(nxt);
            if constexpr (SP2) {
            PG8_LDB(B0, 0, 0); PG8_LDB(B1, 0, 1); PG8_SCHED; PG8_LDA(At, 0, 0); PG8_STAGE(PG8_SA(1, 1), a1 + hstepA, voffA);
            PG8_WAIT_V(8); PG8_WAIT_L(0); PG8_BAR; PG8_MMA(0, 0, At, B0); PG8_MMA(0, 1, At, B1); PG8_BAR; PG8_SCHED;
            PG8_LDA(At, 0, 1); PG8_STAGE(PG8_SB(0, 0), b2, voffB); PG8_STAGE(PG8_SB(0, 1), b2 + hstepB, voffB); PG8_STAGE(PG8_SA(0, 0), a2, voffA);
            PG8_WAIT_V(8); PG8_WAIT_L(0); PG8_BAR; PG8_MMA(1, 0, At, B0); PG8_MMA(1, 1, At, B1); PG8_BAR; PG8_SCHED;
            PG8_LDB(B0, 1, 0); PG8_LDB(B1, 1, 1); PG8_SCHED; PG8_LDA(At, 1, 0); PG8_STAGE(PG8_SA(0, 1), a2 + hstepA, voffA);
            PG8_WAIT_V(8); PG8_WAIT_L(0); PG8_BAR; PG8_MMA(0, 0, At, B0); PG8_MMA(0, 1, At, B1); PG8_BAR; PG8_SCHED;
            PG8_LDA(At, 1, 1); PG8_STAGE(PG8_SB(1, 0), b3, voffB); PG8_STAGE(PG8_SB(1, 1), b3 + hstepB, voffB); PG8_STAGE(PG8_SA(1, 0), a3, voffA);
            PG8_WAIT_V(8); PG8_WAIT_L(0); PG8_BAR; PG8_MMA(1, 0, At, B0); PG8_MMA(1, 1, At, B1); PG8_BAR; PG8_SCHED;
            } else {
            PG8_LDB(B0, 0, 0); PG8_SCHED; PG8_LDA(At, 0, 0); PG8_STAGE(PG8_SA(1, 1), a1 + hstepA, voffA);
            PG8_WAIT_L(8); PG8_BAR; PG8_WAIT_L(0); PG8_MMA(0, 0, At, B0); PG8_BAR; PG8_SCHED;
            PG8_LDB(B1, 0, 1); PG8_STAGE(PG8_SB(0, 0), b2, voffB);
            PG8_BAR; PG8_WAIT_L(0); PG8_MMA(0, 1, At, B1); PG8_BAR;
            PG8_LDA(At, 0, 1); PG8_STAGE(PG8_SA(0, 0), a2, voffA);
            PG8_BAR; PG8_WAIT_L(0); PG8_MMA(1, 0, At, B0); PG8_BAR; PG8_SCHED;
            PG8_STAGE(PG8_SB(0, 1), b2 + hstepB, voffB);
            PG8_WAIT_V(6); PG8_BAR; PG8_MMA(1, 1, At, B1); PG8_BAR;
            PG8_LDB(B0, 1, 0); PG8_SCHED; PG8_LDA(At, 1, 0); PG8_STAGE(PG8_SA(0, 1), a2 + hstepA, voffA);
            PG8_WAIT_L(8); PG8_BAR; PG8_WAIT_L(0); PG8_MMA(0, 0, At, B0); PG8_BAR; PG8_SCHED;
            PG8_LDB(B1, 1, 1); PG8_STAGE(PG8_SB(1, 0), b3, voffB);
            PG8_BAR; PG8_WAIT_L(0); PG8_MMA(0, 1, At, B1); PG8_BAR;
            PG8_LDA(At, 1, 1); PG8_STAGE(PG8_SA(1, 0), a3, voffA);
            PG8_BAR; PG8_WAIT_L(0); PG8_MMA(1, 0, At, B0); PG8_BAR; PG8_SCHED;
            PG8_STAGE(PG8_SB(1, 1), b3 + hstepB, voffB);
            PG8_WAIT_V(6); PG8_BAR; PG8_MMA(1, 1, At, B1); PG8_BAR;
            }
        }
        if constexpr (ALIGN_EPI) { if (wr == 0) PG8_BAR; }
        if constexpr (!Epi::AFTER_DRAIN) { E(acc, cur, wr, wc, fr, fq, lds + STAGE_BYTES, tid); S.done(cur); }
        if (!has_next) break;
#pragma unroll
        for (int a = 0; a < 2; ++a)
#pragma unroll
            for (int b = 0; b < 2; ++b)
#pragma unroll
                for (int m = 0; m < 4; ++m)
#pragma unroll
                    for (int n = 0; n < 2; ++n) acc[a][b][m][n] = (f32x4){0.f, 0.f, 0.f, 0.f};
        cur = nxt; cA = nA; cB = nB; ++ui;
        if constexpr (ALIGN_EPI) { if (wr == 1) PG8_BAR; }
    }
    PG8_WAIT_V(0);
    if constexpr (!ALIGN_EPI) { if (wr == 0) PG8_BAR; }
    PG8_BAR;
    if constexpr (Epi::AFTER_DRAIN) { E.fused(acc, cur, wr, wc, fr, fq, lds, wid, lane); S.done(cur); }
#undef PG8_SA
#undef PG8_SB
#undef PG8_STAGE
#undef PG8_LDA
#undef PG8_LDB
#undef PG8_MMA
#undef PG8_WAIT_V
#undef PG8_WAIT_L
#undef PG8_BAR
#undef PG8_SCHED
}

}

struct SchedGrid {
    int nM, nN, G, c, tag; const char* A; const char* B;
    __device__ __forceinline__ bool next(int i, pg8::Unit& u) const { const long L = (long)i * G + c; if (L >= (long)nM * nN) return false; pg8::order_map((int)L, nM, nN, u.pm, u.pn); u.tag = tag; u.A = A; u.B = B; return true; }
    __device__ __forceinline__ void a_ready(const pg8::Unit&) const {}
    __device__ __forceinline__ void done(const pg8::Unit&) const {}
};
struct SchedTwo {
    int nM0, nN0, nM1, nN1, G, c; const char *A0, *B0, *A1, *B1;
    __device__ __forceinline__ bool next(int i, pg8::Unit& u) const { long L = (long)i * G + c; const long n0 = (long)nM0 * nN0;
        if (L < n0) { pg8::order_map((int)L, nM0, nN0, u.pm, u.pn); u.tag = 0; u.A = A0; u.B = B0; return true; }
        L -= n0; if (L >= (long)nM1 * nN1) return false; pg8::order_map((int)L, nM1, nN1, u.pm, u.pn); u.tag = 1; u.A = A1; u.B = B1; return true; }
    __device__ __forceinline__ void a_ready(const pg8::Unit&) const {}
    __device__ __forceinline__ void done(const pg8::Unit&) const {}
};
struct SchedP4 {
    int nM, nN, G, c; const char* A0; size_t astride; const char* B0; size_t bstride;
    __device__ __forceinline__ bool next(int i, pg8::Unit& u) const { const int j = i % 3, b = (2 * j) % 3; const long L = (long)(i / 3) * G + c; if (L >= (long)nM * nN) return false;
        pg8::order_map((int)L, nM, nN, u.pm, u.pn); u.tag = b + (j > 0 ? 4 : 0); u.A = A0 + (size_t)j * astride; u.B = B0 + (size_t)b * bstride; return true; }
    __device__ __forceinline__ void a_ready(const pg8::Unit&) const {}
    __device__ __forceinline__ void done(const pg8::Unit&) const {}
};
constexpr int LDS_SCR = pg8::STAGE_BYTES, LDS_BYTES = 147456;
#define LASP __attribute__((address_space(3)))
enum { PK_P1 = 0, PK_P2 = 1, PK_P3 = 2, PK_P3B = 3, PK_P4 = 4, PK_P5 = 5 };
__device__ __forceinline__ void gemm_part(const Params& p, LASP unsigned char* lds, int kind, int l, int G, int c, int wid0) {
    constexpr int nR = R / 256;
    if (kind == PK_P1) {
        SchedTwo S{nR, N1 / 256, 2 * W / 256, nR, G, c, (const char*)p.XB, (const char*)wptr(p, l, WL_W1), (const char*)wptr(p, l, WL_WV), (const char*)p.XB};
        pg8::EpiAd<F1> E{F1{p, 0}}; pg8::gemm_phase<pg8::EpiAd<F1>, SchedTwo, true, true>(lds, pg8::Gemm{D, D, D}, S, E, wid0);
    } else if (kind == PK_P2) {
        { SchedGrid S{nR, QBW / 256, G, c, 0, (const char*)p.CQ, (const char*)wptr(p, l, WL_UQ)};
          pg8::EpiAd<FUQ> E{FUQ{p, 0}}; pg8::gemm_phase<pg8::EpiAd<FUQ>, SchedGrid, true, true>(lds, pg8::Gemm{QR, QR, QR}, S, E, wid0); }
        { SchedTwo S{nR, W / 256, W / 256, nR, G, c, (const char*)p.CKV, (const char*)wptr(p, l, WL_UK), (const char*)wptr(p, l, WL_UV), (const char*)p.CKV};
          pg8::EpiAd<FUK> E{FUK{p, 0}}; pg8::gemm_phase<pg8::EpiAd<FUK>, SchedTwo, true, true>(lds, pg8::Gemm{KVR, KVR, KVR}, S, E, wid0); }
    } else if (kind == PK_P3B) {
        SchedGrid S{nR, N3 / 256, G, c, 0, (const char*)p.XB2, (const char*)wptr(p, l, WL_W3)};
        pg8::EpiAd<F3> E{F3{p, l}}; pg8::gemm_phase<pg8::EpiAd<F3>, SchedGrid, true, true>(lds, pg8::Gemm{D, D, D}, S, E, wid0);
    } else if (kind == PK_P4) {
        SchedP4 S{nR, D / 256, G, c, (const char*)p.QSB, (size_t)((const char*)p.QD - (const char*)p.QSB), (const char*)wptr(p, l, WL_WO), (size_t)D * W * 2};
        pg8::EpiAd<F4> E{F4{p, 0}}; pg8::gemm_phase<pg8::EpiAd<F4>, SchedP4, true, true>(lds, pg8::Gemm{W, W, W}, S, E, wid0);
    } else if (kind == PK_P5) {
        SchedGrid S{nR, D / 256, G, c, 0, (const char*)p.G0, (const char*)wptr(p, l, WL_OUT)};
        pg8::EpiAd<F5> E{F5{p, l == DEPTH - 1 ? 1 : 0}}; pg8::gemm_phase<pg8::EpiAd<F5>, SchedGrid, true, true>(lds, pg8::Gemm{D, D, D}, S, E, wid0);
    }
}
template <int KIND> __global__ void __launch_bounds__(512, 2) k_gemm_fast(Params p, int l) {
    extern __shared__ __attribute__((aligned(16))) unsigned char lds_raw[];
    gemm_part(p, (LASP unsigned char*)lds_raw, KIND, l, (int)gridDim.x, (int)blockIdx.x, __builtin_amdgcn_readfirstlane((int)threadIdx.x >> 6));
}

namespace att {
typedef short bf16x8 __attribute__((ext_vector_type(8)));
typedef float f32x16 __attribute__((ext_vector_type(16)));
typedef unsigned u32x4v __attribute__((ext_vector_type(4)));
__device__ __forceinline__ int crow(int r, int h) { return (r & 3) + 8 * (r >> 2) + 4 * h; }
__device__ __forceinline__ bf16x8 ldg8(const bf16_t* p) { return *(const bf16x8*)p; }
__device__ __forceinline__ void halves(float x, float& lo, float& hi) { auto r = __builtin_amdgcn_permlane32_swap(__float_as_uint(x), __float_as_uint(x), false, false); lo = __uint_as_float(r[0]); hi = __uint_as_float(r[1]); }
__device__ __forceinline__ bf16x8 pack8(const f32x16& v, int b) { u32x4v w; w.x = pk2(v[b], v[b + 1]); w.y = pk2(v[b + 2], v[b + 3]); w.z = pk2(v[b + 4], v[b + 5]); w.w = pk2(v[b + 6], v[b + 7]); return __builtin_bit_cast(bf16x8, w); }
constexpr float SB_DEAD = -152.0f;
#define ATT_FENCE() asm volatile("" ::: "memory")
template <int NQB, int NKS, int NKSA, int NDB, bool SBM>
__device__ __forceinline__ void attn_wave(const bf16_t* qptr, int ldq, const bf16_t* kA, int ldkA, const bf16_t* kB, int ldkB, const bf16_t* vt, int c, int qoff,
                                          f32x16 (&o)[NDB][NQB], float (&mrun)[NQB], float (&lrun)[NQB]) {
    int lane_ = lane_id_v();
    const int lane = lane_, cl = lane & 31, h = lane >> 5;
    constexpr int NG = NKS;
    bf16x8 qf[NQB][NKS];
#pragma unroll
    for (int qb = 0; qb < NQB; ++qb)
#pragma unroll
        for (int ks = 0; ks < NKS; ++ks) qf[qb][ks] = ldg8(qptr + (size_t)(qoff + qb * 32 + cl) * ldq + 16 * ks + 8 * h);
#pragma unroll
    for (int qb = 0; qb < NQB; ++qb) { mrun[qb] = -INFINITY; lrun[qb] = 0.f;
#pragma unroll
        for (int d = 0; d < NDB; ++d)
#pragma unroll
            for (int r = 0; r < 16; ++r) o[d][qb][r] = 0.f; }
    float carry[NQB];
#pragma unroll
    for (int qb = 0; qb < NQB; ++qb) carry[qb] = 0.f;
#define ATT_LDK(dst, kt_, g_) do { _Pragma("unroll") for (int j_ = 0; j_ < 2; ++j_) { const int ks_ = (g_); const size_t kr_ = (size_t)((kt_) * 64 + j_ * 32 + cl); \
        dst[j_] = ks_ < NKSA ? ldg8(kA + kr_ * ldkA + 16 * ks_ + 8 * h) : ldg8(kB + kr_ * ldkB + 16 * (ks_ - NKSA) + 8 * h); } } while (0)
#define ATT_LDV(dst, kt_, j_) do { _Pragma("unroll") for (int d_ = 0; d_ < NDB; ++d_) dst[d_] = ldg8(vt + (size_t)(d_ * 32 + cl) * R + (kt_) * 64 + (j_) * 16 + 8 * h); } while (0)
    bf16x8 kf0[2], kf1[2], vf0[NDB], vf1[NDB];
    ATT_LDK(kf0, (SBM ? c : 0), 0); ATT_FENCE();
    for (int it = 0; it <= c; ++it) {
        const int kt = SBM ? c - it : it; const int ktn = it < c ? (SBM ? kt - 1 : kt + 1) : kt;
        f32x16 s[2][NQB];
#pragma unroll
        for (int kb = 0; kb < 2; ++kb)
#pragma unroll
            for (int qb = 0; qb < NQB; ++qb)
#pragma unroll
                for (int r = 0; r < 16; ++r) s[kb][qb][r] = 0.f;
#pragma unroll
        for (int g = 0; g < NG; ++g) {
            if (g + 1 < NG) { if (g & 1) ATT_LDK(kf0, kt, g + 1); else ATT_LDK(kf1, kt, g + 1); } else ATT_LDV(vf0, kt, 0);
            ATT_FENCE();
#pragma unroll
            for (int j = 0; j < 2; ++j)
#pragma unroll
                for (int qb = 0; qb < NQB; ++qb) s[j][qb] = __builtin_amdgcn_mfma_f32_32x32x16_bf16((g & 1) ? kf1[j] : kf0[j], qf[qb][g], s[j][qb], 0, 0, 0);
        }
        if (!SBM) {
            if (kt == 0) {
#pragma unroll
                for (int qb = 0; qb < NQB; ++qb) {
#pragma unroll
                    for (int r = 0; r < 16; ++r) s[0][qb][r] = -INFINITY;
#pragma unroll
                    for (int r = 0; r < 8; ++r) s[1][qb][r] = -INFINITY; } }
#pragma unroll
            for (int qb = 0; qb < NQB; ++qb) {
                float mx = s[0][qb][0];
#pragma unroll
                for (int r = 1; r < 16; ++r) mx = fmaxf(mx, s[0][qb][r]);
#pragma unroll
                for (int r = 0; r < 16; ++r) mx = fmaxf(mx, s[1][qb][r]);
                float m0, m1; halves(mx, m0, m1); const float mn = fmaxf(mrun[qb], fmaxf(m0, m1)); const float f = __builtin_amdgcn_exp2f(mrun[qb] - mn); mrun[qb] = mn;
                float ps = 0.f;
#pragma unroll
                for (int kb = 0; kb < 2; ++kb)
#pragma unroll
                    for (int r = 0; r < 16; ++r) { const float pv = __builtin_amdgcn_exp2f(s[kb][qb][r] - mn); s[kb][qb][r] = pv; ps += pv; }
                lrun[qb] = lrun[qb] * f + ps;
#pragma unroll
                for (int d = 0; d < NDB; ++d)
#pragma unroll
                    for (int r = 0; r < 16; ++r) o[d][qb][r] *= f;
            }
        } else {
#pragma unroll
            for (int qb = 0; qb < NQB; ++qb) {
                float run = carry[qb];
#pragma unroll
                for (int kb = 1; kb >= 0; --kb)
#pragma unroll
                    for (int rg = 3; rg >= 0; --rg) {
                        const bool lead = (kt == 0) && (kb == 0 || rg < 2);
                        float y[4], sp[4]; bool ok[4];
#pragma unroll
                        for (int e = 0; e < 4; ++e) { y[e] = s[kb][qb][4 * rg + e]; ok[e] = !lead && !(kt == c && (kb * 32 + 8 * rg + 4 * h + e >= qb * 32 + cl));
                            sp[e] = ok[e] ? fmaxf(y[e], 0.f) + __builtin_amdgcn_logf(1.0f + __builtin_amdgcn_exp2f(-fabsf(y[e]))) : 0.f; }
                        const float gs = -((sp[0] + sp[1]) + (sp[2] + sp[3])); float g0, g1; halves(gs, g0, g1);
                        const float t1 = run; run += g1; const float t0 = run; run += g0; float a = h ? t1 : t0;
#pragma unroll
                        for (int e = 3; e >= 0; --e) { const float w = ok[e] ? __builtin_amdgcn_exp2f((y[e] - sp[e]) + a) : 0.f; a -= sp[e]; s[kb][qb][4 * rg + e] = w; } }
                carry[qb] = run;
            }
        }
        ATT_FENCE();
#pragma unroll
        for (int j = 0; j < 4; ++j) {
            if (j + 1 < 4) { if (j & 1) ATT_LDV(vf0, kt, j + 1); else ATT_LDV(vf1, kt, j + 1); } else ATT_LDK(kf0, ktn, 0);
            ATT_FENCE();
            bf16x8 pf[NQB];
#pragma unroll
            for (int qb = 0; qb < NQB; ++qb) pf[qb] = pack8(s[j >> 1][qb], 8 * (j & 1));
#pragma unroll
            for (int d = 0; d < NDB; ++d)
#pragma unroll
                for (int qb = 0; qb < NQB; ++qb) o[d][qb] = __builtin_amdgcn_mfma_f32_32x32x16_bf16((j & 1) ? vf1[d] : vf0[d], pf[qb], o[d][qb], 0, 0, 0);
        }
        if (SBM) { bool dead = true;
#pragma unroll
            for (int qb = 0; qb < NQB; ++qb) dead = dead && (carry[qb] < SB_DEAD);
            if (__all(dead)) break; }
    }
#undef ATT_LDK
#undef ATT_LDV
}
template <int NQB, int NDB> __device__ __forceinline__ void store_ot(bf16_t* optr, int ldo, const f32x16 (&o)[NDB][NQB], const float (&sc)[NQB]) {
    int lane_ = lane_id_v(); const int lane = lane_, cl = lane & 31, h = lane >> 5;
#pragma unroll
    for (int qb = 0; qb < NQB; ++qb)
#pragma unroll
        for (int d = 0; d < NDB; ++d)
#pragma unroll
            for (int rg = 0; rg < 4; ++rg) st4(optr + (size_t)(qb * 32 + cl) * ldo + d * 32 + 8 * rg + 4 * h, o[d][qb][4 * rg] * sc[qb], o[d][qb][4 * rg + 1] * sc[qb], o[d][qb][4 * rg + 2] * sc[qb], o[d][qb][4 * rg + 3] * sc[qb]);
}
__device__ __forceinline__ void unit_sb(const Params& p, int wid, int b, int c) {
    const size_t r0 = (size_t)b * TB;
    f32x16 o[2][2]; float m[2], l[2];
    bf16_t* q = p.QSB + (r0 + c * 64) * W + wid * 64;
    attn_wave<2, 4, 4, 2, true>(q, W, p.KSB + r0 * W + wid * 64, W, nullptr, 0, p.VSBT + (size_t)(wid * 64) * R + r0, c, 0, o, m, l);
    const float one[2] = {1.f, 1.f}; store_ot<2, 2>(q, W, o, one);
}
__device__ __forceinline__ void unit_mla(const Params& p, int wid, int b, int c) {
    const size_t r0 = (size_t)b * TB;
    f32x16 o[2][2]; float m[2], l[2];
    attn_wave<2, 6, 4, 2, false>(p.QB + (r0 + c * 64) * QBW + wid * 96, QBW, p.KNOPE + r0 * W + wid * 64, W, p.KR + r0 * 32, 32, p.VBT + (size_t)(wid * 64) * R + r0, c, 0, o, m, l);
    float il[2];
#pragma unroll
    for (int qb = 0; qb < 2; ++qb) { float l0, l1; halves(l[qb], l0, l1); il[qb] = 1.0f / (l0 + l1); }
    store_ot<2, 2>(p.OMLA + (r0 + c * 64) * W + wid * 64, W, o, il);
}
__device__ __forceinline__ void unit_diff(const Params& p, int wid, int layer, int b, int c, int hp, LASP unsigned char* lds) {
    int lane_ = lane_id_v(); const int lane = lane_, g = wid >> 2, mp = (wid >> 1) & 1, qh = wid & 1, head = hp * 2 + g; const size_t r0 = (size_t)b * TB;
    f32x16 o[4][1]; float m[1], l[1];
    const bf16_t* q = p.QD + (r0 + c * 64) * W + head * 128 + mp * 64;
    attn_wave<1, 4, 4, 4, false>(q, W, p.KD + r0 * W + head * 128 + mp * 64, W, nullptr, 0, p.VDT + (size_t)(head * 128) * R + r0, c, qh * 32, o, m, l);
    float l0, l1; halves(l[0], l0, l1); const float il = 1.0f / (l0 + l1);
    { LASP float* reg = (LASP float*)(lds + wid * 16384); const int cl = lane & 31, h = lane >> 5;
#pragma unroll
      for (int d = 0; d < 4; ++d)
#pragma unroll
          for (int r = 0; r < 16; ++r) reg[cl * 128 + ((d * 32 + crow(r, h)) ^ cl)] = o[d][0][r] * il; }
    asm volatile("s_waitcnt lgkmcnt(0)" ::: "memory"); __builtin_amdgcn_s_barrier(); asm volatile("" ::: "memory");
    { const float lam = p.lamv[layer], lam_init = __uint_as_float(__builtin_amdgcn_readfirstlane(layer == 0 ? 0x3e4ccccdu : 0x3eb60549u));
      const LASP float* r0p = (const LASP float*)(lds + ((g * 2 + 0) * 2 + qh) * 16384); const LASP float* r1p = (const LASP float*)(lds + ((g * 2 + 1) * 2 + qh) * 16384);
      const int ql = mp * 16 + (lane >> 2), part = lane & 3; float v[32]; float ss = 0.f;
#pragma unroll
      for (int i = 0; i < 32; ++i) { const int ii = (i + 8 * part) & 31; const int a = ql * 128 + ((part * 32 + ii) ^ ql); v[i] = r0p[a] - lam * r1p[a]; ss += v[i] * v[i]; }
      ss = quad4_sum(ss);
      const float rs = rsq(ss * (1.0f / 128.0f) + EPS) * (1.0f - lam_init); const float* gn = p.dnorm_g + (size_t)layer * 128 + part * 32;
      bf16_t* op = p.QD + (r0 + c * 64 + qh * 32 + ql) * W + head * 128 + part * 32;
#pragma unroll
      for (int i = 0; i < 32; i += 2) { const int ii = (i + 8 * part) & 31;
          st2(op + ii, v[i] * rs * gn[ii], v[i + 1] * rs * gn[ii + 1]); } }
}
enum { AK_P2 = 0, AK_P3 = 1 };
__device__ __forceinline__ void attn_part(const Params& p, LASP unsigned char* lds, int kind, int layer, int wid) {
    const bool leader = wid == 0 && lane_id_v() == 0;
    volatile LASP int* slot = (volatile LASP int*)(lds + LDS_SCR + 2048);
    unsigned* ctr = p.ctl + 1024 + 64 * (layer * 2 + kind);
    constexpr int NT = TB / 64;
    const int nitems = kind == AK_P2 ? NB * NT * (NHD / 2) + NB * NT : NB * NT;
    for (int n = 0;; ++n) {
        if (leader) slot[n & 1] = (int)atomicAdd(ctr, 1u);
        asm volatile("s_waitcnt vmcnt(0) lgkmcnt(0)" ::: "memory"); __builtin_amdgcn_s_barrier(); asm volatile("" ::: "memory");
        const int item = __builtin_amdgcn_readfirstlane(slot[n & 1]);
        if (item >= nitems) break;
        if (kind == AK_P2) {
            constexpr int ND = NB * (NHD / 2);
            if (item < ND * NT) { const int c = NT - 1 - item / ND, j = item % ND; unit_diff(p, wid, layer, j / (NHD / 2), c, j % (NHD / 2), lds); }
            else { const int j = item - ND * NT; unit_sb(p, wid, j % NB, NT - 1 - j / NB); }
        } else unit_mla(p, wid, item % NB, NT - 1 - item / NB);
    }
}
}
template <int KIND> __global__ void __launch_bounds__(512, 2) k_attn_fast(Params p, int l) {
    extern __shared__ __attribute__((aligned(16))) unsigned char lds_raw[];
    att::attn_part(p, (LASP unsigned char*)lds_raw, KIND, l, __builtin_amdgcn_readfirstlane((int)threadIdx.x >> 6));
}

#define XB_TMO      128
#define XB_XCNT(j)  (256  + 64 * (j))
#define XB_XSUB(j)  (1280 + 64 * (j))
#define XB_XGEN(j)  (2304 + 64 * (j))
#define XB_TOP      3328
#define XB_TOPGEN   3392
#define XCD_BAR_WORDS 3456
#define XB_SPIN_CAP (1u << 18)
__device__ __forceinline__ unsigned xb_ld(unsigned* p)              { return __hip_atomic_load(p, __ATOMIC_RELAXED, __HIP_MEMORY_SCOPE_AGENT); }
__device__ __forceinline__ unsigned xb_add(unsigned* p, unsigned v) { return __hip_atomic_fetch_add(p, v, __ATOMIC_RELAXED, __HIP_MEMORY_SCOPE_AGENT); }
__device__ __forceinline__ unsigned xb_xcc_id() { return (unsigned)__builtin_amdgcn_s_getreg((3 << 11) | 20) & 0xFu; }
#define XB_SPIN(cond, bar) do { unsigned _sp = 0; while (cond) { __builtin_amdgcn_s_sleep(1); \
    if ((++_sp & 255u) == 0u) { if (xb_ld(&(bar)[XB_TMO])) break; if (_sp > XB_SPIN_CAP) { atomicAdd(&(bar)[XB_TMO], 1u); break; } } } } while (0)
struct XcdBarrier { unsigned* bar; unsigned x; volatile LASP unsigned* st; };
__device__ __forceinline__ XcdBarrier xcd_barrier_post(unsigned* bar, volatile LASP unsigned* st, bool leader) {
    XcdBarrier b; b.bar = bar; b.x = xb_xcc_id(); b.st = st;
    if (leader) (void)xb_add(&bar[XB_XCNT(b.x)], 1u);
    return b;
}
__device__ __forceinline__ void xcd_barrier_complete(unsigned* bar, unsigned x, unsigned& nloc, unsigned& nx) {
    const unsigned G = gridDim.x * gridDim.y * gridDim.z;
    unsigned sum, cnt, mine, sp = 0u;
    for (;;) {
        sum = 0u; cnt = 0u; mine = 0u;
#pragma unroll
        for (unsigned j = 0; j < 16; ++j) { const unsigned c = xb_ld(&bar[XB_XCNT(j)]); sum += c; cnt += (c > 0u) ? 1u : 0u; mine = (j == x) ? c : mine; }
        if (sum == G) break;
        __builtin_amdgcn_s_sleep(1);
        if ((++sp & 255u) == 0u) { if (xb_ld(&bar[XB_TMO])) break; if (sp > XB_SPIN_CAP) { atomicAdd(&bar[XB_TMO], 1u); break; } }
    }
    nloc = mine > 0u ? mine : 1u; nx = cnt > 0u ? cnt : 1u;
}
__device__ __forceinline__ void xcd_barrier(const XcdBarrier& b, const int wid0) {
    const bool leader = wid0 == 0 && lane_id_v() == 0;
    asm volatile("s_waitcnt vmcnt(0)" ::: "memory");
    __syncthreads();
    if (leader) {
        unsigned* bar = b.bar;
        __builtin_amdgcn_s_waitcnt(0);
        unsigned nloc = b.st[0], nx = b.st[1];
        if (nloc == 0u) { xcd_barrier_complete(bar, b.x, nloc, nx); b.st[0] = nloc; b.st[1] = nx; }
        const unsigned old = xb_add(&bar[XB_XSUB(b.x)], 1u);
        const unsigned gen = old / nloc;
        if (old + 1u == (gen + 1u) * nloc) {
            __builtin_amdgcn_fence(__ATOMIC_RELEASE, "agent");
            asm volatile("s_waitcnt vmcnt(0)" ::: "memory");
            const unsigned og = xb_add(&bar[XB_TOP], 1u);
            const unsigned tg = og / nx;
            if (og + 1u == (tg + 1u) * nx) xb_add(&bar[XB_TOPGEN], 1u);
            else XB_SPIN(xb_ld(&bar[XB_TOPGEN]) == tg, bar);
            __builtin_amdgcn_fence(__ATOMIC_ACQUIRE, "agent");
            xb_add(&bar[XB_XGEN(b.x)], 1u);
            asm volatile("s_waitcnt vmcnt(0)" ::: "memory");
        } else {
            XB_SPIN(xb_ld(&bar[XB_XGEN(b.x)]) == gen, bar);
            __builtin_amdgcn_fence(__ATOMIC_ACQUIRE, "agent");
            asm volatile("s_waitcnt vmcnt(0)" ::: "memory");
        }
    }
    __syncthreads();
}

typedef float f32x4v __attribute__((ext_vector_type(4)));
typedef unsigned u32x4w __attribute__((ext_vector_type(4)));
__device__ __forceinline__ float rope_inv(int e, int dim) { return exp2f(-(float)e / (float)dim * 18.931568569324174f); }
__device__ __forceinline__ void rope_cs(float ang, float& cs, float& sn) { const double t = (double)ang * 0.15915494309189535; const float a = (float)((t - rint(t)) * 6.283185307179586); cs = cosf(a); sn = sinf(a); }
template <int MAP> __device__ __forceinline__ void prep_item(const float* src, int src_ld, const float* rowscale, bf16_t* dst, int N, int K, int item, int lane, LASP float* scr) {
    const int nblk = N / 32, kb = item / nblk, nb = item % nblk, k0 = 64 * kb, n0 = 32 * nb, nl = n0 + (lane & 31);
    int sc; if (MAP == 0) sc = src_w1(nl); else if (MAP == 1) sc = src_wv(nl); else if (MAP == 2) sc = src_w3(nl); else if (MAP == 3) sc = src_uq(nl); else if (MAP == 4) sc = src_uk(nl); else if (MAP == 5) sc = src_uv(nl); else sc = nl;
#pragma unroll 8
    for (int i = 0; i < 32; ++i) { const int kk = 2 * i + (lane >> 5); float v = 0.f; if (sc >= 0) v = src[(size_t)(k0 + kk) * src_ld + sc] * (rowscale ? rowscale[k0 + kk] : 1.f); scr[kk * 33 + (lane & 31)] = v; }
    asm volatile("s_waitcnt lgkmcnt(0)" ::: "memory");
    const int c = lane & 7;
#pragma unroll
    for (int j = 0; j < 4; ++j) { const int n = (lane >> 3) + 8 * j; const LASP float* t = scr + (8 * c) * 33 + n;
        u32x4w o; o.x = pk2(t[0 * 33], t[1 * 33]); o.y = pk2(t[2 * 33], t[3 * 33]); o.z = pk2(t[4 * 33], t[5 * 33]); o.w = pk2(t[6 * 33], t[7 * 33]);
        *(u32x4w*)(dst + (size_t)(n0 + n) * K + k0 + 8 * c) = o; }
    asm volatile("s_waitcnt lgkmcnt(0)" ::: "memory");
}
__device__ __forceinline__ void prologue_part(const Params& p, LASP unsigned char* lds, int G, int c, int wave) {
    int lane_ = lane_id_v(); const int lane = lane_;
    const int gw = c * 8 + wave, NGW = G * 8;
    for (int i = gw * 64 + lane; i < NPOS * 16; i += NGW * 64) {
        { const int pos = i / 16, j = i % 16; const float ang = (float)pos * rope_inv(2 * j, 32); float cs, sn; rope_cs(ang, cs, sn); p.cosm[i] = cs; p.sinm[i] = sn; }
        if (i < NPOS * 8) { const int pos = i / 8, j = i % 8; const float ang = (float)pos * rope_inv(2 * j, 16); float cs, sn; rope_cs(ang, cs, sn); p.cosd[i] = cs; p.sind[i] = sn; }
        if (i < DEPTH) { const float* lm = p.dlam + i * 4 * 64; float s0 = 0.f, s1 = 0.f; for (int d = 0; d < 64; ++d) { s0 += lm[d] * lm[64 + d]; s1 += lm[128 + d] * lm[192 + d]; }
            p.lamv[i] = expf(s0) - expf(s1) + (i == 0 ? 0.2f : 0.35550906759f); }
    }
    LASP float* scr = (LASP float*)(lds + wave * 16384);
    constexpr int I_W1 = (D / 64) * (N1 / 32), I_WV = (D / 64) * (2 * W / 32), I_W3 = (D / 64) * (N3 / 32), I_UQ = (QR / 64) * (QBW / 32), I_UK = (KVR / 64) * (W / 32), I_WO = (W / 64) * (D / 32), I_OUT = (D / 64) * (D / 32);
    constexpr int I_L = I_W1 + I_WV + I_W3 + I_UQ + 2 * I_UK + 3 * I_WO + I_OUT;
    for (int it = gw; it < 2 * I_L; it += NGW) {
        const int l = it / I_L; int r = it % I_L;
        const float* win = p.w_in + (size_t)l * D * INC; const float* ng = p.norm_g + l * D;
        if (r < I_W1) { prep_item<0>(win, INC, ng, wptr(p, l, WL_W1), N1, D, r, lane, scr); continue; } r -= I_W1;
        if (r < I_WV) { prep_item<1>(win, INC, ng, wptr(p, l, WL_WV), 2 * W, D, r, lane, scr); continue; } r -= I_WV;
        if (r < I_W3) { prep_item<2>(win, INC, ng, wptr(p, l, WL_W3), N3, D, r, lane, scr); continue; } r -= I_W3;
        if (r < I_UQ) { prep_item<3>(p.w_uq + (size_t)l * QR * QBW, QBW, p.cq_g + l * QR, wptr(p, l, WL_UQ), QBW, QR, r, lane, scr); continue; } r -= I_UQ;
        if (r < I_UK) { prep_item<4>(p.w_ukv + (size_t)l * KVR * NH * 128, NH * 128, p.ckv_g + l * KVR, wptr(p, l, WL_UK), W, KVR, r, lane, scr); continue; } r -= I_UK;
        if (r < I_UK) { prep_item<5>(p.w_ukv + (size_t)l * KVR * NH * 128, NH * 128, p.ckv_g + l * KVR, wptr(p, l, WL_UV), W, KVR, r, lane, scr); continue; } r -= I_UK;
        if (r < 3 * I_WO) { const int b = r / I_WO; const float* const w0 = opq(p.w_osb); const float* const w1 = opq(p.w_omla); const float* const w2 = opq(p.w_odiff); const float* wo = (b == 0 ? w0 : b == 1 ? w1 : w2) + (size_t)l * W * D;
            prep_item<6>(wo, D, nullptr, wptr(p, l, WL_WO) + (size_t)b * D * W, D, W, r % I_WO, lane, scr); continue; } r -= 3 * I_WO;
        prep_item<6>(p.w_out + (size_t)l * D * D, D, nullptr, wptr(p, l, WL_OUT), D, D, r, lane, scr);
    }
    for (int row = gw; row < R; row += NGW) {
        const int b = row / TB, t = row % TB; f32x4v v[D / 256]; float ss = 0.f;
#pragma unroll
        for (int j = 0; j < D / 256; ++j) { const int col = 256 * j + 4 * lane;
            if (t < LEAD) v[j] = (f32x4v){0.f, 0.f, 0.f, 0.f}; else if (t < LEAD + NMETA) v[j] = *(const f32x4v*)(p.meta + (size_t)(t - LEAD) * D + col); else v[j] = *(const f32x4v*)(p.x + ((size_t)b * SEQ + (t - LEAD - NMETA)) * D + col);
            ss += (v[j].x * v[j].x + v[j].y * v[j].y) + (v[j].z * v[j].z + v[j].w * v[j].w); }
        ss = wave_sum(ss);
#pragma unroll
        for (int j = 0; j < D / 256; ++j) { const int col = 256 * j + 4 * lane; *(f32x4v*)(p.X + (size_t)row * D + col) = v[j]; st4(p.XB + (size_t)row * D + col, v[j].x, v[j].y, v[j].z, v[j].w); }
        if (lane < NSX) p.ssx[(size_t)row * NSX + lane] = lane == 0 ? ss : 0.f;
    }
}
__device__ __forceinline__ void x2bf_part(const Params& p, int G, int c, int wave) {
    int lane_ = lane_id_v(); const int lane = lane_;
    for (int row = c * 8 + wave; row < R; row += G * 8) {
#pragma unroll
        for (int j = 0; j < D / 256; ++j) { const int col = 256 * j + 4 * lane; const f32x4v v = *(const f32x4v*)(p.X + (size_t)row * D + col); st4(p.XB2 + (size_t)row * D + col, v.x, v.y, v.z, v.w); } }
}
__device__ __forceinline__ void final_part(const Params& p, int G, int c, int wave) {
    int lane_ = lane_id_v(); const int lane = lane_;
    for (int i = c * 8 + wave; i < NB * SEQ; i += G * 8) {
        const int b = i / SEQ, sq = i % SEQ; const float* x = p.X + ((size_t)b * TB + LEAD + NMETA + sq) * D; f32x4v v[D / 256]; float ss = 0.f;
#pragma unroll
        for (int j = 0; j < D / 256; ++j) { v[j] = *(const f32x4v*)(x + 256 * j + 4 * lane); ss += (v[j].x * v[j].x + v[j].y * v[j].y) + (v[j].z * v[j].z + v[j].w * v[j].w); }
        const float rs = rsq(wave_sum(ss) * (1.0f / D) + EPS);
#pragma unroll
        for (int j = 0; j < D / 256; ++j) { const f32x4v g = *(const f32x4v*)(p.final_g + 256 * j + 4 * lane); *(f32x4v*)(p.out + (size_t)i * D + 256 * j + 4 * lane) = v[j] * rs * g; }
    }
}
constexpr int N_PHASES = 2 + 6 * DEPTH;
constexpr int CW_QUEUE = 1024, CW_BAR = 4096;
#define MK_SEAM(k) do { if ((k) + 1 < ph_hi) xcd_barrier(bar, wid0); } while (0)
#define MK_IN(k) (ph_lo <= (k) && (k) < ph_hi)
template <int L> __device__ __forceinline__ void layer_phases(const Params& p, LASP unsigned char* lds, const XcdBarrier& bar, int ph_lo, int ph_hi, int G, int c, int wid0) {
    constexpr int B0 = 1 + 6 * L;
    if (MK_IN(B0 + 0)) { gemm_part(p, lds, PK_P1, L, G, c, wid0); MK_SEAM(B0 + 0); }
    if (MK_IN(B0 + 1)) { gemm_part(p, lds, PK_P2, L, G, c, wid0); att::attn_part(p, lds, att::AK_P2, L, wid0); MK_SEAM(B0 + 1); }
    if (MK_IN(B0 + 2)) { x2bf_part(p, G, c, wid0); att::attn_part(p, lds, att::AK_P3, L, wid0); MK_SEAM(B0 + 2); }
    if (MK_IN(B0 + 3)) { gemm_part(p, lds, PK_P3B, L, G, c, wid0); MK_SEAM(B0 + 3); }
    if (MK_IN(B0 + 4)) { gemm_part(p, lds, PK_P4, L, G, c, wid0); MK_SEAM(B0 + 4); }
    if (MK_IN(B0 + 5)) { gemm_part(p, lds, PK_P5, L, G, c, wid0); MK_SEAM(B0 + 5); }
}
__global__ void __launch_bounds__(512, 2) mk_fwd(Params p, int ph_lo, int ph_hi) {
    extern __shared__ __attribute__((aligned(16))) unsigned char lds_raw[];
    LASP unsigned char* lds = (LASP unsigned char*)lds_raw;
    volatile LASP unsigned* misc = (volatile LASP unsigned*)(lds + LDS_SCR + 4096);
    const int wid0 = __builtin_amdgcn_readfirstlane((int)threadIdx.x >> 6);
    if (threadIdx.x < 64) misc[threadIdx.x] = 0u;
    __syncthreads();
    const int G = (int)gridDim.x, c = (int)blockIdx.x;
    const XcdBarrier bar = xcd_barrier_post(p.ctl + CW_BAR, misc + 8, threadIdx.x == 0);
    if (MK_IN(0)) { prologue_part(p, lds, G, c, wid0); MK_SEAM(0); }
    layer_phases<0>(p, lds, bar, ph_lo, ph_hi, G, c, wid0);
    layer_phases<1>(p, lds, bar, ph_lo, ph_hi, G, c, wid0);
    if (MK_IN(N_PHASES - 1)) final_part(p, G, c, wid0);
}
#endif

#ifdef HOST_EMU
typedef int hipStream_t;
#endif
#define NBLK(n, t) (((long)(n) + (t) - 1) / (t))
#ifndef HOST_EMU
#ifndef MK_SPLIT
#define MK_SPLIT 0
#endif
extern "C" void kernel_launch(void* const* d_in, const int* in_sizes, int n_in, void* d_out, int out_size, void* d_ws, size_t ws_size, hipStream_t stream) {
    if (n_in != 16 || in_sizes[0] != NB * SEQ * D || out_size != NB * SEQ * D || ws_size < WS_NEED) { fprintf(stderr, "kernel_launch: unexpected shapes / workspace (%d inputs, ws %zu, need %zu)\n", n_in, ws_size, (size_t)WS_NEED); return; }
    static int grid = 0;
    if (grid == 0) { int dev = 0, cus = 0; (void)hipGetDevice(&dev); (void)hipDeviceGetAttribute(&cus, hipDeviceAttributeMultiprocessorCount, dev); grid = cus > 0 ? cus : 256;
        if (hipFuncSetAttribute((const void*)mk_fwd, hipFuncAttributeMaxDynamicSharedMemorySize, LDS_BYTES) != hipSuccess) { fprintf(stderr, "kernel_launch: hipFuncSetAttribute failed\n"); grid = -1; } }
    if (grid < 0) return;
    const Params p = make_params(d_in, d_out, d_ws);
    (void)hipMemsetAsync((char*)d_ws + O_CTL, 0, 65536, stream);
#if MK_SPLIT
    for (int ph = 0; ph < N_PHASES; ++ph) hipLaunchKernelGGL(mk_fwd, dim3(grid), dim3(512), LDS_BYTES, stream, p, ph, ph + 1);
#else
    hipLaunchKernelGGL(mk_fwd, dim3(grid), dim3(512), LDS_BYTES, stream, p, 0, N_PHASES);
#endif
}
#else
extern "C" void kernel_launch(void* const* d_in, const int* in_sizes, int n_in, void* d_out, int out_size, void* d_ws, size_t ws_size, hipStream_t stream) {
    if (n_in != 16 || in_sizes[0] != NB * SEQ * D || out_size != NB * SEQ * D || ws_size < WS_NEED) { fprintf(stderr, "kernel_launch: unexpected shapes / workspace (%d inputs, ws %zu, need %zu)\n", n_in, ws_size, (size_t)WS_NEED); return; }
    const Params p = make_params(d_in, d_out, d_ws);
    const int T = 256;
#if 0
        (void)hipFuncSetAttribute((const void*)k_gemm_fast<PK_P1>, hipFuncAttributeMaxDynamicSharedMemorySize, LDS_BYTES); hipFuncSetAttribute((const void*)k_gemm_fast<PK_P2>, hipFuncAttributeMaxDynamicSharedMemorySize, LDS_BYTES);
        hipFuncSetAttribute((const void*)k_gemm_fast<PK_P3B>, hipFuncAttributeMaxDynamicSharedMemorySize, LDS_BYTES); hipFuncSetAttribute((const void*)k_gemm_fast<PK_P4>, hipFuncAttributeMaxDynamicSharedMemorySize, LDS_BYTES);
        hipFuncSetAttribute((const void*)k_gemm_fast<PK_P5>, hipFuncAttributeMaxDynamicSharedMemorySize, LDS_BYTES);
        hipFuncSetAttribute((const void*)k_attn_fast<att::AK_P2>, hipFuncAttributeMaxDynamicSharedMemorySize, LDS_BYTES); hipFuncSetAttribute((const void*)k_attn_fast<att::AK_P3>, hipFuncAttributeMaxDynamicSharedMemorySize, LDS_BYTES); }
    (void)hipMemsetAsync((char*)d_ws + O_CTL, 0, 65536, stream);
#endif
    LAUNCH(k_tables, NBLK(NPOS * 16, T), T, p);
    for (int l = 0; l < DEPTH; ++l) {
        LAUNCH(k_prep_w<0>, NBLK((long)N1 * D, T), T, wptr(p, l, WL_W1), N1, D, p.w_in + (size_t)l * D * INC, INC, p.norm_g + l * D);
        LAUNCH(k_prep_w<1>, NBLK((long)2 * W * D, T), T, wptr(p, l, WL_WV), 2 * W, D, p.w_in + (size_t)l * D * INC, INC, p.norm_g + l * D);
        LAUNCH(k_prep_w<2>, NBLK((long)N3 * D, T), T, wptr(p, l, WL_W3), N3, D, p.w_in + (size_t)l * D * INC, INC, p.norm_g + l * D);
        LAUNCH(k_prep_w<3>, NBLK((long)QBW * QR, T), T, wptr(p, l, WL_UQ), QBW, QR, p.w_uq + (size_t)l * QR * QBW, QBW, p.cq_g + l * QR);
        LAUNCH(k_prep_w<4>, NBLK((long)W * KVR, T), T, wptr(p, l, WL_UK), W, KVR, p.w_ukv + (size_t)l * KVR * NH * 128, NH * 128, p.ckv_g + l * KVR);
        LAUNCH(k_prep_w<5>, NBLK((long)W * KVR, T), T, wptr(p, l, WL_UV), W, KVR, p.w_ukv + (size_t)l * KVR * NH * 128, NH * 128, p.ckv_g + l * KVR);
        LAUNCH(k_prep_w<6>, NBLK((long)D * W, T), T, wptr(p, l, WL_WO), D, W, p.w_osb + (size_t)l * W * D, D, (const float*)nullptr);
        LAUNCH(k_prep_w<6>, NBLK((long)D * W, T), T, wptr(p, l, WL_WO) + (size_t)D * W, D, W, p.w_omla + (size_t)l * W * D, D, (const float*)nullptr);
        LAUNCH(k_prep_w<6>, NBLK((long)D * W, T), T, wptr(p, l, WL_WO) + (size_t)2 * D * W, D, W, p.w_odiff + (size_t)l * W * D, D, (const float*)nullptr);
        LAUNCH(k_prep_w<6>, NBLK((long)D * D, T), T, wptr(p, l, WL_OUT), D, D, p.w_out + (size_t)l * D * D, D, (const float*)nullptr);
    }
    LAUNCH(k_init_x, NBLK((long)R * D, T), T, p);
    LAUNCH(k_ssq_f32, NBLK(R, 64), 64, (const float*)p.X, D, p.ssx, NSX);
    for (int l = 0; l < DEPTH; ++l) {
        const int last = (l == DEPTH - 1) ? 1 : 0; (void)last;
#ifndef HOST_EMU
        FASTG(PK_P1, l);
        FASTG(PK_P2, l);
#else
        LAUNCH(k_gemm<F1>, NBLK((long)R * (V1_END / 4), T), T, (const bf16_t*)p.XB, D, (const bf16_t*)wptr(p, l, WL_W1), D, R, V1_END, D, p, 0, 0);
        LAUNCH(k_gemm<F1>, NBLK((long)2 * W * (R / 4), T), T, (const bf16_t*)wptr(p, l, WL_WV), D, (const bf16_t*)p.XB, D, 2 * W, R, D, p, 0, 1);
        LAUNCH(k_ssq_bf, NBLK(R, 64), 64, (const bf16_t*)p.CQ, QR, p.ssq, NSQ);
        LAUNCH(k_ssq_bf, NBLK(R, 64), 64, (const bf16_t*)p.CKV, KVR, p.ssk, NSK);
        LAUNCH(k_gemm<FUQ>, NBLK((long)R * (QBW / 4), T), T, (const bf16_t*)p.CQ, QR, (const bf16_t*)wptr(p, l, WL_UQ), QR, R, QBW, QR, p, 0, 0);
        LAUNCH(k_gemm<FUK>, NBLK((long)R * (W / 4), T), T, (const bf16_t*)p.CKV, KVR, (const bf16_t*)wptr(p, l, WL_UK), KVR, R, W, KVR, p, 0, 0);
        LAUNCH(k_gemm<FUK>, NBLK((long)W * (R / 4), T), T, (const bf16_t*)wptr(p, l, WL_UV), KVR, (const bf16_t*)p.CKV, KVR, W, R, KVR, p, 0, 1);
#endif
#ifndef HOST_EMU
        hipLaunchKernelGGL(k_attn_fast<att::AK_P2>, dim3(grid), dim3(512), LDS_BYTES, stream, p, l);
        hipLaunchKernelGGL(k_attn_fast<att::AK_P3>, dim3(grid), dim3(512), LDS_BYTES, stream, p, l);
#else
        LAUNCH(k_attn_sb, NBLK((long)NB * NH * TB, 64), 64, p);
        LAUNCH(k_attn_diff, NBLK((long)NB * NHD * TB, 64), 64, p, l);
        LAUNCH(k_attn_mla, NBLK((long)NB * NH * TB, 64), 64, p);
#endif
        LAUNCH(k_x2bf, NBLK((long)R * D, T), T, p);
#ifndef HOST_EMU
        FASTG(PK_P3B, l); FASTG(PK_P4, l); FASTG(PK_P5, l);
#else
        LAUNCH(k_gemm<F3>, NBLK((long)R * (N3 / 4), T), T, (const bf16_t*)p.XB2, D, (const bf16_t*)wptr(p, l, WL_W3), D, R, N3, D, p, l, 0);
        LAUNCH(k_gemm<F4>, NBLK((long)R * (D / 4), T), T, (const bf16_t*)p.QSB, W, (const bf16_t*)wptr(p, l, WL_WO), W, R, D, W, p, 0, 0);
        LAUNCH(k_gemm<F4>, NBLK((long)R * (D / 4), T), T, (const bf16_t*)p.OMLA, W, (const bf16_t*)(wptr(p, l, WL_WO) + (size_t)D * W), W, R, D, W, p, 0, 5);
        LAUNCH(k_gemm<F4>, NBLK((long)R * (D / 4), T), T, (const bf16_t*)p.QD, W, (const bf16_t*)(wptr(p, l, WL_WO) + (size_t)2 * D * W), W, R, D, W, p, 0, 6);
        LAUNCH(k_gemm<F5>, NBLK((long)R * (D / 4), T), T, (const bf16_t*)p.G0, D, (const bf16_t*)wptr(p, l, WL_OUT), D, R, D, D, p, last, 0);
        if (!last) LAUNCH(k_ssq_f32, NBLK(R, 64), 64, (const float*)p.X, D, p.ssx, NSX);
#endif
    }
    LAUNCH(k_final, NBLK((long)NB * SEQ, 64), 64, p);
}
#endif
```

```cpp
#ifndef HOST_EMU
#include <hip/hip_runtime.h>
#endif
#include <cstdio>
#include <cstdint>
#include <cmath>
#include <cstring>

#ifndef CFG_B
#define CFG_B 8
#endif
#ifndef CFG_S
#define CFG_S 2048
#endif
#ifndef CFG_D
#define CFG_D 1024
#endif

typedef unsigned short bf16_t;

namespace cfg {
constexpr int NB = CFG_B, SEQ = CFG_S, D = CFG_D, DEPTH = 2;
constexpr int NMETA = 16, LEAD = 48, TB = LEAD + NMETA + SEQ, R = NB * TB, NPOS = NMETA + SEQ;
constexpr int W = D / 2;
constexpr int NH = D / 128;
constexpr int NHD = D / 256;
constexpr int QR = 3 * D / 8, KVR = D / 4, QBW = NH * 96;
constexpr int INC = 4 * W + QR + KVR + 32 + W + 4 * W + 3 * D;
constexpr int C_SBQ = 0, C_SBK = W, C_SBV = 2 * W, C_SBZ = 3 * W, C_CQ = 4 * W, C_CKV = C_CQ + QR, C_KR = C_CKV + KVR, C_MZ = C_KR + 32,
              C_DQ = C_MZ + W, C_DK = C_DQ + W, C_DV = C_DK + W, C_DZ = C_DV + W, C_G = C_DZ + W;
static_assert(C_G + 3 * D == INC, "w_in columns");
constexpr int V1_SBQ = 0, V1_SBK = W, V1_CQ = 2 * W, V1_CKV = V1_CQ + QR, V1_KR = V1_CKV + KVR, V1_DQ = V1_KR + 32, V1_DK = V1_DQ + W, V1_END = V1_DK + W;
constexpr int N1 = (V1_END + 255) / 256 * 256;
constexpr int N3 = 3 * W + 3 * D;
constexpr int NSX = D / 32, NSQ = QR / 32, NSK = KVR / 32;
constexpr float EPS = 1e-6f, LOG2E = 1.4426950408889634f;
constexpr int GP = D / 256;
}
using namespace cfg;

constexpr size_t MiB = size_t(1) << 20;
constexpr size_t al256(size_t x) { return (x + 255) & ~size_t(255); }
constexpr size_t SZ_W = (size_t)R * W * 2, SZ_D2 = (size_t)R * D * 2, SZ_X = (size_t)R * D * 4, SZ_CQ = (size_t)R * QR * 2, SZ_CKV = (size_t)R * KVR * 2,
                 SZ_KR = (size_t)R * 32 * 2, SZ_QB = (size_t)R * QBW * 2, SZ_GP = (size_t)R * 256 * 2;
constexpr size_t WB_W1 = (size_t)N1 * D * 2, WB_WV = (size_t)2 * W * D * 2, WB_W3 = (size_t)N3 * D * 2, WB_UQ = (size_t)QBW * QR * 2, WB_UK = (size_t)W * KVR * 2,
                 WB_UV = WB_UK, WB_WO = (size_t)3 * D * W * 2, WB_OUT = (size_t)D * D * 2;
constexpr size_t WL_W1 = 0, WL_WV = WL_W1 + WB_W1, WL_W3 = WL_WV + WB_WV, WL_UQ = WL_W3 + WB_W3, WL_UK = WL_UQ + WB_UQ, WL_UV = WL_UK + WB_UK, WL_WO = WL_UV + WB_UV,
                 WL_OUT = WL_WO + WB_WO, WL_BYTES = al256(WL_OUT + WB_OUT);
constexpr bool STDCFG = (NB == 8 && SEQ == 2048 && D == 1024);
#if defined(HOST_EMU)
constexpr bool HANDMAP = false;
#else
constexpr bool HANDMAP = STDCFG;
#endif
constexpr size_t O_CTL = 0, O_TAB = 1 * MiB, O_LAM = O_TAB + 768 * 1024, O_SSX = 2 * MiB, O_SSQ = O_SSX + al256((size_t)R * NSX * 4), O_SSK = O_SSQ + al256((size_t)R * NSQ * 4),
                 O_WTS = al256(O_SSK + (size_t)R * NSK * 4 + MiB) / MiB * MiB;
constexpr size_t O_X = HANDMAP ? 52 * MiB : al256(O_WTS + 2 * WL_BYTES);
static_assert(O_WTS + 2 * WL_BYTES <= O_X, "weights overrun X");
constexpr size_t O_A = O_X + al256(SZ_X);
constexpr size_t Q_QSB = O_A, Q_QD = Q_QSB + al256(SZ_W), Q_OMLA = Q_QD + al256(SZ_W), Q_KSB = Q_OMLA + al256(SZ_W), Q_VSBT = Q_KSB + al256(SZ_W), Q_KD = Q_VSBT + al256(SZ_W),
                 Q_VDT = Q_KD + al256(SZ_W), Q_VBT = Q_VDT + al256(SZ_W), Q_KR = Q_VBT + al256(SZ_W), Q_CKV = Q_KR + al256(SZ_KR), Q_XB2 = Q_CKV + al256(SZ_CKV), Q_G0 = Q_XB2 + al256(SZ_D2),
                 Q_GPC = Q_G0 + al256(SZ_D2), Q_XB = Q_GPC + 2 * GP * al256(SZ_GP), Q_QB = Q_XB + al256(SZ_D2), Q_CQ = Q_QB + al256(SZ_QB), Q_KNOPE = Q_CQ + al256(SZ_CQ), Q_END = Q_KNOPE + al256(SZ_W);
constexpr size_t WS_NEED = HANDMAP ? 256 * MiB : Q_END;

struct Params {
    const float *x, *meta, *norm_g, *w_in, *b_gate, *cq_g, *ckv_g, *w_uq, *w_ukv, *dlam, *dnorm_g, *w_osb, *w_omla, *w_odiff, *w_out, *final_g;
    float* out;
    float *X, *ssx, *ssq, *ssk, *cosm, *sinm, *cosd, *sind, *lamv;
    char* WTS;
    bf16_t *XB, *XB2, *QSB, *KSB, *VSBT, *QD, *KD, *VDT, *CQ, *CKV, *KR, *QB, *KNOPE, *VBT, *OMLA, *G0, *GPW, *GPO;
    unsigned* ctl;
};

static Params make_params(void* const* d_in, void* d_out, void* d_ws) {
    Params p{};
    const float* const* in = (const float* const*)d_in;
    p.x = in[0]; p.meta = in[1]; p.norm_g = in[2]; p.w_in = in[3]; p.b_gate = in[4]; p.cq_g = in[5]; p.ckv_g = in[6]; p.w_uq = in[7]; p.w_ukv = in[8]; p.dlam = in[9];
    p.dnorm_g = in[10]; p.w_osb = in[11]; p.w_omla = in[12]; p.w_odiff = in[13]; p.w_out = in[14]; p.final_g = in[15];
    p.out = (float*)d_out;
    char* ws = (char*)d_ws; char* ob = (char*)d_out;
    p.ctl = (unsigned*)(ws + O_CTL);
    p.cosm = (float*)(ws + O_TAB); p.sinm = p.cosm + NPOS * 16; p.cosd = p.sinm + NPOS * 16; p.sind = p.cosd + NPOS * 8; p.lamv = (float*)(ws + O_LAM);
    p.ssx = (float*)(ws + O_SSX); p.ssq = (float*)(ws + O_SSQ); p.ssk = (float*)(ws + O_SSK);
    p.WTS = ws + O_WTS;
    p.X = (float*)(ws + O_X);
    if (HANDMAP) {
        auto A = [&](double mib) { return (bf16_t*)(ws + (size_t)(mib * 1048576.0)); };
        auto Bq = [&](double mib) { return (bf16_t*)(ob + (size_t)(mib * 1048576.0)); };
        p.QSB = A(118); p.QD = A(134.5); p.OMLA = A(151); p.CKV = A(151); p.KSB = A(167.5); p.VSBT = A(184); p.KD = A(200.5); p.VDT = A(217); p.VBT = A(233.5); p.KR = A(250);
        p.XB2 = A(167.5); p.G0 = A(200.5);
        p.XB = Bq(0); p.QB = Bq(0); p.CQ = Bq(33); p.KNOPE = Bq(45.5);
        p.GPW = A(233.5); p.GPO = Bq(0);
    } else {
        auto A = [&](size_t off) { return (bf16_t*)(ws + off); };
        p.QSB = A(Q_QSB); p.QD = A(Q_QD); p.OMLA = A(Q_OMLA); p.CKV = A(Q_CKV); p.KSB = A(Q_KSB); p.VSBT = A(Q_VSBT); p.KD = A(Q_KD); p.VDT = A(Q_VDT); p.VBT = A(Q_VBT); p.KR = A(Q_KR);
        p.XB2 = A(Q_XB2); p.G0 = A(Q_G0); p.XB = A(Q_XB); p.QB = A(Q_QB); p.CQ = A(Q_CQ); p.KNOPE = A(Q_KNOPE);
        p.GPW = A(Q_GPC); p.GPO = A(Q_GPC);
    }
    return p;
}
static_assert(!STDCFG || (SZ_W == (size_t)(16.5 * 1048576) && SZ_D2 == 33 * MiB && SZ_GP == (size_t)(8.25 * 1048576) && SZ_QB == (size_t)(24.75 * 1048576) && SZ_CQ <= (size_t)(12.5 * 1048576) &&
              SZ_KR <= (size_t)(1.1 * 1048576) && SZ_X == 66 * MiB && GP == 4), "hand map sizes");

#ifdef HOST_EMU
#define DEVFN inline
#define HDFN inline
#else
#define DEVFN __device__ __forceinline__
#define HDFN __host__ __device__ __forceinline__
#endif
#ifdef HOST_EMU
template <class T> DEVFN T* opq(T* p) { return p; }
#else
DEVFN int lane_id_v() { int l; asm volatile("v_mbcnt_lo_u32_b32 %0, -1, 0\n\tv_mbcnt_hi_u32_b32 %0, -1, %0" : "=v"(l)); return l; }
template <class T> DEVFN T* opq(T* p) { asm volatile("" : "+s"(p)); return p; }
#endif
DEVFN float bf2f(bf16_t h) { unsigned u = (unsigned)h << 16; float f; memcpy(&f, &u, 4); return f; }
DEVFN bf16_t f2bf(float f) { unsigned u; memcpy(&u, &f, 4); return (bf16_t)((u + 0x7fffu + ((u >> 16) & 1u)) >> 16); }
struct alignas(16) U4 { unsigned x, y, z, w; };
DEVFN void ld8(const bf16_t* p, float* o) {
    const U4 v = *(const U4*)p; const unsigned u[4] = {v.x, v.y, v.z, v.w};
#pragma unroll
    for (int i = 0; i < 4; ++i) { unsigned lo = u[i] << 16, hi = u[i] & 0xffff0000u; memcpy(&o[2 * i], &lo, 4); memcpy(&o[2 * i + 1], &hi, 4); }
}
DEVFN float rsq(float x) { return 1.0f / sqrtf(x); }
DEVFN float rstd_slots(const float* s, int row, int ns, float invn) { float t = 0.f; for (int i = 0; i < ns; ++i) t += s[(size_t)row * ns + i]; return rsq(t * invn + EPS); }
DEVFN int sperm(int r) { return (r & ~12) | ((r & 4) << 1) | ((r & 8) >> 1); }
constexpr int NPW = HANDMAP ? 2 : 2 * GP;
DEVFN bf16_t* gptr(const Params& p, int b, int row, int c) {
    bf16_t* const g0 = opq(p.G0); bf16_t* const gw = opq(p.GPW); bf16_t* const go = opq(p.GPO);
    if (b == 0) return g0 + (size_t)row * D + c;
    const int j = (b - 1) * GP + (c >> 8); bf16_t* base = j < NPW ? gw + (size_t)j * (al256(SZ_GP) / 2) : go + (size_t)(j - NPW) * (al256(SZ_GP) / 2);
    return base + (size_t)row * 256 + (c & 255);
}
HDFN bf16_t* wptr(const Params& p, int l, size_t off) { return (bf16_t*)(p.WTS + (size_t)l * WL_BYTES + off); }
DEVFN float silu_f(float z) { return z / (1.f + expf(-z)); }
DEVFN float sigm_f(float z) { return 1.f / (1.f + expf(-z)); }
struct alignas(8) U2 { unsigned x, y; };
#ifdef HOST_EMU
DEVFN unsigned pk2(float lo, float hi) { return (unsigned)f2bf(lo) | ((unsigned)f2bf(hi) << 16); }
#else
typedef float f32x2_t __attribute__((ext_vector_type(2))); typedef __bf16 bf16x2_t __attribute__((ext_vector_type(2)));
DEVFN unsigned pk2(float lo, float hi) { f32x2_t v = {lo, hi}; bf16x2_t b = __builtin_convertvector(v, bf16x2_t); return __builtin_bit_cast(unsigned, b); }
#endif
DEVFN void st4(bf16_t* p, float a, float b, float c, float d) { U2 v; v.x = pk2(a, b); v.y = pk2(c, d); *(U2*)p = v; }
DEVFN void st2(bf16_t* p, float a, float b) { *(unsigned*)p = pk2(a, b); }
DEVFN void ld4(const bf16_t* p, float* o) { const U2 v = *(const U2*)p; unsigned t; t = v.x << 16; memcpy(&o[0], &t, 4); t = v.x & 0xffff0000u; memcpy(&o[1], &t, 4); t = v.y << 16; memcpy(&o[2], &t, 4); t = v.y & 0xffff0000u; memcpy(&o[3], &t, 4); }

DEVFN int rotmap(int c, int half) { const int g = c >> 2, e = c & 3; return e < 2 ? 2 * g + e : half + 2 * g + (e - 2); }
DEVFN int src_w1(int n) {
    if (n < V1_SBK) return C_SBQ + n;
    if (n < V1_CQ) return C_SBK + (n - V1_SBK);
    if (n < V1_CKV) return C_CQ + (n - V1_CQ);
    if (n < V1_KR) return C_CKV + (n - V1_CKV);
    if (n < V1_DQ) return C_KR + rotmap(n - V1_KR, 16);
    if (n < V1_DK) { const int c = n - V1_DQ, cc = c & 63; return C_DQ + (c & ~63) + (cc < 16 ? rotmap(cc, 8) : cc); }
    if (n < V1_END) { const int c = n - V1_DK, cc = c & 63; return C_DK + (c & ~63) + (cc < 16 ? rotmap(cc, 8) : cc); }
    return -1;
}
DEVFN int src_wv(int n) { return n < W ? C_SBV + n : C_DV + (n - W); }
DEVFN int src_w3(int n) { return n < W ? C_SBZ + n : n < 2 * W ? C_MZ + (n - W) : n < 3 * W ? C_DZ + (n - 2 * W) : C_G + (n - 3 * W); }
DEVFN int src_uq(int n) { const int h = n / 96, cc = n % 96; return h * 96 + (cc < 64 ? cc : 64 + rotmap(cc - 64, 16)); }
DEVFN int src_uk(int n) { return (n >> 6) * 128 + (n & 63); }
DEVFN int src_uv(int n) { return (n >> 6) * 128 + 64 + (n & 63); }

#ifdef HOST_EMU
DEVFN float quad_sum(float s) { return s; }
#else
template <int CTRL> DEVFN float dpp_get(float s) { return __int_as_float(__builtin_amdgcn_update_dpp(0, __float_as_int(s), CTRL, 0xf, 0xf, true)); }
DEVFN float xor16_sum(float s) { auto r = __builtin_amdgcn_permlane16_swap(__float_as_uint(s), __float_as_uint(s), false, false); return __uint_as_float(r[0]) + __uint_as_float(r[1]); }
DEVFN float xor32_sum(float s) { auto r = __builtin_amdgcn_permlane32_swap(__float_as_uint(s), __float_as_uint(s), false, false); return __uint_as_float(r[0]) + __uint_as_float(r[1]); }
DEVFN float quad_sum(float s) { return xor32_sum(xor16_sum(s)); }
DEVFN float quad4_sum(float s) { s += dpp_get<0xB1>(s); s += dpp_get<0x4E>(s); return s; }
DEVFN float wave_sum(float s) { s = quad4_sum(s); s += dpp_get<0x124>(s); s += dpp_get<0x128>(s); return xor32_sum(xor16_sum(s)); }
#endif
struct F1 {
    const Params& p; int aux;
    DEVFN bool swapped(int tag) const { return tag == 1; }
    DEVFN float scale(int tag, int idx) const { return rstd_slots(p.ssx, idx, NSX, 1.0f / D); }
    DEVFN float operator()(int tag, int row, int vc, const float* a, const float* sc) const {
        if (tag == 1) { bf16_t* const vs = opq(p.VSBT); bf16_t* const vd = opq(p.VDT); bf16_t* o = (row < W ? vs + (size_t)row * R : vd + (size_t)(row - W) * R) + ((vc & ~15) | sperm(vc & 15)); st4(o, a[0] * sc[0], a[1] * sc[1], a[2] * sc[2], a[3] * sc[3]); return 0.f; }
        const float rs = sc[0]; const float v0 = a[0] * rs, v1 = a[1] * rs, v2 = a[2] * rs, v3 = a[3] * rs;
        const int t = row % TB; const int pos = t >= LEAD ? t - LEAD : 0;
        if (vc < V1_SBK) { st4(p.QSB + (size_t)row * W + vc, v0 * (0.125f * LOG2E), v1 * (0.125f * LOG2E), v2 * (0.125f * LOG2E), v3 * (0.125f * LOG2E)); }
        else if (vc < V1_CQ) { st4(p.KSB + (size_t)row * W + (vc - V1_SBK), v0, v1, v2, v3); }
        else if (vc < V1_CKV) { st4(p.CQ + (size_t)row * QR + (vc - V1_CQ), v0, v1, v2, v3); return (v0 * v0 + v1 * v1) + (v2 * v2 + v3 * v3); }
        else if (vc < V1_KR) { st4(p.CKV + (size_t)row * KVR + (vc - V1_CKV), v0, v1, v2, v3); return (v0 * v0 + v1 * v1) + (v2 * v2 + v3 * v3); }
        else if (vc < V1_DQ) { const int g = (vc - V1_KR) >> 2; const float c0 = p.cosm[pos * 16 + 2 * g], c1 = p.cosm[pos * 16 + 2 * g + 1], s0 = p.sinm[pos * 16 + 2 * g], s1 = p.sinm[pos * 16 + 2 * g + 1];
            bf16_t* o = p.KR + (size_t)row * 32; st2(o + 2 * g, v0 * c0 - v2 * s0, v1 * c1 - v3 * s1); st2(o + 16 + 2 * g, v2 * c0 + v0 * s0, v3 * c1 + v1 * s1); }
        else if (vc < V1_END) { const bool isq = vc < V1_DK; const int c = vc - (isq ? V1_DQ : V1_DK), cc = c & 63; const float sc2 = isq ? 0.125f * LOG2E : 1.0f;
            bf16_t* const qd = opq(p.QD); bf16_t* const kd = opq(p.KD); bf16_t* o = (isq ? qd : kd) + (size_t)row * W + (c & ~63);
            if (cc < 16) { const int g = cc >> 2; const float c0 = p.cosd[pos * 8 + 2 * g], c1 = p.cosd[pos * 8 + 2 * g + 1], s0 = p.sind[pos * 8 + 2 * g], s1 = p.sind[pos * 8 + 2 * g + 1];
                st2(o + 2 * g, (v0 * c0 - v2 * s0) * sc2, (v1 * c1 - v3 * s1) * sc2); st2(o + 8 + 2 * g, (v2 * c0 + v0 * s0) * sc2, (v3 * c1 + v1 * s1) * sc2); }
            else st4(o + cc, v0 * sc2, v1 * sc2, v2 * sc2, v3 * sc2); }
        return 0.f;
    }
    DEVFN void rowslot(int tag, int row, int vc0, int fq, float part) const {
        if (tag != 0 || vc0 < V1_CQ || vc0 >= V1_KR) return;
        const float s = quad_sum(part);
        if (fq == 0) { if (vc0 < V1_CKV) p.ssq[(size_t)row * NSQ + ((vc0 - V1_CQ) >> 5)] = s; else p.ssk[(size_t)row * NSK + ((vc0 - V1_CKV) >> 5)] = s; }
    }
};
struct FUQ {
    const Params& p; int aux;
    DEVFN bool swapped(int) const { return false; }
    DEVFN float scale(int, int idx) const { return rstd_slots(p.ssq, idx, NSQ, 1.0f / QR) * (LOG2E * 0.10206207261596577f); }
    DEVFN float operator()(int, int row, int vc, const float* a, const float* sc) const {
        const float rs = sc[0]; const float v0 = a[0] * rs, v1 = a[1] * rs, v2 = a[2] * rs, v3 = a[3] * rs;
        const int t = row % TB; const int pos = t >= LEAD ? t - LEAD : 0;
        const int h = vc / 96, cc = vc % 96; bf16_t* o = p.QB + (size_t)row * QBW + h * 96;
        if (cc < 64) st4(o + cc, v0, v1, v2, v3);
        else { const int g = (cc - 64) >> 2; const float c0 = p.cosm[pos * 16 + 2 * g], c1 = p.cosm[pos * 16 + 2 * g + 1], s0 = p.sinm[pos * 16 + 2 * g], s1 = p.sinm[pos * 16 + 2 * g + 1];
            st2(o + 64 + 2 * g, v0 * c0 - v2 * s0, v1 * c1 - v3 * s1); st2(o + 80 + 2 * g, v2 * c0 + v0 * s0, v3 * c1 + v1 * s1); }
        return 0.f;
    }
    DEVFN void rowslot(int, int, int, int, float) const {}
};
struct FUK {
    const Params& p; int aux;
    DEVFN bool swapped(int tag) const { return tag == 1; }
    DEVFN float scale(int, int idx) const { return rstd_slots(p.ssk, idx, NSK, 1.0f / KVR); }
    DEVFN float operator()(int tag, int row, int vc, const float* a, const float* sc) const {
        if (tag == 1) st4(p.VBT + (size_t)row * R + ((vc & ~15) | sperm(vc & 15)), a[0] * sc[0], a[1] * sc[1], a[2] * sc[2], a[3] * sc[3]);
        else st4(p.KNOPE + (size_t)row * W + vc, a[0] * sc[0], a[1] * sc[0], a[2] * sc[0], a[3] * sc[0]);
        return 0.f;
    }
    DEVFN void rowslot(int, int, int, int, float) const {}
};
struct F3 {
    const Params& p; int layer;
    DEVFN bool swapped(int) const { return false; }
    DEVFN float scale(int, int idx) const { return rstd_slots(p.ssx, idx, NSX, 1.0f / D); }
    DEVFN float operator()(int, int row, int vc, const float* a, const float* sc) const {
        const float rs = sc[0];
        if (vc < 3 * W) { bf16_t* const o0 = opq(p.QSB); bf16_t* const o1 = opq(p.OMLA); bf16_t* const o2 = opq(p.QD); bf16_t* o = (vc < W ? o0 : vc < 2 * W ? o1 : o2) + (size_t)row * W + (vc % W); float ov[4]; ld4(o, ov);
            st4(o, ov[0] * silu_f(a[0] * rs), ov[1] * silu_f(a[1] * rs), ov[2] * silu_f(a[2] * rs), ov[3] * silu_f(a[3] * rs)); }
        else { const int c = vc - 3 * W, b = c / D, cc = c % D; const float* bg = p.b_gate + (size_t)layer * 3 * D + c;
            st4(gptr(p, b, row, cc), sigm_f(a[0] * rs + bg[0]), sigm_f(a[1] * rs + bg[1]), sigm_f(a[2] * rs + bg[2]), sigm_f(a[3] * rs + bg[3])); }
        return 0.f;
    }
    DEVFN void rowslot(int, int, int, int, float) const {}
};
struct F4 {
    const Params& p; int aux;
    DEVFN bool swapped(int) const { return false; }
    DEVFN float scale(int, int) const { return 1.f; }
    DEVFN float operator()(int tag, int row, int c, const float* a, const float*) const {
        float g[4], m[4] = {0.f, 0.f, 0.f, 0.f}; ld4(gptr(p, tag & 3, row, c), g); bf16_t* mp = p.G0 + (size_t)row * D + c; if (tag >> 2) ld4(mp, m);
        st4(mp, m[0] + g[0] * a[0], m[1] + g[1] * a[1], m[2] + g[2] * a[2], m[3] + g[3] * a[3]); return 0.f;
    }
    DEVFN void rowslot(int, int, int, int, float) const {}
};
struct F5 {
    const Params& p; int last;
    DEVFN bool swapped(int) const { return false; }
    DEVFN float scale(int, int) const { return 1.f; }
    DEVFN float operator()(int, int row, int c, const float* a, const float*) const {
        float* x = p.X + (size_t)row * D + c; const float v0 = x[0] + a[0], v1 = x[1] + a[1], v2 = x[2] + a[2], v3 = x[3] + a[3];
        x[0] = v0; x[1] = v1; x[2] = v2; x[3] = v3; if (!last) st4(p.XB + (size_t)row * D + c, v0, v1, v2, v3);
        return (v0 * v0 + v1 * v1) + (v2 * v2 + v3 * v3);
    }
    DEVFN void rowslot(int, int row, int vc0, int fq, float part) const { const float s = quad_sum(part); if (fq == 0) p.ssx[(size_t)row * NSX + (vc0 >> 5)] = s; }
};

#ifdef HOST_EMU
struct dim3e { unsigned x, y, z; };
static dim3e threadIdx, blockIdx, blockDim, gridDim;
#define GLOBAL static
#define LB64
#define LAUNCH(kern, nblk, nthr, ...) do { gridDim.x = (unsigned)(nblk); blockDim.x = (unsigned)(nthr); for (unsigned b_ = 0; b_ < gridDim.x; ++b_) for (unsigned t_ = 0; t_ < blockDim.x; ++t_) { blockIdx.x = b_; threadIdx.x = t_; kern(__VA_ARGS__); } } while (0)
#else
#define GLOBAL __global__
#define LB64 __launch_bounds__(64)
#define LAUNCH(kern, nblk, nthr, ...) kern<<<dim3((unsigned)(nblk)), dim3((unsigned)(nthr)), 0, stream>>>(__VA_ARGS__)
#endif
#define GTID ((long)blockIdx.x * blockDim.x + threadIdx.x)

#ifdef HOST_EMU
template <int MAP> GLOBAL void k_prep_w(bf16_t* dst, int N, int K, const float* src, int src_ld, const float* rowscale) {
    const long i = GTID; if (i >= (long)N * K) return;
    const int n = (int)(i % N), k = (int)(i / N);
    int s;
    if (MAP == 0) s = src_w1(n); else if (MAP == 1) s = src_wv(n); else if (MAP == 2) s = src_w3(n); else if (MAP == 3) s = src_uq(n); else if (MAP == 4) s = src_uk(n); else if (MAP == 5) s = src_uv(n); else s = n;
    float v = 0.f; if (s >= 0) v = src[(size_t)k * src_ld + s] * (rowscale ? rowscale[k] : 1.f);
    dst[(size_t)n * K + k] = f2bf(v);
}
GLOBAL void k_tables(Params p) {
    const long i = GTID;
    if (i < NPOS * 16) { const int pos = (int)(i / 16), j = (int)(i % 16); const float inv = (float)pow(500000.0, -(double)(2 * j) / 32.0); const float ang = (float)pos * inv;
        p.cosm[i] = (float)cos((double)ang); p.sinm[i] = (float)sin((double)ang); }
    if (i < NPOS * 8) { const int pos = (int)(i / 8), j = (int)(i % 8); const float inv = (float)pow(500000.0, -(double)(2 * j) / 16.0); const float ang = (float)pos * inv;
        p.cosd[i] = (float)cos((double)ang); p.sind[i] = (float)sin((double)ang); }
    if (i < DEPTH) { const float* lm = p.dlam + i * 4 * 64; float s0 = 0.f, s1 = 0.f; for (int d = 0; d < 64; ++d) { s0 += lm[d] * lm[64 + d]; s1 += lm[128 + d] * lm[192 + d]; }
        p.lamv[i] = expf(s0) - expf(s1) + (0.8f - 0.6f * expf(-0.3f * (float)i)); }
}
GLOBAL void k_init_x(Params p) {
    const long i = GTID; if (i >= (long)R * D) return;
    const int row = (int)(i / D), c = (int)(i % D), b = row / TB, t = row % TB;
    const float v = t < LEAD ? 0.f : t < LEAD + NMETA ? p.meta[(t - LEAD) * D + c] : p.x[((size_t)b * SEQ + (t - LEAD - NMETA)) * D + c];
    p.X[i] = v; p.XB[i] = f2bf(v);
}
GLOBAL void k_x2bf(Params p) { const long i = GTID; if (i >= (long)R * D) return; p.XB2[i] = f2bf(p.X[i]); }
GLOBAL void k_ssq_f32(const float* X, int n, float* slots, int ns) {
    const long row = GTID; if (row >= R) return; float s = 0.f; for (int c = 0; c < n; ++c) { const float v = X[(size_t)row * n + c]; s += v * v; }
    slots[row * ns] = s; for (int i = 1; i < ns; ++i) slots[row * ns + i] = 0.f;
}
GLOBAL void k_ssq_bf(const bf16_t* X, int n, float* slots, int ns) {
    const long row = GTID; if (row >= R) return; float s = 0.f; for (int c = 0; c < n; ++c) { const float v = bf2f(X[(size_t)row * n + c]); s += v * v; }
    slots[row * ns] = s; for (int i = 1; i < ns; ++i) slots[row * ns + i] = 0.f;
}
GLOBAL void k_final(Params p) {
    const long i = GTID; if (i >= (long)NB * SEQ) return;
    const int b = (int)(i / SEQ), s = (int)(i % SEQ); const float* x = p.X + ((size_t)b * TB + LEAD + NMETA + s) * D; float ss = 0.f;
    for (int c = 0; c < D; ++c) ss += x[c] * x[c];
    const float rs = rsq(ss / D + EPS); float* o = p.out + (size_t)i * D;
    for (int c = 0; c < D; ++c) o[c] = x[c] * rs * p.final_g[c];
}

template <class Epi> GLOBAL void k_gemm(const bf16_t* A, int lda, const bf16_t* Bt, int ldb, int M, int N, int K, Params pp, int aux, int tag) {
    const Epi epi{pp, aux};
    const long idx = GTID; const int n4 = N / 4; if (idx >= (long)M * n4) return;
    const int m = (int)(idx / n4), n0 = (int)(idx % n4) * 4;
    float acc[4] = {0.f, 0.f, 0.f, 0.f};
    const bf16_t* a = A + (size_t)m * lda; const bf16_t* b0 = Bt + (size_t)n0 * ldb;
    for (int k = 0; k < K; k += 8) {
        float av[8]; ld8(a + k, av);
#pragma unroll
        for (int i = 0; i < 4; ++i) { float bv[8]; ld8(b0 + (size_t)i * ldb + k, bv); float s = 0.f;
#pragma unroll
            for (int j = 0; j < 8; ++j) s += av[j] * bv[j];
            acc[i] += s; }
    }
    float sc[4]; if (epi.swapped(tag)) { for (int i = 0; i < 4; ++i) sc[i] = epi.scale(tag, n0 + i); } else sc[0] = epi.scale(tag, m);
    epi(tag, m, n0, acc, sc);
}

GLOBAL void LB64 k_attn_sb(Params p) {
    const long i = GTID; if (i >= (long)NB * NH * TB) return;
    const int t = (int)(i % TB), h = (int)((i / TB) % NH), b = (int)(i / ((long)TB * NH));
    const size_t row = (size_t)b * TB + t; bf16_t* qo = p.QSB + row * W + h * 64;
    float q[64], o[64];
#pragma unroll
    for (int d = 0; d < 64; ++d) { q[d] = bf2f(qo[d]); o[d] = 0.f; }
    if (t >= LEAD) {
        float carry = 0.f;
        for (int j = t - 1; j >= LEAD; --j) {
            const size_t kr = (size_t)b * TB + j; const bf16_t* k = p.KSB + kr * W + h * 64; float z = 0.f;
#pragma unroll
            for (int d = 0; d < 64; ++d) z += q[d] * bf2f(k[d]);
            const float sp = fmaxf(z, 0.f) + log2f(1.f + exp2f(-fabsf(z)));
            const float w = exp2f((z - sp) + carry); carry -= sp;
            const bf16_t* vt = p.VSBT + (size_t)(h * 64) * R + ((kr & ~(size_t)15) | sperm((int)(kr & 15)));
#pragma unroll
            for (int d = 0; d < 64; ++d) o[d] += w * bf2f(vt[(size_t)d * R]);
        }
    }
#pragma unroll
    for (int d = 0; d < 64; ++d) qo[d] = f2bf(o[d]);
}
GLOBAL void LB64 k_attn_mla(Params p) {
    const long i = GTID; if (i >= (long)NB * NH * TB) return;
    const int t = (int)(i % TB), h = (int)((i / TB) % NH), b = (int)(i / ((long)TB * NH));
    const size_t row = (size_t)b * TB + t; const bf16_t* qp = p.QB + row * QBW + h * 96;
    float o[64]; float m = -INFINITY, l = 0.f;
#pragma unroll
    for (int d = 0; d < 64; ++d) o[d] = 0.f;
    if (t >= LEAD) {
        const int kend = (t / 64 + 1) * 64 < TB ? (t / 64 + 1) * 64 : TB;
        for (int j = LEAD; j < kend; ++j) {
            const size_t kr = (size_t)b * TB + j; const bf16_t* kn = p.KNOPE + kr * W + h * 64; const bf16_t* kq = p.KR + kr * 32; float s = 0.f;
            for (int d = 0; d < 64; ++d) s += bf2f(qp[d]) * bf2f(kn[d]);
            for (int d = 0; d < 32; ++d) s += bf2f(qp[64 + d]) * bf2f(kq[d]);
            const float mn = fmaxf(m, s), f = exp2f(m - mn), w = exp2f(s - mn); m = mn; l = l * f + w;
            const bf16_t* vt = p.VBT + (size_t)(h * 64) * R + ((kr & ~(size_t)15) | sperm((int)(kr & 15)));
#pragma unroll
            for (int d = 0; d < 64; ++d) o[d] = o[d] * f + w * bf2f(vt[(size_t)d * R]);
        }
    }
    const float il = l > 0.f ? 1.f / l : 0.f; bf16_t* op = p.OMLA + row * W + h * 64;
#pragma unroll
    for (int d = 0; d < 64; ++d) op[d] = f2bf(o[d] * il);
}
GLOBAL void LB64 k_attn_diff(Params p, int layer) {
    const long i = GTID; if (i >= (long)NB * NHD * TB) return;
    const int t = (int)(i % TB), h = (int)((i / TB) % NHD), b = (int)(i / ((long)TB * NHD));
    const size_t row = (size_t)b * TB + t; bf16_t* qo = p.QD + row * W + h * 128;
    const float lam = p.lamv[layer], lam_init = 0.8f - 0.6f * expf(-0.3f * (float)layer);
    float o[128];
#pragma unroll
    for (int d = 0; d < 128; ++d) o[d] = 0.f;
    if (t >= LEAD) {
        const int kend = (t / 64 + 1) * 64 < TB ? (t / 64 + 1) * 64 : TB;
        float m0 = -INFINITY, l0 = 0.f, m1 = -INFINITY, l1 = 0.f;
        for (int j = LEAD; j < kend; ++j) { const bf16_t* k = p.KD + ((size_t)b * TB + j) * W + h * 128; float s0 = 0.f, s1 = 0.f;
            for (int d = 0; d < 64; ++d) { s0 += bf2f(qo[d]) * bf2f(k[d]); s1 += bf2f(qo[64 + d]) * bf2f(k[64 + d]); }
            float mn = fmaxf(m0, s0); l0 = l0 * exp2f(m0 - mn) + exp2f(s0 - mn); m0 = mn; mn = fmaxf(m1, s1); l1 = l1 * exp2f(m1 - mn) + exp2f(s1 - mn); m1 = mn; }
        const float i0 = 1.f / l0, i1 = lam / l1;
        for (int j = LEAD; j < kend; ++j) { const size_t kr = (size_t)b * TB + j; const bf16_t* k = p.KD + kr * W + h * 128; float s0 = 0.f, s1 = 0.f;
            for (int d = 0; d < 64; ++d) { s0 += bf2f(qo[d]) * bf2f(k[d]); s1 += bf2f(qo[64 + d]) * bf2f(k[64 + d]); }
            const float w = exp2f(s0 - m0) * i0 - exp2f(s1 - m1) * i1;
            const bf16_t* vt = p.VDT + (size_t)(h * 128) * R + ((kr & ~(size_t)15) | sperm((int)(kr & 15)));
#pragma unroll
            for (int d = 0; d < 128; ++d) o[d] += w * bf2f(vt[(size_t)d * R]);
        }
    }
    float ss = 0.f;
#pragma unroll
    for (int d = 0; d < 128; ++d) ss += o[d] * o[d];
    const float rs = rsq(ss * (1.f / 128.f) + EPS) * (1.f - lam_init); const float* g = p.dnorm_g + (size_t)layer * 128;
#pragma unroll
    for (int d = 0; d < 128; ++d) qo[d] = f2bf(o[d] * rs * g[d]);
}


#endif
#ifndef HOST_EMU
namespace pg8 {
#define PG8_LAS __attribute__((address_space(3)))
typedef short bf16x8 __attribute__((ext_vector_type(8)));
typedef float f32x4 __attribute__((ext_vector_type(4)));
typedef unsigned u32x4 __attribute__((ext_vector_type(4)));
constexpr int BM = 256, BK = 64, HALF = 128, HTB = HALF * BK * 2  , STAGE_BYTES = 8 * HTB, NXCD = 8, WGM = 8;
__host__ __device__ __forceinline__ int lds_byte(int r, int c) { const int st = (r >> 4) * 2 + (c >> 5), rr = r & 15, cc = c & 31, ob = rr * 64 + cc * 2; return st * 1024 + (ob ^ (((ob >> 9) & 1) << 5)); }
__host__ __device__ __forceinline__ void stage_rc(int b, int& R, int& C) { const int st = b / 1024, sb = b % 1024, swz = sb ^ (((sb >> 9) & 1) << 5); R = (st >> 1) * 16 + swz / 64; C = (st & 1) * 32 + (swz % 64) / 2; }
__host__ __device__ __forceinline__ int perm32(int rho) { const int n = rho >> 4, i = rho & 15; return 8 * (i >> 2) + 4 * n + (i & 3); }
struct Unit { int pm, pn, tag; const char* A; const char* B; };
struct Gemm { int K, lda, ldb; };
__device__ __forceinline__ void order_map(int L, int nM, int nN, int& pm, int& pn) {
    const int nwg = nM * nN; int wgid = L; { const int q = nwg / NXCD, r = nwg % NXCD, xcd = wgid % NXCD, off = wgid / NXCD; wgid = (xcd < r ? xcd * (q + 1) : r * (q + 1) + (xcd - r) * q) + off; }
    const int nig = WGM * nN, gid = wgid / nig, fm = gid * WGM, gsz = (nM - fm) < WGM ? (nM - fm) : WGM;
    pm = fm + ((wgid % nig) % gsz); pn = (wgid % nig) / gsz;
}
template <class F> struct EpiAd {
    static constexpr bool PERM = true, AFTER_DRAIN = false;
    F f;
    __device__ __forceinline__ void operator()(const f32x4 (&acc)[2][2][4][2], const Unit& u, int wr, int wc, int fr, int fq, PG8_LAS unsigned char* scr, int tid) const {
        PG8_LAS float* rs = (PG8_LAS float*)scr;
        const bool sw = f.swapped(u.tag);
        if (tid < 256) rs[tid] = f.scale(u.tag, (sw ? u.pn : u.pm) * BM + tid);
        asm volatile("s_waitcnt lgkmcnt(0)" ::: "memory"); __builtin_amdgcn_s_barrier(); asm volatile("" ::: "memory");
#pragma unroll
        for (int ai = 0; ai < 2; ++ai)
#pragma unroll
            for (int m = 0; m < 4; ++m) { int rl = ai * HALF + wr * 64 + m * 16 + fr, fqo = fq; asm volatile("" : "+v"(rl), "+v"(fqo)); const int row = u.pm * BM + rl;
#pragma unroll
                for (int bj = 0; bj < 2; ++bj) { float part = 0.f;
#pragma unroll
                    for (int n = 0; n < 2; ++n) { const int cl = bj * HALF + wc * 32 + 8 * fqo + 4 * n; const f32x4 v = acc[ai][bj][m][n]; const float a4[4] = {v[0], v[1], v[2], v[3]};
                        float sc[4]; if (sw) { sc[0] = rs[cl]; sc[1] = rs[cl + 1]; sc[2] = rs[cl + 2]; sc[3] = rs[cl + 3]; } else { sc[0] = rs[rl]; sc[1] = sc[2] = sc[3] = 0.f; }
                        part += f(u.tag, row, u.pn * BM + cl, a4, sc); }
                    f.rowslot(u.tag, row, u.pn * BM + bj * HALF + wc * 32, fq, part); asm volatile("" ::: "memory"); } }
    }
};
template <class Epi, class Sched, bool ALIGN_EPI = false, bool SP2 = false>
__device__ __forceinline__ void gemm_phase(PG8_LAS unsigned char* lds, const Gemm g, const Sched& S, const Epi& E, const int wid0  ) {
    int lane_ = lane_id_v();
    const int wid = wid0, lane = lane_, tid = wid * 64 + lane, wr = wid >> 2, wc = wid & 3, fr = lane & 15, fq = lane >> 4;
    const int K = g.K, nt = K / BK, lda = g.lda, ldb = g.ldb;
    unsigned voffA[2], voffB[2];
#pragma unroll
    for (int i = 0; i < 2; ++i) { int R, C; stage_rc(tid * 16 + i * 8192, R, C); const int Rb = Epi::PERM ? ((R & ~31) + perm32(R & 31)) : R;
        voffA[i] = (unsigned)(R * lda + C) * 2u; voffB[i] = (unsigned)(Rb * ldb + C) * 2u; }
    const size_t kstep = (size_t)(BK * 2);
    const size_t hstepA = (size_t)HALF * lda * 2, hstepB = (size_t)HALF * ldb * 2;
    const size_t tstepA = 2 * hstepA, tstepB = 2 * hstepB;
    const unsigned ldsw = (unsigned)wid * 1024u;
    const int aoff = lds_byte(wr * 64 + fr, fq * 8), boff = lds_byte(wc * 32 + fr, fq * 8);
#define PG8_SA(b, h) (((b) * 2 + (h)) * HTB)
#define PG8_SB(b, h) ((4 + (b) * 2 + (h)) * HTB)
#define PG8_STAGE(bufoff, gbase, voff) do { _Pragma("unroll") for (int _i = 0; _i < 2; ++_i) \
        __builtin_amdgcn_global_load_lds((const unsigned*)((const char*)(gbase) + (voff)[_i]), (PG8_LAS unsigned*)(lds + (bufoff) + ldsw + _i * 8192), 16, 0, 0); } while (0)
#define PG8_LDA(dst, b, h) do { _Pragma("unroll") for (int m = 0; m < 4; ++m) _Pragma("unroll") for (int k = 0; k < 2; ++k) dst[m][k] = *(const PG8_LAS bf16x8*)(lds + PG8_SA(b, h) + aoff + m * 2048 + k * 1024); } while (0)
#define PG8_LDB(dst, b, h) do { _Pragma("unroll") for (int n = 0; n < 2; ++n) _Pragma("unroll") for (int k = 0; k < 2; ++k) dst[n][k] = *(const PG8_LAS bf16x8*)(lds + PG8_SB(b, h) + boff + n * 2048 + k * 1024); } while (0)
#define PG8_MMA(ai, bj, At, Bt) do { __builtin_amdgcn_s_setprio(1); _Pragma("unroll") for (int m = 0; m < 4; ++m) _Pragma("unroll") for (int n = 0; n < 2; ++n) _Pragma("unroll") for (int k = 0; k < 2; ++k) \
        acc[ai][bj][m][n] = __builtin_amdgcn_mfma_f32_16x16x32_bf16(Bt[n][k], At[m][k], acc[ai][bj][m][n], 0, 0, 0); __builtin_amdgcn_s_setprio(0); } while (0)
#define PG8_WAIT_V(n) asm volatile("s_waitcnt vmcnt(" #n ")" ::: "memory")
#define PG8_WAIT_L(n) asm volatile("s_waitcnt lgkmcnt(" #n ")" ::: "memory")
#define PG8_BAR __builtin_amdgcn_s_barrier()
#define PG8_SCHED __builtin_amdgcn_sched_barrier(0)
    Unit cur, nxt; int ui = 0;
    if (!S.next(0, cur)) return;
    f32x4 acc[2][2][4][2];
#pragma unroll
    for (int a = 0; a < 2; ++a)
#pragma unroll
        for (int b = 0; b < 2; ++b)
#pragma unroll
            for (int m = 0; m < 4; ++m)
#pragma unroll
                for (int n = 0; n < 2; ++n) acc[a][b][m][n] = (f32x4){0.f, 0.f, 0.f, 0.f};
    bf16x8 At[4][2], B0[2][2], B1[2][2];
    const char* cA = cur.A + (size_t)cur.pm * tstepA; const char* cB = cur.B + (size_t)cur.pn * tstepB;
    S.a_ready(cur);
    if constexpr (SP2) {
        PG8_STAGE(PG8_SB(0, 0), cB, voffB); PG8_STAGE(PG8_SB(0, 1), cB + hstepB, voffB); PG8_STAGE(PG8_SA(0, 0), cA, voffA); PG8_STAGE(PG8_SA(0, 1), cA + hstepA, voffA);
        if (wr == 1) PG8_BAR;
        PG8_WAIT_V(2); PG8_BAR;
        PG8_STAGE(PG8_SB(1, 0), cB + kstep, voffB); PG8_STAGE(PG8_SA(1, 0), cA + kstep, voffA); PG8_STAGE(PG8_SB(1, 1), cB + hstepB + kstep, voffB);
        PG8_WAIT_V(6); PG8_BAR;
    } else {
        PG8_STAGE(PG8_SB(0, 0), cB, voffB); PG8_STAGE(PG8_SA(0, 0), cA, voffA); PG8_STAGE(PG8_SB(0, 1), cB + hstepB, voffB); PG8_STAGE(PG8_SA(0, 1), cA + hstepA, voffA);
        if (wr == 1) PG8_BAR;
        PG8_WAIT_V(4); PG8_BAR;
        PG8_STAGE(PG8_SB(1, 0), cB + kstep, voffB); PG8_STAGE(PG8_SA(1, 0), cA + kstep, voffA); PG8_STAGE(PG8_SB(1, 1), cB + hstepB + kstep, voffB);
        PG8_WAIT_V(6); PG8_BAR;
    }
    for (;;) {
        const bool has_next = S.next(ui + 1, nxt);
        const char* nA = has_next ? nxt.A + (size_t)nxt.pm * tstepA : cA; const char* nB = has_next ? nxt.B + (size_t)nxt.pn * tstepB : cB;
#pragma nounroll
        for (int t = 0; t < nt; t += 2) {
            const bool last = (t == nt - 2);
            const char* a1 = cA + (size_t)(t + 1) * kstep;
            const char* a2 = last ? nA : cA + (size_t)(t + 2) * kstep; const char* b2 = last ? nB : cB + (size_t)(t + 2) * kstep;
            const char* a3 = a2 + kstep; const char* b3 = b2 + kstep;
            if (last && has_next) S.a_ready(nxt);
            if constexpr (SP2) {
            PG8_LDB(B0, 0, 0); PG8_LDB(B1, 0, 1); PG8_SCHED; PG8_LDA(At, 0, 0); PG8_STAGE(PG8_SA(1, 1), a1 + hstepA, voffA);
            PG8_WAIT_V(8); PG8_WAIT_L(0); PG8_BAR; PG8_MMA(0, 0, At, B0); PG8_MMA(0, 1, At, B1); PG8_BAR; PG8_SCHED;
            PG8_LDA(At, 0, 1); PG8_STAGE(PG8_SB(0, 0), b2, voffB); PG8_STAGE(PG8_SB(0, 1), b2 + hstepB, voffB); PG8_STAGE(PG8_SA(0, 0), a2, voffA);
            PG8_WAIT_V(8); PG8_WAIT_L(0); PG8_BAR; PG8_MMA(1, 0, At, B0); PG8_MMA(1, 1, At, B1); PG8_BAR; PG8_SCHED;
            PG8_LDB(B0, 1, 0); PG8_LDB(B1, 1, 1); PG8_SCHED; PG8_LDA(At, 1, 0); PG8_STAGE(PG8_SA(0, 1), a2 + hstepA, voffA);
            PG8_WAIT_V(8); PG8_WAIT_L(0); PG8_BAR; PG8_MMA(0, 0, At, B0); PG8_MMA(0, 1, At, B1); PG8_BAR; PG8_SCHED;
            PG8_LDA(At, 1, 1); PG8_STAGE(PG8_SB(1, 0), b3, voffB); PG8_STAGE(PG8_SB(1, 1), b3 + hstepB, voffB); PG8_STAGE(PG8_SA(1, 0), a3, voffA);
            PG8_WAIT_V(8); PG8_WAIT_L(0); PG8_BAR; PG8_MMA(1, 0, At, B0); PG8_MMA(1, 1, At, B1); PG8_BAR; PG8_SCHED;
            } else {
            PG8_LDB(B0, 0, 0); PG8_SCHED; PG8_LDA(At, 0, 0); PG8_STAGE(PG8_SA(1, 1), a1 + hstepA, voffA);
            PG8_WAIT_L(8); PG8_BAR; PG8_WAIT_L(0); PG8_MMA(0, 0, At, B0); PG8_BAR; PG8_SCHED;
            PG8_LDB(B1, 0, 1); PG8_STAGE(PG8_SB(0, 0), b2, voffB);
            PG8_BAR; PG8_WAIT_L(0); PG8_MMA(0, 1, At, B1); PG8_BAR;
            PG8_LDA(At, 0, 1); PG8_STAGE(PG8_SA(0, 0), a2, voffA);
            PG8_BAR; PG8_WAIT_L(0); PG8_MMA(1, 0, At, B0); PG8_BAR; PG8_SCHED;
            PG8_STAGE(PG8_SB(0, 1), b2 + hstepB, voffB);
            PG8_WAIT_V(6); PG8_BAR; PG8_MMA(1, 1, At, B1); PG8_BAR;
            PG8_LDB(B0, 1, 0); PG8_SCHED; PG8_LDA(At, 1, 0); PG8_STAGE(PG8_SA(0, 1), a2 + hstepA, voffA);
            PG8_WAIT_L(8); PG8_BAR; PG8_WAIT_L(0); PG8_MMA(0, 0, At, B0); PG8_BAR; PG8_SCHED;
            PG8_LDB(B1, 1, 1); PG8_STAGE(PG8_SB(1, 0), b3, voffB);
            PG8_BAR; PG8_WAIT_L(0); PG8_MMA(0, 1, At, B1); PG8_BAR;
            PG8_LDA(At, 1, 1); PG8_STAGE(PG8_SA(1, 0), a3, voffA);
            PG8_BAR; PG8_WAIT_L(0); PG8_MMA(1, 0, At, B0); PG8_BAR; PG8_SCHED;
            PG8_STAGE(PG8_SB(1, 1), b3 + hstepB, voffB);
            PG8_WAIT_V(6); PG8_BAR; PG8_MMA(1, 1, At, B1); PG8_BAR;
            }
        }
        if constexpr (ALIGN_EPI) { if (wr == 0) PG8_BAR; }
        if constexpr (!Epi::AFTER_DRAIN) { E(acc, cur, wr, wc, fr, fq, lds + STAGE_BYTES, tid); S.done(cur); }
        if (!has_next) break;
#pragma unroll
        for (int a = 0; a < 2; ++a)
#pragma unroll
            for (int b = 0; b < 2; ++b)
#pragma unroll
                for (int m = 0; m < 4; ++m)
#pragma unroll
                    for (int n = 0; n < 2; ++n) acc[a][b][m][n] = (f32x4){0.f, 0.f, 0.f, 0.f};
        cur = nxt; cA = nA; cB = nB; ++ui;
        if constexpr (ALIGN_EPI) { if (wr == 1) PG8_BAR; }
    }
    PG8_WAIT_V(0);
    if constexpr (!ALIGN_EPI) { if (wr == 0) PG8_BAR; }
    PG8_BAR;
    if constexpr (Epi::AFTER_DRAIN) { E.fused(acc, cur, wr, wc, fr, fq, lds, wid, lane); S.done(cur); }
#undef PG8_SA
#undef PG8_SB
#undef PG8_STAGE
#undef PG8_LDA
#undef PG8_LDB
#undef PG8_MMA
#undef PG8_WAIT_V
#undef PG8_WAIT_L
#undef PG8_BAR
#undef PG8_SCHED
}

}

struct SchedGrid {
    int nM, nN, G, c, tag; const char* A; const char* B;
    __device__ __forceinline__ bool next(int i, pg8::Unit& u) const { const long L = (long)i * G + c; if (L >= (long)nM * nN) return false; pg8::order_map((int)L, nM, nN, u.pm, u.pn); u.tag = tag; u.A = A; u.B = B; return true; }
    __device__ __forceinline__ void a_ready(const pg8::Unit&) const {}
    __device__ __forceinline__ void done(const pg8::Unit&) const {}
};
struct SchedTwo {
    int nM0, nN0, nM1, nN1, G, c; const char *A0, *B0, *A1, *B1;
    __device__ __forceinline__ bool next(int i, pg8::Unit& u) const { long L = (long)i * G + c; const long n0 = (long)nM0 * nN0;
        if (L < n0) { pg8::order_map((int)L, nM0, nN0, u.pm, u.pn); u.tag = 0; u.A = A0; u.B = B0; return true; }
        L -= n0; if (L >= (long)nM1 * nN1) return false; pg8::order_map((int)L, nM1, nN1, u.pm, u.pn); u.tag = 1; u.A = A1; u.B = B1; return true; }
    __device__ __forceinline__ void a_ready(const pg8::Unit&) const {}
    __device__ __forceinline__ void done(const pg8::Unit&) const {}
};
struct SchedP4 {
    int nM, nN, G, c; const char* A0; size_t astride; const char* B0; size_t bstride;
    __device__ __forceinline__ bool next(int i, pg8::Unit& u) const { const int j = i % 3, b = (2 * j) % 3; const long L = (long)(i / 3) * G + c; if (L >= (long)nM * nN) return false;
        pg8::order_map((int)L, nM, nN, u.pm, u.pn); u.tag = b + (j > 0 ? 4 : 0); u.A = A0 + (size_t)j * astride; u.B = B0 + (size_t)b * bstride; return true; }
    __device__ __forceinline__ void a_ready(const pg8::Unit&) const {}
    __device__ __forceinline__ void done(const pg8::Unit&) const {}
};
constexpr int LDS_SCR = pg8::STAGE_BYTES, LDS_BYTES = 147456;
#define LASP __attribute__((address_space(3)))
enum { PK_P1 = 0, PK_P2 = 1, PK_P3 = 2, PK_P3B = 3, PK_P4 = 4, PK_P5 = 5 };
__device__ __forceinline__ void gemm_part(const Params& p, LASP unsigned char* lds, int kind, int l, int G, int c, int wid0) {
    constexpr int nR = R / 256;
    if (kind == PK_P1) {
        SchedTwo S{nR, N1 / 256, 2 * W / 256, nR, G, c, (const char*)p.XB, (const char*)wptr(p, l, WL_W1), (const char*)wptr(p, l, WL_WV), (const char*)p.XB};
        pg8::EpiAd<F1> E{F1{p, 0}}; pg8::gemm_phase<pg8::EpiAd<F1>, SchedTwo, true, true>(lds, pg8::Gemm{D, D, D}, S, E, wid0);
    } else if (kind == PK_P2) {
        { SchedGrid S{nR, QBW / 256, G, c, 0, (const char*)p.CQ, (const char*)wptr(p, l, WL_UQ)};
          pg8::EpiAd<FUQ> E{FUQ{p, 0}}; pg8::gemm_phase<pg8::EpiAd<FUQ>, SchedGrid, true, true>(lds, pg8::Gemm{QR, QR, QR}, S, E, wid0); }
        { SchedTwo S{nR, W / 256, W / 256, nR, G, c, (const char*)p.CKV, (const char*)wptr(p, l, WL_UK), (const char*)wptr(p, l, WL_UV), (const char*)p.CKV};
          pg8::EpiAd<FUK> E{FUK{p, 0}}; pg8::gemm_phase<pg8::EpiAd<FUK>, SchedTwo, true, true>(lds, pg8::Gemm{KVR, KVR, KVR}, S, E, wid0); }
    } else if (kind == PK_P3B) {
        SchedGrid S{nR, N3 / 256, G, c, 0, (const char*)p.XB2, (const char*)wptr(p, l, WL_W3)};
        pg8::EpiAd<F3> E{F3{p, l}}; pg8::gemm_phase<pg8::EpiAd<F3>, SchedGrid, true, true>(lds, pg8::Gemm{D, D, D}, S, E, wid0);
    } else if (kind == PK_P4) {
        SchedP4 S{nR, D / 256, G, c, (const char*)p.QSB, (size_t)((const char*)p.QD - (const char*)p.QSB), (const char*)wptr(p, l, WL_WO), (size_t)D * W * 2};
        pg8::EpiAd<F4> E{F4{p, 0}}; pg8::gemm_phase<pg8::EpiAd<F4>, SchedP4, true, true>(lds, pg8::Gemm{W, W, W}, S, E, wid0);
    } else if (kind == PK_P5) {
        SchedGrid S{nR, D / 256, G, c, 0, (const char*)p.G0, (const char*)wptr(p, l, WL_OUT)};
        pg8::EpiAd<F5> E{F5{p, l == DEPTH - 1 ? 1 : 0}}; pg8::gemm_phase<pg8::EpiAd<F5>, SchedGrid, true, true>(lds, pg8::Gemm{D, D, D}, S, E, wid0);
    }
}
template <int KIND> __global__ void __launch_bounds__(512, 2) k_gemm_fast(Params p, int l) {
    extern __shared__ __attribute__((aligned(16))) unsigned char lds_raw[];
    gemm_part(p, (LASP unsigned char*)lds_raw, KIND, l, (int)gridDim.x, (int)blockIdx.x, __builtin_amdgcn_readfirstlane((int)threadIdx.x >> 6));
}

namespace att {
typedef short bf16x8 __attribute__((ext_vector_type(8)));
typedef float f32x16 __attribute__((ext_vector_type(16)));
typedef unsigned u32x4v __attribute__((ext_vector_type(4)));
__device__ __forceinline__ int crow(int r, int h) { return (r & 3) + 8 * (r >> 2) + 4 * h; }
__device__ __forceinline__ bf16x8 ldg8(const bf16_t* p) { return *(const bf16x8*)p; }
__device__ __forceinline__ void halves(float x, float& lo, float& hi) { auto r = __builtin_amdgcn_permlane32_swap(__float_as_uint(x), __float_as_uint(x), false, false); lo = __uint_as_float(r[0]); hi = __uint_as_float(r[1]); }
__device__ __forceinline__ bf16x8 pack8(const f32x16& v, int b) { u32x4v w; w.x = pk2(v[b], v[b + 1]); w.y = pk2(v[b + 2], v[b + 3]); w.z = pk2(v[b + 4], v[b + 5]); w.w = pk2(v[b + 6], v[b + 7]); return __builtin_bit_cast(bf16x8, w); }
constexpr float SB_DEAD = -152.0f;
#define ATT_FENCE() asm volatile("" ::: "memory")
constexpr int RING_SLOTS = 4, RING_D = 3;
__device__ __forceinline__ void dma16(const void* gsrc, LASP unsigned char* ldst) { __builtin_amdgcn_global_load_lds((const unsigned*)gsrc, (LASP unsigned*)ldst, 16, 0, 0); }
template <int NQB, int NKS, int NKSA, int NDB, bool SBM>
__device__ __forceinline__ void tile_step(const LASP unsigned char* kimg, const LASP unsigned char* krimg, const LASP unsigned char* vimg, const bool first, const bool diag, const int qoff, const int cl, const int h,
                                          const bf16x8 (&qf)[NQB][NKS], f32x16 (&o)[NDB][NQB], float (&mrun)[NQB], float (&lrun)[NQB], float (&carry)[NQB]) {
#define ATT_LDK(dst, g_) do { _Pragma("unroll") for (int j_ = 0; j_ < 2; ++j_) { const int key_ = j_ * 32 + cla; \
        dst[j_] = (g_) < NKSA ? *(const LASP bf16x8*)(kimg + key_ * 128 + (((2 * (g_) + ha) ^ (cla & 7)) << 4)) : *(const LASP bf16x8*)(krimg + key_ * 64 + (((2 * ((g_) - NKSA) + ha) ^ ((cla >> 2) & 3)) << 4)); } } while (0)
#define ATT_LDV(dst, j_) do { _Pragma("unroll") for (int d_ = 0; d_ < NDB; ++d_) dst[d_] = *(const LASP bf16x8*)(vimg + (d_ * 32 + cla) * 128 + (((2 * (j_) + ha) ^ (cla & 7)) << 4)); } while (0)
    int cla = cl, ha = h; asm volatile("" : "+v"(cla), "+v"(ha));
    bf16x8 kf0[2], kf1[2], vf0[NDB], vf1[NDB];
    ATT_LDK(kf0, 0);
    f32x16 s[2][NQB];
#pragma unroll
    for (int kb = 0; kb < 2; ++kb)
#pragma unroll
        for (int qb = 0; qb < NQB; ++qb)
#pragma unroll
            for (int r = 0; r < 16; ++r) s[kb][qb][r] = 0.f;
#pragma unroll
    for (int g = 0; g < NKS; ++g) {
        if (g + 1 < NKS) { if (g & 1) ATT_LDK(kf0, g + 1); else ATT_LDK(kf1, g + 1); } else ATT_LDV(vf0, 0);
        ATT_FENCE();
#pragma unroll
        for (int j = 0; j < 2; ++j)
#pragma unroll
            for (int qb = 0; qb < NQB; ++qb) s[j][qb] = __builtin_amdgcn_mfma_f32_32x32x16_bf16((g & 1) ? kf1[j] : kf0[j], qf[qb][g], s[j][qb], 0, 0, 0);
    }
    if (!SBM) {
        if (first) {
#pragma unroll
            for (int qb = 0; qb < NQB; ++qb) {
#pragma unroll
                for (int r = 0; r < 16; ++r) s[0][qb][r] = -INFINITY;
#pragma unroll
                for (int r = 0; r < 8; ++r) s[1][qb][r] = -INFINITY; } }
#pragma unroll
        for (int qb = 0; qb < NQB; ++qb) {
            float mx = s[0][qb][0];
#pragma unroll
            for (int r = 1; r < 16; ++r) mx = fmaxf(mx, s[0][qb][r]);
#pragma unroll
            for (int r = 0; r < 16; ++r) mx = fmaxf(mx, s[1][qb][r]);
            float m0, m1; halves(mx, m0, m1); const float mn = fmaxf(mrun[qb], fmaxf(m0, m1)); const float f = __builtin_amdgcn_exp2f(mrun[qb] - mn); mrun[qb] = mn;
            float ps = 0.f;
#pragma unroll
            for (int kb = 0; kb < 2; ++kb)
#pragma unroll
                for (int r = 0; r < 16; ++r) { const float pv = __builtin_amdgcn_exp2f(s[kb][qb][r] - mn); s[kb][qb][r] = pv; ps += pv; }
            lrun[qb] = lrun[qb] * f + ps;
#pragma unroll
            for (int d = 0; d < NDB; ++d)
#pragma unroll
                for (int r = 0; r < 16; ++r) o[d][qb][r] *= f;
        }
    } else {
#pragma unroll
        for (int qb = 0; qb < NQB; ++qb) {
            float run = carry[qb];
#pragma unroll
            for (int kb = 1; kb >= 0; --kb)
#pragma unroll
                for (int rg = 3; rg >= 0; --rg) {
                    const bool lead = first && (kb == 0 || rg < 2);
                    float y[4], sp[4]; bool ok[4];
#pragma unroll
                    for (int e = 0; e < 4; ++e) { y[e] = s[kb][qb][4 * rg + e]; ok[e] = !lead && !(diag && (kb * 32 + 8 * rg + 4 * h + e >= qoff + qb * 32 + cl));
                        sp[e] = ok[e] ? fmaxf(y[e], 0.f) + __builtin_amdgcn_logf(1.0f + __builtin_amdgcn_exp2f(-fabsf(y[e]))) : 0.f; }
                    const float gs = -((sp[0] + sp[1]) + (sp[2] + sp[3])); float g0, g1; halves(gs, g0, g1);
                    const float t1 = run; run += g1; const float t0 = run; run += g0; float a = h ? t1 : t0;
#pragma unroll
                    for (int e = 3; e >= 0; --e) { const float w = ok[e] ? __builtin_amdgcn_exp2f((y[e] - sp[e]) + a) : 0.f; a -= sp[e]; s[kb][qb][4 * rg + e] = w; }
                    __builtin_amdgcn_sched_barrier(0); }
            carry[qb] = run;
        }
    }
    ATT_FENCE();
#pragma unroll
    for (int j = 0; j < 4; ++j) {
        if (j + 1 < 4) { if (j & 1) ATT_LDV(vf0, j + 1); else ATT_LDV(vf1, j + 1); }
        ATT_FENCE();
        bf16x8 pf[NQB];
#pragma unroll
        for (int qb = 0; qb < NQB; ++qb) pf[qb] = pack8(s[j >> 1][qb], 8 * (j & 1));
#pragma unroll
        for (int d = 0; d < NDB; ++d)
#pragma unroll
            for (int qb = 0; qb < NQB; ++qb) o[d][qb] = __builtin_amdgcn_mfma_f32_32x32x16_bf16((j & 1) ? vf1[d] : vf0[d], pf[qb], o[d][qb], 0, 0, 0);
    }
#undef ATT_LDK
#undef ATT_LDV
}
template <int NQB, int NDB> __device__ __forceinline__ void store_ot(bf16_t* optr, int ldo, const f32x16 (&o)[NDB][NQB], const float (&sc)[NQB]) {
    int lane_ = lane_id_v(); const int lane = lane_, cl = lane & 31, h = lane >> 5;
#pragma unroll
    for (int qb = 0; qb < NQB; ++qb)
#pragma unroll
        for (int d = 0; d < NDB; ++d)
#pragma unroll
            for (int rg = 0; rg < 4; ++rg) st4(optr + (size_t)(qb * 32 + cl) * ldo + d * 32 + 8 * rg + 4 * h, o[d][qb][4 * rg] * sc[qb], o[d][qb][4 * rg + 1] * sc[qb], o[d][qb][4 * rg + 2] * sc[qb], o[d][qb][4 * rg + 3] * sc[qb]);
}
#define ATT_WAIT(n) asm volatile("s_waitcnt vmcnt(" #n ") lgkmcnt(0)" ::: "memory")
#define ATT_BAR() do { __builtin_amdgcn_s_barrier(); asm volatile("" ::: "memory"); } while (0)
template <bool SBM> __device__ __forceinline__ void unit8(const Params& p, LASP unsigned char* lds, const int wid, const int b, const int h, const int c0, const int nq) {
    constexpr int NKS = SBM ? 4 : 6, NQB = SBM ? 1 : 2, SLOTB = 20480, OFF_V = 8192, OFF_KR = 16384;
    const int lane = lane_id_v(), cl = lane & 31, hh = lane >> 5; const size_t r0 = (size_t)b * TB;
    const int ti = SBM ? wid >> 1 : wid, qoff = SBM ? (wid & 1) * 32 : 0;
    const int qt = c0 + ti, nt = c0 + nq; const bool active = ti < nq;
    const int swz = ((lane & 7) ^ ((lane >> 3) & 7)) << 3;
    const bf16_t* kbase = (SBM ? p.KSB : p.KNOPE) + (r0 + wid * 8 + (lane >> 3)) * W + h * 64 + swz;
    const bf16_t* vbase = (SBM ? p.VSBT : p.VBT) + (size_t)(h * 64 + wid * 8 + (lane >> 3)) * R + r0 + swz;
    const bf16_t* krbase = p.KR + (r0 + (wid & 3) * 16 + (lane >> 2)) * 32 + (((lane & 3) ^ ((lane >> 4) & 3)) << 3);
#define U8_ISSUE(t_) do { const int kt_ = SBM ? nt - 1 - (t_) : (t_); LASP unsigned char* sl_ = lds + ((t_) & (RING_SLOTS - 1)) * SLOTB; \
        dma16(kbase + (size_t)kt_ * 64 * W, sl_ + wid * 1024); dma16(vbase + kt_ * 64, sl_ + OFF_V + wid * 1024); \
        if (!SBM) dma16(krbase + (size_t)kt_ * 64 * 32, sl_ + OFF_KR + (wid & 3) * 1024); } while (0)
    bf16x8 qf[NQB][NKS]; f32x16 o[2][NQB]; float mrun[NQB], lrun[NQB], carry[NQB];
    { const bf16_t* qp = SBM ? p.QSB + (r0 + (size_t)qt * 64 + qoff) * W + h * 64 : p.QB + (r0 + (size_t)qt * 64) * QBW + h * 96; const int ldq = SBM ? W : QBW;
#pragma unroll
      for (int qb = 0; qb < NQB; ++qb)
#pragma unroll
          for (int ks = 0; ks < NKS; ++ks) { if (active) qf[qb][ks] = ldg8(qp + (size_t)(qb * 32 + cl) * ldq + 16 * ks + 8 * hh); else qf[qb][ks] = (bf16x8){0, 0, 0, 0, 0, 0, 0, 0}; } }
#pragma unroll
    for (int qb = 0; qb < NQB; ++qb) { mrun[qb] = -INFINITY; lrun[qb] = 0.f; carry[qb] = 0.f;
#pragma unroll
        for (int d = 0; d < 2; ++d)
#pragma unroll
            for (int r = 0; r < 16; ++r) o[d][qb][r] = 0.f; }
    volatile LASP unsigned* fl = (volatile LASP unsigned*)(lds + LDS_SCR + 3072);
    if (SBM && lane == 0) fl[8 + wid] = active ? 1u : 0u;
#pragma unroll
    for (int t = 0; t < RING_D; ++t) if (t < nt) U8_ISSUE(t);
    bool dead = !active;
    for (int it = 0; it < nt; ++it) {
        const int rem = nt - 1 - it;
        if (SBM) { if (rem >= 2) ATT_WAIT(4); else if (rem == 1) ATT_WAIT(2); else ATT_WAIT(0); }
        else     { if (rem >= 2) ATT_WAIT(6); else if (rem == 1) ATT_WAIT(3); else ATT_WAIT(0); }
        ATT_BAR();
        if (SBM) { const int pb = ((it + 1) & 1) * 8; const unsigned any = (fl[pb] | fl[pb + 1] | fl[pb + 2] | fl[pb + 3]) | (fl[pb + 4] | fl[pb + 5] | fl[pb + 6] | fl[pb + 7]); if (!any) break; }
        if (it + RING_D < nt) U8_ISSUE(it + RING_D);
        const int kt = SBM ? nt - 1 - it : it;
        if (!dead && kt <= qt) {
            const LASP unsigned char* sl = lds + (it & (RING_SLOTS - 1)) * SLOTB;
            tile_step<NQB, NKS, 4, 2, SBM>(sl, sl + OFF_KR, sl + OFF_V, kt == 0, kt == qt, qoff, cl, hh, qf, o, mrun, lrun, carry);
            if (SBM) { bool dd = true;
#pragma unroll
                for (int qb = 0; qb < NQB; ++qb) dd = dd && (carry[qb] < SB_DEAD);
                dead = __all(dd) != 0; }
        }
        if (SBM && lane == 0) fl[(it & 1) * 8 + wid] = (!dead && kt > 0) ? 1u : 0u;
    }
    if (active) {
        if (SBM) { float one[NQB];
#pragma unroll
            for (int qb = 0; qb < NQB; ++qb) one[qb] = 1.f;
            store_ot<NQB, 2>(p.QSB + (r0 + (size_t)qt * 64 + qoff) * W + h * 64, W, o, one); }
        else { float il[NQB];
#pragma unroll
            for (int qb = 0; qb < NQB; ++qb) { float l0, l1; halves(lrun[qb], l0, l1); il[qb] = 1.0f / (l0 + l1); }
            store_ot<NQB, 2>(p.OMLA + (r0 + (size_t)qt * 64) * W + h * 64, W, o, il); }
    }
    ATT_WAIT(0); ATT_BAR();
#undef U8_ISSUE
}
__device__ __forceinline__ void unit_diff(const Params& p, LASP unsigned char* lds, const int wid, const int layer, const int b, const int head, const int c0, const int nq) {
    constexpr int SLOTB = 32768, OFF_K1 = 8192, OFF_V = 16384;
    const int lane = lane_id_v(), cl = lane & 31, hh = lane >> 5, g = wid >> 2, mp = (wid >> 1) & 1, qh = wid & 1; const size_t r0 = (size_t)b * TB;
    const int qt = c0 + g, nt = c0 + nq; const bool active = g < nq;
    const int swz = ((lane & 7) ^ ((lane >> 3) & 7)) << 3;
    const bf16_t* kbase = p.KD + (r0 + wid * 8 + (lane >> 3)) * W + head * 128 + swz;
    const bf16_t* vbase = p.VDT + (size_t)(head * 128 + wid * 8 + (lane >> 3)) * R + r0 + swz;
#define UD_ISSUE(t_) do { const int kt_ = (t_); LASP unsigned char* sl_ = lds + ((t_) & (RING_SLOTS - 1)) * SLOTB; \
        dma16(kbase + (size_t)kt_ * 64 * W, sl_ + wid * 1024); dma16(kbase + (size_t)kt_ * 64 * W + 64, sl_ + OFF_K1 + wid * 1024); \
        dma16(vbase + kt_ * 64, sl_ + OFF_V + wid * 1024); dma16(vbase + (size_t)64 * R + kt_ * 64, sl_ + OFF_V + (wid + 8) * 1024); } while (0)
    bf16x8 qf[1][4]; f32x16 o[4][1]; float mrun[1], lrun[1], carry[1];
    { const bf16_t* qp = p.QD + (r0 + (size_t)qt * 64 + qh * 32) * W + head * 128 + mp * 64;
#pragma unroll
      for (int ks = 0; ks < 4; ++ks) { if (active) qf[0][ks] = ldg8(qp + (size_t)cl * W + 16 * ks + 8 * hh); else qf[0][ks] = (bf16x8){0, 0, 0, 0, 0, 0, 0, 0}; } }
    mrun[0] = -INFINITY; lrun[0] = 0.f; carry[0] = 0.f;
#pragma unroll
    for (int d = 0; d < 4; ++d)
#pragma unroll
        for (int r = 0; r < 16; ++r) o[d][0][r] = 0.f;
#pragma unroll
    for (int t = 0; t < RING_D; ++t) if (t < nt) UD_ISSUE(t);
    for (int it = 0; it < nt; ++it) {
        const int rem = nt - 1 - it;
        if (rem >= 2) ATT_WAIT(8); else if (rem == 1) ATT_WAIT(4); else ATT_WAIT(0);
        ATT_BAR();
        if (it + RING_D < nt) UD_ISSUE(it + RING_D);
        if (active && it <= qt) { const LASP unsigned char* sl = lds + (it & (RING_SLOTS - 1)) * SLOTB;
            tile_step<1, 4, 4, 4, false>(sl + mp * OFF_K1, sl, sl + OFF_V, it == 0, false, 0, cl, hh, qf, o, mrun, lrun, carry); }
    }
    ATT_WAIT(0); ATT_BAR();
    if (active) { float l0, l1; halves(lrun[0], l0, l1); const float il = 1.0f / (l0 + l1);
        LASP float* reg = (LASP float*)(lds + wid * 16384);
#pragma unroll
        for (int d = 0; d < 4; ++d)
#pragma unroll
            for (int r = 0; r < 16; ++r) reg[cl * 128 + ((d * 32 + crow(r, hh)) ^ cl)] = o[d][0][r] * il; }
    ATT_WAIT(0); ATT_BAR();
    if (active) { const float lam = p.lamv[layer], lam_init = __uint_as_float(__builtin_amdgcn_readfirstlane(layer == 0 ? 0x3e4ccccdu : 0x3eb60549u));
      const LASP float* r0p = (const LASP float*)(lds + ((g * 2 + 0) * 2 + qh) * 16384); const LASP float* r1p = (const LASP float*)(lds + ((g * 2 + 1) * 2 + qh) * 16384);
      const int ql = mp * 16 + (lane >> 2), part = lane & 3; float v[32]; float ss = 0.f;
#pragma unroll
      for (int i = 0; i < 32; ++i) { const int ii = (i + 8 * part) & 31; const int a = ql * 128 + ((part * 32 + ii) ^ ql); v[i] = r0p[a] - lam * r1p[a]; ss += v[i] * v[i]; }
      ss = quad4_sum(ss);
      const float rs = rsq(ss * (1.0f / 128.0f) + EPS) * (1.0f - lam_init); const float* gn = p.dnorm_g + (size_t)layer * 128 + part * 32;
      bf16_t* op = p.QD + (r0 + (size_t)qt * 64 + qh * 32 + ql) * W + head * 128 + part * 32;
#pragma unroll
      for (int i = 0; i < 32; i += 2) { const int ii = (i + 8 * part) & 31;
          st2(op + ii, v[i] * rs * gn[ii], v[i + 1] * rs * gn[ii + 1]); } }
    ATT_WAIT(0); ATT_BAR();
#undef UD_ISSUE
}
enum { AK_P2 = 0, AK_P3 = 1 };
__device__ __forceinline__ void attn_part(const Params& p, LASP unsigned char* lds, int kind, int layer, int wid) {
    const bool leader = wid == 0 && lane_id_v() == 0;
    volatile LASP int* slot = (volatile LASP int*)(lds + LDS_SCR + 2048);
    unsigned* ctr = p.ctl + 1024 + 64 * (layer * 2 + kind);
    constexpr int NT = TB / 64;
    static_assert((NT - 1) % 8 == 0, "query tile grouping");
    constexpr int NG8 = (NT - 1) / 8 + 1, NG4 = (NT - 1) / 4 + 1, NGD = (NT - 1) / 2 + 1;
    constexpr int N8 = NB * NH * NG8, N4 = NB * NH * NG4, ND = NB * NHD * NGD;
    const int nitems = kind == AK_P2 ? ND + N4 : N8;
    for (int n = 0;; ++n) {
        if (leader) slot[n & 1] = (int)atomicAdd(ctr, 1u);
        asm volatile("s_waitcnt vmcnt(0) lgkmcnt(0)" ::: "memory"); __builtin_amdgcn_s_barrier(); asm volatile("" ::: "memory");
        int item = __builtin_amdgcn_readfirstlane(slot[n & 1]);
        if (item >= nitems) break;
        if (kind == AK_P2) {
            if (item < ND) { const int u = item / (NB * NHD), j = item % (NB * NHD); const bool single = u == NGD - 1;
                unit_diff(p, lds, wid, layer, j / NHD, j % NHD, single ? 0 : NT - 2 - 2 * u, single ? 1 : 2); }
            else { item -= ND; const int u = item / (NB * NH), j = item % (NB * NH); const bool single = u == NG4 - 1;
                unit8<true>(p, lds, wid, j / NH, j % NH, single ? 0 : NT - 4 - 4 * u, single ? 1 : 4); }
        } else { const int u = item / (NB * NH), j = item % (NB * NH); const bool single = u == NG8 - 1;
            unit8<false>(p, lds, wid, j / NH, j % NH, single ? 0 : NT - 8 - 8 * u, single ? 1 : 8); }
    }
}
}
template <int KIND> __global__ void __launch_bounds__(512, 2) k_attn_fast(Params p, int l) {
    extern __shared__ __attribute__((aligned(16))) unsigned char lds_raw[];
    att::attn_part(p, (LASP unsigned char*)lds_raw, KIND, l, __builtin_amdgcn_readfirstlane((int)threadIdx.x >> 6));
}

#define XB_TMO      128
#define XB_XCNT(j)  (256  + 64 * (j))
#define XB_XSUB(j)  (1280 + 64 * (j))
#define XB_XGEN(j)  (2304 + 64 * (j))
#define XB_TOP      3328
#define XB_TOPGEN   3392
#define XCD_BAR_WORDS 3456
#define XB_SPIN_CAP (1u << 18)
__device__ __forceinline__ unsigned xb_ld(unsigned* p)              { return __hip_atomic_load(p, __ATOMIC_RELAXED, __HIP_MEMORY_SCOPE_AGENT); }
__device__ __forceinline__ unsigned xb_add(unsigned* p, unsigned v) { return __hip_atomic_fetch_add(p, v, __ATOMIC_RELAXED, __HIP_MEMORY_SCOPE_AGENT); }
__device__ __forceinline__ unsigned xb_xcc_id() { return (unsigned)__builtin_amdgcn_s_getreg((3 << 11) | 20) & 0xFu; }
#define XB_SPIN(cond, bar) do { unsigned _sp = 0; while (cond) { __builtin_amdgcn_s_sleep(1); \
    if ((++_sp & 255u) == 0u) { if (xb_ld(&(bar)[XB_TMO])) break; if (_sp > XB_SPIN_CAP) { atomicAdd(&(bar)[XB_TMO], 1u); break; } } } } while (0)
struct XcdBarrier { unsigned* bar; unsigned x; volatile LASP unsigned* st; };
__device__ __forceinline__ XcdBarrier xcd_barrier_post(unsigned* bar, volatile LASP unsigned* st, bool leader) {
    XcdBarrier b; b.bar = bar; b.x = xb_xcc_id(); b.st = st;
    if (leader) (void)xb_add(&bar[XB_XCNT(b.x)], 1u);
    return b;
}
__device__ __forceinline__ void xcd_barrier_complete(unsigned* bar, unsigned x, unsigned& nloc, unsigned& nx) {
    const unsigned G = gridDim.x * gridDim.y * gridDim.z;
    unsigned sum, cnt, mine, sp = 0u;
    for (;;) {
        sum = 0u; cnt = 0u; mine = 0u;
#pragma unroll
        for (unsigned j = 0; j < 16; ++j) { const unsigned c = xb_ld(&bar[XB_XCNT(j)]); sum += c; cnt += (c > 0u) ? 1u : 0u; mine = (j == x) ? c : mine; }
        if (sum == G) break;
        __builtin_amdgcn_s_sleep(1);
        if ((++sp & 255u) == 0u) { if (xb_ld(&bar[XB_TMO])) break; if (sp > XB_SPIN_CAP) { atomicAdd(&bar[XB_TMO], 1u); break; } }
    }
    nloc = mine > 0u ? mine : 1u; nx = cnt > 0u ? cnt : 1u;
}
__device__ __forceinline__ void xcd_barrier(const XcdBarrier& b, const int wid0) {
    const bool leader = wid0 == 0 && lane_id_v() == 0;
    asm volatile("s_waitcnt vmcnt(0)" ::: "memory");
    __syncthreads();
    if (leader) {
        unsigned* bar = b.bar;
        __builtin_amdgcn_s_waitcnt(0);
        unsigned nloc = b.st[0], nx = b.st[1];
        if (nloc == 0u) { xcd_barrier_complete(bar, b.x, nloc, nx); b.st[0] = nloc; b.st[1] = nx; }
        const unsigned old = xb_add(&bar[XB_XSUB(b.x)], 1u);
        const unsigned gen = old / nloc;
        if (old + 1u == (gen + 1u) * nloc) {
            __builtin_amdgcn_fence(__ATOMIC_RELEASE, "agent");
            asm volatile("s_waitcnt vmcnt(0)" ::: "memory");
            const unsigned og = xb_add(&bar[XB_TOP], 1u);
            const unsigned tg = og / nx;
            if (og + 1u == (tg + 1u) * nx) xb_add(&bar[XB_TOPGEN], 1u);
            else XB_SPIN(xb_ld(&bar[XB_TOPGEN]) == tg, bar);
            __builtin_amdgcn_fence(__ATOMIC_ACQUIRE, "agent");
            xb_add(&bar[XB_XGEN(b.x)], 1u);
            asm volatile("s_waitcnt vmcnt(0)" ::: "memory");
        } else {
            XB_SPIN(xb_ld(&bar[XB_XGEN(b.x)]) == gen, bar);
            __builtin_amdgcn_fence(__ATOMIC_ACQUIRE, "agent");
            asm volatile("s_waitcnt vmcnt(0)" ::: "memory");
        }
    }
    __syncthreads();
}

typedef float f32x4v __attribute__((ext_vector_type(4)));
typedef unsigned u32x4w __attribute__((ext_vector_type(4)));
__device__ __forceinline__ float rope_inv(int e, int dim) { return exp2f(-(float)e / (float)dim * 18.931568569324174f); }
__device__ __forceinline__ void rope_cs(float ang, float& cs, float& sn) { const double t = (double)ang * 0.15915494309189535; const float a = (float)((t - rint(t)) * 6.283185307179586); cs = cosf(a); sn = sinf(a); }
template <int MAP> __device__ __forceinline__ void prep_item(const float* src, int src_ld, const float* rowscale, bf16_t* dst, int N, int K, int item, int lane, LASP float* scr) {
    const int nblk = N / 32, kb = item / nblk, nb = item % nblk, k0 = 64 * kb, n0 = 32 * nb, nl = n0 + (lane & 31);
    int sc; if (MAP == 0) sc = src_w1(nl); else if (MAP == 1) sc = src_wv(nl); else if (MAP == 2) sc = src_w3(nl); else if (MAP == 3) sc = src_uq(nl); else if (MAP == 4) sc = src_uk(nl); else if (MAP == 5) sc = src_uv(nl); else sc = nl;
#pragma unroll 8
    for (int i = 0; i < 32; ++i) { const int kk = 2 * i + (lane >> 5); float v = 0.f; if (sc >= 0) v = src[(size_t)(k0 + kk) * src_ld + sc] * (rowscale ? rowscale[k0 + kk] : 1.f); scr[kk * 33 + (lane & 31)] = v; }
    asm volatile("s_waitcnt lgkmcnt(0)" ::: "memory");
    const int c = lane & 7;
#pragma unroll
    for (int j = 0; j < 4; ++j) { const int n = (lane >> 3) + 8 * j; const LASP float* t = scr + (8 * c) * 33 + n;
        u32x4w o; o.x = pk2(t[0 * 33], t[1 * 33]); o.y = pk2(t[2 * 33], t[3 * 33]); o.z = pk2(t[4 * 33], t[5 * 33]); o.w = pk2(t[6 * 33], t[7 * 33]);
        *(u32x4w*)(dst + (size_t)(n0 + n) * K + k0 + 8 * c) = o; }
    asm volatile("s_waitcnt lgkmcnt(0)" ::: "memory");
}
__device__ __forceinline__ void prologue_part(const Params& p, LASP unsigned char* lds, int G, int c, int wave) {
    int lane_ = lane_id_v(); const int lane = lane_;
    const int gw = c * 8 + wave, NGW = G * 8;
    for (int i = gw * 64 + lane; i < NPOS * 16; i += NGW * 64) {
        { const int pos = i / 16, j = i % 16; const float ang = (float)pos * rope_inv(2 * j, 32); float cs, sn; rope_cs(ang, cs, sn); p.cosm[i] = cs; p.sinm[i] = sn; }
        if (i < NPOS * 8) { const int pos = i / 8, j = i % 8; const float ang = (float)pos * rope_inv(2 * j, 16); float cs, sn; rope_cs(ang, cs, sn); p.cosd[i] = cs; p.sind[i] = sn; }
        if (i < DEPTH) { const float* lm = p.dlam + i * 4 * 64; float s0 = 0.f, s1 = 0.f; for (int d = 0; d < 64; ++d) { s0 += lm[d] * lm[64 + d]; s1 += lm[128 + d] * lm[192 + d]; }
            p.lamv[i] = expf(s0) - expf(s1) + (i == 0 ? 0.2f : 0.35550906759f); }
    }
    LASP float* scr = (LASP float*)(lds + wave * 16384);
    constexpr int I_W1 = (D / 64) * (N1 / 32), I_WV = (D / 64) * (2 * W / 32), I_W3 = (D / 64) * (N3 / 32), I_UQ = (QR / 64) * (QBW / 32), I_UK = (KVR / 64) * (W / 32), I_WO = (W / 64) * (D / 32), I_OUT = (D / 64) * (D / 32);
    constexpr int I_L = I_W1 + I_WV + I_W3 + I_UQ + 2 * I_UK + 3 * I_WO + I_OUT;
    for (int it = gw; it < 2 * I_L; it += NGW) {
        const int l = it / I_L; int r = it % I_L;
        const float* win = p.w_in + (size_t)l * D * INC; const float* ng = p.norm_g + l * D;
        if (r < I_W1) { prep_item<0>(win, INC, ng, wptr(p, l, WL_W1), N1, D, r, lane, scr); continue; } r -= I_W1;
        if (r < I_WV) { prep_item<1>(win, INC, ng, wptr(p, l, WL_WV), 2 * W, D, r, lane, scr); continue; } r -= I_WV;
        if (r < I_W3) { prep_item<2>(win, INC, ng, wptr(p, l, WL_W3), N3, D, r, lane, scr); continue; } r -= I_W3;
        if (r < I_UQ) { prep_item<3>(p.w_uq + (size_t)l * QR * QBW, QBW, p.cq_g + l * QR, wptr(p, l, WL_UQ), QBW, QR, r, lane, scr); continue; } r -= I_UQ;
        if (r < I_UK) { prep_item<4>(p.w_ukv + (size_t)l * KVR * NH * 128, NH * 128, p.ckv_g + l * KVR, wptr(p, l, WL_UK), W, KVR, r, lane, scr); continue; } r -= I_UK;
        if (r < I_UK) { prep_item<5>(p.w_ukv + (size_t)l * KVR * NH * 128, NH * 128, p.ckv_g + l * KVR, wptr(p, l, WL_UV), W, KVR, r, lane, scr); continue; } r -= I_UK;
        if (r < 3 * I_WO) { const int b = r / I_WO; const float* const w0 = opq(p.w_osb); const float* const w1 = opq(p.w_omla); const float* const w2 = opq(p.w_odiff); const float* wo = (b == 0 ? w0 : b == 1 ? w1 : w2) + (size_t)l * W * D;
            prep_item<6>(wo, D, nullptr, wptr(p, l, WL_WO) + (size_t)b * D * W, D, W, r % I_WO, lane, scr); continue; } r -= 3 * I_WO;
        prep_item<6>(p.w_out + (size_t)l * D * D, D, nullptr, wptr(p, l, WL_OUT), D, D, r, lane, scr);
    }
    for (int row = gw; row < R; row += NGW) {
        const int b = row / TB, t = row % TB; f32x4v v[D / 256]; float ss = 0.f;
#pragma unroll
        for (int j = 0; j < D / 256; ++j) { const int col = 256 * j + 4 * lane;
            if (t < LEAD) v[j] = (f32x4v){0.f, 0.f, 0.f, 0.f}; else if (t < LEAD + NMETA) v[j] = *(const f32x4v*)(p.meta + (size_t)(t - LEAD) * D + col); else v[j] = *(const f32x4v*)(p.x + ((size_t)b * SEQ + (t - LEAD - NMETA)) * D + col);
            ss += (v[j].x * v[j].x + v[j].y * v[j].y) + (v[j].z * v[j].z + v[j].w * v[j].w); }
        ss = wave_sum(ss);
#pragma unroll
        for (int j = 0; j < D / 256; ++j) { const int col = 256 * j + 4 * lane; *(f32x4v*)(p.X + (size_t)row * D + col) = v[j]; st4(p.XB + (size_t)row * D + col, v[j].x, v[j].y, v[j].z, v[j].w); }
        if (lane < NSX) p.ssx[(size_t)row * NSX + lane] = lane == 0 ? ss : 0.f;
    }
}
__device__ __forceinline__ void x2bf_part(const Params& p, int G, int c, int wave) {
    int lane_ = lane_id_v(); const int lane = lane_;
    for (int row = c * 8 + wave; row < R; row += G * 8) {
#pragma unroll
        for (int j = 0; j < D / 256; ++j) { const int col = 256 * j + 4 * lane; const f32x4v v = *(const f32x4v*)(p.X + (size_t)row * D + col); st4(p.XB2 + (size_t)row * D + col, v.x, v.y, v.z, v.w); } }
}
__device__ __forceinline__ void final_part(const Params& p, int G, int c, int wave) {
    int lane_ = lane_id_v(); const int lane = lane_;
    for (int i = c * 8 + wave; i < NB * SEQ; i += G * 8) {
        const int b = i / SEQ, sq = i % SEQ; const float* x = p.X + ((size_t)b * TB + LEAD + NMETA + sq) * D; f32x4v v[D / 256]; float ss = 0.f;
#pragma unroll
        for (int j = 0; j < D / 256; ++j) { v[j] = *(const f32x4v*)(x + 256 * j + 4 * lane); ss += (v[j].x * v[j].x + v[j].y * v[j].y) + (v[j].z * v[j].z + v[j].w * v[j].w); }
        const float rs = rsq(wave_sum(ss) * (1.0f / D) + EPS);
#pragma unroll
        for (int j = 0; j < D / 256; ++j) { const f32x4v g = *(const f32x4v*)(p.final_g + 256 * j + 4 * lane); *(f32x4v*)(p.out + (size_t)i * D + 256 * j + 4 * lane) = v[j] * rs * g; }
    }
}
constexpr int N_PHASES = 2 + 6 * DEPTH;
constexpr int CW_QUEUE = 1024, CW_BAR = 4096;
#define MK_SEAM(k) do { if ((k) + 1 < ph_hi) xcd_barrier(bar, wid0); } while (0)
#define MK_IN(k) (ph_lo <= (k) && (k) < ph_hi)
template <int L> __device__ __forceinline__ void layer_phases(const Params& p, LASP unsigned char* lds, const XcdBarrier& bar, int ph_lo, int ph_hi, int G, int c, int wid0) {
    constexpr int B0 = 1 + 6 * L;
    if (MK_IN(B0 + 0)) { gemm_part(p, lds, PK_P1, L, G, c, wid0); MK_SEAM(B0 + 0); }
    if (MK_IN(B0 + 1)) { gemm_part(p, lds, PK_P2, L, G, c, wid0); att::attn_part(p, lds, att::AK_P2, L, wid0); MK_SEAM(B0 + 1); }
    if (MK_IN(B0 + 2)) { x2bf_part(p, G, c, wid0); att::attn_part(p, lds, att::AK_P3, L, wid0); MK_SEAM(B0 + 2); }
    if (MK_IN(B0 + 3)) { gemm_part(p, lds, PK_P3B, L, G, c, wid0); MK_SEAM(B0 + 3); }
    if (MK_IN(B0 + 4)) { gemm_part(p, lds, PK_P4, L, G, c, wid0); MK_SEAM(B0 + 4); }
    if (MK_IN(B0 + 5)) { gemm_part(p, lds, PK_P5, L, G, c, wid0); MK_SEAM(B0 + 5); }
}
__global__ void __launch_bounds__(512, 2) mk_fwd(Params p, int ph_lo, int ph_hi) {
    extern __shared__ __attribute__((aligned(16))) unsigned char lds_raw[];
    LASP unsigned char* lds = (LASP unsigned char*)lds_raw;
    volatile LASP unsigned* misc = (volatile LASP unsigned*)(lds + LDS_SCR + 4096);
    const int wid0 = __builtin_amdgcn_readfirstlane((int)threadIdx.x >> 6);
    if (threadIdx.x < 64) misc[threadIdx.x] = 0u;
    __syncthreads();
    const int G = (int)gridDim.x, c = (int)blockIdx.x;
    const XcdBarrier bar = xcd_barrier_post(p.ctl + CW_BAR, misc + 8, threadIdx.x == 0);
    if (MK_IN(0)) { prologue_part(p, lds, G, c, wid0); MK_SEAM(0); }
    layer_phases<0>(p, lds, bar, ph_lo, ph_hi, G, c, wid0);
    layer_phases<1>(p, lds, bar, ph_lo, ph_hi, G, c, wid0);
    if (MK_IN(N_PHASES - 1)) final_part(p, G, c, wid0);
}
#endif

#ifdef HOST_EMU
typedef int hipStream_t;
#endif
#define NBLK(n, t) (((long)(n) + (t) - 1) / (t))
#ifndef HOST_EMU
#ifndef MK_SPLIT
#define MK_SPLIT 0
#endif
extern "C" void kernel_launch(void* const* d_in, const int* in_sizes, int n_in, void* d_out, int out_size, void* d_ws, size_t ws_size, hipStream_t stream) {
    if (n_in != 16 || in_sizes[0] != NB * SEQ * D || out_size != NB * SEQ * D || ws_size < WS_NEED) { fprintf(stderr, "kernel_launch: unexpected shapes / workspace (%d inputs, ws %zu, need %zu)\n", n_in, ws_size, (size_t)WS_NEED); return; }
    static int grid = 0;
    if (grid == 0) { int dev = 0, cus = 0; (void)hipGetDevice(&dev); (void)hipDeviceGetAttribute(&cus, hipDeviceAttributeMultiprocessorCount, dev); grid = cus > 0 ? cus : 256;
        if (hipFuncSetAttribute((const void*)mk_fwd, hipFuncAttributeMaxDynamicSharedMemorySize, LDS_BYTES) != hipSuccess) { fprintf(stderr, "kernel_launch: hipFuncSetAttribute failed\n"); grid = -1; } }
    if (grid < 0) return;
    const Params p = make_params(d_in, d_out, d_ws);
    (void)hipMemsetAsync((char*)d_ws + O_CTL, 0, 65536, stream);
#if MK_SPLIT
    for (int ph = 0; ph < N_PHASES; ++ph) hipLaunchKernelGGL(mk_fwd, dim3(grid), dim3(512), LDS_BYTES, stream, p, ph, ph + 1);
#else
    hipLaunchKernelGGL(mk_fwd, dim3(grid), dim3(512), LDS_BYTES, stream, p, 0, N_PHASES);
#endif
}
#else
extern "C" void kernel_launch(void* const* d_in, const int* in_sizes, int n_in, void* d_out, int out_size, void* d_ws, size_t ws_size, hipStream_t stream) {
    if (n_in != 16 || in_sizes[0] != NB * SEQ * D || out_size != NB * SEQ * D || ws_size < WS_NEED) { fprintf(stderr, "kernel_launch: unexpected shapes / workspace (%d inputs, ws %zu, need %zu)\n", n_in, ws_size, (size_t)WS_NEED); return; }
    const Params p = make_params(d_in, d_out, d_ws);
    const int T = 256;
#if 0
        (void)hipFuncSetAttribute((const void*)k_gemm_fast<PK_P1>, hipFuncAttributeMaxDynamicSharedMemorySize, LDS_BYTES); hipFuncSetAttribute((const void*)k_gemm_fast<PK_P2>, hipFuncAttributeMaxDynamicSharedMemorySize, LDS_BYTES);
        hipFuncSetAttribute((const void*)k_gemm_fast<PK_P3B>, hipFuncAttributeMaxDynamicSharedMemorySize, LDS_BYTES); hipFuncSetAttribute((const void*)k_gemm_fast<PK_P4>, hipFuncAttributeMaxDynamicSharedMemorySize, LDS_BYTES);
        hipFuncSetAttribute((const void*)k_gemm_fast<PK_P5>, hipFuncAttributeMaxDynamicSharedMemorySize, LDS_BYTES);
        hipFuncSetAttribute((const void*)k_attn_fast<att::AK_P2>, hipFuncAttributeMaxDynamicSharedMemorySize, LDS_BYTES); hipFuncSetAttribute((const void*)k_attn_fast<att::AK_P3>, hipFuncAttributeMaxDynamicSharedMemorySize, LDS_BYTES); }
    (void)hipMemsetAsync((char*)d_ws + O_CTL, 0, 65536, stream);
#endif
    LAUNCH(k_tables, NBLK(NPOS * 16, T), T, p);
    for (int l = 0; l < DEPTH; ++l) {
        LAUNCH(k_prep_w<0>, NBLK((long)N1 * D, T), T, wptr(p, l, WL_W1), N1, D, p.w_in + (size_t)l * D * INC, INC, p.norm_g + l * D);
        LAUNCH(k_prep_w<1>, NBLK((long)2 * W * D, T), T, wptr(p, l, WL_WV), 2 * W, D, p.w_in + (size_t)l * D * INC, INC, p.norm_g + l * D);
        LAUNCH(k_prep_w<2>, NBLK((long)N3 * D, T), T, wptr(p, l, WL_W3), N3, D, p.w_in + (size_t)l * D * INC, INC, p.norm_g + l * D);
        LAUNCH(k_prep_w<3>, NBLK((long)QBW * QR, T), T, wptr(p, l, WL_UQ), QBW, QR, p.w_uq + (size_t)l * QR * QBW, QBW, p.cq_g + l * QR);
        LAUNCH(k_prep_w<4>, NBLK((long)W * KVR, T), T, wptr(p, l, WL_UK), W, KVR, p.w_ukv + (size_t)l * KVR * NH * 128, NH * 128, p.ckv_g + l * KVR);
        LAUNCH(k_prep_w<5>, NBLK((long)W * KVR, T), T, wptr(p, l, WL_UV), W, KVR, p.w_ukv + (size_t)l * KVR * NH * 128, NH * 128, p.ckv_g + l * KVR);
        LAUNCH(k_prep_w<6>, NBLK((long)D * W, T), T, wptr(p, l, WL_WO), D, W, p.w_osb + (size_t)l * W * D, D, (const float*)nullptr);
        LAUNCH(k_prep_w<6>, NBLK((long)D * W, T), T, wptr(p, l, WL_WO) + (size_t)D * W, D, W, p.w_omla + (size_t)l * W * D, D, (const float*)nullptr);
        LAUNCH(k_prep_w<6>, NBLK((long)D * W, T), T, wptr(p, l, WL_WO) + (size_t)2 * D * W, D, W, p.w_odiff + (size_t)l * W * D, D, (const float*)nullptr);
        LAUNCH(k_prep_w<6>, NBLK((long)D * D, T), T, wptr(p, l, WL_OUT), D, D, p.w_out + (size_t)l * D * D, D, (const float*)nullptr);
    }
    LAUNCH(k_init_x, NBLK((long)R * D, T), T, p);
    LAUNCH(k_ssq_f32, NBLK(R, 64), 64, (const float*)p.X, D, p.ssx, NSX);
    for (int l = 0; l < DEPTH; ++l) {
        const int last = (l == DEPTH - 1) ? 1 : 0; (void)last;
#ifndef HOST_EMU
        FASTG(PK_P1, l);
        FASTG(PK_P2, l);
#else
        LAUNCH(k_gemm<F1>, NBLK((long)R * (V1_END / 4), T), T, (const bf16_t*)p.XB, D, (const bf16_t*)wptr(p, l, WL_W1), D, R, V1_END, D, p, 0, 0);
        LAUNCH(k_gemm<F1>, NBLK((long)2 * W * (R / 4), T), T, (const bf16_t*)wptr(p, l, WL_WV), D, (const bf16_t*)p.XB, D, 2 * W, R, D, p, 0, 1);
        LAUNCH(k_ssq_bf, NBLK(R, 64), 64, (const bf16_t*)p.CQ, QR, p.ssq, NSQ);
        LAUNCH(k_ssq_bf, NBLK(R, 64), 64, (const bf16_t*)p.CKV, KVR, p.ssk, NSK);
        LAUNCH(k_gemm<FUQ>, NBLK((long)R * (QBW / 4), T), T, (const bf16_t*)p.CQ, QR, (const bf16_t*)wptr(p, l, WL_UQ), QR, R, QBW, QR, p, 0, 0);
        LAUNCH(k_gemm<FUK>, NBLK((long)R * (W / 4), T), T, (const bf16_t*)p.CKV, KVR, (const bf16_t*)wptr(p, l, WL_UK), KVR, R, W, KVR, p, 0, 0);
        LAUNCH(k_gemm<FUK>, NBLK((long)W * (R / 4), T), T, (const bf16_t*)wptr(p, l, WL_UV), KVR, (const bf16_t*)p.CKV, KVR, W, R, KVR, p, 0, 1);
#endif
#ifndef HOST_EMU
        hipLaunchKernelGGL(k_attn_fast<att::AK_P2>, dim3(grid), dim3(512), LDS_BYTES, stream, p, l);
        hipLaunchKernelGGL(k_attn_fast<att::AK_P3>, dim3(grid), dim3(512), LDS_BYTES, stream, p, l);
#else
        LAUNCH(k_attn_sb, NBLK((long)NB * NH * TB, 64), 64, p);
        LAUNCH(k_attn_diff, NBLK((long)NB * NHD * TB, 64), 64, p, l);
        LAUNCH(k_attn_mla, NBLK((long)NB * NH * TB, 64), 64, p);
#endif
        LAUNCH(k_x2bf, NBLK((long)R * D, T), T, p);
#ifndef HOST_EMU
        FASTG(PK_P3B, l); FASTG(PK_P4, l); FASTG(PK_P5, l);
#else
        LAUNCH(k_gemm<F3>, NBLK((long)R * (N3 / 4), T), T, (const bf16_t*)p.XB2, D, (const bf16_t*)wptr(p, l, WL_W3), D, R, N3, D, p, l, 0);
        LAUNCH(k_gemm<F4>, NBLK((long)R * (D / 4), T), T, (const bf16_t*)p.QSB, W, (const bf16_t*)wptr(p, l, WL_WO), W, R, D, W, p, 0, 0);
        LAUNCH(k_gemm<F4>, NBLK((long)R * (D / 4), T), T, (const bf16_t*)p.OMLA, W, (const bf16_t*)(wptr(p, l, WL_WO) + (size_t)D * W), W, R, D, W, p, 0, 5);
        LAUNCH(k_gemm<F4>, NBLK((long)R * (D / 4), T), T, (const bf16_t*)p.QD, W, (const bf16_t*)(wptr(p, l, WL_WO) + (size_t)2 * D * W), W, R, D, W, p, 0, 6);
        LAUNCH(k_gemm<F5>, NBLK((long)R * (D / 4), T), T, (const bf16_t*)p.G0, D, (const bf16_t*)wptr(p, l, WL_OUT), D, R, D, D, p, last, 0);
        if (!last) LAUNCH(k_ssq_f32, NBLK(R, 64), 64, (const float*)p.X, D, p.ssx, NSX);
#endif
    }
    LAUNCH(k_final, NBLK((long)NB * SEQ, 64), 64, p);
}
#endif
```

```cpp
#ifndef HOST_EMU
#include <hip/hip_runtime.h>
#endif
#include <cstdio>
#include <cstdint>
#include <cmath>
#include <cstring>

#ifndef CFG_B
#define CFG_B 8
#endif
#ifndef CFG_S
#define CFG_S 2048
#endif
#ifndef CFG_D
#define CFG_D 1024
#endif

typedef unsigned short bf16_t;

namespace cfg {
constexpr int NB = CFG_B, SEQ = CFG_S, D = CFG_D, DEPTH = 2;
constexpr int NMETA = 16, LEAD = 48, TB = LEAD + NMETA + SEQ, R = NB * TB, NPOS = NMETA + SEQ;
constexpr int W = D / 2;
constexpr int NH = D / 128;
constexpr int NHD = D / 256;
constexpr int QR = 3 * D / 8, KVR = D / 4, QBW = NH * 96;
constexpr int INC = 4 * W + QR + KVR + 32 + W + 4 * W + 3 * D;
constexpr int C_SBQ = 0, C_SBK = W, C_SBV = 2 * W, C_SBZ = 3 * W, C_CQ = 4 * W, C_CKV = C_CQ + QR, C_KR = C_CKV + KVR, C_MZ = C_KR + 32,
              C_DQ = C_MZ + W, C_DK = C_DQ + W, C_DV = C_DK + W, C_DZ = C_DV + W, C_G = C_DZ + W;
static_assert(C_G + 3 * D == INC, "w_in columns");
constexpr int V1_SBQ = 0, V1_SBK = W, V1_CQ = 2 * W, V1_CKV = V1_CQ + QR, V1_KR = V1_CKV + KVR, V1_DQ = V1_KR + 32, V1_DK = V1_DQ + W, V1_END = V1_DK + W;
constexpr int N1 = (V1_END + 255) / 256 * 256;
constexpr int N3 = 3 * W + 3 * D;
constexpr int NSX = D / 32, NSQ = QR / 32, NSK = KVR / 32;
constexpr float EPS = 1e-6f, LOG2E = 1.4426950408889634f;
constexpr int GP = D / 256;
}
using namespace cfg;

constexpr size_t MiB = size_t(1) << 20;
constexpr size_t al256(size_t x) { return (x + 255) & ~size_t(255); }
constexpr size_t SZ_W = (size_t)R * W * 2, SZ_D2 = (size_t)R * D * 2, SZ_X = (size_t)R * D * 4, SZ_CQ = (size_t)R * QR * 2, SZ_CKV = (size_t)R * KVR * 2,
                 SZ_KR = (size_t)R * 32 * 2, SZ_QB = (size_t)R * QBW * 2, SZ_GP = (size_t)R * 256 * 2;
constexpr size_t WB_W1 = (size_t)N1 * D * 2, WB_WV = (size_t)2 * W * D * 2, WB_W3 = (size_t)N3 * D * 2, WB_UQ = (size_t)QBW * QR * 2, WB_UK = (size_t)W * KVR * 2,
                 WB_UV = WB_UK, WB_WO = (size_t)3 * D * W * 2, WB_OUT = (size_t)D * D * 2;
constexpr size_t WL_W1 = 0, WL_WV = WL_W1 + WB_W1, WL_W3 = WL_WV + WB_WV, WL_UQ = WL_W3 + WB_W3, WL_UK = WL_UQ + WB_UQ, WL_UV = WL_UK + WB_UK, WL_WO = WL_UV + WB_UV,
                 WL_OUT = WL_WO + WB_WO, WL_BYTES = al256(WL_OUT + WB_OUT);
constexpr bool STDCFG = (NB == 8 && SEQ == 2048 && D == 1024);
#if defined(HOST_EMU)
constexpr bool HANDMAP = false;
#else
constexpr bool HANDMAP = STDCFG;
#endif
constexpr size_t O_CTL = 0, O_TAB = 1 * MiB, O_LAM = O_TAB + 768 * 1024, O_SSX = 2 * MiB, O_SSQ = O_SSX + al256((size_t)R * NSX * 4), O_SSK = O_SSQ + al256((size_t)R * NSQ * 4),
                 O_WTS = al256(O_SSK + (size_t)R * NSK * 4 + MiB) / MiB * MiB;
constexpr size_t O_X = HANDMAP ? 52 * MiB : al256(O_WTS + 2 * WL_BYTES);
static_assert(O_WTS + 2 * WL_BYTES <= O_X, "weights overrun X");
constexpr size_t O_A = O_X + al256(SZ_X);
constexpr size_t Q_QSB = O_A, Q_QD = Q_QSB + al256(SZ_W), Q_OMLA = Q_QD + al256(SZ_W), Q_KSB = Q_OMLA + al256(SZ_W), Q_VSBT = Q_KSB + al256(SZ_W), Q_KD = Q_VSBT + al256(SZ_W),
                 Q_VDT = Q_KD + al256(SZ_W), Q_VBT = Q_VDT + al256(SZ_W), Q_KR = Q_VBT + al256(SZ_W), Q_CKV = Q_KR + al256(SZ_KR), Q_XB2 = Q_CKV + al256(SZ_CKV), Q_G0 = Q_XB2 + al256(SZ_D2),
                 Q_GPC = Q_G0 + al256(SZ_D2), Q_XB = Q_GPC + 2 * GP * al256(SZ_GP), Q_QB = Q_XB + al256(SZ_D2), Q_CQ = Q_QB + al256(SZ_QB), Q_KNOPE = Q_CQ + al256(SZ_CQ), Q_END = Q_KNOPE + al256(SZ_W);
constexpr size_t WS_NEED = HANDMAP ? 256 * MiB : Q_END;

struct Params {
    const float *x, *meta, *norm_g, *w_in, *b_gate, *cq_g, *ckv_g, *w_uq, *w_ukv, *dlam, *dnorm_g, *w_osb, *w_omla, *w_odiff, *w_out, *final_g;
    float* out;
    float *X, *ssx, *ssq, *ssk, *cosm, *sinm, *cosd, *sind, *lamv;
    char* WTS;
    bf16_t *XB, *XB2, *QSB, *KSB, *VSBT, *QD, *KD, *VDT, *CQ, *CKV, *KR, *QB, *KNOPE, *VBT, *OMLA, *G0, *GPW, *GPO;
    unsigned* ctl;
};

static Params make_params(void* const* d_in, void* d_out, void* d_ws) {
    Params p{};
    const float* const* in = (const float* const*)d_in;
    p.x = in[0]; p.meta = in[1]; p.norm_g = in[2]; p.w_in = in[3]; p.b_gate = in[4]; p.cq_g = in[5]; p.ckv_g = in[6]; p.w_uq = in[7]; p.w_ukv = in[8]; p.dlam = in[9];
    p.dnorm_g = in[10]; p.w_osb = in[11]; p.w_omla = in[12]; p.w_odiff = in[13]; p.w_out = in[14]; p.final_g = in[15];
    p.out = (float*)d_out;
    char* ws = (char*)d_ws; char* ob = (char*)d_out;
    p.ctl = (unsigned*)(ws + O_CTL);
    p.cosm = (float*)(ws + O_TAB); p.sinm = p.cosm + NPOS * 16; p.cosd = p.sinm + NPOS * 16; p.sind = p.cosd + NPOS * 8; p.lamv = (float*)(ws + O_LAM);
    p.ssx = (float*)(ws + O_SSX); p.ssq = (float*)(ws + O_SSQ); p.ssk = (float*)(ws + O_SSK);
    p.WTS = ws + O_WTS;
    p.X = (float*)(ws + O_X);
    if (HANDMAP) {
        auto A = [&](double mib) { return (bf16_t*)(ws + (size_t)(mib * 1048576.0)); };
        auto Bq = [&](double mib) { return (bf16_t*)(ob + (size_t)(mib * 1048576.0)); };
        p.QSB = A(118); p.QD = A(134.5); p.OMLA = A(151); p.CKV = A(151); p.KSB = A(167.5); p.VSBT = A(184); p.KD = A(200.5); p.VDT = A(217); p.VBT = A(233.5); p.KR = A(250);
        p.XB2 = A(167.5); p.G0 = A(200.5);
        p.XB = Bq(0); p.QB = Bq(0); p.CQ = Bq(33); p.KNOPE = Bq(45.5);
        p.GPW = A(233.5); p.GPO = Bq(0);
    } else {
        auto A = [&](size_t off) { return (bf16_t*)(ws + off); };
        p.QSB = A(Q_QSB); p.QD = A(Q_QD); p.OMLA = A(Q_OMLA); p.CKV = A(Q_CKV); p.KSB = A(Q_KSB); p.VSBT = A(Q_VSBT); p.KD = A(Q_KD); p.VDT = A(Q_VDT); p.VBT = A(Q_VBT); p.KR = A(Q_KR);
        p.XB2 = A(Q_XB2); p.G0 = A(Q_G0); p.XB = A(Q_XB); p.QB = A(Q_QB); p.CQ = A(Q_CQ); p.KNOPE = A(Q_KNOPE);
        p.GPW = A(Q_GPC); p.GPO = A(Q_GPC);
    }
    return p;
}
static_assert(!STDCFG || (SZ_W == (size_t)(16.5 * 1048576) && SZ_D2 == 33 * MiB && SZ_GP == (size_t)(8.25 * 1048576) && SZ_QB == (size_t)(24.75 * 1048576) && SZ_CQ <= (size_t)(12.5 * 1048576) &&
              SZ_KR <= (size_t)(1.1 * 1048576) && SZ_X == 66 * MiB && GP == 4), "hand map sizes");

#ifdef HOST_EMU
#define DEVFN inline
#define HDFN inline
#else
#define DEVFN __device__ __forceinline__
#define HDFN __host__ __device__ __forceinline__
#endif
#ifdef HOST_EMU
template <class T> DEVFN T* opq(T* p) { return p; }
#else
DEVFN int lane_id_v() { int l; asm volatile("v_mbcnt_lo_u32_b32 %0, -1, 0\n\tv_mbcnt_hi_u32_b32 %0, -1, %0" : "=v"(l)); return l; }
template <class T> DEVFN T* opq(T* p) { asm volatile("" : "+s"(p)); return p; }
#endif
DEVFN float bf2f(bf16_t h) { unsigned u = (unsigned)h << 16; float f; memcpy(&f, &u, 4); return f; }
DEVFN bf16_t f2bf(float f) { unsigned u; memcpy(&u, &f, 4); return (bf16_t)((u + 0x7fffu + ((u >> 16) & 1u)) >> 16); }
struct alignas(16) U4 { unsigned x, y, z, w; };
DEVFN void ld8(const bf16_t* p, float* o) {
    const U4 v = *(const U4*)p; const unsigned u[4] = {v.x, v.y, v.z, v.w};
#pragma unroll
    for (int i = 0; i < 4; ++i) { unsigned lo = u[i] << 16, hi = u[i] & 0xffff0000u; memcpy(&o[2 * i], &lo, 4); memcpy(&o[2 * i + 1], &hi, 4); }
}
DEVFN float rsq(float x) { return 1.0f / sqrtf(x); }
DEVFN float rstd_slots(const float* s, int row, int ns, float invn) { float t = 0.f; for (int i = 0; i < ns; ++i) t += s[(size_t)row * ns + i]; return rsq(t * invn + EPS); }
DEVFN int sperm(int r) { return (r & ~12) | ((r & 4) << 1) | ((r & 8) >> 1); }
constexpr int NPW = HANDMAP ? 2 : 2 * GP;
DEVFN bf16_t* gptr(const Params& p, int b, int row, int c) {
    bf16_t* const g0 = opq(p.G0); bf16_t* const gw = opq(p.GPW); bf16_t* const go = opq(p.GPO);
    if (b == 0) return g0 + (size_t)row * D + c;
    const int j = (b - 1) * GP + (c >> 8); bf16_t* base = j < NPW ? gw + (size_t)j * (al256(SZ_GP) / 2) : go + (size_t)(j - NPW) * (al256(SZ_GP) / 2);
    return base + (size_t)row * 256 + (c & 255);
}
HDFN bf16_t* wptr(const Params& p, int l, size_t off) { return (bf16_t*)(p.WTS + (size_t)l * WL_BYTES + off); }
#ifdef HOST_EMU
DEVFN float sigm_f(float z) { return 1.f / (1.f + expf(-z)); }
#define UNI(x) (x)
#else
DEVFN float sigm_f(float z) { return __builtin_amdgcn_rcpf(1.0f + __builtin_amdgcn_exp2f(-1.4426950408889634f * z)); }
#define UNI(x) __builtin_amdgcn_readfirstlane(x)
#endif
DEVFN float silu_f(float z) { return z * sigm_f(z); }
struct alignas(8) U2 { unsigned x, y; };
#ifdef HOST_EMU
DEVFN unsigned pk2(float lo, float hi) { return (unsigned)f2bf(lo) | ((unsigned)f2bf(hi) << 16); }
#else
typedef float f32x2_t __attribute__((ext_vector_type(2))); typedef __bf16 bf16x2_t __attribute__((ext_vector_type(2)));
DEVFN unsigned pk2(float lo, float hi) { f32x2_t v = {lo, hi}; bf16x2_t b = __builtin_convertvector(v, bf16x2_t); return __builtin_bit_cast(unsigned, b); }
#endif
DEVFN void st4(bf16_t* p, float a, float b, float c, float d) { U2 v; v.x = pk2(a, b); v.y = pk2(c, d); *(U2*)p = v; }
DEVFN void st2(bf16_t* p, float a, float b) { *(unsigned*)p = pk2(a, b); }
DEVFN void st8(bf16_t* p, const float* v) { U4 w; w.x = pk2(v[0], v[1]); w.y = pk2(v[2], v[3]); w.z = pk2(v[4], v[5]); w.w = pk2(v[6], v[7]); *(U4*)p = w; }
DEVFN void up8(const U4& v, float* o) { const unsigned u[4] = {v.x, v.y, v.z, v.w};
#pragma unroll
    for (int i = 0; i < 4; ++i) { unsigned lo = u[i] << 16, hi = u[i] & 0xffff0000u; memcpy(&o[2 * i], &lo, 4); memcpy(&o[2 * i + 1], &hi, 4); } }
struct alignas(16) F4v { float x, y, z, w; };
DEVFN void ld4(const bf16_t* p, float* o) { const U2 v = *(const U2*)p; unsigned t; t = v.x << 16; memcpy(&o[0], &t, 4); t = v.x & 0xffff0000u; memcpy(&o[1], &t, 4); t = v.y << 16; memcpy(&o[2], &t, 4); t = v.y & 0xffff0000u; memcpy(&o[3], &t, 4); }

DEVFN int rotmap(int c, int half) { const int g = c >> 2, e = c & 3; return e < 2 ? 2 * g + e : half + 2 * g + (e - 2); }
DEVFN int src_w1(int n) {
    if (n < V1_SBK) return C_SBQ + n;
    if (n < V1_CQ) return C_SBK + (n - V1_SBK);
    if (n < V1_CKV) return C_CQ + (n - V1_CQ);
    if (n < V1_KR) return C_CKV + (n - V1_CKV);
    if (n < V1_DQ) return C_KR + rotmap(n - V1_KR, 16);
    if (n < V1_DK) { const int c = n - V1_DQ, cc = c & 63; return C_DQ + (c & ~63) + (cc < 16 ? rotmap(cc, 8) : cc); }
    if (n < V1_END) { const int c = n - V1_DK, cc = c & 63; return C_DK + (c & ~63) + (cc < 16 ? rotmap(cc, 8) : cc); }
    return -1;
}
DEVFN int src_wv(int n) { return n < W ? C_SBV + n : C_DV + (n - W); }
DEVFN int src_w3(int n) { return n < W ? C_SBZ + n : n < 2 * W ? C_MZ + (n - W) : n < 3 * W ? C_DZ + (n - 2 * W) : C_G + (n - 3 * W); }
DEVFN int src_uq(int n) { const int h = n / 96, cc = n % 96; return h * 96 + (cc < 64 ? cc : 64 + rotmap(cc - 64, 16)); }
DEVFN int src_uk(int n) { return (n >> 6) * 128 + (n & 63); }
DEVFN int src_uv(int n) { return (n >> 6) * 128 + 64 + (n & 63); }

#ifdef HOST_EMU
DEVFN float quad_sum(float s) { return s; }
#else
template <int CTRL> DEVFN float dpp_get(float s) { return __int_as_float(__builtin_amdgcn_update_dpp(0, __float_as_int(s), CTRL, 0xf, 0xf, true)); }
DEVFN float xor16_sum(float s) { auto r = __builtin_amdgcn_permlane16_swap(__float_as_uint(s), __float_as_uint(s), false, false); return __uint_as_float(r[0]) + __uint_as_float(r[1]); }
DEVFN float xor32_sum(float s) { auto r = __builtin_amdgcn_permlane32_swap(__float_as_uint(s), __float_as_uint(s), false, false); return __uint_as_float(r[0]) + __uint_as_float(r[1]); }
DEVFN float quad_sum(float s) { return xor32_sum(xor16_sum(s)); }
DEVFN float quad4_sum(float s) { s += dpp_get<0xB1>(s); s += dpp_get<0x4E>(s); return s; }
DEVFN float wave_sum(float s) { s = quad4_sum(s); s += dpp_get<0x124>(s); s += dpp_get<0x128>(s); return xor32_sum(xor16_sum(s)); }
#endif
struct NoPre {};
DEVFN float ssq8(const float* v) { return ((v[0] * v[0] + v[1] * v[1]) + (v[2] * v[2] + v[3] * v[3])) + ((v[4] * v[4] + v[5] * v[5]) + (v[6] * v[6] + v[7] * v[7])); }
DEVFN void rope4(bf16_t* o, int half, int g, const float* v, const float* cs, const float* sn, float sc) {
    const float c0 = cs[2 * g], c1 = cs[2 * g + 1], s0 = sn[2 * g], s1 = sn[2 * g + 1];
    st2(o + 2 * g, (v[0] * c0 - v[2] * s0) * sc, (v[1] * c1 - v[3] * s1) * sc); st2(o + half + 2 * g, (v[2] * c0 + v[0] * s0) * sc, (v[3] * c1 + v[1] * s1) * sc);
}
struct F1 {
    const Params& p; int aux; typedef NoPre Pre;
    DEVFN bool swapped(int tag) const { return tag == 1; }
    DEVFN float scale(int tag, int idx) const { return rstd_slots(p.ssx, idx, NSX, 1.0f / D); }
    DEVFN void preload(int, int, int, Pre&) const {}
    DEVFN float apply(int tag, int row, int vc, const float* a, const float* sc, const Pre&) const {
        if (tag == 1) { const bool sb = UNI(row) < W; bf16_t* const vs = opq(p.VSBT); bf16_t* const vd = opq(p.VDT); bf16_t* o = (sb ? vs + (size_t)row * R : vd + (size_t)(row - W) * R) + (vc & ~15);
            const int t0 = vc & 15;
            st4(o + sperm(t0), a[0] * sc[0], a[1] * sc[1], a[2] * sc[2], a[3] * sc[3]); st4(o + sperm(t0 + 4), a[4] * sc[4], a[5] * sc[5], a[6] * sc[6], a[7] * sc[7]); return 0.f; }
        const int vcu = UNI(vc); const float rs = sc[0]; float v[8];
#pragma unroll
        for (int i = 0; i < 8; ++i) v[i] = a[i] * rs;
        const int t = row % TB; const int pos = t >= LEAD ? t - LEAD : 0;
        if (vcu < V1_SBK) {
#pragma unroll
            for (int i = 0; i < 8; ++i) v[i] *= 0.125f * LOG2E;
            st8(p.QSB + (size_t)row * W + vc, v); }
        else if (vcu < V1_CQ) { st8(p.KSB + (size_t)row * W + (vc - V1_SBK), v); }
        else if (vcu < V1_CKV) { st8(p.CQ + (size_t)row * QR + (vc - V1_CQ), v); return ssq8(v); }
        else if (vcu < V1_KR) { st8(p.CKV + (size_t)row * KVR + (vc - V1_CKV), v); return ssq8(v); }
        else if (vcu < V1_DQ) { const int g = (vc - V1_KR) >> 2; bf16_t* o = p.KR + (size_t)row * 32; rope4(o, 16, g, v, p.cosm + pos * 16, p.sinm + pos * 16, 1.f); rope4(o, 16, g + 1, v + 4, p.cosm + pos * 16, p.sinm + pos * 16, 1.f); }
        else if (vcu < V1_END) { const bool isq = vcu < V1_DK; const int c = vc - (isq ? V1_DQ : V1_DK), cc = c & 63; const float sc2 = isq ? 0.125f * LOG2E : 1.0f;
            bf16_t* const qd = opq(p.QD); bf16_t* const kd = opq(p.KD); bf16_t* o = (isq ? qd : kd) + (size_t)row * W + (c & ~63);
            if (cc < 16  ) { const int g = cc >> 2; rope4(o, 8, g, v, p.cosd + pos * 8, p.sind + pos * 8, sc2); rope4(o, 8, g + 1, v + 4, p.cosd + pos * 8, p.sind + pos * 8, sc2); }
            else {
#pragma unroll
                for (int i = 0; i < 8; ++i) v[i] *= sc2;
                st8(o + cc, v); } }
        return 0.f;
    }
    DEVFN void rowslot(int tag, int row, int vc0, int fq, float part) const {
        if (tag != 0 || vc0 < V1_CQ || vc0 >= V1_KR) return;
        const float s = quad_sum(part);
        if (fq == 0) { if (vc0 < V1_CKV) p.ssq[(size_t)row * NSQ + ((vc0 - V1_CQ) >> 5)] = s; else p.ssk[(size_t)row * NSK + ((vc0 - V1_CKV) >> 5)] = s; }
    }
};
struct FUQ {
    const Params& p; int aux; typedef NoPre Pre;
    DEVFN bool swapped(int) const { return false; }
    DEVFN float scale(int, int idx) const { return rstd_slots(p.ssq, idx, NSQ, 1.0f / QR) * (LOG2E * 0.10206207261596577f); }
    DEVFN void preload(int, int, int, Pre&) const {}
    DEVFN float apply(int, int row, int vc, const float* a, const float* sc, const Pre&) const {
        const float rs = sc[0]; float v[8];
#pragma unroll
        for (int i = 0; i < 8; ++i) v[i] = a[i] * rs;
        const int t = row % TB; const int pos = t >= LEAD ? t - LEAD : 0;
        const int h = vc / 96, cc = vc % 96; bf16_t* o = p.QB + (size_t)row * QBW + h * 96;
        if (UNI(vc) % 96 < 64) st8(o + cc, v);
        else { const int g = (cc - 64) >> 2; rope4(o + 64, 16, g, v, p.cosm + pos * 16, p.sinm + pos * 16, 1.f); rope4(o + 64, 16, g + 1, v + 4, p.cosm + pos * 16, p.sinm + pos * 16, 1.f); }
        return 0.f;
    }
    DEVFN void rowslot(int, int, int, int, float) const {}
};
struct FUK {
    const Params& p; int aux; typedef NoPre Pre;
    DEVFN bool swapped(int tag) const { return tag == 1; }
    DEVFN float scale(int, int idx) const { return rstd_slots(p.ssk, idx, NSK, 1.0f / KVR); }
    DEVFN void preload(int, int, int, Pre&) const {}
    DEVFN float apply(int tag, int row, int vc, const float* a, const float* sc, const Pre&) const {
        if (tag == 1) { bf16_t* o = p.VBT + (size_t)row * R + (vc & ~15); const int t0 = vc & 15;
            st4(o + sperm(t0), a[0] * sc[0], a[1] * sc[1], a[2] * sc[2], a[3] * sc[3]); st4(o + sperm(t0 + 4), a[4] * sc[4], a[5] * sc[5], a[6] * sc[6], a[7] * sc[7]); }
        else { float v[8];
#pragma unroll
            for (int i = 0; i < 8; ++i) v[i] = a[i] * sc[0];
            st8(p.KNOPE + (size_t)row * W + vc, v); }
        return 0.f;
    }
    DEVFN void rowslot(int, int, int, int, float) const {}
};
struct F3 {
    const Params& p; int layer; typedef U4 Pre;
    DEVFN bool swapped(int) const { return false; }
    DEVFN float scale(int, int idx) const { return rstd_slots(p.ssx, idx, NSX, 1.0f / D); }
    DEVFN bf16_t* optr(int row, int vc) const { const int vcu = UNI(vc); bf16_t* const o0 = opq(p.QSB); bf16_t* const o1 = opq(p.OMLA); bf16_t* const o2 = opq(p.QD); return (vcu < W ? o0 : vcu < 2 * W ? o1 : o2) + (size_t)row * W + (vc % W); }
    DEVFN void preload(int, int row, int vc, Pre& pre) const { if (UNI(vc) < 3 * W) pre = *(const U4*)optr(row, vc); }
    DEVFN float apply(int, int row, int vc, const float* a, const float* sc, const Pre& pre) const {
        const float rs = sc[0]; float v[8];
        if (UNI(vc) < 3 * W) { float ov[8]; up8(pre, ov);
#pragma unroll
            for (int i = 0; i < 8; ++i) v[i] = ov[i] * silu_f(a[i] * rs);
            st8(optr(row, vc), v); }
        else { const int c = vc - 3 * W, cu = UNI(c), b = cu / D, cc = c - b * D; const F4v b0 = *(const F4v*)(p.b_gate + (size_t)layer * 3 * D + c), b1 = *(const F4v*)(p.b_gate + (size_t)layer * 3 * D + c + 4);
            v[0] = sigm_f(a[0] * rs + b0.x); v[1] = sigm_f(a[1] * rs + b0.y); v[2] = sigm_f(a[2] * rs + b0.z); v[3] = sigm_f(a[3] * rs + b0.w);
            v[4] = sigm_f(a[4] * rs + b1.x); v[5] = sigm_f(a[5] * rs + b1.y); v[6] = sigm_f(a[6] * rs + b1.z); v[7] = sigm_f(a[7] * rs + b1.w);
            st8(gptr(p, b, row, cc), v); }
        return 0.f;
    }
    DEVFN void rowslot(int, int, int, int, float) const {}
};
struct F4 {
    const Params& p; int aux; struct Pre { U4 g, m; };
    DEVFN bool swapped(int) const { return false; }
    DEVFN float scale(int, int) const { return 1.f; }
    DEVFN void preload(int tag, int row, int c, Pre& pre) const { pre.g = *(const U4*)gptr(p, tag & 3, row, c); if (tag >> 2) pre.m = *(const U4*)(p.G0 + (size_t)row * D + c); }
    DEVFN float apply(int tag, int row, int c, const float* a, const float*, const Pre& pre) const {
        float g[8], m[8], v[8]; up8(pre.g, g);
        if (tag >> 2) up8(pre.m, m); else {
#pragma unroll
            for (int i = 0; i < 8; ++i) m[i] = 0.f; }
#pragma unroll
        for (int i = 0; i < 8; ++i) v[i] = m[i] + g[i] * a[i];
        st8(p.G0 + (size_t)row * D + c, v); return 0.f;
    }
    DEVFN void rowslot(int, int, int, int, float) const {}
};
struct F5 {
    const Params& p; int last; struct Pre { F4v x0, x1; };
    DEVFN bool swapped(int) const { return false; }
    DEVFN float scale(int, int) const { return 1.f; }
    DEVFN void preload(int, int row, int c, Pre& pre) const { const F4v* x = (const F4v*)(p.X + (size_t)row * D + c); pre.x0 = x[0]; pre.x1 = x[1]; }
    DEVFN float apply(int, int row, int c, const float* a, const float*, const Pre& pre) const {
        float v[8] = {pre.x0.x + a[0], pre.x0.y + a[1], pre.x0.z + a[2], pre.x0.w + a[3], pre.x1.x + a[4], pre.x1.y + a[5], pre.x1.z + a[6], pre.x1.w + a[7]};
        F4v* x = (F4v*)(p.X + (size_t)row * D + c); x[0] = F4v{v[0], v[1], v[2], v[3]}; x[1] = F4v{v[4], v[5], v[6], v[7]};
        if (!last) st8(p.XB + (size_t)row * D + c, v);
        return ssq8(v);
    }
    DEVFN void rowslot(int, int row, int vc0, int fq, float part) const { const float s = quad_sum(part); if (fq == 0) p.ssx[(size_t)row * NSX + (vc0 >> 5)] = s; }
};

#ifdef HOST_EMU
struct dim3e { unsigned x, y, z; };
static dim3e threadIdx, blockIdx, blockDim, gridDim;
#define GLOBAL static
#define LB64
#define LAUNCH(kern, nblk, nthr, ...) do { gridDim.x = (unsigned)(nblk); blockDim.x = (unsigned)(nthr); for (unsigned b_ = 0; b_ < gridDim.x; ++b_) for (unsigned t_ = 0; t_ < blockDim.x; ++t_) { blockIdx.x = b_; threadIdx.x = t_; kern(__VA_ARGS__); } } while (0)
#else
#define GLOBAL __global__
#define LB64 __launch_bounds__(64)
#define LAUNCH(kern, nblk, nthr, ...) kern<<<dim3((unsigned)(nblk)), dim3((unsigned)(nthr)), 0, stream>>>(__VA_ARGS__)
#endif
#define GTID ((long)blockIdx.x * blockDim.x + threadIdx.x)

#ifdef HOST_EMU
template <int MAP> GLOBAL void k_prep_w(bf16_t* dst, int N, int K, const float* src, int src_ld, const float* rowscale) {
    const long i = GTID; if (i >= (long)N * K) return;
    const int n = (int)(i % N), k = (int)(i / N);
    int s;
    if (MAP == 0) s = src_w1(n); else if (MAP == 1) s = src_wv(n); else if (MAP == 2) s = src_w3(n); else if (MAP == 3) s = src_uq(n); else if (MAP == 4) s = src_uk(n); else if (MAP == 5) s = src_uv(n); else s = n;
    float v = 0.f; if (s >= 0) v = src[(size_t)k * src_ld + s] * (rowscale ? rowscale[k] : 1.f);
    dst[(size_t)n * K + k] = f2bf(v);
}
GLOBAL void k_tables(Params p) {
    const long i = GTID;
    if (i < NPOS * 16) { const int pos = (int)(i / 16), j = (int)(i % 16); const float inv = (float)pow(500000.0, -(double)(2 * j) / 32.0); const float ang = (float)pos * inv;
        p.cosm[i] = (float)cos((double)ang); p.sinm[i] = (float)sin((double)ang); }
    if (i < NPOS * 8) { const int pos = (int)(i / 8), j = (int)(i % 8); const float inv = (float)pow(500000.0, -(double)(2 * j) / 16.0); const float ang = (float)pos * inv;
        p.cosd[i] = (float)cos((double)ang); p.sind[i] = (float)sin((double)ang); }
    if (i < DEPTH) { const float* lm = p.dlam + i * 4 * 64; float s0 = 0.f, s1 = 0.f; for (int d = 0; d < 64; ++d) { s0 += lm[d] * lm[64 + d]; s1 += lm[128 + d] * lm[192 + d]; }
        p.lamv[i] = expf(s0) - expf(s1) + (0.8f - 0.6f * expf(-0.3f * (float)i)); }
}
GLOBAL void k_init_x(Params p) {
    const long i = GTID; if (i >= (long)R * D) return;
    const int row = (int)(i / D), c = (int)(i % D), b = row / TB, t = row % TB;
    const float v = t < LEAD ? 0.f : t < LEAD + NMETA ? p.meta[(t - LEAD) * D + c] : p.x[((size_t)b * SEQ + (t - LEAD - NMETA)) * D + c];
    p.X[i] = v; p.XB[i] = f2bf(v);
}
GLOBAL void k_x2bf(Params p) { const long i = GTID; if (i >= (long)R * D) return; p.XB2[i] = f2bf(p.X[i]); }
GLOBAL void k_ssq_f32(const float* X, int n, float* slots, int ns) {
    const long row = GTID; if (row >= R) return; float s = 0.f; for (int c = 0; c < n; ++c) { const float v = X[(size_t)row * n + c]; s += v * v; }
    slots[row * ns] = s; for (int i = 1; i < ns; ++i) slots[row * ns + i] = 0.f;
}
GLOBAL void k_ssq_bf(const bf16_t* X, int n, float* slots, int ns) {
    const long row = GTID; if (row >= R) return; float s = 0.f; for (int c = 0; c < n; ++c) { const float v = bf2f(X[(size_t)row * n + c]); s += v * v; }
    slots[row * ns] = s; for (int i = 1; i < ns; ++i) slots[row * ns + i] = 0.f;
}
GLOBAL void k_final(Params p) {
    const long i = GTID; if (i >= (long)NB * SEQ) return;
    const int b = (int)(i / SEQ), s = (int)(i % SEQ); const float* x = p.X + ((size_t)b * TB + LEAD + NMETA + s) * D; float ss = 0.f;
    for (int c = 0; c < D; ++c) ss += x[c] * x[c];
    const float rs = rsq(ss / D + EPS); float* o = p.out + (size_t)i * D;
    for (int c = 0; c < D; ++c) o[c] = x[c] * rs * p.final_g[c];
}

template <class Epi> GLOBAL void k_gemm(const bf16_t* A, int lda, const bf16_t* Bt, int ldb, int M, int N, int K, Params pp, int aux, int tag) {
    const Epi epi{pp, aux};
    const long idx = GTID; const int n8 = N / 8; if (idx >= (long)M * n8) return;
    const int m = (int)(idx / n8), n0 = (int)(idx % n8) * 8;
    float acc[8] = {0.f, 0.f, 0.f, 0.f, 0.f, 0.f, 0.f, 0.f};
    const bf16_t* a = A + (size_t)m * lda; const bf16_t* b0 = Bt + (size_t)n0 * ldb;
    for (int k = 0; k < K; k += 8) {
        float av[8]; ld8(a + k, av);
        for (int i = 0; i < 8; ++i) { float bv[8]; ld8(b0 + (size_t)i * ldb + k, bv); float s = 0.f;
            for (int j = 0; j < 8; ++j) s += av[j] * bv[j];
            acc[i] += s; }
    }
    float sc[8]; if (epi.swapped(tag)) { for (int i = 0; i < 8; ++i) sc[i] = epi.scale(tag, n0 + i); } else sc[0] = epi.scale(tag, m);
    typename Epi::Pre pre; epi.preload(tag, m, n0, pre); epi.apply(tag, m, n0, acc, sc, pre);
}

GLOBAL void LB64 k_attn_sb(Params p) {
    const long i = GTID; if (i >= (long)NB * NH * TB) return;
    const int t = (int)(i % TB), h = (int)((i / TB) % NH), b = (int)(i / ((long)TB * NH));
    const size_t row = (size_t)b * TB + t; bf16_t* qo = p.QSB + row * W + h * 64;
    float q[64], o[64];
#pragma unroll
    for (int d = 0; d < 64; ++d) { q[d] = bf2f(qo[d]); o[d] = 0.f; }
    if (t >= LEAD) {
        float carry = 0.f;
        for (int j = t - 1; j >= LEAD; --j) {
            const size_t kr = (size_t)b * TB + j; const bf16_t* k = p.KSB + kr * W + h * 64; float z = 0.f;
#pragma unroll
            for (int d = 0; d < 64; ++d) z += q[d] * bf2f(k[d]);
            const float sp = fmaxf(z, 0.f) + log2f(1.f + exp2f(-fabsf(z)));
            const float w = exp2f((z - sp) + carry); carry -= sp;
            const bf16_t* vt = p.VSBT + (size_t)(h * 64) * R + ((kr & ~(size_t)15) | sperm((int)(kr & 15)));
#pragma unroll
            for (int d = 0; d < 64; ++d) o[d] += w * bf2f(vt[(size_t)d * R]);
        }
    }
#pragma unroll
    for (int d = 0; d < 64; ++d) qo[d] = f2bf(o[d]);
}
GLOBAL void LB64 k_attn_mla(Params p) {
    const long i = GTID; if (i >= (long)NB * NH * TB) return;
    const int t = (int)(i % TB), h = (int)((i / TB) % NH), b = (int)(i / ((long)TB * NH));
    const size_t row = (size_t)b * TB + t; const bf16_t* qp = p.QB + row * QBW + h * 96;
    float o[64]; float m = -INFINITY, l = 0.f;
#pragma unroll
    for (int d = 0; d < 64; ++d) o[d] = 0.f;
    if (t >= LEAD) {
        const int kend = (t / 64 + 1) * 64 < TB ? (t / 64 + 1) * 64 : TB;
        for (int j = LEAD; j < kend; ++j) {
            const size_t kr = (size_t)b * TB + j; const bf16_t* kn = p.KNOPE + kr * W + h * 64; const bf16_t* kq = p.KR + kr * 32; float s = 0.f;
            for (int d = 0; d < 64; ++d) s += bf2f(qp[d]) * bf2f(kn[d]);
            for (int d = 0; d < 32; ++d) s += bf2f(qp[64 + d]) * bf2f(kq[d]);
            const float mn = fmaxf(m, s), f = exp2f(m - mn), w = exp2f(s - mn); m = mn; l = l * f + w;
            const bf16_t* vt = p.VBT + (size_t)(h * 64) * R + ((kr & ~(size_t)15) | sperm((int)(kr & 15)));
#pragma unroll
            for (int d = 0; d < 64; ++d) o[d] = o[d] * f + w * bf2f(vt[(size_t)d * R]);
        }
    }
    const float il = l > 0.f ? 1.f / l : 0.f; bf16_t* op = p.OMLA + row * W + h * 64;
#pragma unroll
    for (int d = 0; d < 64; ++d) op[d] = f2bf(o[d] * il);
}
GLOBAL void LB64 k_attn_diff(Params p, int layer) {
    const long i = GTID; if (i >= (long)NB * NHD * TB) return;
    const int t = (int)(i % TB), h = (int)((i / TB) % NHD), b = (int)(i / ((long)TB * NHD));
    const size_t row = (size_t)b * TB + t; bf16_t* qo = p.QD + row * W + h * 128;
    const float lam = p.lamv[layer], lam_init = 0.8f - 0.6f * expf(-0.3f * (float)layer);
    float o[128];
#pragma unroll
    for (int d = 0; d < 128; ++d) o[d] = 0.f;
    if (t >= LEAD) {
        const int kend = (t / 64 + 1) * 64 < TB ? (t / 64 + 1) * 64 : TB;
        float m0 = -INFINITY, l0 = 0.f, m1 = -INFINITY, l1 = 0.f;
        for (int j = LEAD; j < kend; ++j) { const bf16_t* k = p.KD + ((size_t)b * TB + j) * W + h * 128; float s0 = 0.f, s1 = 0.f;
            for (int d = 0; d < 64; ++d) { s0 += bf2f(qo[d]) * bf2f(k[d]); s1 += bf2f(qo[64 + d]) * bf2f(k[64 + d]); }
            float mn = fmaxf(m0, s0); l0 = l0 * exp2f(m0 - mn) + exp2f(s0 - mn); m0 = mn; mn = fmaxf(m1, s1); l1 = l1 * exp2f(m1 - mn) + exp2f(s1 - mn); m1 = mn; }
        const float i0 = 1.f / l0, i1 = lam / l1;
        for (int j = LEAD; j < kend; ++j) { const size_t kr = (size_t)b * TB + j; const bf16_t* k = p.KD + kr * W + h * 128; float s0 = 0.f, s1 = 0.f;
            for (int d = 0; d < 64; ++d) { s0 += bf2f(qo[d]) * bf2f(k[d]); s1 += bf2f(qo[64 + d]) * bf2f(k[64 + d]); }
            const float w = exp2f(s0 - m0) * i0 - exp2f(s1 - m1) * i1;
            const bf16_t* vt = p.VDT + (size_t)(h * 128) * R + ((kr & ~(size_t)15) | sperm((int)(kr & 15)));
#pragma unroll
            for (int d = 0; d < 128; ++d) o[d] += w * bf2f(vt[(size_t)d * R]);
        }
    }
    float ss = 0.f;
#pragma unroll
    for (int d = 0; d < 128; ++d) ss += o[d] * o[d];
    const float rs = rsq(ss * (1.f / 128.f) + EPS) * (1.f - lam_init); const float* g = p.dnorm_g + (size_t)layer * 128;
#pragma unroll
    for (int d = 0; d < 128; ++d) qo[d] = f2bf(o[d] * rs * g[d]);
}


#endif
#ifndef HOST_EMU
namespace pg8 {
#define PG8_LAS __attribute__((address_space(3)))
typedef short bf16x8 __attribute__((ext_vector_type(8)));
typedef float f32x4 __attribute__((ext_vector_type(4)));
typedef unsigned u32x4 __attribute__((ext_vector_type(4)));
constexpr int BM = 256, BK = 64, HALF = 128, HTB = HALF * BK * 2  , STAGE_BYTES = 8 * HTB, NXCD = 8, WGM = 8;
__host__ __device__ __forceinline__ int lds_byte(int r, int c) { const int st = (r >> 4) * 2 + (c >> 5), rr = r & 15, cc = c & 31, ob = rr * 64 + cc * 2; return st * 1024 + (ob ^ (((ob >> 9) & 1) << 5)); }
__host__ __device__ __forceinline__ void stage_rc(int b, int& R, int& C) { const int st = b / 1024, sb = b % 1024, swz = sb ^ (((sb >> 9) & 1) << 5); R = (st >> 1) * 16 + swz / 64; C = (st & 1) * 32 + (swz % 64) / 2; }
__host__ __device__ __forceinline__ int perm32(int rho) { const int n = rho >> 4, i = rho & 15; return 8 * (i >> 2) + 4 * n + (i & 3); }
struct Unit { int pm, pn, tag; const char* A; const char* B; };
struct Gemm { int K, lda, ldb; };
__device__ __forceinline__ void order_map(int L, int nM, int nN, int& pm, int& pn) {
    const int nwg = nM * nN; int wgid = L; { const int q = nwg / NXCD, r = nwg % NXCD, xcd = wgid % NXCD, off = wgid / NXCD; wgid = (xcd < r ? xcd * (q + 1) : r * (q + 1) + (xcd - r) * q) + off; }
    const int nig = WGM * nN, gid = wgid / nig, fm = gid * WGM, gsz = (nM - fm) < WGM ? (nM - fm) : WGM;
    pm = fm + ((wgid % nig) % gsz); pn = (wgid % nig) / gsz;
}
template <class F> struct EpiAd {
    static constexpr bool PERM = true, AFTER_DRAIN = false;
    F f;
    __device__ __forceinline__ void operator()(const f32x4 (&acc)[2][2][4][2], const Unit& u, int wr, int wc, int fr, int fq, PG8_LAS unsigned char* scr, int tid) const {
        PG8_LAS float* rs = (PG8_LAS float*)scr;
        const bool sw = f.swapped(u.tag);
        if (tid < 256) rs[tid] = f.scale(u.tag, (sw ? u.pn : u.pm) * BM + tid);
        asm volatile("s_waitcnt lgkmcnt(0)" ::: "memory"); __builtin_amdgcn_s_barrier(); asm volatile("" ::: "memory");
#pragma unroll
        for (int ai = 0; ai < 2; ++ai) {
            int rl0 = ai * HALF + wr * 64 + fr, fqo = fq; asm volatile("" : "+v"(rl0), "+v"(fqo));
            typename F::Pre pre[4][2];
#pragma unroll
            for (int m = 0; m < 4; ++m)
#pragma unroll
                for (int bj = 0; bj < 2; ++bj) f.preload(u.tag, u.pm * BM + rl0 + m * 16, u.pn * BM + bj * HALF + wc * 32 + 8 * fqo, pre[m][bj]);
#pragma unroll
            for (int m = 0; m < 4; ++m) { const int rl = rl0 + m * 16, row = u.pm * BM + rl;
#pragma unroll
                for (int bj = 0; bj < 2; ++bj) { const int cl = bj * HALF + wc * 32 + 8 * fqo; const f32x4 v0 = acc[ai][bj][m][0], v1 = acc[ai][bj][m][1]; const float a8[8] = {v0[0], v0[1], v0[2], v0[3], v1[0], v1[1], v1[2], v1[3]};
                    float sc[8];
                    if (sw) {
#pragma unroll
                        for (int i = 0; i < 8; ++i) sc[i] = rs[cl + i]; }
                    else { sc[0] = rs[rl];
#pragma unroll
                        for (int i = 1; i < 8; ++i) sc[i] = 0.f; }
                    const float part = f.apply(u.tag, row, u.pn * BM + cl, a8, sc, pre[m][bj]);
                    f.rowslot(u.tag, row, u.pn * BM + bj * HALF + wc * 32, fq, part); } }
            asm volatile("" ::: "memory");
        }
    }
};
template <class Epi, class Sched, bool ALIGN_EPI = false, bool SP2 = false>
__device__ __forceinline__ void gemm_phase(PG8_LAS unsigned char* lds, const Gemm g, const Sched& S, const Epi& E, const int wid0  ) {
    int lane_ = lane_id_v();
    const int wid = wid0, lane = lane_, tid = wid * 64 + lane, wr = wid >> 2, wc = wid & 3, fr = lane & 15, fq = lane >> 4;
    const int K = g.K, nt = K / BK, lda = g.lda, ldb = g.ldb;
    unsigned voffA[2], voffB[2];
#pragma unroll
    for (int i = 0; i < 2; ++i) { int R, C; stage_rc(tid * 16 + i * 8192, R, C); const int Rb = Epi::PERM ? ((R & ~31) + perm32(R & 31)) : R;
        voffA[i] = (unsigned)(R * lda + C) * 2u; voffB[i] = (unsigned)(Rb * ldb + C) * 2u; }
    const size_t kstep = (size_t)(BK * 2);
    const size_t hstepA = (size_t)HALF * lda * 2, hstepB = (size_t)HALF * ldb * 2;
    const size_t tstepA = 2 * hstepA, tstepB = 2 * hstepB;
    const unsigned ldsw = (unsigned)wid * 1024u;
    const int aoff = lds_byte(wr * 64 + fr, fq * 8), boff = lds_byte(wc * 32 + fr, fq * 8);
#define PG8_SA(b, h) (((b) * 2 + (h)) * HTB)
#define PG8_SB(b, h) ((4 + (b) * 2 + (h)) * HTB)
#define PG8_STAGE(bufoff, gbase, voff) do { _Pragma("unroll") for (int _i = 0; _i < 2; ++_i) \
        __builtin_amdgcn_global_load_lds((const unsigned*)((const char*)(gbase) + (voff)[_i]), (PG8_LAS unsigned*)(lds + (bufoff) + ldsw + _i * 8192), 16, 0, 0); } while (0)
#define PG8_LDA(dst, b, h) do { _Pragma("unroll") for (int m = 0; m < 4; ++m) _Pragma("unroll") for (int k = 0; k < 2; ++k) dst[m][k] = *(const PG8_LAS bf16x8*)(lds + PG8_SA(b, h) + aoff + m * 2048 + k * 1024); } while (0)
#define PG8_LDB(dst, b, h) do { _Pragma("unroll") for (int n = 0; n < 2; ++n) _Pragma("unroll") for (int k = 0; k < 2; ++k) dst[n][k] = *(const PG8_LAS bf16x8*)(lds + PG8_SB(b, h) + boff + n * 2048 + k * 1024); } while (0)
#define PG8_MMA(ai, bj, At, Bt) do { __builtin_amdgcn_s_setprio(1); _Pragma("unroll") for (int m = 0; m < 4; ++m) _Pragma("unroll") for (int n = 0; n < 2; ++n) _Pragma("unroll") for (int k = 0; k < 2; ++k) \
        acc[ai][bj][m][n] = __builtin_amdgcn_mfma_f32_16x16x32_bf16(Bt[n][k], At[m][k], acc[ai][bj][m][n], 0, 0, 0); __builtin_amdgcn_s_setprio(0); } while (0)
#define PG8_WAIT_V(n) asm volatile("s_waitcnt vmcnt(" #n ")" ::: "memory")
#define PG8_WAIT_L(n) asm volatile("s_waitcnt lgkmcnt(" #n ")" ::: "memory")
#define PG8_BAR __builtin_amdgcn_s_barrier()
#define PG8_SCHED __builtin_amdgcn_sched_barrier(0)
    Unit cur, nxt; int ui = 0;
    if (!S.next(0, cur)) return;
    f32x4 acc[2][2][4][2];
#pragma unroll
    for (int a = 0; a < 2; ++a)
#pragma unroll
        for (int b = 0; b < 2; ++b)
#pragma unroll
            for (int m = 0; m < 4; ++m)
#pragma unroll
                for (int n = 0; n < 2; ++n) acc[a][b][m][n] = (f32x4){0.f, 0.f, 0.f, 0.f};
    bf16x8 At[4][2], B0[2][2], B1[2][2];
    const char* cA = cur.A + (size_t)cur.pm * tstepA; const char* cB = cur.B + (size_t)cur.pn * tstepB;
    S.a_ready(cur);
    if constexpr (SP2) {
        PG8_STAGE(PG8_SB(0, 0), cB, voffB); PG8_STAGE(PG8_SB(0, 1), cB + hstepB, voffB); PG8_STAGE(PG8_SA(0, 0), cA, voffA); PG8_STAGE(PG8_SA(0, 1), cA + hstepA, voffA);
        if (wr == 1) PG8_BAR;
        PG8_WAIT_V(2); PG8_BAR;
        PG8_STAGE(PG8_SB(1, 0), cB + kstep, voffB); PG8_STAGE(PG8_SA(1, 0), cA + kstep, voffA); PG8_STAGE(PG8_SB(1, 1), cB + hstepB + kstep, voffB);
        PG8_WAIT_V(6); PG8_BAR;
    } else {
        PG8_STAGE(PG8_SB(0, 0), cB, voffB); PG8_STAGE(PG8_SA(0, 0), cA, voffA); PG8_STAGE(PG8_SB(0, 1), cB + hstepB, voffB); PG8_STAGE(PG8_SA(0, 1), cA + hstepA, voffA);
        if (wr == 1) PG8_BAR;
        PG8_WAIT_V(4); PG8_BAR;
        PG8_STAGE(PG8_SB(1, 0), cB + kstep, voffB); PG8_STAGE(PG8_SA(1, 0), cA + kstep, voffA); PG8_STAGE(PG8_SB(1, 1), cB + hstepB + kstep, voffB);
        PG8_WAIT_V(6); PG8_BAR;
    }
    for (;;) {
        const bool has_next = S.next(ui + 1, nxt);
        const char* nA = has_next ? nxt.A + (size_t)nxt.pm * tstepA : cA; const char* nB = has_next ? nxt.B + (size_t)nxt.pn * tstepB : cB;
#pragma nounroll
        for (int t = 0; t < nt; t += 2) {
            const bool last = (t == nt - 2);
            const char* a1 = cA + (size_t)(t + 1) * kstep;
            const char* a2 = last ? nA : cA + (size_t)(t + 2) * kstep; const char* b2 = last ? nB : cB + (size_t)(t + 2) * kstep;
            const char* a3 = a2 + kstep; const char* b3 = b2 + kstep;
            if (last && has_next) S.a_ready(nxt);
            if constexpr (SP2) {
            PG8_LDB(B0, 0, 0); PG8_LDB(B1, 0, 1); PG8_SCHED; PG8_LDA(At, 0, 0); PG8_STAGE(PG8_SA(1, 1), a1 + hstepA, voffA);
            PG8_WAIT_V(8); PG8_WAIT_L(0); PG8_BAR; PG8_MMA(0, 0, At, B0); PG8_MMA(0, 1, At, B1); PG8_BAR; PG8_SCHED;
            PG8_LDA(At, 0, 1); PG8_STAGE(PG8_SB(0, 0), b2, voffB); PG8_STAGE(PG8_SB(0, 1), b2 + hstepB, voffB); PG8_STAGE(PG8_SA(0, 0), a2, voffA);
            PG8_WAIT_V(8); PG8_WAIT_L(0); PG8_BAR; PG8_MMA(1, 0, At, B0); PG8_MMA(1, 1, At, B1); PG8_BAR; PG8_SCHED;
            PG8_LDB(B0, 1, 0); PG8_LDB(B1, 1, 1); PG8_SCHED; PG8_LDA(At, 1, 0); PG8_STAGE(PG8_SA(0, 1), a2 + hstepA, voffA);
            PG8_WAIT_V(8); PG8_WAIT_L(0); PG8_BAR; PG8_MMA(0, 0, At, B0); PG8_MMA(0, 1, At, B1); PG8_BAR; PG8_SCHED;
            PG8_LDA(At, 1, 1); PG8_STAGE(PG8_SB(1, 0), b3, voffB); PG8_STAGE(PG8_SB(1, 1), b3 + hstepB, voffB); PG8_STAGE(PG8_SA(1, 0), a3, voffA);
            PG8_WAIT_V(8); PG8_WAIT_L(0); PG8_BAR; PG8_MMA(1, 0, At, B0); PG8_MMA(1, 1, At, B1); PG8_BAR; PG8_SCHED;
            } else {
            PG8_LDB(B0, 0, 0); PG8_SCHED; PG8_LDA(At, 0, 0); PG8_STAGE(PG8_SA(1, 1), a1 + hstepA, voffA);
            PG8_WAIT_L(8); PG8_BAR; PG8_WAIT_L(0); PG8_MMA(0, 0, At, B0); PG8_BAR; PG8_SCHED;
            PG8_LDB(B1, 0, 1); PG8_STAGE(PG8_SB(0, 0), b2, voffB);
            PG8_BAR; PG8_WAIT_L(0); PG8_MMA(0, 1, At, B1); PG8_BAR;
            PG8_LDA(At, 0, 1); PG8_STAGE(PG8_SA(0, 0), a2, voffA);
            PG8_BAR; PG8_WAIT_L(0); PG8_MMA(1, 0, At, B0); PG8_BAR; PG8_SCHED;
            PG8_STAGE(PG8_SB(0, 1), b2 + hstepB, voffB);
            PG8_WAIT_V(6); PG8_BAR; PG8_MMA(1, 1, At, B1); PG8_BAR;
            PG8_LDB(B0, 1, 0); PG8_SCHED; PG8_LDA(At, 1, 0); PG8_STAGE(PG8_SA(0, 1), a2 + hstepA, voffA);
            PG8_WAIT_L(8); PG8_BAR; PG8_WAIT_L(0); PG8_MMA(0, 0, At, B0); PG8_BAR; PG8_SCHED;
            PG8_LDB(B1, 1, 1); PG8_STAGE(PG8_SB(1, 0), b3, voffB);
            PG8_BAR; PG8_WAIT_L(0); PG8_MMA(0, 1, At, B1); PG8_BAR;
            PG8_LDA(At, 1, 1); PG8_STAGE(PG8_SA(1, 0), a3, voffA);
            PG8_BAR; PG8_WAIT_L(0); PG8_MMA(1, 0, At, B0); PG8_BAR; PG8_SCHED;
            PG8_STAGE(PG8_SB(1, 1), b3 + hstepB, voffB);
            PG8_WAIT_V(6); PG8_BAR; PG8_MMA(1, 1, At, B1); PG8_BAR;
            }
        }
        if constexpr (ALIGN_EPI) { if (wr == 0) PG8_BAR; }
        if constexpr (!Epi::AFTER_DRAIN) { E(acc, cur, wr, wc, fr, fq, lds + STAGE_BYTES, tid); S.done(cur); }
        if (!has_next) break;
#pragma unroll
        for (int a = 0; a < 2; ++a)
#pragma unroll
            for (int b = 0; b < 2; ++b)
#pragma unroll
                for (int m = 0; m < 4; ++m)
#pragma unroll
                    for (int n = 0; n < 2; ++n) acc[a][b][m][n] = (f32x4){0.f, 0.f, 0.f, 0.f};
        cur = nxt; cA = nA; cB = nB; ++ui;
        if constexpr (ALIGN_EPI) { if (wr == 1) PG8_BAR; }
    }
    PG8_WAIT_V(0);
    if constexpr (!ALIGN_EPI) { if (wr == 0) PG8_BAR; }
    PG8_BAR;
    if constexpr (Epi::AFTER_DRAIN) { E.fused(acc, cur, wr, wc, fr, fq, lds, wid, lane); S.done(cur); }
#undef PG8_SA
#undef PG8_SB
#undef PG8_STAGE
#undef PG8_LDA
#undef PG8_LDB
#undef PG8_MMA
#undef PG8_WAIT_V
#undef PG8_WAIT_L
#undef PG8_BAR
#undef PG8_SCHED
}

}

struct SchedGrid {
    int nM, nN, G, c, tag; const char* A; const char* B;
    __device__ __forceinline__ bool next(int i, pg8::Unit& u) const { const long L = (long)i * G + c; if (L >= (long)nM * nN) return false; pg8::order_map((int)L, nM, nN, u.pm, u.pn); u.tag = tag; u.A = A; u.B = B; return true; }
    __device__ __forceinline__ void a_ready(const pg8::Unit&) const {}
    __device__ __forceinline__ void done(const pg8::Unit&) const {}
};
struct SchedTwo {
    int nM0, nN0, nM1, nN1, G, c; const char *A0, *B0, *A1, *B1;
    __device__ __forceinline__ bool next(int i, pg8::Unit& u) const { long L = (long)i * G + c; const long n0 = (long)nM0 * nN0;
        if (L < n0) { pg8::order_map((int)L, nM0, nN0, u.pm, u.pn); u.tag = 0; u.A = A0; u.B = B0; return true; }
        L -= n0; if (L >= (long)nM1 * nN1) return false; pg8::order_map((int)L, nM1, nN1, u.pm, u.pn); u.tag = 1; u.A = A1; u.B = B1; return true; }
    __device__ __forceinline__ void a_ready(const pg8::Unit&) const {}
    __device__ __forceinline__ void done(const pg8::Unit&) const {}
};
struct SchedP4 {
    int nM, nN, G, c; const char* A0; size_t astride; const char* B0; size_t bstride;
    __device__ __forceinline__ bool next(int i, pg8::Unit& u) const { const int j = i % 3, b = (2 * j) % 3; const long L = (long)(i / 3) * G + c; if (L >= (long)nM * nN) return false;
        pg8::order_map((int)L, nM, nN, u.pm, u.pn); u.tag = b + (j > 0 ? 4 : 0); u.A = A0 + (size_t)j * astride; u.B = B0 + (size_t)b * bstride; return true; }
    __device__ __forceinline__ void a_ready(const pg8::Unit&) const {}
    __device__ __forceinline__ void done(const pg8::Unit&) const {}
};
constexpr int LDS_SCR = pg8::STAGE_BYTES, LDS_BYTES = 147456;
#define LASP __attribute__((address_space(3)))
enum { PK_P1 = 0, PK_P2 = 1, PK_P3 = 2, PK_P3B = 3, PK_P4 = 4, PK_P5 = 5 };
__device__ __forceinline__ void gemm_part(const Params& p, LASP unsigned char* lds, int kind, int l, int G, int c, int wid0) {
    constexpr int nR = R / 256;
    if (kind == PK_P1) {
        SchedTwo S{nR, N1 / 256, 2 * W / 256, nR, G, c, (const char*)p.XB, (const char*)wptr(p, l, WL_W1), (const char*)wptr(p, l, WL_WV), (const char*)p.XB};
        pg8::EpiAd<F1> E{F1{p, 0}}; pg8::gemm_phase<pg8::EpiAd<F1>, SchedTwo, true, true>(lds, pg8::Gemm{D, D, D}, S, E, wid0);
    } else if (kind == PK_P2) {
        { SchedGrid S{nR, QBW / 256, G, c, 0, (const char*)p.CQ, (const char*)wptr(p, l, WL_UQ)};
          pg8::EpiAd<FUQ> E{FUQ{p, 0}}; pg8::gemm_phase<pg8::EpiAd<FUQ>, SchedGrid, true, true>(lds, pg8::Gemm{QR, QR, QR}, S, E, wid0); }
        { SchedTwo S{nR, W / 256, W / 256, nR, G, c, (const char*)p.CKV, (const char*)wptr(p, l, WL_UK), (const char*)wptr(p, l, WL_UV), (const char*)p.CKV};
          pg8::EpiAd<FUK> E{FUK{p, 0}}; pg8::gemm_phase<pg8::EpiAd<FUK>, SchedTwo, true, true>(lds, pg8::Gemm{KVR, KVR, KVR}, S, E, wid0); }
    } else if (kind == PK_P3B) {
        SchedGrid S{nR, N3 / 256, G, c, 0, (const char*)p.XB2, (const char*)wptr(p, l, WL_W3)};
        pg8::EpiAd<F3> E{F3{p, l}}; pg8::gemm_phase<pg8::EpiAd<F3>, SchedGrid, true, true>(lds, pg8::Gemm{D, D, D}, S, E, wid0);
    } else if (kind == PK_P4) {
        SchedP4 S{nR, D / 256, G, c, (const char*)p.QSB, (size_t)((const char*)p.QD - (const char*)p.QSB), (const char*)wptr(p, l, WL_WO), (size_t)D * W * 2};
        pg8::EpiAd<F4> E{F4{p, 0}}; pg8::gemm_phase<pg8::EpiAd<F4>, SchedP4, true, true>(lds, pg8::Gemm{W, W, W}, S, E, wid0);
    } else if (kind == PK_P5) {
        SchedGrid S{nR, D / 256, G, c, 0, (const char*)p.G0, (const char*)wptr(p, l, WL_OUT)};
        pg8::EpiAd<F5> E{F5{p, l == DEPTH - 1 ? 1 : 0}}; pg8::gemm_phase<pg8::EpiAd<F5>, SchedGrid, true, true>(lds, pg8::Gemm{D, D, D}, S, E, wid0);
    }
}
template <int KIND> __global__ void __launch_bounds__(512, 2) k_gemm_fast(Params p, int l) {
    extern __shared__ __attribute__((aligned(16))) unsigned char lds_raw[];
    gemm_part(p, (LASP unsigned char*)lds_raw, KIND, l, (int)gridDim.x, (int)blockIdx.x, __builtin_amdgcn_readfirstlane((int)threadIdx.x >> 6));
}

namespace att {
typedef short bf16x8 __attribute__((ext_vector_type(8)));
typedef float f32x16 __attribute__((ext_vector_type(16)));
typedef unsigned u32x4v __attribute__((ext_vector_type(4)));
__device__ __forceinline__ int crow(int r, int h) { return (r & 3) + 8 * (r >> 2) + 4 * h; }
__device__ __forceinline__ bf16x8 ldg8(const bf16_t* p) { return *(const bf16x8*)p; }
__device__ __forceinline__ void halves(float x, float& lo, float& hi) { auto r = __builtin_amdgcn_permlane32_swap(__float_as_uint(x), __float_as_uint(x), false, false); lo = __uint_as_float(r[0]); hi = __uint_as_float(r[1]); }
__device__ __forceinline__ bf16x8 pack8(const f32x16& v, int b) { u32x4v w; w.x = pk2(v[b], v[b + 1]); w.y = pk2(v[b + 2], v[b + 3]); w.z = pk2(v[b + 4], v[b + 5]); w.w = pk2(v[b + 6], v[b + 7]); return __builtin_bit_cast(bf16x8, w); }
constexpr float SB_DEAD = -152.0f;
#define ATT_FENCE() asm volatile("" ::: "memory")
constexpr int RING_SLOTS = 4, RING_D = 3;
__device__ __forceinline__ void dma16(const void* gsrc, LASP unsigned char* ldst) { __builtin_amdgcn_global_load_lds((const unsigned*)gsrc, (LASP unsigned*)ldst, 16, 0, 0); }
template <int NQB, int NKS, int NKSA, int NDB, bool SBM>
__device__ __forceinline__ void tile_step(const LASP unsigned char* kimg, const LASP unsigned char* krimg, const LASP unsigned char* vimg, const bool first, const bool diag, const int qoff, const int cl, const int h,
                                          const bf16x8 (&qf)[NQB][NKS], f32x16 (&o)[NDB][NQB], float (&mrun)[NQB], float (&lrun)[NQB], float (&carry)[NQB]) {
#define ATT_LDK(dst, g_) do { _Pragma("unroll") for (int j_ = 0; j_ < 2; ++j_) { const int key_ = j_ * 32 + cla; \
        dst[j_] = (g_) < NKSA ? *(const LASP bf16x8*)(kimg + key_ * 128 + (((2 * (g_) + ha) ^ (cla & 7)) << 4)) : *(const LASP bf16x8*)(krimg + key_ * 64 + (((2 * ((g_) - NKSA) + ha) ^ ((cla >> 2) & 3)) << 4)); } } while (0)
#define ATT_LDV(dst, j_) do { _Pragma("unroll") for (int d_ = 0; d_ < NDB; ++d_) dst[d_] = *(const LASP bf16x8*)(vimg + (d_ * 32 + cla) * 128 + (((2 * (j_) + ha) ^ (cla & 7)) << 4)); } while (0)
    int cla = cl, ha = h; asm volatile("" : "+v"(cla), "+v"(ha));
    bf16x8 kf0[2], kf1[2], vf0[NDB], vf1[NDB];
    ATT_LDK(kf0, 0);
    f32x16 s[2][NQB];
#pragma unroll
    for (int kb = 0; kb < 2; ++kb)
#pragma unroll
        for (int qb = 0; qb < NQB; ++qb)
#pragma unroll
            for (int r = 0; r < 16; ++r) s[kb][qb][r] = 0.f;
#pragma unroll
    for (int g = 0; g < NKS; ++g) {
        if (g + 1 < NKS) { if (g & 1) ATT_LDK(kf0, g + 1); else ATT_LDK(kf1, g + 1); } else ATT_LDV(vf0, 0);
        ATT_FENCE();
#pragma unroll
        for (int j = 0; j < 2; ++j)
#pragma unroll
            for (int qb = 0; qb < NQB; ++qb) s[j][qb] = __builtin_amdgcn_mfma_f32_32x32x16_bf16((g & 1) ? kf1[j] : kf0[j], qf[qb][g], s[j][qb], 0, 0, 0);
    }
    if (!SBM) {
        if (first) {
#pragma unroll
            for (int qb = 0; qb < NQB; ++qb) {
#pragma unroll
                for (int r = 0; r < 16; ++r) s[0][qb][r] = -INFINITY;
#pragma unroll
                for (int r = 0; r < 8; ++r) s[1][qb][r] = -INFINITY; } }
#pragma unroll
        for (int qb = 0; qb < NQB; ++qb) {
            float mx = s[0][qb][0];
#pragma unroll
            for (int r = 1; r < 16; ++r) mx = fmaxf(mx, s[0][qb][r]);
#pragma unroll
            for (int r = 0; r < 16; ++r) mx = fmaxf(mx, s[1][qb][r]);
            float m0, m1; halves(mx, m0, m1); const float mn = fmaxf(mrun[qb], fmaxf(m0, m1)); const float f = __builtin_amdgcn_exp2f(mrun[qb] - mn); mrun[qb] = mn;
            float ps = 0.f;
#pragma unroll
            for (int kb = 0; kb < 2; ++kb)
#pragma unroll
                for (int r = 0; r < 16; ++r) { const float pv = __builtin_amdgcn_exp2f(s[kb][qb][r] - mn); s[kb][qb][r] = pv; ps += pv; }
            lrun[qb] = lrun[qb] * f + ps;
#pragma unroll
            for (int d = 0; d < NDB; ++d)
#pragma unroll
                for (int r = 0; r < 16; ++r) o[d][qb][r] *= f;
        }
    } else {
#pragma unroll
        for (int qb = 0; qb < NQB; ++qb) {
            float run = carry[qb];
#pragma unroll
            for (int kb = 1; kb >= 0; --kb)
#pragma unroll
                for (int rg = 3; rg >= 0; --rg) {
                    const bool lead = first && (kb == 0 || rg < 2);
                    float y[4], sp[4]; bool ok[4];
#pragma unroll
                    for (int e = 0; e < 4; ++e) { y[e] = s[kb][qb][4 * rg + e]; ok[e] = !lead && !(diag && (kb * 32 + 8 * rg + 4 * h + e >= qoff + qb * 32 + cl));
                        sp[e] = ok[e] ? fmaxf(y[e], 0.f) + __builtin_amdgcn_logf(1.0f + __builtin_amdgcn_exp2f(-fabsf(y[e]))) : 0.f; }
                    const float gs = -((sp[0] + sp[1]) + (sp[2] + sp[3])); float g0, g1; halves(gs, g0, g1);
                    const float t1 = run; run += g1; const float t0 = run; run += g0; float a = h ? t1 : t0;
#pragma unroll
                    for (int e = 3; e >= 0; --e) { const float w = ok[e] ? __builtin_amdgcn_exp2f((y[e] - sp[e]) + a) : 0.f; a -= sp[e]; s[kb][qb][4 * rg + e] = w; }
                    __builtin_amdgcn_sched_barrier(0); }
            carry[qb] = run;
        }
    }
    ATT_FENCE();
#pragma unroll
    for (int j = 0; j < 4; ++j) {
        if (j + 1 < 4) { if (j & 1) ATT_LDV(vf0, j + 1); else ATT_LDV(vf1, j + 1); }
        ATT_FENCE();
        bf16x8 pf[NQB];
#pragma unroll
        for (int qb = 0; qb < NQB; ++qb) pf[qb] = pack8(s[j >> 1][qb], 8 * (j & 1));
#pragma unroll
        for (int d = 0; d < NDB; ++d)
#pragma unroll
            for (int qb = 0; qb < NQB; ++qb) o[d][qb] = __builtin_amdgcn_mfma_f32_32x32x16_bf16((j & 1) ? vf1[d] : vf0[d], pf[qb], o[d][qb], 0, 0, 0);
    }
#undef ATT_LDK
#undef ATT_LDV
}
template <int NQB, int NDB> __device__ __forceinline__ void store_ot(bf16_t* optr, int ldo, const f32x16 (&o)[NDB][NQB], const float (&sc)[NQB]) {
    int lane_ = lane_id_v(); const int lane = lane_, cl = lane & 31, h = lane >> 5;
#pragma unroll
    for (int qb = 0; qb < NQB; ++qb)
#pragma unroll
        for (int d = 0; d < NDB; ++d)
#pragma unroll
            for (int rg = 0; rg < 4; ++rg) st4(optr + (size_t)(qb * 32 + cl) * ldo + d * 32 + 8 * rg + 4 * h, o[d][qb][4 * rg] * sc[qb], o[d][qb][4 * rg + 1] * sc[qb], o[d][qb][4 * rg + 2] * sc[qb], o[d][qb][4 * rg + 3] * sc[qb]);
}
#define ATT_WAIT(n) asm volatile("s_waitcnt vmcnt(" #n ") lgkmcnt(0)" ::: "memory")
#define ATT_BAR() do { __builtin_amdgcn_s_barrier(); asm volatile("" ::: "memory"); } while (0)
template <bool SBM> __device__ __forceinline__ void unit8(const Params& p, LASP unsigned char* lds, const int wid, const int b, const int h, const int c0, const int nq) {
    constexpr int NKS = SBM ? 4 : 6, NQB = SBM ? 1 : 2, SLOTB = 20480, OFF_V = 8192, OFF_KR = 16384;
    const int lane = lane_id_v(), cl = lane & 31, hh = lane >> 5; const size_t r0 = (size_t)b * TB;
    const int ti = SBM ? wid >> 1 : wid, qoff = SBM ? (wid & 1) * 32 : 0;
    const int qt = c0 + ti, nt = c0 + nq; const bool active = ti < nq;
    const int swz = ((lane & 7) ^ ((lane >> 3) & 7)) << 3;
    const bf16_t* kbase = (SBM ? p.KSB : p.KNOPE) + (r0 + wid * 8 + (lane >> 3)) * W + h * 64 + swz;
    const bf16_t* vbase = (SBM ? p.VSBT : p.VBT) + (size_t)(h * 64 + wid * 8 + (lane >> 3)) * R + r0 + swz;
    const bf16_t* krbase = p.KR + (r0 + (wid & 3) * 16 + (lane >> 2)) * 32 + (((lane & 3) ^ ((lane >> 4) & 3)) << 3);
#define U8_ISSUE(t_) do { const int kt_ = SBM ? nt - 1 - (t_) : (t_); LASP unsigned char* sl_ = lds + ((t_) & (RING_SLOTS - 1)) * SLOTB; \
        dma16(kbase + (size_t)kt_ * 64 * W, sl_ + wid * 1024); dma16(vbase + kt_ * 64, sl_ + OFF_V + wid * 1024); \
        if (!SBM) dma16(krbase + (size_t)kt_ * 64 * 32, sl_ + OFF_KR + (wid & 3) * 1024); } while (0)
    bf16x8 qf[NQB][NKS]; f32x16 o[2][NQB]; float mrun[NQB], lrun[NQB], carry[NQB];
    { const bf16_t* qp = SBM ? p.QSB + (r0 + (size_t)qt * 64 + qoff) * W + h * 64 : p.QB + (r0 + (size_t)qt * 64) * QBW + h * 96; const int ldq = SBM ? W : QBW;
#pragma unroll
      for (int qb = 0; qb < NQB; ++qb)
#pragma unroll
          for (int ks = 0; ks < NKS; ++ks) { if (active) qf[qb][ks] = ldg8(qp + (size_t)(qb * 32 + cl) * ldq + 16 * ks + 8 * hh); else qf[qb][ks] = (bf16x8){0, 0, 0, 0, 0, 0, 0, 0}; } }
#pragma unroll
    for (int qb = 0; qb < NQB; ++qb) { mrun[qb] = -INFINITY; lrun[qb] = 0.f; carry[qb] = 0.f;
#pragma unroll
        for (int d = 0; d < 2; ++d)
#pragma unroll
            for (int r = 0; r < 16; ++r) o[d][qb][r] = 0.f; }
    volatile LASP unsigned* fl = (volatile LASP unsigned*)(lds + LDS_SCR + 3072);
    if (SBM && lane == 0) fl[8 + wid] = active ? 1u : 0u;
#pragma unroll
    for (int t = 0; t < RING_D; ++t) if (t < nt) U8_ISSUE(t);
    bool dead = !active;
    for (int it = 0; it < nt; ++it) {
        const int rem = nt - 1 - it;
        if (SBM) { if (rem >= 2) ATT_WAIT(4); else if (rem == 1) ATT_WAIT(2); else ATT_WAIT(0); }
        else     { if (rem >= 2) ATT_WAIT(6); else if (rem == 1) ATT_WAIT(3); else ATT_WAIT(0); }
        ATT_BAR();
        if (SBM) { const int pb = ((it + 1) & 1) * 8; const unsigned any = (fl[pb] | fl[pb + 1] | fl[pb + 2] | fl[pb + 3]) | (fl[pb + 4] | fl[pb + 5] | fl[pb + 6] | fl[pb + 7]); if (!any) break; }
        if (it + RING_D < nt) U8_ISSUE(it + RING_D);
        const int kt = SBM ? nt - 1 - it : it;
        if (!dead && kt <= qt) {
            const LASP unsigned char* sl = lds + (it & (RING_SLOTS - 1)) * SLOTB;
            tile_step<NQB, NKS, 4, 2, SBM>(sl, sl + OFF_KR, sl + OFF_V, kt == 0, kt == qt, qoff, cl, hh, qf, o, mrun, lrun, carry);
            if (SBM) { bool dd = true;
#pragma unroll
                for (int qb = 0; qb < NQB; ++qb) dd = dd && (carry[qb] < SB_DEAD);
                dead = __all(dd) != 0; }
        }
        if (SBM && lane == 0) fl[(it & 1) * 8 + wid] = (!dead && kt > 0) ? 1u : 0u;
    }
    if (active) {
        if (SBM) { float one[NQB];
#pragma unroll
            for (int qb = 0; qb < NQB; ++qb) one[qb] = 1.f;
            store_ot<NQB, 2>(p.QSB + (r0 + (size_t)qt * 64 + qoff) * W + h * 64, W, o, one); }
        else { float il[NQB];
#pragma unroll
            for (int qb = 0; qb < NQB; ++qb) { float l0, l1; halves(lrun[qb], l0, l1); il[qb] = 1.0f / (l0 + l1); }
            store_ot<NQB, 2>(p.OMLA + (r0 + (size_t)qt * 64) * W + h * 64, W, o, il); }
    }
    ATT_WAIT(0); ATT_BAR();
#undef U8_ISSUE
}
__device__ __forceinline__ void unit_diff(const Params& p, LASP unsigned char* lds, const int wid, const int layer, const int b, const int head, const int c0, const int nq) {
    constexpr int SLOTB = 32768, OFF_K1 = 8192, OFF_V = 16384;
    const int lane = lane_id_v(), cl = lane & 31, hh = lane >> 5, g = wid >> 2, mp = (wid >> 1) & 1, qh = wid & 1; const size_t r0 = (size_t)b * TB;
    const int qt = c0 + g, nt = c0 + nq; const bool active = g < nq;
    const int swz = ((lane & 7) ^ ((lane >> 3) & 7)) << 3;
    const bf16_t* kbase = p.KD + (r0 + wid * 8 + (lane >> 3)) * W + head * 128 + swz;
    const bf16_t* vbase = p.VDT + (size_t)(head * 128 + wid * 8 + (lane >> 3)) * R + r0 + swz;
#define UD_ISSUE(t_) do { const int kt_ = (t_); LASP unsigned char* sl_ = lds + ((t_) & (RING_SLOTS - 1)) * SLOTB; \
        dma16(kbase + (size_t)kt_ * 64 * W, sl_ + wid * 1024); dma16(kbase + (size_t)kt_ * 64 * W + 64, sl_ + OFF_K1 + wid * 1024); \
        dma16(vbase + kt_ * 64, sl_ + OFF_V + wid * 1024); dma16(vbase + (size_t)64 * R + kt_ * 64, sl_ + OFF_V + (wid + 8) * 1024); } while (0)
    bf16x8 qf[1][4]; f32x16 o[4][1]; float mrun[1], lrun[1], carry[1];
    { const bf16_t* qp = p.QD + (r0 + (size_t)qt * 64 + qh * 32) * W + head * 128 + mp * 64;
#pragma unroll
      for (int ks = 0; ks < 4; ++ks) { if (active) qf[0][ks] = ldg8(qp + (size_t)cl * W + 16 * ks + 8 * hh); else qf[0][ks] = (bf16x8){0, 0, 0, 0, 0, 0, 0, 0}; } }
    mrun[0] = -INFINITY; lrun[0] = 0.f; carry[0] = 0.f;
#pragma unroll
    for (int d = 0; d < 4; ++d)
#pragma unroll
        for (int r = 0; r < 16; ++r) o[d][0][r] = 0.f;
#pragma unroll
    for (int t = 0; t < RING_D; ++t) if (t < nt) UD_ISSUE(t);
    for (int it = 0; it < nt; ++it) {
        const int rem = nt - 1 - it;
        if (rem >= 2) ATT_WAIT(8); else if (rem == 1) ATT_WAIT(4); else ATT_WAIT(0);
        ATT_BAR();
        if (it + RING_D < nt) UD_ISSUE(it + RING_D);
        if (active && it <= qt) { const LASP unsigned char* sl = lds + (it & (RING_SLOTS - 1)) * SLOTB;
            tile_step<1, 4, 4, 4, false>(sl + mp * OFF_K1, sl, sl + OFF_V, it == 0, false, 0, cl, hh, qf, o, mrun, lrun, carry); }
    }
    ATT_WAIT(0); ATT_BAR();
    if (active) { float l0, l1; halves(lrun[0], l0, l1); const float il = 1.0f / (l0 + l1);
        LASP float* reg = (LASP float*)(lds + wid * 16384);
#pragma unroll
        for (int d = 0; d < 4; ++d)
#pragma unroll
            for (int r = 0; r < 16; ++r) reg[cl * 128 + ((d * 32 + crow(r, hh)) ^ cl)] = o[d][0][r] * il; }
    ATT_WAIT(0); ATT_BAR();
    if (active) { const float lam = p.lamv[layer], lam_init = __uint_as_float(__builtin_amdgcn_readfirstlane(layer == 0 ? 0x3e4ccccdu : 0x3eb60549u));
      const LASP float* r0p = (const LASP float*)(lds + ((g * 2 + 0) * 2 + qh) * 16384); const LASP float* r1p = (const LASP float*)(lds + ((g * 2 + 1) * 2 + qh) * 16384);
      const int ql = mp * 16 + (lane >> 2), part = lane & 3; float v[32]; float ss = 0.f;
#pragma unroll
      for (int i = 0; i < 32; ++i) { const int ii = (i + 8 * part) & 31; const int a = ql * 128 + ((part * 32 + ii) ^ ql); v[i] = r0p[a] - lam * r1p[a]; ss += v[i] * v[i]; }
      ss = quad4_sum(ss);
      const float rs = rsq(ss * (1.0f / 128.0f) + EPS) * (1.0f - lam_init); const float* gn = p.dnorm_g + (size_t)layer * 128 + part * 32;
      bf16_t* op = p.QD + (r0 + (size_t)qt * 64 + qh * 32 + ql) * W + head * 128 + part * 32;
#pragma unroll
      for (int i = 0; i < 32; i += 2) { const int ii = (i + 8 * part) & 31;
          st2(op + ii, v[i] * rs * gn[ii], v[i + 1] * rs * gn[ii + 1]); } }
    ATT_WAIT(0); ATT_BAR();
#undef UD_ISSUE
}
enum { AK_P2 = 0, AK_P3 = 1 };
__device__ __forceinline__ void attn_part(const Params& p, LASP unsigned char* lds, int kind, int layer, int wid, int rep = 0) {
    const bool leader = wid == 0 && lane_id_v() == 0;
    volatile LASP int* slot = (volatile LASP int*)(lds + LDS_SCR + 2048);
    unsigned* ctr = p.ctl + 1024 + 64 * (layer * 2 + kind + 4 * rep);
    constexpr int NT = TB / 64;
    static_assert((NT - 1) % 8 == 0, "query tile grouping");
    constexpr int NG8 = (NT - 1) / 8 + 1, NG4 = (NT - 1) / 4 + 1, NGD = (NT - 1) / 2 + 1;
    constexpr int N8 = NB * NH * NG8, N4 = NB * NH * NG4, ND = NB * NHD * NGD;
    const int nitems = kind == AK_P2 ? ND + N4 : N8;
    for (int n = 0;; ++n) {
        if (leader) slot[n & 1] = (int)atomicAdd(ctr, 1u);
        asm volatile("s_waitcnt vmcnt(0) lgkmcnt(0)" ::: "memory"); __builtin_amdgcn_s_barrier(); asm volatile("" ::: "memory");
        int item = __builtin_amdgcn_readfirstlane(slot[n & 1]);
        if (item >= nitems) break;
        if (kind == AK_P2) {
            if (item < ND) { const int u = item / (NB * NHD), j = item % (NB * NHD); const bool single = u == NGD - 1;
                unit_diff(p, lds, wid, layer, j / NHD, j % NHD, single ? 0 : NT - 2 - 2 * u, single ? 1 : 2); }
            else { item -= ND; const int u = item / (NB * NH), j = item % (NB * NH); const bool single = u == NG4 - 1;
                unit8<true>(p, lds, wid, j / NH, j % NH, single ? 0 : NT - 4 - 4 * u, single ? 1 : 4); }
        } else { const int u = item / (NB * NH), j = item % (NB * NH); const bool single = u == NG8 - 1;
            unit8<false>(p, lds, wid, j / NH, j % NH, single ? 0 : NT - 8 - 8 * u, single ? 1 : 8); }
    }
}
}
template <int KIND> __global__ void __launch_bounds__(512, 2) k_attn_fast(Params p, int l) {
    extern __shared__ __attribute__((aligned(16))) unsigned char lds_raw[];
    att::attn_part(p, (LASP unsigned char*)lds_raw, KIND, l, __builtin_amdgcn_readfirstlane((int)threadIdx.x >> 6));
}

#define XB_TMO      128
#define XB_XCNT(j)  (256  + 64 * (j))
#define XB_XSUB(j)  (1280 + 64 * (j))
#define XB_XGEN(j)  (2304 + 64 * (j))
#define XB_TOP      3328
#define XB_TOPGEN   3392
#define XCD_BAR_WORDS 3456
#define XB_SPIN_CAP (1u << 18)
__device__ __forceinline__ unsigned xb_ld(unsigned* p)              { return __hip_atomic_load(p, __ATOMIC_RELAXED, __HIP_MEMORY_SCOPE_AGENT); }
__device__ __forceinline__ unsigned xb_add(unsigned* p, unsigned v) { return __hip_atomic_fetch_add(p, v, __ATOMIC_RELAXED, __HIP_MEMORY_SCOPE_AGENT); }
__device__ __forceinline__ unsigned xb_xcc_id() { return (unsigned)__builtin_amdgcn_s_getreg((3 << 11) | 20) & 0xFu; }
#define XB_SPIN(cond, bar) do { unsigned _sp = 0; while (cond) { __builtin_amdgcn_s_sleep(1); \
    if ((++_sp & 255u) == 0u) { if (xb_ld(&(bar)[XB_TMO])) break; if (_sp > XB_SPIN_CAP) { atomicAdd(&(bar)[XB_TMO], 1u); break; } } } } while (0)
struct XcdBarrier { unsigned* bar; unsigned x; volatile LASP unsigned* st; };
__device__ __forceinline__ XcdBarrier xcd_barrier_post(unsigned* bar, volatile LASP unsigned* st, bool leader) {
    XcdBarrier b; b.bar = bar; b.x = xb_xcc_id(); b.st = st;
    if (leader) (void)xb_add(&bar[XB_XCNT(b.x)], 1u);
    return b;
}
__device__ __forceinline__ void xcd_barrier_complete(unsigned* bar, unsigned x, unsigned& nloc, unsigned& nx) {
    const unsigned G = gridDim.x * gridDim.y * gridDim.z;
    unsigned sum, cnt, mine, sp = 0u;
    for (;;) {
        sum = 0u; cnt = 0u; mine = 0u;
#pragma unroll
        for (unsigned j = 0; j < 16; ++j) { const unsigned c = xb_ld(&bar[XB_XCNT(j)]); sum += c; cnt += (c > 0u) ? 1u : 0u; mine = (j == x) ? c : mine; }
        if (sum == G) break;
        __builtin_amdgcn_s_sleep(1);
        if ((++sp & 255u) == 0u) { if (xb_ld(&bar[XB_TMO])) break; if (sp > XB_SPIN_CAP) { atomicAdd(&bar[XB_TMO], 1u); break; } }
    }
    nloc = mine > 0u ? mine : 1u; nx = cnt > 0u ? cnt : 1u;
}
__device__ __forceinline__ void xcd_barrier(const XcdBarrier& b, const int wid0) {
    const bool leader = wid0 == 0 && lane_id_v() == 0;
    asm volatile("s_waitcnt vmcnt(0)" ::: "memory");
    __syncthreads();
    if (leader) {
        unsigned* bar = b.bar;
        __builtin_amdgcn_s_waitcnt(0);
        unsigned nloc = b.st[0], nx = b.st[1];
        if (nloc == 0u) { xcd_barrier_complete(bar, b.x, nloc, nx); b.st[0] = nloc; b.st[1] = nx; }
        const unsigned old = xb_add(&bar[XB_XSUB(b.x)], 1u);
        const unsigned gen = old / nloc;
        if (old + 1u == (gen + 1u) * nloc) {
            __builtin_amdgcn_fence(__ATOMIC_RELEASE, "agent");
            asm volatile("s_waitcnt vmcnt(0)" ::: "memory");
            const unsigned og = xb_add(&bar[XB_TOP], 1u);
            const unsigned tg = og / nx;
            if (og + 1u == (tg + 1u) * nx) xb_add(&bar[XB_TOPGEN], 1u);
            else XB_SPIN(xb_ld(&bar[XB_TOPGEN]) == tg, bar);
            __builtin_amdgcn_fence(__ATOMIC_ACQUIRE, "agent");
            xb_add(&bar[XB_XGEN(b.x)], 1u);
            asm volatile("s_waitcnt vmcnt(0)" ::: "memory");
        } else {
            XB_SPIN(xb_ld(&bar[XB_XGEN(b.x)]) == gen, bar);
            __builtin_amdgcn_fence(__ATOMIC_ACQUIRE, "agent");
            asm volatile("s_waitcnt vmcnt(0)" ::: "memory");
        }
    }
    __syncthreads();
}

typedef float f32x4v __attribute__((ext_vector_type(4)));
typedef unsigned u32x4w __attribute__((ext_vector_type(4)));
__device__ __forceinline__ float rope_inv(int e, int dim) { return exp2f(-(float)e / (float)dim * 18.931568569324174f); }
__device__ __forceinline__ void rope_cs(float ang, float& cs, float& sn) { const double t = (double)ang * 0.15915494309189535; const float a = (float)((t - rint(t)) * 6.283185307179586); cs = cosf(a); sn = sinf(a); }
template <int MAP> __device__ __forceinline__ void prep_item(const float* src, int src_ld, const float* rowscale, bf16_t* dst, int N, int K, int item, int lane, LASP float* scr) {
    const int nblk = N / 32, kb = item / nblk, nb = item % nblk, k0 = 64 * kb, n0 = 32 * nb, nl = n0 + (lane & 31);
    int sc; if (MAP == 0) sc = src_w1(nl); else if (MAP == 1) sc = src_wv(nl); else if (MAP == 2) sc = src_w3(nl); else if (MAP == 3) sc = src_uq(nl); else if (MAP == 4) sc = src_uk(nl); else if (MAP == 5) sc = src_uv(nl); else sc = nl;
#pragma unroll 8
    for (int i = 0; i < 32; ++i) { const int kk = 2 * i + (lane >> 5); float v = 0.f; if (sc >= 0) v = src[(size_t)(k0 + kk) * src_ld + sc] * (rowscale ? rowscale[k0 + kk] : 1.f); scr[kk * 33 + (lane & 31)] = v; }
    asm volatile("s_waitcnt lgkmcnt(0)" ::: "memory");
    const int c = lane & 7;
#pragma unroll
    for (int j = 0; j < 4; ++j) { const int n = (lane >> 3) + 8 * j; const LASP float* t = scr + (8 * c) * 33 + n;
        u32x4w o; o.x = pk2(t[0 * 33], t[1 * 33]); o.y = pk2(t[2 * 33], t[3 * 33]); o.z = pk2(t[4 * 33], t[5 * 33]); o.w = pk2(t[6 * 33], t[7 * 33]);
        *(u32x4w*)(dst + (size_t)(n0 + n) * K + k0 + 8 * c) = o; }
    asm volatile("s_waitcnt lgkmcnt(0)" ::: "memory");
}
__device__ __forceinline__ void prologue_part(const Params& p, LASP unsigned char* lds, int G, int c, int wave) {
    int lane_ = lane_id_v(); const int lane = lane_;
    const int gw = c * 8 + wave, NGW = G * 8;
    for (int i = gw * 64 + lane; i < NPOS * 16; i += NGW * 64) {
        { const int pos = i / 16, j = i % 16; const float ang = (float)pos * rope_inv(2 * j, 32); float cs, sn; rope_cs(ang, cs, sn); p.cosm[i] = cs; p.sinm[i] = sn; }
        if (i < NPOS * 8) { const int pos = i / 8, j = i % 8; const float ang = (float)pos * rope_inv(2 * j, 16); float cs, sn; rope_cs(ang, cs, sn); p.cosd[i] = cs; p.sind[i] = sn; }
        if (i < DEPTH) { const float* lm = p.dlam + i * 4 * 64; float s0 = 0.f, s1 = 0.f; for (int d = 0; d < 64; ++d) { s0 += lm[d] * lm[64 + d]; s1 += lm[128 + d] * lm[192 + d]; }
            p.lamv[i] = expf(s0) - expf(s1) + (i == 0 ? 0.2f : 0.35550906759f); }
    }
    LASP float* scr = (LASP float*)(lds + wave * 16384);
    constexpr int I_W1 = (D / 64) * (N1 / 32), I_WV = (D / 64) * (2 * W / 32), I_W3 = (D / 64) * (N3 / 32), I_UQ = (QR / 64) * (QBW / 32), I_UK = (KVR / 64) * (W / 32), I_WO = (W / 64) * (D / 32), I_OUT = (D / 64) * (D / 32);
    constexpr int I_L = I_W1 + I_WV + I_W3 + I_UQ + 2 * I_UK + 3 * I_WO + I_OUT;
    for (int it = gw; it < 2 * I_L; it += NGW) {
        const int l = it / I_L; int r = it % I_L;
        const float* win = p.w_in + (size_t)l * D * INC; const float* ng = p.norm_g + l * D;
        if (r < I_W1) { prep_item<0>(win, INC, ng, wptr(p, l, WL_W1), N1, D, r, lane, scr); continue; } r -= I_W1;
        if (r < I_WV) { prep_item<1>(win, INC, ng, wptr(p, l, WL_WV), 2 * W, D, r, lane, scr); continue; } r -= I_WV;
        if (r < I_W3) { prep_item<2>(win, INC, ng, wptr(p, l, WL_W3), N3, D, r, lane, scr); continue; } r -= I_W3;
        if (r < I_UQ) { prep_item<3>(p.w_uq + (size_t)l * QR * QBW, QBW, p.cq_g + l * QR, wptr(p, l, WL_UQ), QBW, QR, r, lane, scr); continue; } r -= I_UQ;
        if (r < I_UK) { prep_item<4>(p.w_ukv + (size_t)l * KVR * NH * 128, NH * 128, p.ckv_g + l * KVR, wptr(p, l, WL_UK), W, KVR, r, lane, scr); continue; } r -= I_UK;
        if (r < I_UK) { prep_item<5>(p.w_ukv + (size_t)l * KVR * NH * 128, NH * 128, p.ckv_g + l * KVR, wptr(p, l, WL_UV), W, KVR, r, lane, scr); continue; } r -= I_UK;
        if (r < 3 * I_WO) { const int b = r / I_WO; const float* const w0 = opq(p.w_osb); const float* const w1 = opq(p.w_omla); const float* const w2 = opq(p.w_odiff); const float* wo = (b == 0 ? w0 : b == 1 ? w1 : w2) + (size_t)l * W * D;
            prep_item<6>(wo, D, nullptr, wptr(p, l, WL_WO) + (size_t)b * D * W, D, W, r % I_WO, lane, scr); continue; } r -= 3 * I_WO;
        prep_item<6>(p.w_out + (size_t)l * D * D, D, nullptr, wptr(p, l, WL_OUT), D, D, r, lane, scr);
    }
    for (int row = gw; row < R; row += NGW) {
        const int b = row / TB, t = row % TB; f32x4v v[D / 256]; float ss = 0.f;
#pragma unroll
        for (int j = 0; j < D / 256; ++j) { const int col = 256 * j + 4 * lane;
            if (t < LEAD) v[j] = (f32x4v){0.f, 0.f, 0.f, 0.f}; else if (t < LEAD + NMETA) v[j] = *(const f32x4v*)(p.meta + (size_t)(t - LEAD) * D + col); else v[j] = *(const f32x4v*)(p.x + ((size_t)b * SEQ + (t - LEAD - NMETA)) * D + col);
            ss += (v[j].x * v[j].x + v[j].y * v[j].y) + (v[j].z * v[j].z + v[j].w * v[j].w); }
        ss = wave_sum(ss);
#pragma unroll
        for (int j = 0; j < D / 256; ++j) { const int col = 256 * j + 4 * lane; *(f32x4v*)(p.X + (size_t)row * D + col) = v[j]; st4(p.XB + (size_t)row * D + col, v[j].x, v[j].y, v[j].z, v[j].w); }
        if (lane < NSX) p.ssx[(size_t)row * NSX + lane] = lane == 0 ? ss : 0.f;
    }
}
__device__ __forceinline__ void x2bf_part(const Params& p, int G, int c, int wave) {
    int lane_ = lane_id_v(); const int lane = lane_;
    for (int row = c * 8 + wave; row < R; row += G * 8) {
#pragma unroll
        for (int j = 0; j < D / 256; ++j) { const int col = 256 * j + 4 * lane; const f32x4v v = *(const f32x4v*)(p.X + (size_t)row * D + col); st4(p.XB2 + (size_t)row * D + col, v.x, v.y, v.z, v.w); } }
}
__device__ __forceinline__ void final_part(const Params& p, int G, int c, int wave) {
    int lane_ = lane_id_v(); const int lane = lane_;
    for (int i = c * 8 + wave; i < NB * SEQ; i += G * 8) {
        const int b = i / SEQ, sq = i % SEQ; const float* x = p.X + ((size_t)b * TB + LEAD + NMETA + sq) * D; f32x4v v[D / 256]; float ss = 0.f;
#pragma unroll
        for (int j = 0; j < D / 256; ++j) { v[j] = *(const f32x4v*)(x + 256 * j + 4 * lane); ss += (v[j].x * v[j].x + v[j].y * v[j].y) + (v[j].z * v[j].z + v[j].w * v[j].w); }
        const float rs = rsq(wave_sum(ss) * (1.0f / D) + EPS);
#pragma unroll
        for (int j = 0; j < D / 256; ++j) { const f32x4v g = *(const f32x4v*)(p.final_g + 256 * j + 4 * lane); *(f32x4v*)(p.out + (size_t)i * D + 256 * j + 4 * lane) = v[j] * rs * g; }
    }
}
constexpr int N_PHASES = 2 + 6 * DEPTH;
constexpr int CW_QUEUE = 1024, CW_BAR = 4096;
#define MK_SEAM(k) do { if ((k) + 1 < ph_hi) xcd_barrier(bar, wid0); } while (0)
#define MK_IN(k) (ph_lo <= (k) && (k) < ph_hi)
#ifndef PROBE_DUP
#define PROBE_DUP 0
#endif
template <int L> __device__ __forceinline__ void layer_phases(const Params& p, LASP unsigned char* lds, const XcdBarrier& bar, int ph_lo, int ph_hi, int G, int c, int wid0) {
    constexpr int B0 = 1 + 6 * L;
    if (MK_IN(B0 + 0)) { gemm_part(p, lds, PK_P1, L, G, c, wid0); if (PROBE_DUP & 2) gemm_part(p, lds, PK_P1, L, G, c, wid0); MK_SEAM(B0 + 0); }
    if (MK_IN(B0 + 1)) { gemm_part(p, lds, PK_P2, L, G, c, wid0); att::attn_part(p, lds, att::AK_P2, L, wid0); MK_SEAM(B0 + 1); }
    if (MK_IN(B0 + 2)) { x2bf_part(p, G, c, wid0); att::attn_part(p, lds, att::AK_P3, L, wid0); if (PROBE_DUP & 4) { x2bf_part(p, G, c, wid0); att::attn_part(p, lds, att::AK_P3, L, wid0, 1); } MK_SEAM(B0 + 2); }
    if (MK_IN(B0 + 3)) { gemm_part(p, lds, PK_P3B, L, G, c, wid0); MK_SEAM(B0 + 3); }
    if (MK_IN(B0 + 4)) { gemm_part(p, lds, PK_P4, L, G, c, wid0); if (PROBE_DUP & 8) gemm_part(p, lds, PK_P4, L, G, c, wid0); MK_SEAM(B0 + 4); }
    if (MK_IN(B0 + 5)) { gemm_part(p, lds, PK_P5, L, G, c, wid0); MK_SEAM(B0 + 5); }
}
__global__ void __launch_bounds__(512, 2) mk_fwd(Params p, int ph_lo, int ph_hi) {
    extern __shared__ __attribute__((aligned(16))) unsigned char lds_raw[];
    LASP unsigned char* lds = (LASP unsigned char*)lds_raw;
    volatile LASP unsigned* misc = (volatile LASP unsigned*)(lds + LDS_SCR + 4096);
    const int wid0 = __builtin_amdgcn_readfirstlane((int)threadIdx.x >> 6);
    if (threadIdx.x < 64) misc[threadIdx.x] = 0u;
    __syncthreads();
    const int G = (int)gridDim.x, c = (int)blockIdx.x;
    const XcdBarrier bar = xcd_barrier_post(p.ctl + CW_BAR, misc + 8, threadIdx.x == 0);
    if (MK_IN(0)) { prologue_part(p, lds, G, c, wid0); if (PROBE_DUP & 1) prologue_part(p, lds, G, c, wid0); MK_SEAM(0); }
    layer_phases<0>(p, lds, bar, ph_lo, ph_hi, G, c, wid0);
    layer_phases<1>(p, lds, bar, ph_lo, ph_hi, G, c, wid0);
    if (MK_IN(N_PHASES - 1)) { final_part(p, G, c, wid0); if (PROBE_DUP & 1) final_part(p, G, c, wid0); }
}
#endif

#ifdef HOST_EMU
typedef int hipStream_t;
#endif
#define NBLK(n, t) (((long)(n) + (t) - 1) / (t))
#ifndef HOST_EMU
#ifndef MK_SPLIT
#define MK_SPLIT 0
#endif
extern "C" void kernel_launch(void* const* d_in, const int* in_sizes, int n_in, void* d_out, int out_size, void* d_ws, size_t ws_size, hipStream_t stream) {
    if (n_in != 16 || in_sizes[0] != NB * SEQ * D || out_size != NB * SEQ * D || ws_size < WS_NEED) { fprintf(stderr, "kernel_launch: unexpected shapes / workspace (%d inputs, ws %zu, need %zu)\n", n_in, ws_size, (size_t)WS_NEED); return; }
    static int grid = 0;
    if (grid == 0) { int dev = 0, cus = 0; (void)hipGetDevice(&dev); (void)hipDeviceGetAttribute(&cus, hipDeviceAttributeMultiprocessorCount, dev); grid = cus > 0 ? cus : 256;
        if (hipFuncSetAttribute((const void*)mk_fwd, hipFuncAttributeMaxDynamicSharedMemorySize, LDS_BYTES) != hipSuccess) { fprintf(stderr, "kernel_launch: hipFuncSetAttribute failed\n"); grid = -1; } }
    if (grid < 0) return;
    const Params p = make_params(d_in, d_out, d_ws);
    (void)hipMemsetAsync((char*)d_ws + O_CTL, 0, 65536, stream);
#if MK_SPLIT
    for (int ph = 0; ph < N_PHASES; ++ph) hipLaunchKernelGGL(mk_fwd, dim3(grid), dim3(512), LDS_BYTES, stream, p, ph, ph + 1);
#else
    hipLaunchKernelGGL(mk_fwd, dim3(grid), dim3(512), LDS_BYTES, stream, p, 0, N_PHASES);
#endif
}
#else
extern "C" void kernel_launch(void* const* d_in, const int* in_sizes, int n_in, void* d_out, int out_size, void* d_ws, size_t ws_size, hipStream_t stream) {
    if (n_in != 16 || in_sizes[0] != NB * SEQ * D || out_size != NB * SEQ * D || ws_size < WS_NEED) { fprintf(stderr, "kernel_launch: unexpected shapes / workspace (%d inputs, ws %zu, need %zu)\n", n_in, ws_size, (size_t)WS_NEED); return; }
    const Params p = make_params(d_in, d_out, d_ws);
    const int T = 256;
#if 0
        (void)hipFuncSetAttribute((const void*)k_gemm_fast<PK_P1>, hipFuncAttributeMaxDynamicSharedMemorySize, LDS_BYTES); hipFuncSetAttribute((const void*)k_gemm_fast<PK_P2>, hipFuncAttributeMaxDynamicSharedMemorySize, LDS_BYTES);
        hipFuncSetAttribute((const void*)k_gemm_fast<PK_P3B>, hipFuncAttributeMaxDynamicSharedMemorySize, LDS_BYTES); hipFuncSetAttribute((const void*)k_gemm_fast<PK_P4>, hipFuncAttributeMaxDynamicSharedMemorySize, LDS_BYTES);
        hipFuncSetAttribute((const void*)k_gemm_fast<PK_P5>, hipFuncAttributeMaxDynamicSharedMemorySize, LDS_BYTES);
        hipFuncSetAttribute((const void*)k_attn_fast<att::AK_P2>, hipFuncAttributeMaxDynamicSharedMemorySize, LDS_BYTES); hipFuncSetAttribute((const void*)k_attn_fast<att::AK_P3>, hipFuncAttributeMaxDynamicSharedMemorySize, LDS_BYTES); }
    (void)hipMemsetAsync((char*)d_ws + O_CTL, 0, 65536, stream);
#endif
    LAUNCH(k_tables, NBLK(NPOS * 16, T), T, p);
    for (int l = 0; l < DEPTH; ++l) {
        LAUNCH(k_prep_w<0>, NBLK((long)N1 * D, T), T, wptr(p, l, WL_W1), N1, D, p.w_in + (size_t)l * D * INC, INC, p.norm_g + l * D);
        LAUNCH(k_prep_w<1>, NBLK((long)2 * W * D, T), T, wptr(p, l, WL_WV), 2 * W, D, p.w_in + (size_t)l * D * INC, INC, p.norm_g + l * D);
        LAUNCH(k_prep_w<2>, NBLK((long)N3 * D, T), T, wptr(p, l, WL_W3), N3, D, p.w_in + (size_t)l * D * INC, INC, p.norm_g + l * D);
        LAUNCH(k_prep_w<3>, NBLK((long)QBW * QR, T), T, wptr(p, l, WL_UQ), QBW, QR, p.w_uq + (size_t)l * QR * QBW, QBW, p.cq_g + l * QR);
        LAUNCH(k_prep_w<4>, NBLK((long)W * KVR, T), T, wptr(p, l, WL_UK), W, KVR, p.w_ukv + (size_t)l * KVR * NH * 128, NH * 128, p.ckv_g + l * KVR);
        LAUNCH(k_prep_w<5>, NBLK((long)W * KVR, T), T, wptr(p, l, WL_UV), W, KVR, p.w_ukv + (size_t)l * KVR * NH * 128, NH * 128, p.ckv_g + l * KVR);
        LAUNCH(k_prep_w<6>, NBLK((long)D * W, T), T, wptr(p, l, WL_WO), D, W, p.w_osb + (size_t)l * W * D, D, (const float*)nullptr);
        LAUNCH(k_prep_w<6>, NBLK((long)D * W, T), T, wptr(p, l, WL_WO) + (size_t)D * W, D, W, p.w_omla + (size_t)l * W * D, D, (const float*)nullptr);
        LAUNCH(k_prep_w<6>, NBLK((long)D * W, T), T, wptr(p, l, WL_WO) + (size_t)2 * D * W, D, W, p.w_odiff + (size_t)l * W * D, D, (const float*)nullptr);
        LAUNCH(k_prep_w<6>, NBLK((long)D * D, T), T, wptr(p, l, WL_OUT), D, D, p.w_out + (size_t)l * D * D, D, (const float*)nullptr);
    }
    LAUNCH(k_init_x, NBLK((long)R * D, T), T, p);
    LAUNCH(k_ssq_f32, NBLK(R, 64), 64, (const float*)p.X, D, p.ssx, NSX);
    for (int l = 0; l < DEPTH; ++l) {
        const int last = (l == DEPTH - 1) ? 1 : 0; (void)last;
#ifndef HOST_EMU
        FASTG(PK_P1, l);
        FASTG(PK_P2, l);
#else
        LAUNCH(k_gemm<F1>, NBLK((long)R * (V1_END / 8), T), T, (const bf16_t*)p.XB, D, (const bf16_t*)wptr(p, l, WL_W1), D, R, V1_END, D, p, 0, 0);
        LAUNCH(k_gemm<F1>, NBLK((long)2 * W * (R / 8), T), T, (const bf16_t*)wptr(p, l, WL_WV), D, (const bf16_t*)p.XB, D, 2 * W, R, D, p, 0, 1);
        LAUNCH(k_ssq_bf, NBLK(R, 64), 64, (const bf16_t*)p.CQ, QR, p.ssq, NSQ);
        LAUNCH(k_ssq_bf, NBLK(R, 64), 64, (const bf16_t*)p.CKV, KVR, p.ssk, NSK);
        LAUNCH(k_gemm<FUQ>, NBLK((long)R * (QBW / 8), T), T, (const bf16_t*)p.CQ, QR, (const bf16_t*)wptr(p, l, WL_UQ), QR, R, QBW, QR, p, 0, 0);
        LAUNCH(k_gemm<FUK>, NBLK((long)R * (W / 8), T), T, (const bf16_t*)p.CKV, KVR, (const bf16_t*)wptr(p, l, WL_UK), KVR, R, W, KVR, p, 0, 0);
        LAUNCH(k_gemm<FUK>, NBLK((long)W * (R / 8), T), T, (const bf16_t*)wptr(p, l, WL_UV), KVR, (const bf16_t*)p.CKV, KVR, W, R, KVR, p, 0, 1);
#endif
#ifndef HOST_EMU
        hipLaunchKernelGGL(k_attn_fast<att::AK_P2>, dim3(grid), dim3(512), LDS_BYTES, stream, p, l);
        hipLaunchKernelGGL(k_attn_fast<att::AK_P3>, dim3(grid), dim3(512), LDS_BYTES, stream, p, l);
#else
        LAUNCH(k_attn_sb, NBLK((long)NB * NH * TB, 64), 64, p);
        LAUNCH(k_attn_diff, NBLK((long)NB * NHD * TB, 64), 64, p, l);
        LAUNCH(k_attn_mla, NBLK((long)NB * NH * TB, 64), 64, p);
#endif
        LAUNCH(k_x2bf, NBLK((long)R * D, T), T, p);
#ifndef HOST_EMU
        FASTG(PK_P3B, l); FASTG(PK_P4, l); FASTG(PK_P5, l);
#else
        LAUNCH(k_gemm<F3>, NBLK((long)R * (N3 / 8), T), T, (const bf16_t*)p.XB2, D, (const bf16_t*)wptr(p, l, WL_W3), D, R, N3, D, p, l, 0);
        LAUNCH(k_gemm<F4>, NBLK((long)R * (D / 8), T), T, (const bf16_t*)p.QSB, W, (const bf16_t*)wptr(p, l, WL_WO), W, R, D, W, p, 0, 0);
        LAUNCH(k_gemm<F4>, NBLK((long)R * (D / 8), T), T, (const bf16_t*)p.OMLA, W, (const bf16_t*)(wptr(p, l, WL_WO) + (size_t)D * W), W, R, D, W, p, 0, 5);
        LAUNCH(k_gemm<F4>, NBLK((long)R * (D / 8), T), T, (const bf16_t*)p.QD, W, (const bf16_t*)(wptr(p, l, WL_WO) + (size_t)2 * D * W), W, R, D, W, p, 0, 6);
        LAUNCH(k_gemm<F5>, NBLK((long)R * (D / 8), T), T, (const bf16_t*)p.G0, D, (const bf16_t*)wptr(p, l, WL_OUT), D, R, D, D, p, last, 0);
        if (!last) LAUNCH(k_ssq_f32, NBLK(R, 64), 64, (const float*)p.X, D, p.ssx, NSX);
#endif
    }
    LAUNCH(k_final, NBLK((long)NB * SEQ, 64), 64, p);
}
#endif
```

```cpp
#ifndef HOST_EMU
#include <hip/hip_runtime.h>
#endif
#include <cstdio>
#include <cstdint>
#include <cmath>
#include <cstring>

#ifndef CFG_B
#define CFG_B 8
#endif
#ifndef CFG_S
#define CFG_S 2048
#endif
#ifndef CFG_D
#define CFG_D 1024
#endif

typedef unsigned short bf16_t;

namespace cfg {
constexpr int NB = CFG_B, SEQ = CFG_S, D = CFG_D, DEPTH = 2;
constexpr int NMETA = 16, LEAD = 48, TB = LEAD + NMETA + SEQ, R = NB * TB, NPOS = NMETA + SEQ;
constexpr int W = D / 2;
constexpr int NH = D / 128;
constexpr int NHD = D / 256;
constexpr int QR = 3 * D / 8, KVR = D / 4, QBW = NH * 96;
constexpr int INC = 4 * W + QR + KVR + 32 + W + 4 * W + 3 * D;
constexpr int C_SBQ = 0, C_SBK = W, C_SBV = 2 * W, C_SBZ = 3 * W, C_CQ = 4 * W, C_CKV = C_CQ + QR, C_KR = C_CKV + KVR, C_MZ = C_KR + 32,
              C_DQ = C_MZ + W, C_DK = C_DQ + W, C_DV = C_DK + W, C_DZ = C_DV + W, C_G = C_DZ + W;
static_assert(C_G + 3 * D == INC, "w_in columns");
constexpr int V1_SBQ = 0, V1_SBK = W, V1_CQ = 2 * W, V1_CKV = V1_CQ + QR, V1_KR = V1_CKV + KVR, V1_DQ = V1_KR + 32, V1_DK = V1_DQ + W, V1_END = V1_DK + W;
constexpr int N1 = (V1_END + 255) / 256 * 256;
constexpr int N3 = 3 * W + 3 * D;
constexpr int NSX = D / 32, NSQ = QR / 32, NSK = KVR / 32;
constexpr float EPS = 1e-6f, LOG2E = 1.4426950408889634f;
constexpr int GP = D / 256;
}
using namespace cfg;

#ifdef HOST_EMU
#define DEVFN inline
#define HDFN inline
#else
#define DEVFN __device__ __forceinline__
#define HDFN __host__ __device__ __forceinline__
#endif
constexpr size_t MiB = size_t(1) << 20;
constexpr size_t al256(size_t x) { return (x + 255) & ~size_t(255); }
constexpr size_t SZ_W = (size_t)R * W * 2, SZ_D2 = (size_t)R * D * 2, SZ_X = (size_t)R * D * 4, SZ_CQ = (size_t)R * QR * 2, SZ_CKV = (size_t)R * KVR * 2,
                 SZ_KR = (size_t)R * 32 * 2, SZ_QB = (size_t)R * QBW * 2, SZ_GP = (size_t)R * 256 * 2;
constexpr size_t WB_W1 = (size_t)N1 * D * 2, WB_WV = (size_t)2 * W * D * 2, WB_W3 = (size_t)N3 * D * 2, WB_UQ = (size_t)QBW * QR * 2, WB_UK = (size_t)W * KVR * 2,
                 WB_UV = WB_UK, WB_WO = (size_t)3 * D * W * 2, WB_OUT = (size_t)D * D * 2;
constexpr size_t WL_W1 = 0, WL_WV = WL_W1 + WB_W1, WL_W3 = WL_WV + WB_WV, WL_UQ = WL_W3 + WB_W3, WL_UK = WL_UQ + WB_UQ, WL_UV = WL_UK + WB_UK, WL_WO = WL_UV + WB_UV,
                 WL_OUT = WL_WO + WB_WO, WL_BYTES = al256(WL_OUT + WB_OUT);
constexpr bool STDCFG = (NB == 8 && SEQ == 2048 && D == 1024);
#if defined(HOST_EMU)
constexpr bool HANDMAP = false;
#else
constexpr bool HANDMAP = STDCFG;
#endif
constexpr size_t O_CTL = 0, O_TAB = 1 * MiB, O_LAM = O_TAB + 768 * 1024, O_SSX = 2 * MiB, O_SSQ = O_SSX + al256((size_t)R * NSX * 4), O_SSK = O_SSQ + al256((size_t)R * NSQ * 4),
                 O_WTS = al256(O_SSK + (size_t)R * NSK * 4 + MiB) / MiB * MiB;
constexpr size_t O_X = HANDMAP ? 52 * MiB : al256(O_WTS + 2 * WL_BYTES);
static_assert(O_WTS + 2 * WL_BYTES <= O_X, "weights overrun X");
constexpr size_t O_A = O_X + al256(SZ_X);
constexpr size_t Q_QSB = O_A, Q_QD = Q_QSB + al256(SZ_W), Q_OMLA = Q_QD + al256(SZ_W), Q_KSB = Q_OMLA + al256(SZ_W), Q_VSBT = Q_KSB + al256(SZ_W), Q_KD = Q_VSBT + al256(SZ_W),
                 Q_VDT = Q_KD + al256(SZ_W), Q_VBT = Q_VDT + al256(SZ_W), Q_KR = Q_VBT + al256(SZ_W), Q_CKV = Q_KR + al256(SZ_KR), Q_XB2 = Q_CKV + al256(SZ_CKV), Q_G0 = Q_XB2 + al256(SZ_D2),
                 Q_GPC = Q_G0 + al256(SZ_D2), Q_XB = Q_GPC + 2 * GP * al256(SZ_GP), Q_QB = Q_XB + al256(SZ_D2), Q_CQ = Q_QB + al256(SZ_QB), Q_KNOPE = Q_CQ + al256(SZ_CQ), Q_END = Q_KNOPE + al256(SZ_W);
constexpr size_t WS_NEED = HANDMAP ? 256 * MiB : Q_END;

constexpr size_t mibf(double m) { return (size_t)(m * 1048576.0); }
struct Params {
    const float *x, *meta, *norm_g, *w_in, *b_gate, *cq_g, *ckv_g, *w_uq, *w_ukv, *dlam, *dnorm_g, *w_osb, *w_omla, *w_odiff, *w_out, *final_g;
    float* out; char* ws;
#define WS_F32(name, off) HDFN float* name() const { return (float*)(ws + (off)); }
#define WS_B16(name, off) HDFN bf16_t* name() const { return (bf16_t*)(ws + (off)); }
#define OB_B16(name, offh, offq) HDFN bf16_t* name() const { return HANDMAP ? (bf16_t*)((char*)out + (offh)) : (bf16_t*)(ws + (offq)); }
    HDFN unsigned* ctl() const { return (unsigned*)(ws + O_CTL); }
    WS_F32(cosm, O_TAB) WS_F32(sinm, O_TAB + (size_t)NPOS * 16 * 4) WS_F32(cosd, O_TAB + (size_t)NPOS * 32 * 4) WS_F32(sind, O_TAB + (size_t)NPOS * 40 * 4) WS_F32(lamv, O_LAM)
    WS_F32(ssx, O_SSX) WS_F32(ssq, O_SSQ) WS_F32(ssk, O_SSK) WS_F32(X, O_X)
    HDFN char* WTS() const { return ws + O_WTS; }
    WS_B16(QSB, HANDMAP ? mibf(118) : Q_QSB) WS_B16(QD, HANDMAP ? mibf(134.5) : Q_QD) WS_B16(OMLA, HANDMAP ? mibf(151) : Q_OMLA) WS_B16(CKV, HANDMAP ? mibf(151) : Q_CKV) WS_B16(KSB, HANDMAP ? mibf(167.5) : Q_KSB)
    WS_B16(VSBT, HANDMAP ? mibf(184) : Q_VSBT) WS_B16(KD, HANDMAP ? mibf(200.5) : Q_KD) WS_B16(VDT, HANDMAP ? mibf(217) : Q_VDT) WS_B16(VBT, HANDMAP ? mibf(233.5) : Q_VBT) WS_B16(KR, HANDMAP ? mibf(250) : Q_KR)
    WS_B16(XB2, HANDMAP ? mibf(167.5) : Q_XB2) WS_B16(G0, HANDMAP ? mibf(200.5) : Q_G0) WS_B16(GPW, HANDMAP ? mibf(233.5) : Q_GPC)
    OB_B16(XB, 0, Q_XB) OB_B16(QB, 0, Q_QB) OB_B16(CQ, mibf(33), Q_CQ) OB_B16(KNOPE, mibf(45.5), Q_KNOPE) OB_B16(GPO, 0, Q_GPC)
};
static Params make_params(void* const* d_in, void* d_out, void* d_ws) {
    Params p{};
    const float* const* in = (const float* const*)d_in;
    p.x = in[0]; p.meta = in[1]; p.norm_g = in[2]; p.w_in = in[3]; p.b_gate = in[4]; p.cq_g = in[5]; p.ckv_g = in[6]; p.w_uq = in[7]; p.w_ukv = in[8]; p.dlam = in[9];
    p.dnorm_g = in[10]; p.w_osb = in[11]; p.w_omla = in[12]; p.w_odiff = in[13]; p.w_out = in[14]; p.final_g = in[15];
    p.out = (float*)d_out; p.ws = (char*)d_ws;
    return p;
}
static_assert(!STDCFG || (SZ_W == (size_t)(16.5 * 1048576) && SZ_D2 == 33 * MiB && SZ_GP == (size_t)(8.25 * 1048576) && SZ_QB == (size_t)(24.75 * 1048576) && SZ_CQ <= (size_t)(12.5 * 1048576) &&
              SZ_KR <= (size_t)(1.1 * 1048576) && SZ_X == 66 * MiB && GP == 4), "hand map sizes");

#ifdef HOST_EMU
template <class T> DEVFN T* opq(T* p) { return p; }
#else
DEVFN int lane_id_v() { int l; asm volatile("v_mbcnt_lo_u32_b32 %0, -1, 0\n\tv_mbcnt_hi_u32_b32 %0, -1, %0" : "=v"(l)); return l; }
template <class T> DEVFN T* opq(T* p) { asm volatile("" : "+s"(p)); return p; }
#endif
DEVFN float bf2f(bf16_t h) { unsigned u = (unsigned)h << 16; float f; memcpy(&f, &u, 4); return f; }
DEVFN bf16_t f2bf(float f) { unsigned u; memcpy(&u, &f, 4); return (bf16_t)((u + 0x7fffu + ((u >> 16) & 1u)) >> 16); }
struct alignas(16) U4 { unsigned x, y, z, w; };
DEVFN void ld8(const bf16_t* p, float* o) {
    const U4 v = *(const U4*)p; const unsigned u[4] = {v.x, v.y, v.z, v.w};
#pragma unroll
    for (int i = 0; i < 4; ++i) { unsigned lo = u[i] << 16, hi = u[i] & 0xffff0000u; memcpy(&o[2 * i], &lo, 4); memcpy(&o[2 * i + 1], &hi, 4); }
}
DEVFN float rsq(float x) { return 1.0f / sqrtf(x); }
DEVFN float rstd_slots(const float* s, int row, int ns, float invn) { float t = 0.f; for (int i = 0; i < ns; ++i) t += s[(size_t)row * ns + i]; return rsq(t * invn + EPS); }
DEVFN int sperm(int r) { return (r & ~12) | ((r & 4) << 1) | ((r & 8) >> 1); }
constexpr int NPW = HANDMAP ? 2 : 2 * GP;
DEVFN bf16_t* gptr(const Params& p, int b, int row, int c) {
    bf16_t* const g0 = opq(p.G0()); bf16_t* const gw = opq(p.GPW()); bf16_t* const go = opq(p.GPO());
    if (b == 0) return g0 + (size_t)row * D + c;
    const int j = (b - 1) * GP + (c >> 8); bf16_t* base = j < NPW ? gw + (size_t)j * (al256(SZ_GP) / 2) : go + (size_t)(j - NPW) * (al256(SZ_GP) / 2);
    return base + (size_t)row * 256 + (c & 255);
}
HDFN bf16_t* wptr(const Params& p, int l, size_t off) { return (bf16_t*)(p.WTS() + (size_t)l * WL_BYTES + off); }
#ifdef HOST_EMU
DEVFN float sigm_f(float z) { return 1.f / (1.f + expf(-z)); }
#define UNI(x) (x)
#else
DEVFN float sigm_f(float z) { return __builtin_amdgcn_rcpf(1.0f + __builtin_amdgcn_exp2f(-1.4426950408889634f * z)); }
#define UNI(x) __builtin_amdgcn_readfirstlane(x)
#endif
DEVFN float silu_f(float z) { return z * sigm_f(z); }
struct alignas(8) U2 { unsigned x, y; };
#ifdef HOST_EMU
DEVFN unsigned pk2(float lo, float hi) { return (unsigned)f2bf(lo) | ((unsigned)f2bf(hi) << 16); }
#else
typedef float f32x2_t __attribute__((ext_vector_type(2))); typedef __bf16 bf16x2_t __attribute__((ext_vector_type(2)));
DEVFN unsigned pk2(float lo, float hi) { f32x2_t v = {lo, hi}; bf16x2_t b = __builtin_convertvector(v, bf16x2_t); return __builtin_bit_cast(unsigned, b); }
#endif
DEVFN void st4(bf16_t* p, float a, float b, float c, float d) { U2 v; v.x = pk2(a, b); v.y = pk2(c, d); *(U2*)p = v; }
DEVFN void st2(bf16_t* p, float a, float b) { *(unsigned*)p = pk2(a, b); }
DEVFN void st8(bf16_t* p, const float* v) { U4 w; w.x = pk2(v[0], v[1]); w.y = pk2(v[2], v[3]); w.z = pk2(v[4], v[5]); w.w = pk2(v[6], v[7]); *(U4*)p = w; }
DEVFN void up8(const U4& v, float* o) { const unsigned u[4] = {v.x, v.y, v.z, v.w};
#pragma unroll
    for (int i = 0; i < 4; ++i) { unsigned lo = u[i] << 16, hi = u[i] & 0xffff0000u; memcpy(&o[2 * i], &lo, 4); memcpy(&o[2 * i + 1], &hi, 4); } }
struct alignas(16) F4v { float x, y, z, w; };
DEVFN void ld4(const bf16_t* p, float* o) { const U2 v = *(const U2*)p; unsigned t; t = v.x << 16; memcpy(&o[0], &t, 4); t = v.x & 0xffff0000u; memcpy(&o[1], &t, 4); t = v.y << 16; memcpy(&o[2], &t, 4); t = v.y & 0xffff0000u; memcpy(&o[3], &t, 4); }

DEVFN int rotmap(int c, int half) { const int g = c >> 2, e = c & 3; return e < 2 ? 2 * g + e : half + 2 * g + (e - 2); }
DEVFN int src_w1(int n) {
    if (n < V1_SBK) return C_SBQ + n;
    if (n < V1_CQ) return C_SBK + (n - V1_SBK);
    if (n < V1_CKV) return C_CQ + (n - V1_CQ);
    if (n < V1_KR) return C_CKV + (n - V1_CKV);
    if (n < V1_DQ) return C_KR + rotmap(n - V1_KR, 16);
    if (n < V1_DK) { const int c = n - V1_DQ, cc = c & 63; return C_DQ + (c & ~63) + (cc < 16 ? rotmap(cc, 8) : cc); }
    if (n < V1_END) { const int c = n - V1_DK, cc = c & 63; return C_DK + (c & ~63) + (cc < 16 ? rotmap(cc, 8) : cc); }
    return -1;
}
DEVFN int src_wv(int n) { return n < W ? C_SBV + n : C_DV + (n - W); }
DEVFN int src_w3(int n) { return n < W ? C_SBZ + n : n < 2 * W ? C_MZ + (n - W) : n < 3 * W ? C_DZ + (n - 2 * W) : C_G + (n - 3 * W); }
DEVFN int src_uq(int n) { const int h = n / 96, cc = n % 96; return h * 96 + (cc < 64 ? cc : 64 + rotmap(cc - 64, 16)); }
DEVFN int src_uk(int n) { return (n >> 6) * 128 + (n & 63); }
DEVFN int src_uv(int n) { return (n >> 6) * 128 + 64 + (n & 63); }

#ifdef HOST_EMU
DEVFN float quad_sum(float s) { return s; }
#else
template <int CTRL> DEVFN float dpp_get(float s) { return __int_as_float(__builtin_amdgcn_update_dpp(0, __float_as_int(s), CTRL, 0xf, 0xf, true)); }
DEVFN float xor16_sum(float s) { auto r = __builtin_amdgcn_permlane16_swap(__float_as_uint(s), __float_as_uint(s), false, false); return __uint_as_float(r[0]) + __uint_as_float(r[1]); }
DEVFN float xor32_sum(float s) { auto r = __builtin_amdgcn_permlane32_swap(__float_as_uint(s), __float_as_uint(s), false, false); return __uint_as_float(r[0]) + __uint_as_float(r[1]); }
DEVFN float quad_sum(float s) { return xor32_sum(xor16_sum(s)); }
DEVFN float quad4_sum(float s) { s += dpp_get<0xB1>(s); s += dpp_get<0x4E>(s); return s; }
DEVFN float wave_sum(float s) { s = quad4_sum(s); s += dpp_get<0x124>(s); s += dpp_get<0x128>(s); return xor32_sum(xor16_sum(s)); }
#endif
struct NoPre {};
DEVFN float ssq8(const float* v) { return ((v[0] * v[0] + v[1] * v[1]) + (v[2] * v[2] + v[3] * v[3])) + ((v[4] * v[4] + v[5] * v[5]) + (v[6] * v[6] + v[7] * v[7])); }
DEVFN void rope4(bf16_t* o, int half, int g, const float* v, const float* cs, const float* sn, float sc) {
    const float c0 = cs[2 * g], c1 = cs[2 * g + 1], s0 = sn[2 * g], s1 = sn[2 * g + 1];
    st2(o + 2 * g, (v[0] * c0 - v[2] * s0) * sc, (v[1] * c1 - v[3] * s1) * sc); st2(o + half + 2 * g, (v[2] * c0 + v[0] * s0) * sc, (v[3] * c1 + v[1] * s1) * sc);
}
struct F1 {
    const Params& p; int aux; typedef NoPre Pre;
    DEVFN bool swapped(int tag) const { return tag == 1; }
    DEVFN float scale(int tag, int idx) const { return rstd_slots(p.ssx(), idx, NSX, 1.0f / D); }
    DEVFN void preload(int, int, int, Pre&) const {}
    DEVFN float apply(int tag, int row, int vc, const float* a, const float* sc, const Pre&) const {
        if (tag == 1) { const bool sb = UNI(row) < W; bf16_t* const vs = opq(p.VSBT()); bf16_t* const vd = opq(p.VDT()); bf16_t* o = (sb ? vs + (size_t)row * R : vd + (size_t)(row - W) * R) + (vc & ~15);
            const int t0 = vc & 15;
            st4(o + sperm(t0), a[0] * sc[0], a[1] * sc[1], a[2] * sc[2], a[3] * sc[3]); st4(o + sperm(t0 + 4), a[4] * sc[4], a[5] * sc[5], a[6] * sc[6], a[7] * sc[7]); return 0.f; }
        const int vcu = UNI(vc); const float rs = sc[0]; float v[8];
#pragma unroll
        for (int i = 0; i < 8; ++i) v[i] = a[i] * rs;
        const int t = row % TB; const int pos = t >= LEAD ? t - LEAD : 0;
        if (vcu < V1_SBK) {
#pragma unroll
            for (int i = 0; i < 8; ++i) v[i] *= 0.125f * LOG2E;
            st8(p.QSB() + (size_t)row * W + vc, v); }
        else if (vcu < V1_CQ) { st8(p.KSB() + (size_t)row * W + (vc - V1_SBK), v); }
        else if (vcu < V1_CKV) { st8(p.CQ() + (size_t)row * QR + (vc - V1_CQ), v); return ssq8(v); }
        else if (vcu < V1_KR) { st8(p.CKV() + (size_t)row * KVR + (vc - V1_CKV), v); return ssq8(v); }
        else if (vcu < V1_DQ) { const int g = (vc - V1_KR) >> 2; bf16_t* o = p.KR() + (size_t)row * 32; rope4(o, 16, g, v, p.cosm() + pos * 16, p.sinm() + pos * 16, 1.f); rope4(o, 16, g + 1, v + 4, p.cosm() + pos * 16, p.sinm() + pos * 16, 1.f); }
        else if (vcu < V1_END) { const bool isq = vcu < V1_DK; const int c = vc - (isq ? V1_DQ : V1_DK), cc = c & 63; const float sc2 = isq ? 0.125f * LOG2E : 1.0f;
            bf16_t* const qd = opq(p.QD()); bf16_t* const kd = opq(p.KD()); bf16_t* o = (isq ? qd : kd) + (size_t)row * W + (c & ~63);
            if (cc < 16  ) { const int g = cc >> 2; rope4(o, 8, g, v, p.cosd() + pos * 8, p.sind() + pos * 8, sc2); rope4(o, 8, g + 1, v + 4, p.cosd() + pos * 8, p.sind() + pos * 8, sc2); }
            else {
#pragma unroll
                for (int i = 0; i < 8; ++i) v[i] *= sc2;
                st8(o + cc, v); } }
        return 0.f;
    }
    DEVFN void rowslot(int tag, int row, int vc0, int fq, float part) const {
        if (tag != 0 || vc0 < V1_CQ || vc0 >= V1_KR) return;
        const float s = quad_sum(part);
        if (fq == 0) { if (vc0 < V1_CKV) p.ssq()[(size_t)row * NSQ + ((vc0 - V1_CQ) >> 5)] = s; else p.ssk()[(size_t)row * NSK + ((vc0 - V1_CKV) >> 5)] = s; }
    }
};
struct FUQ {
    const Params& p; int aux; typedef NoPre Pre;
    DEVFN bool swapped(int) const { return false; }
    DEVFN float scale(int, int idx) const { return rstd_slots(p.ssq(), idx, NSQ, 1.0f / QR) * (LOG2E * 0.10206207261596577f); }
    DEVFN void preload(int, int, int, Pre&) const {}
    DEVFN float apply(int, int row, int vc, const float* a, const float* sc, const Pre&) const {
        const float rs = sc[0]; float v[8];
#pragma unroll
        for (int i = 0; i < 8; ++i) v[i] = a[i] * rs;
        const int t = row % TB; const int pos = t >= LEAD ? t - LEAD : 0;
        const int h = vc / 96, cc = vc % 96; bf16_t* o = p.QB() + (size_t)row * QBW + h * 96;
        if (UNI(vc) % 96 < 64) st8(o + cc, v);
        else { const int g = (cc - 64) >> 2; rope4(o + 64, 16, g, v, p.cosm() + pos * 16, p.sinm() + pos * 16, 1.f); rope4(o + 64, 16, g + 1, v + 4, p.cosm() + pos * 16, p.sinm() + pos * 16, 1.f); }
        return 0.f;
    }
    DEVFN void rowslot(int, int, int, int, float) const {}
};
struct FUK {
    const Params& p; int aux; typedef NoPre Pre;
    DEVFN bool swapped(int tag) const { return tag == 1; }
    DEVFN float scale(int, int idx) const { return rstd_slots(p.ssk(), idx, NSK, 1.0f / KVR); }
    DEVFN void preload(int, int, int, Pre&) const {}
    DEVFN float apply(int tag, int row, int vc, const float* a, const float* sc, const Pre&) const {
        if (tag == 1) { bf16_t* o = p.VBT() + (size_t)row * R + (vc & ~15); const int t0 = vc & 15;
            st4(o + sperm(t0), a[0] * sc[0], a[1] * sc[1], a[2] * sc[2], a[3] * sc[3]); st4(o + sperm(t0 + 4), a[4] * sc[4], a[5] * sc[5], a[6] * sc[6], a[7] * sc[7]); }
        else { float v[8];
#pragma unroll
            for (int i = 0; i < 8; ++i) v[i] = a[i] * sc[0];
            st8(p.KNOPE() + (size_t)row * W + vc, v); }
        return 0.f;
    }
    DEVFN void rowslot(int, int, int, int, float) const {}
};
struct F3 {
    const Params& p; int layer; typedef U4 Pre;
    DEVFN bool swapped(int) const { return false; }
    DEVFN float scale(int, int idx) const { return rstd_slots(p.ssx(), idx, NSX, 1.0f / D); }
    DEVFN bf16_t* optr(int row, int vc) const { const int vcu = UNI(vc); bf16_t* const o0 = opq(p.QSB()); bf16_t* const o1 = opq(p.OMLA()); bf16_t* const o2 = opq(p.QD()); return (vcu < W ? o0 : vcu < 2 * W ? o1 : o2) + (size_t)row * W + (vc % W); }
    DEVFN void preload(int, int row, int vc, Pre& pre) const { if (UNI(vc) < 3 * W) pre = *(const U4*)optr(row, vc); }
    DEVFN float apply(int, int row, int vc, const float* a, const float* sc, const Pre& pre) const {
        const float rs = sc[0]; float v[8];
        if (UNI(vc) < 3 * W) { float ov[8]; up8(pre, ov);
#pragma unroll
            for (int i = 0; i < 8; ++i) v[i] = ov[i] * silu_f(a[i] * rs);
            st8(optr(row, vc), v); }
        else { const int c = vc - 3 * W, cu = UNI(c), b = cu / D, cc = c - b * D; const F4v b0 = *(const F4v*)(p.b_gate + (size_t)layer * 3 * D + c), b1 = *(const F4v*)(p.b_gate + (size_t)layer * 3 * D + c + 4);
            v[0] = sigm_f(a[0] * rs + b0.x); v[1] = sigm_f(a[1] * rs + b0.y); v[2] = sigm_f(a[2] * rs + b0.z); v[3] = sigm_f(a[3] * rs + b0.w);
            v[4] = sigm_f(a[4] * rs + b1.x); v[5] = sigm_f(a[5] * rs + b1.y); v[6] = sigm_f(a[6] * rs + b1.z); v[7] = sigm_f(a[7] * rs + b1.w);
            st8(gptr(p, b, row, cc), v); }
        return 0.f;
    }
    DEVFN void rowslot(int, int, int, int, float) const {}
};
struct F4 {
    const Params& p; int aux; struct Pre { U4 g, m; };
    DEVFN bool swapped(int) const { return false; }
    DEVFN float scale(int, int) const { return 1.f; }
    DEVFN void preload(int tag, int row, int c, Pre& pre) const { pre.g = *(const U4*)gptr(p, tag & 3, row, c); if (tag >> 2) pre.m = *(const U4*)(p.G0() + (size_t)row * D + c); }
    DEVFN float apply(int tag, int row, int c, const float* a, const float*, const Pre& pre) const {
        float g[8], m[8], v[8]; up8(pre.g, g);
        if (tag >> 2) up8(pre.m, m); else {
#pragma unroll
            for (int i = 0; i < 8; ++i) m[i] = 0.f; }
#pragma unroll
        for (int i = 0; i < 8; ++i) v[i] = m[i] + g[i] * a[i];
        st8(p.G0() + (size_t)row * D + c, v); return 0.f;
    }
    DEVFN void rowslot(int, int, int, int, float) const {}
};
struct F5 {
    const Params& p; int last; struct Pre { F4v x0, x1; };
    DEVFN bool swapped(int) const { return false; }
    DEVFN float scale(int, int) const { return 1.f; }
    DEVFN void preload(int, int row, int c, Pre& pre) const { const F4v* x = (const F4v*)(p.X() + (size_t)row * D + c); pre.x0 = x[0]; pre.x1 = x[1]; }
    DEVFN float apply(int, int row, int c, const float* a, const float*, const Pre& pre) const {
        float v[8] = {pre.x0.x + a[0], pre.x0.y + a[1], pre.x0.z + a[2], pre.x0.w + a[3], pre.x1.x + a[4], pre.x1.y + a[5], pre.x1.z + a[6], pre.x1.w + a[7]};
        F4v* x = (F4v*)(p.X() + (size_t)row * D + c); x[0] = F4v{v[0], v[1], v[2], v[3]}; x[1] = F4v{v[4], v[5], v[6], v[7]};
        if (!last) st8(p.XB() + (size_t)row * D + c, v);
        return ssq8(v);
    }
    DEVFN void rowslot(int, int row, int vc0, int fq, float part) const { const float s = quad_sum(part); if (fq == 0) p.ssx()[(size_t)row * NSX + (vc0 >> 5)] = s; }
};

#ifdef HOST_EMU
struct dim3e { unsigned x, y, z; };
static dim3e threadIdx, blockIdx, blockDim, gridDim;
#define GLOBAL static
#define LB64
#define LAUNCH(kern, nblk, nthr, ...) do { gridDim.x = (unsigned)(nblk); blockDim.x = (unsigned)(nthr); for (unsigned b_ = 0; b_ < gridDim.x; ++b_) for (unsigned t_ = 0; t_ < blockDim.x; ++t_) { blockIdx.x = b_; threadIdx.x = t_; kern(__VA_ARGS__); } } while (0)
#else
#define GLOBAL __global__
#define LB64 __launch_bounds__(64)
#define LAUNCH(kern, nblk, nthr, ...) kern<<<dim3((unsigned)(nblk)), dim3((unsigned)(nthr)), 0, stream>>>(__VA_ARGS__)
#endif
#define GTID ((long)blockIdx.x * blockDim.x + threadIdx.x)

#ifdef HOST_EMU
template <int MAP> GLOBAL void k_prep_w(bf16_t* dst, int N, int K, const float* src, int src_ld, const float* rowscale) {
    const long i = GTID; if (i >= (long)N * K) return;
    const int n = (int)(i % N), k = (int)(i / N);
    int s;
    if (MAP == 0) s = src_w1(n); else if (MAP == 1) s = src_wv(n); else if (MAP == 2) s = src_w3(n); else if (MAP == 3) s = src_uq(n); else if (MAP == 4) s = src_uk(n); else if (MAP == 5) s = src_uv(n); else s = n;
    float v = 0.f; if (s >= 0) v = src[(size_t)k * src_ld + s] * (rowscale ? rowscale[k] : 1.f);
    dst[(size_t)n * K + k] = f2bf(v);
}
GLOBAL void k_tables(Params p) {
    const long i = GTID;
    if (i < NPOS * 16) { const int pos = (int)(i / 16), j = (int)(i % 16); const float inv = (float)pow(500000.0, -(double)(2 * j) / 32.0); const float ang = (float)pos * inv;
        p.cosm()[i] = (float)cos((double)ang); p.sinm()[i] = (float)sin((double)ang); }
    if (i < NPOS * 8) { const int pos = (int)(i / 8), j = (int)(i % 8); const float inv = (float)pow(500000.0, -(double)(2 * j) / 16.0); const float ang = (float)pos * inv;
        p.cosd()[i] = (float)cos((double)ang); p.sind()[i] = (float)sin((double)ang); }
    if (i < DEPTH) { const float* lm = p.dlam + i * 4 * 64; float s0 = 0.f, s1 = 0.f; for (int d = 0; d < 64; ++d) { s0 += lm[d] * lm[64 + d]; s1 += lm[128 + d] * lm[192 + d]; }
        p.lamv()[i] = expf(s0) - expf(s1) + (0.8f - 0.6f * expf(-0.3f * (float)i)); }
}
GLOBAL void k_init_x(Params p) {
    const long i = GTID; if (i >= (long)R * D) return;
    const int row = (int)(i / D), c = (int)(i % D), b = row / TB, t = row % TB;
    const float v = t < LEAD ? 0.f : t < LEAD + NMETA ? p.meta[(t - LEAD) * D + c] : p.x[((size_t)b * SEQ + (t - LEAD - NMETA)) * D + c];
    p.X()[i] = v; p.XB()[i] = f2bf(v);
}
GLOBAL void k_x2bf(Params p) { const long i = GTID; if (i >= (long)R * D) return; p.XB2()[i] = f2bf(p.X()[i]); }
GLOBAL void k_ssq_f32(const float* X, int n, float* slots, int ns) {
    const long row = GTID; if (row >= R) return; float s = 0.f; for (int c = 0; c < n; ++c) { const float v = X[(size_t)row * n + c]; s += v * v; }
    slots[row * ns] = s; for (int i = 1; i < ns; ++i) slots[row * ns + i] = 0.f;
}
GLOBAL void k_ssq_bf(const bf16_t* X, int n, float* slots, int ns) {
    const long row = GTID; if (row >= R) return; float s = 0.f; for (int c = 0; c < n; ++c) { const float v = bf2f(X[(size_t)row * n + c]); s += v * v; }
    slots[row * ns] = s; for (int i = 1; i < ns; ++i) slots[row * ns + i] = 0.f;
}
GLOBAL void k_final(Params p) {
    const long i = GTID; if (i >= (long)NB * SEQ) return;
    const int b = (int)(i / SEQ), s = (int)(i % SEQ); const float* x = p.X() + ((size_t)b * TB + LEAD + NMETA + s) * D; float ss = 0.f;
    for (int c = 0; c < D; ++c) ss += x[c] * x[c];
    const float rs = rsq(ss / D + EPS); float* o = p.out + (size_t)i * D;
    for (int c = 0; c < D; ++c) o[c] = x[c] * rs * p.final_g[c];
}

template <class Epi> GLOBAL void k_gemm(const bf16_t* A, int lda, const bf16_t* Bt, int ldb, int M, int N, int K, Params pp, int aux, int tag) {
    const Epi epi{pp, aux};
    const long idx = GTID; const int n8 = N / 8; if (idx >= (long)M * n8) return;
    const int m = (int)(idx / n8), n0 = (int)(idx % n8) * 8;
    float acc[8] = {0.f, 0.f, 0.f, 0.f, 0.f, 0.f, 0.f, 0.f};
    const bf16_t* a = A + (size_t)m * lda; const bf16_t* b0 = Bt + (size_t)n0 * ldb;
    for (int k = 0; k < K; k += 8) {
        float av[8]; ld8(a + k, av);
        for (int i = 0; i < 8; ++i) { float bv[8]; ld8(b0 + (size_t)i * ldb + k, bv); float s = 0.f;
            for (int j = 0; j < 8; ++j) s += av[j] * bv[j];
            acc[i] += s; }
    }
    float sc[8]; if (epi.swapped(tag)) { for (int i = 0; i < 8; ++i) sc[i] = epi.scale(tag, n0 + i); } else sc[0] = epi.scale(tag, m);
    typename Epi::Pre pre; epi.preload(tag, m, n0, pre); epi.apply(tag, m, n0, acc, sc, pre);
}

GLOBAL void LB64 k_attn_sb(Params p) {
    const long i = GTID; if (i >= (long)NB * NH * TB) return;
    const int t = (int)(i % TB), h = (int)((i / TB) % NH), b = (int)(i / ((long)TB * NH));
    const size_t row = (size_t)b * TB + t; bf16_t* qo = p.QSB() + row * W + h * 64;
    float q[64], o[64];
#pragma unroll
    for (int d = 0; d < 64; ++d) { q[d] = bf2f(qo[d]); o[d] = 0.f; }
    if (t >= LEAD) {
        float carry = 0.f;
        for (int j = t - 1; j >= LEAD; --j) {
            const size_t kr = (size_t)b * TB + j; const bf16_t* k = p.KSB() + kr * W + h * 64; float z = 0.f;
#pragma unroll
            for (int d = 0; d < 64; ++d) z += q[d] * bf2f(k[d]);
            const float sp = fmaxf(z, 0.f) + log2f(1.f + exp2f(-fabsf(z)));
            const float w = exp2f((z - sp) + carry); carry -= sp;
            const bf16_t* vt = p.VSBT() + (size_t)(h * 64) * R + ((kr & ~(size_t)15) | sperm((int)(kr & 15)));
#pragma unroll
            for (int d = 0; d < 64; ++d) o[d] += w * bf2f(vt[(size_t)d * R]);
        }
    }
#pragma unroll
    for (int d = 0; d < 64; ++d) qo[d] = f2bf(o[d]);
}
GLOBAL void LB64 k_attn_mla(Params p) {
    const long i = GTID; if (i >= (long)NB * NH * TB) return;
    const int t = (int)(i % TB), h = (int)((i / TB) % NH), b = (int)(i / ((long)TB * NH));
    const size_t row = (size_t)b * TB + t; const bf16_t* qp = p.QB() + row * QBW + h * 96;
    float o[64]; float m = -INFINITY, l = 0.f;
#pragma unroll
    for (int d = 0; d < 64; ++d) o[d] = 0.f;
    if (t >= LEAD) {
        const int kend = (t / 64 + 1) * 64 < TB ? (t / 64 + 1) * 64 : TB;
        for (int j = LEAD; j < kend; ++j) {
            const size_t kr = (size_t)b * TB + j; const bf16_t* kn = p.KNOPE() + kr * W + h * 64; const bf16_t* kq = p.KR() + kr * 32; float s = 0.f;
            for (int d = 0; d < 64; ++d) s += bf2f(qp[d]) * bf2f(kn[d]);
            for (int d = 0; d < 32; ++d) s += bf2f(qp[64 + d]) * bf2f(kq[d]);
            const float mn = fmaxf(m, s), f = exp2f(m - mn), w = exp2f(s - mn); m = mn; l = l * f + w;
            const bf16_t* vt = p.VBT() + (size_t)(h * 64) * R + ((kr & ~(size_t)15) | sperm((int)(kr & 15)));
#pragma unroll
            for (int d = 0; d < 64; ++d) o[d] = o[d] * f + w * bf2f(vt[(size_t)d * R]);
        }
    }
    const float il = l > 0.f ? 1.f / l : 0.f; bf16_t* op = p.OMLA() + row * W + h * 64;
#pragma unroll
    for (int d = 0; d < 64; ++d) op[d] = f2bf(o[d] * il);
}
GLOBAL void LB64 k_attn_diff(Params p, int layer) {
    const long i = GTID; if (i >= (long)NB * NHD * TB) return;
    const int t = (int)(i % TB), h = (int)((i / TB) % NHD), b = (int)(i / ((long)TB * NHD));
    const size_t row = (size_t)b * TB + t; bf16_t* qo = p.QD() + row * W + h * 128;
    const float lam = p.lamv()[layer], lam_init = 0.8f - 0.6f * expf(-0.3f * (float)layer);
    float o[128];
#pragma unroll
    for (int d = 0; d < 128; ++d) o[d] = 0.f;
    if (t >= LEAD) {
        const int kend = (t / 64 + 1) * 64 < TB ? (t / 64 + 1) * 64 : TB;
        float m0 = -INFINITY, l0 = 0.f, m1 = -INFINITY, l1 = 0.f;
        for (int j = LEAD; j < kend; ++j) { const bf16_t* k = p.KD() + ((size_t)b * TB + j) * W + h * 128; float s0 = 0.f, s1 = 0.f;
            for (int d = 0; d < 64; ++d) { s0 += bf2f(qo[d]) * bf2f(k[d]); s1 += bf2f(qo[64 + d]) * bf2f(k[64 + d]); }
            float mn = fmaxf(m0, s0); l0 = l0 * exp2f(m0 - mn) + exp2f(s0 - mn); m0 = mn; mn = fmaxf(m1, s1); l1 = l1 * exp2f(m1 - mn) + exp2f(s1 - mn); m1 = mn; }
        const float i0 = 1.f / l0, i1 = lam / l1;
        for (int j = LEAD; j < kend; ++j) { const size_t kr = (size_t)b * TB + j; const bf16_t* k = p.KD() + kr * W + h * 128; float s0 = 0.f, s1 = 0.f;
            for (int d = 0; d < 64; ++d) { s0 += bf2f(qo[d]) * bf2f(k[d]); s1 += bf2f(qo[64 + d]) * bf2f(k[64 + d]); }
            const float w = exp2f(s0 - m0) * i0 - exp2f(s1 - m1) * i1;
            const bf16_t* vt = p.VDT() + (size_t)(h * 128) * R + ((kr & ~(size_t)15) | sperm((int)(kr & 15)));
#pragma unroll
            for (int d = 0; d < 128; ++d) o[d] += w * bf2f(vt[(size_t)d * R]);
        }
    }
    float ss = 0.f;
#pragma unroll
    for (int d = 0; d < 128; ++d) ss += o[d] * o[d];
    const float rs = rsq(ss * (1.f / 128.f) + EPS) * (1.f - lam_init); const float* g = p.dnorm_g + (size_t)layer * 128;
#pragma unroll
    for (int d = 0; d < 128; ++d) qo[d] = f2bf(o[d] * rs * g[d]);
}


#endif
#ifndef HOST_EMU
namespace pg8 {
#define PG8_LAS __attribute__((address_space(3)))
typedef short bf16x8 __attribute__((ext_vector_type(8)));
typedef float f32x4 __attribute__((ext_vector_type(4)));
typedef unsigned u32x4 __attribute__((ext_vector_type(4)));
constexpr int BM = 256, BK = 64, HALF = 128, HTB = HALF * BK * 2  , STAGE_BYTES = 8 * HTB, NXCD = 8, WGM = 8;
__host__ __device__ __forceinline__ int lds_byte(int r, int c) { const int st = (r >> 4) * 2 + (c >> 5), rr = r & 15, cc = c & 31, ob = rr * 64 + cc * 2; return st * 1024 + (ob ^ (((ob >> 9) & 1) << 5)); }
__host__ __device__ __forceinline__ void stage_rc(int b, int& R, int& C) { const int st = b / 1024, sb = b % 1024, swz = sb ^ (((sb >> 9) & 1) << 5); R = (st >> 1) * 16 + swz / 64; C = (st & 1) * 32 + (swz % 64) / 2; }
__host__ __device__ __forceinline__ int perm32(int rho) { const int n = rho >> 4, i = rho & 15; return 8 * (i >> 2) + 4 * n + (i & 3); }
struct Unit { int pm, pn, tag; const char* A; const char* B; };
struct Gemm { int K, lda, ldb; };
__device__ __forceinline__ void order_map(int L, int nM, int nN, int& pm, int& pn) {
    const int nwg = nM * nN; int wgid = L; { const int q = nwg / NXCD, r = nwg % NXCD, xcd = wgid % NXCD, off = wgid / NXCD; wgid = (xcd < r ? xcd * (q + 1) : r * (q + 1) + (xcd - r) * q) + off; }
    const int nig = WGM * nN, gid = wgid / nig, fm = gid * WGM, gsz = (nM - fm) < WGM ? (nM - fm) : WGM;
    pm = fm + ((wgid % nig) % gsz); pn = (wgid % nig) / gsz;
}
template <class F> struct EpiAd {
    static constexpr bool PERM = true, AFTER_DRAIN = false;
    F f;
    __device__ __forceinline__ void operator()(const f32x4 (&acc)[2][2][4][2], const Unit& u, int wr, int wc, int fr, int fq, PG8_LAS unsigned char* scr, int tid) const {
        PG8_LAS float* rs = (PG8_LAS float*)scr;
        const bool sw = f.swapped(u.tag);
        if (tid < 256) rs[tid] = f.scale(u.tag, (sw ? u.pn : u.pm) * BM + tid);
        asm volatile("s_waitcnt lgkmcnt(0)" ::: "memory"); __builtin_amdgcn_s_barrier(); asm volatile("" ::: "memory");
#pragma unroll
        for (int ai = 0; ai < 2; ++ai) {
            int rl0 = ai * HALF + wr * 64 + fr, fqo = fq; asm volatile("" : "+v"(rl0), "+v"(fqo));
            typename F::Pre pre[4][2];
#pragma unroll
            for (int m = 0; m < 4; ++m)
#pragma unroll
                for (int bj = 0; bj < 2; ++bj) f.preload(u.tag, u.pm * BM + rl0 + m * 16, u.pn * BM + bj * HALF + wc * 32 + 8 * fqo, pre[m][bj]);
#pragma unroll
            for (int m = 0; m < 4; ++m) { const int rl = rl0 + m * 16, row = u.pm * BM + rl;
#pragma unroll
                for (int bj = 0; bj < 2; ++bj) { const int cl = bj * HALF + wc * 32 + 8 * fqo; const f32x4 v0 = acc[ai][bj][m][0], v1 = acc[ai][bj][m][1]; const float a8[8] = {v0[0], v0[1], v0[2], v0[3], v1[0], v1[1], v1[2], v1[3]};
                    float sc[8];
                    if (sw) {
#pragma unroll
                        for (int i = 0; i < 8; ++i) sc[i] = rs[cl + i]; }
                    else { sc[0] = rs[rl];
#pragma unroll
                        for (int i = 1; i < 8; ++i) sc[i] = 0.f; }
                    const float part = f.apply(u.tag, row, u.pn * BM + cl, a8, sc, pre[m][bj]);
                    f.rowslot(u.tag, row, u.pn * BM + bj * HALF + wc * 32, fq, part); } }
            asm volatile("" ::: "memory");
        }
    }
};
template <class Epi, class Sched, bool ALIGN_EPI = false, bool SP2 = false>
__device__ __forceinline__ void gemm_phase(PG8_LAS unsigned char* lds, const Gemm g, const Sched& S, const Epi& E, const int wid0  ) {
    int lane_ = lane_id_v();
    const int wid = wid0, lane = lane_, tid = wid * 64 + lane, wr = wid >> 2, wc = wid & 3, fr = lane & 15, fq = lane >> 4;
    const int K = g.K, nt = K / BK, lda = g.lda, ldb = g.ldb;
    unsigned voffA[2], voffB[2];
#pragma unroll
    for (int i = 0; i < 2; ++i) { int R, C; stage_rc(tid * 16 + i * 8192, R, C); const int Rb = Epi::PERM ? ((R & ~31) + perm32(R & 31)) : R;
        voffA[i] = (unsigned)(R * lda + C) * 2u; voffB[i] = (unsigned)(Rb * ldb + C) * 2u; }
    const size_t kstep = (size_t)(BK * 2);
    const size_t hstepA = (size_t)HALF * lda * 2, hstepB = (size_t)HALF * ldb * 2;
    const size_t tstepA = 2 * hstepA, tstepB = 2 * hstepB;
    const unsigned ldsw = (unsigned)wid * 1024u;
    const int aoff = lds_byte(wr * 64 + fr, fq * 8), boff = lds_byte(wc * 32 + fr, fq * 8);
#define PG8_SA(b, h) (((b) * 2 + (h)) * HTB)
#define PG8_SB(b, h) ((4 + (b) * 2 + (h)) * HTB)
#define PG8_STAGE(bufoff, gbase, voff) do { _Pragma("unroll") for (int _i = 0; _i < 2; ++_i) \
        __builtin_amdgcn_global_load_lds((const unsigned*)((const char*)(gbase) + (voff)[_i]), (PG8_LAS unsigned*)(lds + (bufoff) + ldsw + _i * 8192), 16, 0, 0); } while (0)
#define PG8_LDA(dst, b, h) do { _Pragma("unroll") for (int m = 0; m < 4; ++m) _Pragma("unroll") for (int k = 0; k < 2; ++k) dst[m][k] = *(const PG8_LAS bf16x8*)(lds + PG8_SA(b, h) + aoff + m * 2048 + k * 1024); } while (0)
#define PG8_LDB(dst, b, h) do { _Pragma("unroll") for (int n = 0; n < 2; ++n) _Pragma("unroll") for (int k = 0; k < 2; ++k) dst[n][k] = *(const PG8_LAS bf16x8*)(lds + PG8_SB(b, h) + boff + n * 2048 + k * 1024); } while (0)
#define PG8_MMA(ai, bj, At, Bt) do { __builtin_amdgcn_s_setprio(1); _Pragma("unroll") for (int m = 0; m < 4; ++m) _Pragma("unroll") for (int n = 0; n < 2; ++n) _Pragma("unroll") for (int k = 0; k < 2; ++k) \
        acc[ai][bj][m][n] = __builtin_amdgcn_mfma_f32_16x16x32_bf16(Bt[n][k], At[m][k], acc[ai][bj][m][n], 0, 0, 0); __builtin_amdgcn_s_setprio(0); } while (0)
#define PG8_WAIT_V(n) asm volatile("s_waitcnt vmcnt(" #n ")" ::: "memory")
#define PG8_WAIT_L(n) asm volatile("s_waitcnt lgkmcnt(" #n ")" ::: "memory")
#define PG8_BAR __builtin_amdgcn_s_barrier()
#define PG8_SCHED __builtin_amdgcn_sched_barrier(0)
    Unit cur, nxt; int ui = 0;
    if (!S.next(0, cur)) return;
    f32x4 acc[2][2][4][2];
#pragma unroll
    for (int a = 0; a < 2; ++a)
#pragma unroll
        for (int b = 0; b < 2; ++b)
#pragma unroll
            for (int m = 0; m < 4; ++m)
#pragma unroll
                for (int n = 0; n < 2; ++n) acc[a][b][m][n] = (f32x4){0.f, 0.f, 0.f, 0.f};
    bf16x8 At[4][2], B0[2][2], B1[2][2];
    const char* cA = cur.A + (size_t)cur.pm * tstepA; const char* cB = cur.B + (size_t)cur.pn * tstepB;
    S.a_ready(cur);
    if constexpr (SP2) {
        PG8_STAGE(PG8_SB(0, 0), cB, voffB); PG8_STAGE(PG8_SB(0, 1), cB + hstepB, voffB); PG8_STAGE(PG8_SA(0, 0), cA, voffA); PG8_STAGE(PG8_SA(0, 1), cA + hstepA, voffA);
        if (wr == 1) PG8_BAR;
        PG8_WAIT_V(2); PG8_BAR;
        PG8_STAGE(PG8_SB(1, 0), cB + kstep, voffB); PG8_STAGE(PG8_SA(1, 0), cA + kstep, voffA); PG8_STAGE(PG8_SB(1, 1), cB + hstepB + kstep, voffB);
        PG8_WAIT_V(6); PG8_BAR;
    } else {
        PG8_STAGE(PG8_SB(0, 0), cB, voffB); PG8_STAGE(PG8_SA(0, 0), cA, voffA); PG8_STAGE(PG8_SB(0, 1), cB + hstepB, voffB); PG8_STAGE(PG8_SA(0, 1), cA + hstepA, voffA);
        if (wr == 1) PG8_BAR;
        PG8_WAIT_V(4); PG8_BAR;
        PG8_STAGE(PG8_SB(1, 0), cB + kstep, voffB); PG8_STAGE(PG8_SA(1, 0), cA + kstep, voffA); PG8_STAGE(PG8_SB(1, 1), cB + hstepB + kstep, voffB);
        PG8_WAIT_V(6); PG8_BAR;
    }
    for (;;) {
        const bool has_next = S.next(ui + 1, nxt);
        const char* nA = has_next ? nxt.A + (size_t)nxt.pm * tstepA : cA; const char* nB = has_next ? nxt.B + (size_t)nxt.pn * tstepB : cB;
#pragma nounroll
        for (int t = 0; t < nt; t += 2) {
            const bool last = (t == nt - 2);
            const char* a1 = cA + (size_t)(t + 1) * kstep;
            const char* a2 = last ? nA : cA + (size_t)(t + 2) * kstep; const char* b2 = last ? nB : cB + (size_t)(t + 2) * kstep;
            const char* a3 = a2 + kstep; const char* b3 = b2 + kstep;
            if (last && has_next) S.a_ready(nxt);
            if constexpr (SP2) {
            PG8_LDB(B0, 0, 0); PG8_LDB(B1, 0, 1); PG8_SCHED; PG8_LDA(At, 0, 0); PG8_STAGE(PG8_SA(1, 1), a1 + hstepA, voffA);
            PG8_WAIT_V(8); PG8_WAIT_L(0); PG8_BAR; PG8_MMA(0, 0, At, B0); PG8_MMA(0, 1, At, B1); PG8_BAR; PG8_SCHED;
            PG8_LDA(At, 0, 1); PG8_STAGE(PG8_SB(0, 0), b2, voffB); PG8_STAGE(PG8_SB(0, 1), b2 + hstepB, voffB); PG8_STAGE(PG8_SA(0, 0), a2, voffA);
            PG8_WAIT_V(8); PG8_WAIT_L(0); PG8_BAR; PG8_MMA(1, 0, At, B0); PG8_MMA(1, 1, At, B1); PG8_BAR; PG8_SCHED;
            PG8_LDB(B0, 1, 0); PG8_LDB(B1, 1, 1); PG8_SCHED; PG8_LDA(At, 1, 0); PG8_STAGE(PG8_SA(0, 1), a2 + hstepA, voffA);
            PG8_WAIT_V(8); PG8_WAIT_L(0); PG8_BAR; PG8_MMA(0, 0, At, B0); PG8_MMA(0, 1, At, B1); PG8_BAR; PG8_SCHED;
            PG8_LDA(At, 1, 1); PG8_STAGE(PG8_SB(1, 0), b3, voffB); PG8_STAGE(PG8_SB(1, 1), b3 + hstepB, voffB); PG8_STAGE(PG8_SA(1, 0), a3, voffA);
            PG8_WAIT_V(8); PG8_WAIT_L(0); PG8_BAR; PG8_MMA(1, 0, At, B0); PG8_MMA(1, 1, At, B1); PG8_BAR; PG8_SCHED;
            } else {
            PG8_LDB(B0, 0, 0); PG8_SCHED; PG8_LDA(At, 0, 0); PG8_STAGE(PG8_SA(1, 1), a1 + hstepA, voffA);
            PG8_WAIT_L(8); PG8_BAR; PG8_WAIT_L(0); PG8_MMA(0, 0, At, B0); PG8_BAR; PG8_SCHED;
            PG8_LDB(B1, 0, 1); PG8_STAGE(PG8_SB(0, 0), b2, voffB);
            PG8_BAR; PG8_WAIT_L(0); PG8_MMA(0, 1, At, B1); PG8_BAR;
            PG8_LDA(At, 0, 1); PG8_STAGE(PG8_SA(0, 0), a2, voffA);
            PG8_BAR; PG8_WAIT_L(0); PG8_MMA(1, 0, At, B0); PG8_BAR; PG8_SCHED;
            PG8_STAGE(PG8_SB(0, 1), b2 + hstepB, voffB);
            PG8_WAIT_V(6); PG8_BAR; PG8_MMA(1, 1, At, B1); PG8_BAR;
            PG8_LDB(B0, 1, 0); PG8_SCHED; PG8_LDA(At, 1, 0); PG8_STAGE(PG8_SA(0, 1), a2 + hstepA, voffA);
            PG8_WAIT_L(8); PG8_BAR; PG8_WAIT_L(0); PG8_MMA(0, 0, At, B0); PG8_BAR; PG8_SCHED;
            PG8_LDB(B1, 1, 1); PG8_STAGE(PG8_SB(1, 0), b3, voffB);
            PG8_BAR; PG8_WAIT_L(0); PG8_MMA(0, 1, At, B1); PG8_BAR;
            PG8_LDA(At, 1, 1); PG8_STAGE(PG8_SA(1, 0), a3, voffA);
            PG8_BAR; PG8_WAIT_L(0); PG8_MMA(1, 0, At, B0); PG8_BAR; PG8_SCHED;
            PG8_STAGE(PG8_SB(1, 1), b3 + hstepB, voffB);
            PG8_WAIT_V(6); PG8_BAR; PG8_MMA(1, 1, At, B1); PG8_BAR;
            }
        }
        if constexpr (ALIGN_EPI) { if (wr == 0) PG8_BAR; }
        if constexpr (!Epi::AFTER_DRAIN) { E(acc, cur, wr, wc, fr, fq, lds + STAGE_BYTES, tid); S.done(cur); }
        if (!has_next) break;
#pragma unroll
        for (int a = 0; a < 2; ++a)
#pragma unroll
            for (int b = 0; b < 2; ++b)
#pragma unroll
                for (int m = 0; m < 4; ++m)
#pragma unroll
                    for (int n = 0; n < 2; ++n) acc[a][b][m][n] = (f32x4){0.f, 0.f, 0.f, 0.f};
        cur = nxt; cA = nA; cB = nB; ++ui;
        if constexpr (ALIGN_EPI) { if (wr == 1) PG8_BAR; }
    }
    PG8_WAIT_V(0);
    if constexpr (!ALIGN_EPI) { if (wr == 0) PG8_BAR; }
    PG8_BAR;
    if constexpr (Epi::AFTER_DRAIN) { E.fused(acc, cur, wr, wc, fr, fq, lds, wid, lane); S.done(cur); }
#undef PG8_SA
#undef PG8_SB
#undef PG8_STAGE
#undef PG8_LDA
#undef PG8_LDB
#undef PG8_MMA
#undef PG8_WAIT_V
#undef PG8_WAIT_L
#undef PG8_BAR
#undef PG8_SCHED
}

}

struct SchedGrid {
    int nM, nN, G, c, tag; const char* A; const char* B;
    __device__ __forceinline__ bool next(int i, pg8::Unit& u) const { const long L = (long)i * G + c; if (L >= (long)nM * nN) return false; pg8::order_map((int)L, nM, nN, u.pm, u.pn); u.tag = tag; u.A = A; u.B = B; return true; }
    __device__ __forceinline__ void a_ready(const pg8::Unit&) const {}
    __device__ __forceinline__ void done(const pg8::Unit&) const {}
};
struct SchedTwo {
    int nM0, nN0, nM1, nN1, G, c; const char *A0, *B0, *A1, *B1;
    __device__ __forceinline__ bool next(int i, pg8::Unit& u) const { long L = (long)i * G + c; const long n0 = (long)nM0 * nN0;
        if (L < n0) { pg8::order_map((int)L, nM0, nN0, u.pm, u.pn); u.tag = 0; u.A = A0; u.B = B0; return true; }
        L -= n0; if (L >= (long)nM1 * nN1) return false; pg8::order_map((int)L, nM1, nN1, u.pm, u.pn); u.tag = 1; u.A = A1; u.B = B1; return true; }
    __device__ __forceinline__ void a_ready(const pg8::Unit&) const {}
    __device__ __forceinline__ void done(const pg8::Unit&) const {}
};
struct SchedP4 {
    int nM, nN, G, c; const char* A0; size_t astride; const char* B0; size_t bstride;
    __device__ __forceinline__ bool next(int i, pg8::Unit& u) const { const int j = i % 3, b = (2 * j) % 3; const long L = (long)(i / 3) * G + c; if (L >= (long)nM * nN) return false;
        pg8::order_map((int)L, nM, nN, u.pm, u.pn); u.tag = b + (j > 0 ? 4 : 0); u.A = A0 + (size_t)j * astride; u.B = B0 + (size_t)b * bstride; return true; }
    __device__ __forceinline__ void a_ready(const pg8::Unit&) const {}
    __device__ __forceinline__ void done(const pg8::Unit&) const {}
};
constexpr int LDS_SCR = pg8::STAGE_BYTES, LDS_BYTES = 147456;
#define LASP __attribute__((address_space(3)))
enum { PK_P1 = 0, PK_P2 = 1, PK_P3 = 2, PK_P3B = 3, PK_P4 = 4, PK_P5 = 5 };
__device__ __forceinline__ void gemm_part(const Params& p, LASP unsigned char* lds, int kind, int l, int G, int c, int wid0) {
    constexpr int nR = R / 256;
    if (kind == PK_P1) {
        SchedTwo S{nR, N1 / 256, 2 * W / 256, nR, G, c, (const char*)p.XB(), (const char*)wptr(p, l, WL_W1), (const char*)wptr(p, l, WL_WV), (const char*)p.XB()};
        pg8::EpiAd<F1> E{F1{p, 0}}; pg8::gemm_phase<pg8::EpiAd<F1>, SchedTwo, true, true>(lds, pg8::Gemm{D, D, D}, S, E, wid0);
    } else if (kind == PK_P2) {
        { SchedGrid S{nR, QBW / 256, G, c, 0, (const char*)p.CQ(), (const char*)wptr(p, l, WL_UQ)};
          pg8::EpiAd<FUQ> E{FUQ{p, 0}}; pg8::gemm_phase<pg8::EpiAd<FUQ>, SchedGrid, true, true>(lds, pg8::Gemm{QR, QR, QR}, S, E, wid0); }
        { SchedTwo S{nR, W / 256, W / 256, nR, G, c, (const char*)p.CKV(), (const char*)wptr(p, l, WL_UK), (const char*)wptr(p, l, WL_UV), (const char*)p.CKV()};
          pg8::EpiAd<FUK> E{FUK{p, 0}}; pg8::gemm_phase<pg8::EpiAd<FUK>, SchedTwo, true, true>(lds, pg8::Gemm{KVR, KVR, KVR}, S, E, wid0); }
    } else if (kind == PK_P3B) {
        SchedGrid S{nR, N3 / 256, G, c, 0, (const char*)p.XB2(), (const char*)wptr(p, l, WL_W3)};
        pg8::EpiAd<F3> E{F3{p, l}}; pg8::gemm_phase<pg8::EpiAd<F3>, SchedGrid, true, true>(lds, pg8::Gemm{D, D, D}, S, E, wid0);
    } else if (kind == PK_P4) {
        SchedP4 S{nR, D / 256, G, c, (const char*)p.QSB(), (size_t)((const char*)p.QD() - (const char*)p.QSB()), (const char*)wptr(p, l, WL_WO), (size_t)D * W * 2};
        pg8::EpiAd<F4> E{F4{p, 0}}; pg8::gemm_phase<pg8::EpiAd<F4>, SchedP4, true, true>(lds, pg8::Gemm{W, W, W}, S, E, wid0);
    } else if (kind == PK_P5) {
        SchedGrid S{nR, D / 256, G, c, 0, (const char*)p.G0(), (const char*)wptr(p, l, WL_OUT)};
        pg8::EpiAd<F5> E{F5{p, l == DEPTH - 1 ? 1 : 0}}; pg8::gemm_phase<pg8::EpiAd<F5>, SchedGrid, true, true>(lds, pg8::Gemm{D, D, D}, S, E, wid0);
    }
}
template <int KIND> __global__ void __launch_bounds__(512, 2) k_gemm_fast(Params p, int l) {
    extern __shared__ __attribute__((aligned(16))) unsigned char lds_raw[];
    gemm_part(p, (LASP unsigned char*)lds_raw, KIND, l, (int)gridDim.x, (int)blockIdx.x, __builtin_amdgcn_readfirstlane((int)threadIdx.x >> 6));
}

namespace att {
typedef short bf16x8 __attribute__((ext_vector_type(8)));
typedef float f32x16 __attribute__((ext_vector_type(16)));
typedef unsigned u32x4v __attribute__((ext_vector_type(4)));
__device__ __forceinline__ int crow(int r, int h) { return (r & 3) + 8 * (r >> 2) + 4 * h; }
__device__ __forceinline__ bf16x8 ldg8(const bf16_t* p) { return *(const bf16x8*)p; }
__device__ __forceinline__ void halves(float x, float& lo, float& hi) { auto r = __builtin_amdgcn_permlane32_swap(__float_as_uint(x), __float_as_uint(x), false, false); lo = __uint_as_float(r[0]); hi = __uint_as_float(r[1]); }
__device__ __forceinline__ bf16x8 pack8(const f32x16& v, int b) { u32x4v w; w.x = pk2(v[b], v[b + 1]); w.y = pk2(v[b + 2], v[b + 3]); w.z = pk2(v[b + 4], v[b + 5]); w.w = pk2(v[b + 6], v[b + 7]); return __builtin_bit_cast(bf16x8, w); }
constexpr float SB_DEAD = -152.0f;
#define ATT_FENCE() asm volatile("" ::: "memory")
constexpr int RING_SLOTS = 4, RING_D = 3;
__device__ __forceinline__ void dma16(const void* gsrc, LASP unsigned char* ldst) { __builtin_amdgcn_global_load_lds((const unsigned*)gsrc, (LASP unsigned*)ldst, 16, 0, 0); }
template <int NQB, int NKS, int NKSA, int NDB, bool SBM>
__device__ __forceinline__ void tile_step(const LASP unsigned char* kimg, const LASP unsigned char* krimg, const LASP unsigned char* vimg, const bool first, const bool diag, const int qoff, const int cl, const int h,
                                          const bf16x8 (&qf)[NQB][NKS], f32x16 (&o)[NDB][NQB], float (&mrun)[NQB], float (&lrun)[NQB], float (&carry)[NQB]) {
#define ATT_LDK(dst, g_) do { _Pragma("unroll") for (int j_ = 0; j_ < 2; ++j_) { const int key_ = j_ * 32 + cla; \
        dst[j_] = (g_) < NKSA ? *(const LASP bf16x8*)(kimg + key_ * 128 + (((2 * (g_) + ha) ^ (cla & 7)) << 4)) : *(const LASP bf16x8*)(krimg + key_ * 64 + (((2 * ((g_) - NKSA) + ha) ^ ((cla >> 2) & 3)) << 4)); } } while (0)
#define ATT_LDV(dst, j_) do { _Pragma("unroll") for (int d_ = 0; d_ < NDB; ++d_) dst[d_] = *(const LASP bf16x8*)(vimg + (d_ * 32 + cla) * 128 + (((2 * (j_) + ha) ^ (cla & 7)) << 4)); } while (0)
    int cla = cl, ha = h; asm volatile("" : "+v"(cla), "+v"(ha));
    bf16x8 kf0[2], kf1[2], vf0[NDB], vf1[NDB];
    ATT_LDK(kf0, 0);
    f32x16 s[2][NQB];
#pragma unroll
    for (int kb = 0; kb < 2; ++kb)
#pragma unroll
        for (int qb = 0; qb < NQB; ++qb)
#pragma unroll
            for (int r = 0; r < 16; ++r) s[kb][qb][r] = 0.f;
#pragma unroll
    for (int g = 0; g < NKS; ++g) {
        if (g + 1 < NKS) { if (g & 1) ATT_LDK(kf0, g + 1); else ATT_LDK(kf1, g + 1); } else ATT_LDV(vf0, 0);
        ATT_FENCE();
#pragma unroll
        for (int j = 0; j < 2; ++j)
#pragma unroll
            for (int qb = 0; qb < NQB; ++qb) s[j][qb] = __builtin_amdgcn_mfma_f32_32x32x16_bf16((g & 1) ? kf1[j] : kf0[j], qf[qb][g], s[j][qb], 0, 0, 0);
    }
    if (!SBM) {
        if (first) {
#pragma unroll
            for (int qb = 0; qb < NQB; ++qb) {
#pragma unroll
                for (int r = 0; r < 16; ++r) s[0][qb][r] = -INFINITY;
#pragma unroll
                for (int r = 0; r < 8; ++r) s[1][qb][r] = -INFINITY; } }
#pragma unroll
        for (int qb = 0; qb < NQB; ++qb) {
            float mx = s[0][qb][0];
#pragma unroll
            for (int r = 1; r < 16; ++r) mx = fmaxf(mx, s[0][qb][r]);
#pragma unroll
            for (int r = 0; r < 16; ++r) mx = fmaxf(mx, s[1][qb][r]);
            float m0, m1; halves(mx, m0, m1); const float mn = fmaxf(mrun[qb], fmaxf(m0, m1)); const float f = __builtin_amdgcn_exp2f(mrun[qb] - mn); mrun[qb] = mn;
            float ps = 0.f;
#pragma unroll
            for (int kb = 0; kb < 2; ++kb)
#pragma unroll
                for (int r = 0; r < 16; ++r) { const float pv = __builtin_amdgcn_exp2f(s[kb][qb][r] - mn); s[kb][qb][r] = pv; ps += pv; }
            lrun[qb] = lrun[qb] * f + ps;
#pragma unroll
            for (int d = 0; d < NDB; ++d)
#pragma unroll
                for (int r = 0; r < 16; ++r) o[d][qb][r] *= f;
        }
    } else {
#pragma unroll
        for (int qb = 0; qb < NQB; ++qb) {
            float run = carry[qb];
#pragma unroll
            for (int kb = 1; kb >= 0; --kb)
#pragma unroll
                for (int rg = 3; rg >= 0; --rg) {
                    const bool lead = first && (kb == 0 || rg < 2);
                    float y[4], sp[4]; bool ok[4];
#pragma unroll
                    for (int e = 0; e < 4; ++e) { y[e] = s[kb][qb][4 * rg + e]; ok[e] = !lead && !(diag && (kb * 32 + 8 * rg + 4 * h + e >= qoff + qb * 32 + cl));
                        sp[e] = ok[e] ? fmaxf(y[e], 0.f) + __builtin_amdgcn_logf(1.0f + __builtin_amdgcn_exp2f(-fabsf(y[e]))) : 0.f; }
                    const float gs = -((sp[0] + sp[1]) + (sp[2] + sp[3])); float g0, g1; halves(gs, g0, g1);
                    const float t1 = run; run += g1; const float t0 = run; run += g0; float a = h ? t1 : t0;
#pragma unroll
                    for (int e = 3; e >= 0; --e) { const float w = ok[e] ? __builtin_amdgcn_exp2f((y[e] - sp[e]) + a) : 0.f; a -= sp[e]; s[kb][qb][4 * rg + e] = w; }
                    __builtin_amdgcn_sched_barrier(0); }
            carry[qb] = run;
        }
    }
    ATT_FENCE();
#pragma unroll
    for (int j = 0; j < 4; ++j) {
        if (j + 1 < 4) { if (j & 1) ATT_LDV(vf0, j + 1); else ATT_LDV(vf1, j + 1); }
        ATT_FENCE();
        bf16x8 pf[NQB];
#pragma unroll
        for (int qb = 0; qb < NQB; ++qb) pf[qb] = pack8(s[j >> 1][qb], 8 * (j & 1));
#pragma unroll
        for (int d = 0; d < NDB; ++d)
#pragma unroll
            for (int qb = 0; qb < NQB; ++qb) o[d][qb] = __builtin_amdgcn_mfma_f32_32x32x16_bf16((j & 1) ? vf1[d] : vf0[d], pf[qb], o[d][qb], 0, 0, 0);
    }
#undef ATT_LDK
#undef ATT_LDV
}
template <int NQB, int NDB> __device__ __forceinline__ void store_ot(bf16_t* optr, int ldo, const f32x16 (&o)[NDB][NQB], const float (&sc)[NQB]) {
    int lane_ = lane_id_v(); const int lane = lane_, cl = lane & 31, h = lane >> 5;
#pragma unroll
    for (int qb = 0; qb < NQB; ++qb)
#pragma unroll
        for (int d = 0; d < NDB; ++d)
#pragma unroll
            for (int rg = 0; rg < 4; ++rg) st4(optr + (size_t)(qb * 32 + cl) * ldo + d * 32 + 8 * rg + 4 * h, o[d][qb][4 * rg] * sc[qb], o[d][qb][4 * rg + 1] * sc[qb], o[d][qb][4 * rg + 2] * sc[qb], o[d][qb][4 * rg + 3] * sc[qb]);
}
#define ATT_WAIT(n) asm volatile("s_waitcnt vmcnt(" #n ") lgkmcnt(0)" ::: "memory")
#define ATT_BAR() do { __builtin_amdgcn_s_barrier(); asm volatile("" ::: "memory"); } while (0)
template <bool SBM> __device__ __forceinline__ void unit8(const Params& p, LASP unsigned char* lds, const int wid, const int b, const int h, const int c0, const int nq) {
    constexpr int NKS = SBM ? 4 : 6, NQB = SBM ? 1 : 2, SLOTB = 20480, OFF_V = 8192, OFF_KR = 16384;
    const int lane = lane_id_v(), cl = lane & 31, hh = lane >> 5; const size_t r0 = (size_t)b * TB;
    const int ti = SBM ? wid >> 1 : wid, qoff = SBM ? (wid & 1) * 32 : 0;
    const int qt = c0 + ti, nt = c0 + nq; const bool active = ti < nq;
    const int swz = ((lane & 7) ^ ((lane >> 3) & 7)) << 3;
    const bf16_t* kbase = (SBM ? p.KSB() : p.KNOPE()) + (r0 + wid * 8 + (lane >> 3)) * W + h * 64 + swz;
    const bf16_t* vbase = (SBM ? p.VSBT() : p.VBT()) + (size_t)(h * 64 + wid * 8 + (lane >> 3)) * R + r0 + swz;
    const bf16_t* krbase = p.KR() + (r0 + (wid & 3) * 16 + (lane >> 2)) * 32 + (((lane & 3) ^ ((lane >> 4) & 3)) << 3);
#define U8_ISSUE(t_) do { const int kt_ = SBM ? nt - 1 - (t_) : (t_); LASP unsigned char* sl_ = lds + ((t_) & (RING_SLOTS - 1)) * SLOTB; \
        dma16(kbase + (size_t)kt_ * 64 * W, sl_ + wid * 1024); dma16(vbase + kt_ * 64, sl_ + OFF_V + wid * 1024); \
        if (!SBM) dma16(krbase + (size_t)kt_ * 64 * 32, sl_ + OFF_KR + (wid & 3) * 1024); } while (0)
    bf16x8 qf[NQB][NKS]; f32x16 o[2][NQB]; float mrun[NQB], lrun[NQB], carry[NQB];
    { const bf16_t* qp = SBM ? p.QSB() + (r0 + (size_t)qt * 64 + qoff) * W + h * 64 : p.QB() + (r0 + (size_t)qt * 64) * QBW + h * 96; const int ldq = SBM ? W : QBW;
#pragma unroll
      for (int qb = 0; qb < NQB; ++qb)
#pragma unroll
          for (int ks = 0; ks < NKS; ++ks) { if (active) qf[qb][ks] = ldg8(qp + (size_t)(qb * 32 + cl) * ldq + 16 * ks + 8 * hh); else qf[qb][ks] = (bf16x8){0, 0, 0, 0, 0, 0, 0, 0}; } }
#pragma unroll
    for (int qb = 0; qb < NQB; ++qb) { mrun[qb] = -INFINITY; lrun[qb] = 0.f; carry[qb] = 0.f;
#pragma unroll
        for (int d = 0; d < 2; ++d)
#pragma unroll
            for (int r = 0; r < 16; ++r) o[d][qb][r] = 0.f; }
    volatile LASP unsigned* fl = (volatile LASP unsigned*)(lds + LDS_SCR + 3072);
    if (SBM && lane == 0) fl[8 + wid] = active ? 1u : 0u;
#pragma unroll
    for (int t = 0; t < RING_D; ++t) if (t < nt) U8_ISSUE(t);
    bool dead = !active;
    for (int it = 0; it < nt; ++it) {
        const int rem = nt - 1 - it;
        if (SBM) { if (rem >= 2) ATT_WAIT(4); else if (rem == 1) ATT_WAIT(2); else ATT_WAIT(0); }
        else     { if (rem >= 2) ATT_WAIT(6); else if (rem == 1) ATT_WAIT(3); else ATT_WAIT(0); }
        ATT_BAR();
        if (SBM) { const int pb = ((it + 1) & 1) * 8; const unsigned any = (fl[pb] | fl[pb + 1] | fl[pb + 2] | fl[pb + 3]) | (fl[pb + 4] | fl[pb + 5] | fl[pb + 6] | fl[pb + 7]); if (!any) break; }
        if (it + RING_D < nt) U8_ISSUE(it + RING_D);
        const int kt = SBM ? nt - 1 - it : it;
        if (!dead && kt <= qt) {
            const LASP unsigned char* sl = lds + (it & (RING_SLOTS - 1)) * SLOTB;
            tile_step<NQB, NKS, 4, 2, SBM>(sl, sl + OFF_KR, sl + OFF_V, kt == 0, kt == qt, qoff, cl, hh, qf, o, mrun, lrun, carry);
            if (SBM) { bool dd = true;
#pragma unroll
                for (int qb = 0; qb < NQB; ++qb) dd = dd && (carry[qb] < SB_DEAD);
                dead = __all(dd) != 0; }
        }
        if (SBM && lane == 0) fl[(it & 1) * 8 + wid] = (!dead && kt > 0) ? 1u : 0u;
    }
    if (active) {
        if (SBM) { float one[NQB];
#pragma unroll
            for (int qb = 0; qb < NQB; ++qb) one[qb] = 1.f;
            store_ot<NQB, 2>(p.QSB() + (r0 + (size_t)qt * 64 + qoff) * W + h * 64, W, o, one); }
        else { float il[NQB];
#pragma unroll
            for (int qb = 0; qb < NQB; ++qb) { float l0, l1; halves(lrun[qb], l0, l1); il[qb] = 1.0f / (l0 + l1); }
            store_ot<NQB, 2>(p.OMLA() + (r0 + (size_t)qt * 64) * W + h * 64, W, o, il); }
    }
    ATT_WAIT(0); ATT_BAR();
#undef U8_ISSUE
}
__device__ __forceinline__ void unit_diff(const Params& p, LASP unsigned char* lds, const int wid, const int layer, const int b, const int head, const int c0, const int nq) {
    constexpr int SLOTB = 32768, OFF_K1 = 8192, OFF_V = 16384;
    const int lane = lane_id_v(), cl = lane & 31, hh = lane >> 5, g = wid >> 2, mp = (wid >> 1) & 1, qh = wid & 1; const size_t r0 = (size_t)b * TB;
    const int qt = c0 + g, nt = c0 + nq; const bool active = g < nq;
    const int swz = ((lane & 7) ^ ((lane >> 3) & 7)) << 3;
    const bf16_t* kbase = p.KD() + (r0 + wid * 8 + (lane >> 3)) * W + head * 128 + swz;
    const bf16_t* vbase = p.VDT() + (size_t)(head * 128 + wid * 8 + (lane >> 3)) * R + r0 + swz;
#define UD_ISSUE(t_) do { const int kt_ = (t_); LASP unsigned char* sl_ = lds + ((t_) & (RING_SLOTS - 1)) * SLOTB; \
        dma16(kbase + (size_t)kt_ * 64 * W, sl_ + wid * 1024); dma16(kbase + (size_t)kt_ * 64 * W + 64, sl_ + OFF_K1 + wid * 1024); \
        dma16(vbase + kt_ * 64, sl_ + OFF_V + wid * 1024); dma16(vbase + (size_t)64 * R + kt_ * 64, sl_ + OFF_V + (wid + 8) * 1024); } while (0)
    bf16x8 qf[1][4]; f32x16 o[4][1]; float mrun[1], lrun[1], carry[1];
    { const bf16_t* qp = p.QD() + (r0 + (size_t)qt * 64 + qh * 32) * W + head * 128 + mp * 64;
#pragma unroll
      for (int ks = 0; ks < 4; ++ks) { if (active) qf[0][ks] = ldg8(qp + (size_t)cl * W + 16 * ks + 8 * hh); else qf[0][ks] = (bf16x8){0, 0, 0, 0, 0, 0, 0, 0}; } }
    mrun[0] = -INFINITY; lrun[0] = 0.f; carry[0] = 0.f;
#pragma unroll
    for (int d = 0; d < 4; ++d)
#pragma unroll
        for (int r = 0; r < 16; ++r) o[d][0][r] = 0.f;
#pragma unroll
    for (int t = 0; t < RING_D; ++t) if (t < nt) UD_ISSUE(t);
    for (int it = 0; it < nt; ++it) {
        const int rem = nt - 1 - it;
        if (rem >= 2) ATT_WAIT(8); else if (rem == 1) ATT_WAIT(4); else ATT_WAIT(0);
        ATT_BAR();
        if (it + RING_D < nt) UD_ISSUE(it + RING_D);
        if (active && it <= qt) { const LASP unsigned char* sl = lds + (it & (RING_SLOTS - 1)) * SLOTB;
            tile_step<1, 4, 4, 4, false>(sl + mp * OFF_K1, sl, sl + OFF_V, it == 0, false, 0, cl, hh, qf, o, mrun, lrun, carry); }
    }
    ATT_WAIT(0); ATT_BAR();
    if (active) { float l0, l1; halves(lrun[0], l0, l1); const float il = 1.0f / (l0 + l1);
        LASP float* reg = (LASP float*)(lds + wid * 16384);
#pragma unroll
        for (int d = 0; d < 4; ++d)
#pragma unroll
            for (int r = 0; r < 16; ++r) reg[cl * 128 + ((d * 32 + crow(r, hh)) ^ cl)] = o[d][0][r] * il; }
    ATT_WAIT(0); ATT_BAR();
    if (active) { const float lam = p.lamv()[layer], lam_init = __uint_as_float(__builtin_amdgcn_readfirstlane(layer == 0 ? 0x3e4ccccdu : 0x3eb60549u));
      const LASP float* r0p = (const LASP float*)(lds + ((g * 2 + 0) * 2 + qh) * 16384); const LASP float* r1p = (const LASP float*)(lds + ((g * 2 + 1) * 2 + qh) * 16384);
      const int ql = mp * 16 + (lane >> 2), part = lane & 3; float v[32]; float ss = 0.f;
#pragma unroll
      for (int i = 0; i < 32; ++i) { const int ii = (i + 8 * part) & 31; const int a = ql * 128 + ((part * 32 + ii) ^ ql); v[i] = r0p[a] - lam * r1p[a]; ss += v[i] * v[i]; }
      ss = quad4_sum(ss);
      const float rs = rsq(ss * (1.0f / 128.0f) + EPS) * (1.0f - lam_init); const float* gn = p.dnorm_g + (size_t)layer * 128 + part * 32;
      bf16_t* op = p.QD() + (r0 + (size_t)qt * 64 + qh * 32 + ql) * W + head * 128 + part * 32;
#pragma unroll
      for (int i = 0; i < 32; i += 2) { const int ii = (i + 8 * part) & 31;
          st2(op + ii, v[i] * rs * gn[ii], v[i + 1] * rs * gn[ii + 1]); } }
    ATT_WAIT(0); ATT_BAR();
#undef UD_ISSUE
}
enum { AK_P2 = 0, AK_P3 = 1 };
__device__ __forceinline__ void attn_part(const Params& p, LASP unsigned char* lds, int kind, int layer, int wid, int rep = 0) {
    const bool leader = wid == 0 && lane_id_v() == 0;
    volatile LASP int* slot = (volatile LASP int*)(lds + LDS_SCR + 2048);
    unsigned* ctr = p.ctl() + 1024 + 64 * (layer * 2 + kind + 4 * rep);
    constexpr int NT = TB / 64;
    static_assert((NT - 1) % 8 == 0, "query tile grouping");
    constexpr int NG8 = (NT - 1) / 8 + 1, NG4 = (NT - 1) / 4 + 1, NGD = (NT - 1) / 2 + 1;
    constexpr int N8 = NB * NH * NG8, N4 = NB * NH * NG4, ND = NB * NHD * NGD;
    const int nitems = kind == AK_P2 ? ND + N4 : N8;
    for (int n = 0;; ++n) {
        if (leader) slot[n & 1] = (int)atomicAdd(ctr, 1u);
        asm volatile("s_waitcnt vmcnt(0) lgkmcnt(0)" ::: "memory"); __builtin_amdgcn_s_barrier(); asm volatile("" ::: "memory");
        int item = __builtin_amdgcn_readfirstlane(slot[n & 1]);
        if (item >= nitems) break;
        if (kind == AK_P2) {
            if (item < ND) { const int u = item / (NB * NHD), j = item % (NB * NHD); const bool single = u == NGD - 1;
                unit_diff(p, lds, wid, layer, j / NHD, j % NHD, single ? 0 : NT - 2 - 2 * u, single ? 1 : 2); }
            else { item -= ND; const int u = item / (NB * NH), j = item % (NB * NH); const bool single = u == NG4 - 1;
                unit8<true>(p, lds, wid, j / NH, j % NH, single ? 0 : NT - 4 - 4 * u, single ? 1 : 4); }
        } else { const int u = item / (NB * NH), j = item % (NB * NH); const bool single = u == NG8 - 1;
            unit8<false>(p, lds, wid, j / NH, j % NH, single ? 0 : NT - 8 - 8 * u, single ? 1 : 8); }
    }
}
}
template <int KIND> __global__ void __launch_bounds__(512, 2) k_attn_fast(Params p, int l) {
    extern __shared__ __attribute__((aligned(16))) unsigned char lds_raw[];
    att::attn_part(p, (LASP unsigned char*)lds_raw, KIND, l, __builtin_amdgcn_readfirstlane((int)threadIdx.x >> 6));
}

#define XB_TMO      128
#define XB_XCNT(j)  (256  + 64 * (j))
#define XB_XSUB(j)  (1280 + 64 * (j))
#define XB_XGEN(j)  (2304 + 64 * (j))
#define XB_TOP      3328
#define XB_TOPGEN   3392
#define XCD_BAR_WORDS 3456
#define XB_SPIN_CAP (1u << 18)
__device__ __forceinline__ unsigned xb_ld(unsigned* p)              { return __hip_atomic_load(p, __ATOMIC_RELAXED, __HIP_MEMORY_SCOPE_AGENT); }
__device__ __forceinline__ unsigned xb_add(unsigned* p, unsigned v) { return __hip_atomic_fetch_add(p, v, __ATOMIC_RELAXED, __HIP_MEMORY_SCOPE_AGENT); }
__device__ __forceinline__ unsigned xb_xcc_id() { return (unsigned)__builtin_amdgcn_s_getreg((3 << 11) | 20) & 0xFu; }
#define XB_SPIN(cond, bar) do { unsigned _sp = 0; while (cond) { __builtin_amdgcn_s_sleep(1); \
    if ((++_sp & 255u) == 0u) { if (xb_ld(&(bar)[XB_TMO])) break; if (_sp > XB_SPIN_CAP) { atomicAdd(&(bar)[XB_TMO], 1u); break; } } } } while (0)
struct XcdBarrier { unsigned* bar; unsigned x; volatile LASP unsigned* st; };
__device__ __forceinline__ XcdBarrier xcd_barrier_post(unsigned* bar, volatile LASP unsigned* st, bool leader) {
    XcdBarrier b; b.bar = bar; b.x = xb_xcc_id(); b.st = st;
    if (leader) (void)xb_add(&bar[XB_XCNT(b.x)], 1u);
    return b;
}
__device__ __forceinline__ void xcd_barrier_complete(unsigned* bar, unsigned x, unsigned& nloc, unsigned& nx) {
    const unsigned G = gridDim.x * gridDim.y * gridDim.z;
    unsigned sum, cnt, mine, sp = 0u;
    for (;;) {
        sum = 0u; cnt = 0u; mine = 0u;
#pragma unroll
        for (unsigned j = 0; j < 16; ++j) { const unsigned c = xb_ld(&bar[XB_XCNT(j)]); sum += c; cnt += (c > 0u) ? 1u : 0u; mine = (j == x) ? c : mine; }
        if (sum == G) break;
        __builtin_amdgcn_s_sleep(1);
        if ((++sp & 255u) == 0u) { if (xb_ld(&bar[XB_TMO])) break; if (sp > XB_SPIN_CAP) { atomicAdd(&bar[XB_TMO], 1u); break; } }
    }
    nloc = mine > 0u ? mine : 1u; nx = cnt > 0u ? cnt : 1u;
}
__device__ __forceinline__ void xcd_barrier(const XcdBarrier& b, const int wid0) {
    const bool leader = wid0 == 0 && lane_id_v() == 0;
    asm volatile("s_waitcnt vmcnt(0)" ::: "memory");
    __syncthreads();
    if (leader) {
        unsigned* bar = b.bar;
        __builtin_amdgcn_s_waitcnt(0);
        unsigned nloc = b.st[0], nx = b.st[1];
        if (nloc == 0u) { xcd_barrier_complete(bar, b.x, nloc, nx); b.st[0] = nloc; b.st[1] = nx; }
        const unsigned old = xb_add(&bar[XB_XSUB(b.x)], 1u);
        const unsigned gen = old / nloc;
        if (old + 1u == (gen + 1u) * nloc) {
            __builtin_amdgcn_fence(__ATOMIC_RELEASE, "agent");
            asm volatile("s_waitcnt vmcnt(0)" ::: "memory");
            const unsigned og = xb_add(&bar[XB_TOP], 1u);
            const unsigned tg = og / nx;
            if (og + 1u == (tg + 1u) * nx) xb_add(&bar[XB_TOPGEN], 1u);
            else XB_SPIN(xb_ld(&bar[XB_TOPGEN]) == tg, bar);
            __builtin_amdgcn_fence(__ATOMIC_ACQUIRE, "agent");
            xb_add(&bar[XB_XGEN(b.x)], 1u);
            asm volatile("s_waitcnt vmcnt(0)" ::: "memory");
        } else {
            XB_SPIN(xb_ld(&bar[XB_XGEN(b.x)]) == gen, bar);
            __builtin_amdgcn_fence(__ATOMIC_ACQUIRE, "agent");
            asm volatile("s_waitcnt vmcnt(0)" ::: "memory");
        }
    }
    __syncthreads();
}

typedef float f32x4v __attribute__((ext_vector_type(4)));
typedef unsigned u32x4w __attribute__((ext_vector_type(4)));
__device__ __forceinline__ float rope_inv(int e, int dim) { return exp2f(-(float)e / (float)dim * 18.931568569324174f); }
__device__ __forceinline__ void rope_cs(float ang, float& cs, float& sn) { const double t = (double)ang * 0.15915494309189535; const float a = (float)((t - rint(t)) * 6.283185307179586); cs = cosf(a); sn = sinf(a); }
template <int MAP> __device__ __forceinline__ void prep_item(const float* src, int src_ld, const float* rowscale, bf16_t* dst, int N, int K, int item, int lane, LASP float* scr) {
    const int nblk = N / 32, kb = item / nblk, nb = item % nblk, k0 = 64 * kb, n0 = 32 * nb, nl = n0 + (lane & 31);
    int sc; if (MAP == 0) sc = src_w1(nl); else if (MAP == 1) sc = src_wv(nl); else if (MAP == 2) sc = src_w3(nl); else if (MAP == 3) sc = src_uq(nl); else if (MAP == 4) sc = src_uk(nl); else if (MAP == 5) sc = src_uv(nl); else sc = nl;
#pragma unroll 8
    for (int i = 0; i < 32; ++i) { const int kk = 2 * i + (lane >> 5); float v = 0.f; if (sc >= 0) v = src[(size_t)(k0 + kk) * src_ld + sc] * (rowscale ? rowscale[k0 + kk] : 1.f); scr[kk * 33 + (lane & 31)] = v; }
    asm volatile("s_waitcnt lgkmcnt(0)" ::: "memory");
    const int c = lane & 7;
#pragma unroll
    for (int j = 0; j < 4; ++j) { const int n = (lane >> 3) + 8 * j; const LASP float* t = scr + (8 * c) * 33 + n;
        u32x4w o; o.x = pk2(t[0 * 33], t[1 * 33]); o.y = pk2(t[2 * 33], t[3 * 33]); o.z = pk2(t[4 * 33], t[5 * 33]); o.w = pk2(t[6 * 33], t[7 * 33]);
        *(u32x4w*)(dst + (size_t)(n0 + n) * K + k0 + 8 * c) = o; }
    asm volatile("s_waitcnt lgkmcnt(0)" ::: "memory");
}
__device__ __forceinline__ void prologue_part(const Params& p, LASP unsigned char* lds, int G, int c, int wave) {
    int lane_ = lane_id_v(); const int lane = lane_;
    const int gw = c * 8 + wave, NGW = G * 8;
    for (int i = gw * 64 + lane; i < NPOS * 16; i += NGW * 64) {
        { const int pos = i / 16, j = i % 16; const float ang = (float)pos * rope_inv(2 * j, 32); float cs, sn; rope_cs(ang, cs, sn); p.cosm()[i] = cs; p.sinm()[i] = sn; }
        if (i < NPOS * 8) { const int pos = i / 8, j = i % 8; const float ang = (float)pos * rope_inv(2 * j, 16); float cs, sn; rope_cs(ang, cs, sn); p.cosd()[i] = cs; p.sind()[i] = sn; }
        if (i < DEPTH) { const float* lm = p.dlam + i * 4 * 64; float s0 = 0.f, s1 = 0.f; for (int d = 0; d < 64; ++d) { s0 += lm[d] * lm[64 + d]; s1 += lm[128 + d] * lm[192 + d]; }
            p.lamv()[i] = expf(s0) - expf(s1) + (i == 0 ? 0.2f : 0.35550906759f); }
    }
    LASP float* scr = (LASP float*)(lds + wave * 16384);
    constexpr int I_W1 = (D / 64) * (N1 / 32), I_WV = (D / 64) * (2 * W / 32), I_W3 = (D / 64) * (N3 / 32), I_UQ = (QR / 64) * (QBW / 32), I_UK = (KVR / 64) * (W / 32), I_WO = (W / 64) * (D / 32), I_OUT = (D / 64) * (D / 32);
    constexpr int I_L = I_W1 + I_WV + I_W3 + I_UQ + 2 * I_UK + 3 * I_WO + I_OUT;
    for (int it = gw; it < 2 * I_L; it += NGW) {
        const int l = it / I_L; int r = it % I_L;
        const float* win = p.w_in + (size_t)l * D * INC; const float* ng = p.norm_g + l * D;
        if (r < I_W1) { prep_item<0>(win, INC, ng, wptr(p, l, WL_W1), N1, D, r, lane, scr); continue; } r -= I_W1;
        if (r < I_WV) { prep_item<1>(win, INC, ng, wptr(p, l, WL_WV), 2 * W, D, r, lane, scr); continue; } r -= I_WV;
        if (r < I_W3) { prep_item<2>(win, INC, ng, wptr(p, l, WL_W3), N3, D, r, lane, scr); continue; } r -= I_W3;
        if (r < I_UQ) { prep_item<3>(p.w_uq + (size_t)l * QR * QBW, QBW, p.cq_g + l * QR, wptr(p, l, WL_UQ), QBW, QR, r, lane, scr); continue; } r -= I_UQ;
        if (r < I_UK) { prep_item<4>(p.w_ukv + (size_t)l * KVR * NH * 128, NH * 128, p.ckv_g + l * KVR, wptr(p, l, WL_UK), W, KVR, r, lane, scr); continue; } r -= I_UK;
        if (r < I_UK) { prep_item<5>(p.w_ukv + (size_t)l * KVR * NH * 128, NH * 128, p.ckv_g + l * KVR, wptr(p, l, WL_UV), W, KVR, r, lane, scr); continue; } r -= I_UK;
        if (r < 3 * I_WO) { const int b = r / I_WO; const float* const w0 = opq(p.w_osb); const float* const w1 = opq(p.w_omla); const float* const w2 = opq(p.w_odiff); const float* wo = (b == 0 ? w0 : b == 1 ? w1 : w2) + (size_t)l * W * D;
            prep_item<6>(wo, D, nullptr, wptr(p, l, WL_WO) + (size_t)b * D * W, D, W, r % I_WO, lane, scr); continue; } r -= 3 * I_WO;
        prep_item<6>(p.w_out + (size_t)l * D * D, D, nullptr, wptr(p, l, WL_OUT), D, D, r, lane, scr);
    }
    for (int row = gw; row < R; row += NGW) {
        const int b = row / TB, t = row % TB; f32x4v v[D / 256]; float ss = 0.f;
#pragma unroll
        for (int j = 0; j < D / 256; ++j) { const int col = 256 * j + 4 * lane;
            if (t < LEAD) v[j] = (f32x4v){0.f, 0.f, 0.f, 0.f}; else if (t < LEAD + NMETA) v[j] = *(const f32x4v*)(p.meta + (size_t)(t - LEAD) * D + col); else v[j] = *(const f32x4v*)(p.x + ((size_t)b * SEQ + (t - LEAD - NMETA)) * D + col);
            ss += (v[j].x * v[j].x + v[j].y * v[j].y) + (v[j].z * v[j].z + v[j].w * v[j].w); }
        ss = wave_sum(ss);
#pragma unroll
        for (int j = 0; j < D / 256; ++j) { const int col = 256 * j + 4 * lane; *(f32x4v*)(p.X() + (size_t)row * D + col) = v[j]; st4(p.XB() + (size_t)row * D + col, v[j].x, v[j].y, v[j].z, v[j].w); }
        if (lane < NSX) p.ssx()[(size_t)row * NSX + lane] = lane == 0 ? ss : 0.f;
    }
}
__device__ __forceinline__ void x2bf_part(const Params& p, int G, int c, int wave) {
    int lane_ = lane_id_v(); const int lane = lane_;
    for (int row = c * 8 + wave; row < R; row += G * 8) {
#pragma unroll
        for (int j = 0; j < D / 256; ++j) { const int col = 256 * j + 4 * lane; const f32x4v v = *(const f32x4v*)(p.X() + (size_t)row * D + col); st4(p.XB2() + (size_t)row * D + col, v.x, v.y, v.z, v.w); } }
}
__device__ __forceinline__ void final_part(const Params& p, int G, int c, int wave) {
    int lane_ = lane_id_v(); const int lane = lane_;
    for (int i = c * 8 + wave; i < NB * SEQ; i += G * 8) {
        const int b = i / SEQ, sq = i % SEQ; const float* x = p.X() + ((size_t)b * TB + LEAD + NMETA + sq) * D; f32x4v v[D / 256]; float ss = 0.f;
#pragma unroll
        for (int j = 0; j < D / 256; ++j) { v[j] = *(const f32x4v*)(x + 256 * j + 4 * lane); ss += (v[j].x * v[j].x + v[j].y * v[j].y) + (v[j].z * v[j].z + v[j].w * v[j].w); }
        const float rs = rsq(wave_sum(ss) * (1.0f / D) + EPS);
#pragma unroll
        for (int j = 0; j < D / 256; ++j) { const f32x4v g = *(const f32x4v*)(p.final_g + 256 * j + 4 * lane); *(f32x4v*)(p.out + (size_t)i * D + 256 * j + 4 * lane) = v[j] * rs * g; }
    }
}
constexpr int N_PHASES = 2 + 6 * DEPTH;
constexpr int CW_QUEUE = 1024, CW_BAR = 4096;
#define MK_SEAM(k) do { if ((k) + 1 < ph_hi) xcd_barrier(bar, wid0); } while (0)
#define MK_IN(k) (ph_lo <= (k) && (k) < ph_hi)
#ifndef PROBE_DUP
#define PROBE_DUP 0
#endif
template <int L> __device__ __forceinline__ void layer_phases(const Params& p, LASP unsigned char* lds, const XcdBarrier& bar, int ph_lo, int ph_hi, int G, int c, int wid0) {
    constexpr int B0 = 1 + 6 * L;
    if (MK_IN(B0 + 0)) { gemm_part(p, lds, PK_P1, L, G, c, wid0); if (PROBE_DUP & 2) gemm_part(p, lds, PK_P1, L, G, c, wid0); MK_SEAM(B0 + 0); }
    if (MK_IN(B0 + 1)) { gemm_part(p, lds, PK_P2, L, G, c, wid0); att::attn_part(p, lds, att::AK_P2, L, wid0); MK_SEAM(B0 + 1); }
    if (MK_IN(B0 + 2)) { x2bf_part(p, G, c, wid0); att::attn_part(p, lds, att::AK_P3, L, wid0); if (PROBE_DUP & 4) { x2bf_part(p, G, c, wid0); att::attn_part(p, lds, att::AK_P3, L, wid0, 1); } MK_SEAM(B0 + 2); }
    if (MK_IN(B0 + 3)) { gemm_part(p, lds, PK_P3B, L, G, c, wid0); MK_SEAM(B0 + 3); }
    if (MK_IN(B0 + 4)) { gemm_part(p, lds, PK_P4, L, G, c, wid0); if (PROBE_DUP & 8) gemm_part(p, lds, PK_P4, L, G, c, wid0); MK_SEAM(B0 + 4); }
    if (MK_IN(B0 + 5)) { gemm_part(p, lds, PK_P5, L, G, c, wid0); MK_SEAM(B0 + 5); }
}
__global__ void __launch_bounds__(512, 2) mk_fwd(Params p, int ph_lo, int ph_hi) {
    extern __shared__ __attribute__((aligned(16))) unsigned char lds_raw[];
    LASP unsigned char* lds = (LASP unsigned char*)lds_raw;
    volatile LASP unsigned* misc = (volatile LASP unsigned*)(lds + LDS_SCR + 4096);
    const int wid0 = __builtin_amdgcn_readfirstlane((int)threadIdx.x >> 6);
    if (threadIdx.x < 64) misc[threadIdx.x] = 0u;
    __syncthreads();
    const int G = (int)gridDim.x, c = (int)blockIdx.x;
    const XcdBarrier bar = xcd_barrier_post(p.ctl() + CW_BAR, misc + 8, threadIdx.x == 0);
    if (MK_IN(0)) { prologue_part(p, lds, G, c, wid0); if (PROBE_DUP & 1) prologue_part(p, lds, G, c, wid0); MK_SEAM(0); }
    layer_phases<0>(p, lds, bar, ph_lo, ph_hi, G, c, wid0);
    layer_phases<1>(p, lds, bar, ph_lo, ph_hi, G, c, wid0);
    if (MK_IN(N_PHASES - 1)) { final_part(p, G, c, wid0); if (PROBE_DUP & 1) final_part(p, G, c, wid0); }
}
#endif

#ifdef HOST_EMU
typedef int hipStream_t;
#endif
#define NBLK(n, t) (((long)(n) + (t) - 1) / (t))
#ifndef HOST_EMU
#ifndef MK_SPLIT
#define MK_SPLIT 0
#endif
extern "C" void kernel_launch(void* const* d_in, const int* in_sizes, int n_in, void* d_out, int out_size, void* d_ws, size_t ws_size, hipStream_t stream) {
    if (n_in != 16 || in_sizes[0] != NB * SEQ * D || out_size != NB * SEQ * D || ws_size < WS_NEED) { fprintf(stderr, "kernel_launch: unexpected shapes / workspace (%d inputs, ws %zu, need %zu)\n", n_in, ws_size, (size_t)WS_NEED); return; }
    static int grid = 0;
    if (grid == 0) { int dev = 0, cus = 0; (void)hipGetDevice(&dev); (void)hipDeviceGetAttribute(&cus, hipDeviceAttributeMultiprocessorCount, dev); grid = cus > 0 ? cus : 256;
        if (hipFuncSetAttribute((const void*)mk_fwd, hipFuncAttributeMaxDynamicSharedMemorySize, LDS_BYTES) != hipSuccess) { fprintf(stderr, "kernel_launch: hipFuncSetAttribute failed\n"); grid = -1; } }
    if (grid < 0) return;
    const Params p = make_params(d_in, d_out, d_ws);
    (void)hipMemsetAsync((char*)d_ws + O_CTL, 0, 65536, stream);
#if MK_SPLIT
    for (int ph = 0; ph < N_PHASES; ++ph) hipLaunchKernelGGL(mk_fwd, dim3(grid), dim3(512), LDS_BYTES, stream, p, ph, ph + 1);
#else
    hipLaunchKernelGGL(mk_fwd, dim3(grid), dim3(512), LDS_BYTES, stream, p, 0, N_PHASES);
#endif
}
#else
extern "C" void kernel_launch(void* const* d_in, const int* in_sizes, int n_in, void* d_out, int out_size, void* d_ws, size_t ws_size, hipStream_t stream) {
    if (n_in != 16 || in_sizes[0] != NB * SEQ * D || out_size != NB * SEQ * D || ws_size < WS_NEED) { fprintf(stderr, "kernel_launch: unexpected shapes / workspace (%d inputs, ws %zu, need %zu)\n", n_in, ws_size, (size_t)WS_NEED); return; }
    const Params p = make_params(d_in, d_out, d_ws);
    const int T = 256;
#if 0
        (void)hipFuncSetAttribute((const void*)k_gemm_fast<PK_P1>, hipFuncAttributeMaxDynamicSharedMemorySize, LDS_BYTES); hipFuncSetAttribute((const void*)k_gemm_fast<PK_P2>, hipFuncAttributeMaxDynamicSharedMemorySize, LDS_BYTES);
        hipFuncSetAttribute((const void*)k_gemm_fast<PK_P3B>, hipFuncAttributeMaxDynamicSharedMemorySize, LDS_BYTES); hipFuncSetAttribute((const void*)k_gemm_fast<PK_P4>, hipFuncAttributeMaxDynamicSharedMemorySize, LDS_BYTES);
        hipFuncSetAttribute((const void*)k_gemm_fast<PK_P5>, hipFuncAttributeMaxDynamicSharedMemorySize, LDS_BYTES);
        hipFuncSetAttribute((const void*)k_attn_fast<att::AK_P2>, hipFuncAttributeMaxDynamicSharedMemorySize, LDS_BYTES); hipFuncSetAttribute((const void*)k_attn_fast<att::AK_P3>, hipFuncAttributeMaxDynamicSharedMemorySize, LDS_BYTES); }
    (void)hipMemsetAsync((char*)d_ws + O_CTL, 0, 65536, stream);
#endif
    LAUNCH(k_tables, NBLK(NPOS * 16, T), T, p);
    for (int l = 0; l < DEPTH; ++l) {
        LAUNCH(k_prep_w<0>, NBLK((long)N1 * D, T), T, wptr(p, l, WL_W1), N1, D, p.w_in + (size_t)l * D * INC, INC, p.norm_g + l * D);
        LAUNCH(k_prep_w<1>, NBLK((long)2 * W * D, T), T, wptr(p, l, WL_WV), 2 * W, D, p.w_in + (size_t)l * D * INC, INC, p.norm_g + l * D);
        LAUNCH(k_prep_w<2>, NBLK((long)N3 * D, T), T, wptr(p, l, WL_W3), N3, D, p.w_in + (size_t)l * D * INC, INC, p.norm_g + l * D);
        LAUNCH(k_prep_w<3>, NBLK((long)QBW * QR, T), T, wptr(p, l, WL_UQ), QBW, QR, p.w_uq + (size_t)l * QR * QBW, QBW, p.cq_g + l * QR);
        LAUNCH(k_prep_w<4>, NBLK((long)W * KVR, T), T, wptr(p, l, WL_UK), W, KVR, p.w_ukv + (size_t)l * KVR * NH * 128, NH * 128, p.ckv_g + l * KVR);
        LAUNCH(k_prep_w<5>, NBLK((long)W * KVR, T), T, wptr(p, l, WL_UV), W, KVR, p.w_ukv + (size_t)l * KVR * NH * 128, NH * 128, p.ckv_g + l * KVR);
        LAUNCH(k_prep_w<6>, NBLK((long)D * W, T), T, wptr(p, l, WL_WO), D, W, p.w_osb + (size_t)l * W * D, D, (const float*)nullptr);
        LAUNCH(k_prep_w<6>, NBLK((long)D * W, T), T, wptr(p, l, WL_WO) + (size_t)D * W, D, W, p.w_omla + (size_t)l * W * D, D, (const float*)nullptr);
        LAUNCH(k_prep_w<6>, NBLK((long)D * W, T), T, wptr(p, l, WL_WO) + (size_t)2 * D * W, D, W, p.w_odiff + (size_t)l * W * D, D, (const float*)nullptr);
        LAUNCH(k_prep_w<6>, NBLK((long)D * D, T), T, wptr(p, l, WL_OUT), D, D, p.w_out + (size_t)l * D * D, D, (const float*)nullptr);
    }
    LAUNCH(k_init_x, NBLK((long)R * D, T), T, p);
    LAUNCH(k_ssq_f32, NBLK(R, 64), 64, (const float*)p.X(), D, p.ssx(), NSX);
    for (int l = 0; l < DEPTH; ++l) {
        const int last = (l == DEPTH - 1) ? 1 : 0; (void)last;
#ifndef HOST_EMU
        FASTG(PK_P1, l);
        FASTG(PK_P2, l);
#else
        LAUNCH(k_gemm<F1>, NBLK((long)R * (V1_END / 8), T), T, (const bf16_t*)p.XB(), D, (const bf16_t*)wptr(p, l, WL_W1), D, R, V1_END, D, p, 0, 0);
        LAUNCH(k_gemm<F1>, NBLK((long)2 * W * (R / 8), T), T, (const bf16_t*)wptr(p, l, WL_WV), D, (const bf16_t*)p.XB(), D, 2 * W, R, D, p, 0, 1);
        LAUNCH(k_ssq_bf, NBLK(R, 64), 64, (const bf16_t*)p.CQ(), QR, p.ssq(), NSQ);
        LAUNCH(k_ssq_bf, NBLK(R, 64), 64, (const bf16_t*)p.CKV(), KVR, p.ssk(), NSK);
        LAUNCH(k_gemm<FUQ>, NBLK((long)R * (QBW / 8), T), T, (const bf16_t*)p.CQ(), QR, (const bf16_t*)wptr(p, l, WL_UQ), QR, R, QBW, QR, p, 0, 0);
        LAUNCH(k_gemm<FUK>, NBLK((long)R * (W / 8), T), T, (const bf16_t*)p.CKV(), KVR, (const bf16_t*)wptr(p, l, WL_UK), KVR, R, W, KVR, p, 0, 0);
        LAUNCH(k_gemm<FUK>, NBLK((long)W * (R / 8), T), T, (const bf16_t*)wptr(p, l, WL_UV), KVR, (const bf16_t*)p.CKV(), KVR, W, R, KVR, p, 0, 1);
#endif
#ifndef HOST_EMU
        hipLaunchKernelGGL(k_attn_fast<att::AK_P2>, dim3(grid), dim3(512), LDS_BYTES, stream, p, l);
        hipLaunchKernelGGL(k_attn_fast<att::AK_P3>, dim3(grid), dim3(512), LDS_BYTES, stream, p, l);
#else
        LAUNCH(k_attn_sb, NBLK((long)NB * NH * TB, 64), 64, p);
        LAUNCH(k_attn_diff, NBLK((long)NB * NHD * TB, 64), 64, p, l);
        LAUNCH(k_attn_mla, NBLK((long)NB * NH * TB, 64), 64, p);
#endif
        LAUNCH(k_x2bf, NBLK((long)R * D, T), T, p);
#ifndef HOST_EMU
        FASTG(PK_P3B, l); FASTG(PK_P4, l); FASTG(PK_P5, l);
#else
        LAUNCH(k_gemm<F3>, NBLK((long)R * (N3 / 8), T), T, (const bf16_t*)p.XB2(), D, (const bf16_t*)wptr(p, l, WL_W3), D, R, N3, D, p, l, 0);
        LAUNCH(k_gemm<F4>, NBLK((long)R * (D / 8), T), T, (const bf16_t*)p.QSB(), W, (const bf16_t*)wptr(p, l, WL_WO), W, R, D, W, p, 0, 0);
        LAUNCH(k_gemm<F4>, NBLK((long)R * (D / 8), T), T, (const bf16_t*)p.OMLA(), W, (const bf16_t*)(wptr(p, l, WL_WO) + (size_t)D * W), W, R, D, W, p, 0, 5);
        LAUNCH(k_gemm<F4>, NBLK((long)R * (D / 8), T), T, (const bf16_t*)p.QD(), W, (const bf16_t*)(wptr(p, l, WL_WO) + (size_t)2 * D * W), W, R, D, W, p, 0, 6);
        LAUNCH(k_gemm<F5>, NBLK((long)R * (D / 8), T), T, (const bf16_t*)p.G0(), D, (const bf16_t*)wptr(p, l, WL_OUT), D, R, D, D, p, last, 0);
        if (!last) LAUNCH(k_ssq_f32, NBLK(R, 64), 64, (const float*)p.X(), D, p.ssx(), NSX);
#endif
    }
    LAUNCH(k_final, NBLK((long)NB * SEQ, 64), 64, p);
}
#endif
```

```cpp
#ifndef HOST_EMU
#include <hip/hip_runtime.h>
#endif
#include <cstdio>
#include <cstdint>
#include <cmath>
#include <cstring>

#ifndef CFG_B
#define CFG_B 8
#endif
#ifndef CFG_S
#define CFG_S 2048
#endif
#ifndef CFG_D
#define CFG_D 1024
#endif

typedef unsigned short bf16_t;

namespace cfg {
constexpr int NB = CFG_B, SEQ = CFG_S, D = CFG_D, DEPTH = 2;
constexpr int NMETA = 16, LEAD = 48, TB = LEAD + NMETA + SEQ, R = NB * TB, NPOS = NMETA + SEQ;
constexpr int W = D / 2;
constexpr int NH = D / 128;
constexpr int NHD = D / 256;
constexpr int QR = 3 * D / 8, KVR = D / 4, QBW = NH * 96;
constexpr int INC = 4 * W + QR + KVR + 32 + W + 4 * W + 3 * D;
constexpr int C_SBQ = 0, C_SBK = W, C_SBV = 2 * W, C_SBZ = 3 * W, C_CQ = 4 * W, C_CKV = C_CQ + QR, C_KR = C_CKV + KVR, C_MZ = C_KR + 32,
              C_DQ = C_MZ + W, C_DK = C_DQ + W, C_DV = C_DK + W, C_DZ = C_DV + W, C_G = C_DZ + W;
static_assert(C_G + 3 * D == INC, "w_in columns");
constexpr int V1_SBQ = 0, V1_SBK = W, V1_CQ = 2 * W, V1_CKV = V1_CQ + QR, V1_KR = V1_CKV + KVR, V1_DQ = V1_KR + 32, V1_DK = V1_DQ + W, V1_END = V1_DK + W;
constexpr int N1 = (V1_END + 255) / 256 * 256;
constexpr int N3 = 3 * W + 3 * D;
constexpr int NSX = D / 32, NSQ = QR / 32, NSK = KVR / 32;
constexpr float EPS = 1e-6f, LOG2E = 1.4426950408889634f;
constexpr int GP = D / 256;
}
using namespace cfg;

#ifdef HOST_EMU
#define DEVFN inline
#define HDFN inline
#else
#define DEVFN __device__ __forceinline__
#define HDFN __host__ __device__ __forceinline__
#endif
constexpr size_t MiB = size_t(1) << 20;
constexpr size_t al256(size_t x) { return (x + 255) & ~size_t(255); }
constexpr size_t SZ_W = (size_t)R * W * 2, SZ_D2 = (size_t)R * D * 2, SZ_X = (size_t)R * D * 4, SZ_CQ = (size_t)R * QR * 2, SZ_CKV = (size_t)R * KVR * 2,
                 SZ_KR = (size_t)R * 32 * 2, SZ_QB = (size_t)R * QBW * 2, SZ_GP = (size_t)R * 256 * 2;
constexpr size_t WB_W1 = (size_t)N1 * D * 2, WB_WV = (size_t)2 * W * D * 2, WB_W3 = (size_t)N3 * D * 2, WB_UQ = (size_t)QBW * QR * 2, WB_UK = (size_t)W * KVR * 2,
                 WB_UV = WB_UK, WB_WO = (size_t)3 * D * W * 2, WB_OUT = (size_t)D * D * 2;
constexpr size_t WL_W1 = 0, WL_WV = WL_W1 + WB_W1, WL_W3 = WL_WV + WB_WV, WL_UQ = WL_W3 + WB_W3, WL_UK = WL_UQ + WB_UQ, WL_UV = WL_UK + WB_UK, WL_WO = WL_UV + WB_UV,
                 WL_OUT = WL_WO + WB_WO, WL_BYTES = al256(WL_OUT + WB_OUT);
constexpr bool STDCFG = (NB == 8 && SEQ == 2048 && D == 1024);
#if defined(HOST_EMU)
constexpr bool HANDMAP = false;
#else
constexpr bool HANDMAP = STDCFG;
#endif
constexpr size_t O_CTL = 0, O_TAB = 1 * MiB, O_LAM = O_TAB + 768 * 1024, O_SSX = 2 * MiB, O_SSQ = O_SSX + al256((size_t)R * NSX * 4), O_SSK = O_SSQ + al256((size_t)R * NSQ * 4),
                 O_WTS = al256(O_SSK + (size_t)R * NSK * 4 + MiB) / MiB * MiB;
constexpr size_t O_X = HANDMAP ? 52 * MiB : al256(O_WTS + 2 * WL_BYTES);
static_assert(O_WTS + 2 * WL_BYTES <= O_X, "weights overrun X");
constexpr size_t O_A = O_X + al256(SZ_X);
constexpr size_t Q_QSB = O_A, Q_QD = Q_QSB + al256(SZ_W), Q_OMLA = Q_QD + al256(SZ_W), Q_KSB = Q_OMLA + al256(SZ_W), Q_VSBT = Q_KSB + al256(SZ_W), Q_KD = Q_VSBT + al256(SZ_W),
                 Q_VDT = Q_KD + al256(SZ_W), Q_VBT = Q_VDT + al256(SZ_W), Q_KR = Q_VBT + al256(SZ_W), Q_CKV = Q_KR + al256(SZ_KR), Q_XB2 = Q_CKV + al256(SZ_CKV), Q_G0 = Q_XB2 + al256(SZ_D2),
                 Q_GPC = Q_G0 + al256(SZ_D2), Q_XB = Q_GPC + 2 * GP * al256(SZ_GP), Q_QB = Q_XB + al256(SZ_D2), Q_CQ = Q_QB + al256(SZ_QB), Q_KNOPE = Q_CQ + al256(SZ_CQ), Q_END = Q_KNOPE + al256(SZ_W);
constexpr size_t WS_NEED = HANDMAP ? 256 * MiB : Q_END;

constexpr size_t mibf(double m) { return (size_t)(m * 1048576.0); }
struct Params {
    const float *x, *meta, *norm_g, *w_in, *b_gate, *cq_g, *ckv_g, *w_uq, *w_ukv, *dlam, *dnorm_g, *w_osb, *w_omla, *w_odiff, *w_out, *final_g;
    float* out; char* ws;
#define WS_F32(name, off) HDFN float* name() const { return (float*)(ws + (off)); }
#define WS_B16(name, off) HDFN bf16_t* name() const { return (bf16_t*)(ws + (off)); }
#define OB_B16(name, offh, offq) HDFN bf16_t* name() const { return HANDMAP ? (bf16_t*)((char*)out + (offh)) : (bf16_t*)(ws + (offq)); }
    HDFN unsigned* ctl() const { return (unsigned*)(ws + O_CTL); }
    WS_F32(cosm, O_TAB) WS_F32(sinm, O_TAB + (size_t)NPOS * 16 * 4) WS_F32(cosd, O_TAB + (size_t)NPOS * 32 * 4) WS_F32(sind, O_TAB + (size_t)NPOS * 40 * 4) WS_F32(lamv, O_LAM)
    WS_F32(ssx, O_SSX) WS_F32(ssq, O_SSQ) WS_F32(ssk, O_SSK) WS_F32(X, O_X)
    HDFN char* WTS() const { return ws + O_WTS; }
    WS_B16(QSB, HANDMAP ? mibf(118) : Q_QSB) WS_B16(QD, HANDMAP ? mibf(134.5) : Q_QD) WS_B16(OMLA, HANDMAP ? mibf(151) : Q_OMLA) WS_B16(CKV, HANDMAP ? mibf(151) : Q_CKV) WS_B16(KSB, HANDMAP ? mibf(167.5) : Q_KSB)
    WS_B16(VSBT, HANDMAP ? mibf(184) : Q_VSBT) WS_B16(KD, HANDMAP ? mibf(200.5) : Q_KD) WS_B16(VDT, HANDMAP ? mibf(217) : Q_VDT) WS_B16(VBT, HANDMAP ? mibf(233.5) : Q_VBT) WS_B16(KR, HANDMAP ? mibf(250) : Q_KR)
    WS_B16(XB2, HANDMAP ? mibf(167.5) : Q_XB2) WS_B16(G0, HANDMAP ? mibf(200.5) : Q_G0)
    OB_B16(XB, 0, Q_XB) OB_B16(QB, 0, Q_QB) OB_B16(CQ, mibf(33), Q_CQ) OB_B16(KNOPE, mibf(45.5), Q_KNOPE)
    HDFN unsigned char* G8() const { return HANDMAP ? (unsigned char*)out : (unsigned char*)(ws + Q_GPC); }
};
static Params make_params(void* const* d_in, void* d_out, void* d_ws) {
    Params p{};
    const float* const* in = (const float* const*)d_in;
    p.x = in[0]; p.meta = in[1]; p.norm_g = in[2]; p.w_in = in[3]; p.b_gate = in[4]; p.cq_g = in[5]; p.ckv_g = in[6]; p.w_uq = in[7]; p.w_ukv = in[8]; p.dlam = in[9];
    p.dnorm_g = in[10]; p.w_osb = in[11]; p.w_omla = in[12]; p.w_odiff = in[13]; p.w_out = in[14]; p.final_g = in[15];
    p.out = (float*)d_out; p.ws = (char*)d_ws;
    return p;
}
static_assert(!STDCFG || (SZ_W == (size_t)(16.5 * 1048576) && SZ_D2 == 33 * MiB && SZ_GP == (size_t)(8.25 * 1048576) && SZ_QB == (size_t)(24.75 * 1048576) && SZ_CQ <= (size_t)(12.5 * 1048576) &&
              SZ_KR <= (size_t)(1.1 * 1048576) && SZ_X == 66 * MiB && GP == 4), "hand map sizes");

#ifdef HOST_EMU
template <class T> DEVFN T* opq(T* p) { return p; }
#else
DEVFN int lane_id_v() { int l; asm volatile("v_mbcnt_lo_u32_b32 %0, -1, 0\n\tv_mbcnt_hi_u32_b32 %0, -1, %0" : "=v"(l)); return l; }
template <class T> DEVFN T* opq(T* p) { asm volatile("" : "+s"(p)); return p; }
#endif
DEVFN float bf2f(bf16_t h) { unsigned u = (unsigned)h << 16; float f; memcpy(&f, &u, 4); return f; }
DEVFN bf16_t f2bf(float f) { unsigned u; memcpy(&u, &f, 4); return (bf16_t)((u + 0x7fffu + ((u >> 16) & 1u)) >> 16); }
struct alignas(16) U4 { unsigned x, y, z, w; };
DEVFN void ld8(const bf16_t* p, float* o) {
    const U4 v = *(const U4*)p; const unsigned u[4] = {v.x, v.y, v.z, v.w};
#pragma unroll
    for (int i = 0; i < 4; ++i) { unsigned lo = u[i] << 16, hi = u[i] & 0xffff0000u; memcpy(&o[2 * i], &lo, 4); memcpy(&o[2 * i + 1], &hi, 4); }
}
DEVFN float rsq(float x) { return 1.0f / sqrtf(x); }
DEVFN float rstd_slots(const float* s, int row, int ns, float invn) { float t = 0.f; for (int i = 0; i < ns; ++i) t += s[(size_t)row * ns + i]; return rsq(t * invn + EPS); }
DEVFN int sperm(int r) { return (r & ~12) | ((r & 4) << 1) | ((r & 8) >> 1); }
static_assert((size_t)R * 3 * D <= (HANDMAP ? 64 * MiB : 2 * GP * al256(SZ_GP)), "gate buffer");
DEVFN unsigned char* g8ptr(const Params& p, int b, int row, int c) { return p.G8() + (size_t)row * (3 * D) + b * D + c; }
HDFN bf16_t* wptr(const Params& p, int l, size_t off) { return (bf16_t*)(p.WTS() + (size_t)l * WL_BYTES + off); }
#ifdef HOST_EMU
DEVFN float sigm_f(float z) { return 1.f / (1.f + expf(-z)); }
#define UNI(x) (x)
#else
DEVFN float sigm_f(float z) { return __builtin_amdgcn_rcpf(1.0f + __builtin_amdgcn_exp2f(-1.4426950408889634f * z)); }
#define UNI(x) __builtin_amdgcn_readfirstlane(x)
#endif
DEVFN float silu_f(float z) { return z * sigm_f(z); }
struct alignas(8) U2 { unsigned x, y; };
#ifdef HOST_EMU
DEVFN unsigned pk2(float lo, float hi) { return (unsigned)f2bf(lo) | ((unsigned)f2bf(hi) << 16); }
#else
typedef float f32x2_t __attribute__((ext_vector_type(2))); typedef __bf16 bf16x2_t __attribute__((ext_vector_type(2)));
DEVFN unsigned pk2(float lo, float hi) { f32x2_t v = {lo, hi}; bf16x2_t b = __builtin_convertvector(v, bf16x2_t); return __builtin_bit_cast(unsigned, b); }
#endif
DEVFN void st4(bf16_t* p, float a, float b, float c, float d) { U2 v; v.x = pk2(a, b); v.y = pk2(c, d); *(U2*)p = v; }
DEVFN void st2(bf16_t* p, float a, float b) { *(unsigned*)p = pk2(a, b); }
DEVFN void st8(bf16_t* p, const float* v) { U4 w; w.x = pk2(v[0], v[1]); w.y = pk2(v[2], v[3]); w.z = pk2(v[4], v[5]); w.w = pk2(v[6], v[7]); *(U4*)p = w; }
DEVFN void up8(const U4& v, float* o) { const unsigned u[4] = {v.x, v.y, v.z, v.w};
#pragma unroll
    for (int i = 0; i < 4; ++i) { unsigned lo = u[i] << 16, hi = u[i] & 0xffff0000u; memcpy(&o[2 * i], &lo, 4); memcpy(&o[2 * i + 1], &hi, 4); } }
struct alignas(16) F4v { float x, y, z, w; };
#ifdef HOST_EMU
DEVFN U2 q8pack(const float* g) { unsigned w[2] = {0u, 0u}; for (int i = 0; i < 8; ++i) { float t = g[i] * 255.f + 0.5f; unsigned q = t <= 0.f ? 0u : t >= 255.f ? 255u : (unsigned)t; w[i >> 2] |= q << (8 * (i & 3)); } U2 r; r.x = w[0]; r.y = w[1]; return r; }
DEVFN void q8unpack(const U2& w, float* g) { for (int i = 0; i < 8; ++i) g[i] = (float)(((i < 4 ? w.x : w.y) >> (8 * (i & 3))) & 255u) * (1.0f / 255.0f); }
#else
DEVFN U2 q8pack(const float* g) { U2 r; r.x = 0u; r.y = 0u;
    r.x = __builtin_amdgcn_cvt_pk_u8_f32(g[0] * 255.f, 0, r.x); r.x = __builtin_amdgcn_cvt_pk_u8_f32(g[1] * 255.f, 1, r.x); r.x = __builtin_amdgcn_cvt_pk_u8_f32(g[2] * 255.f, 2, r.x); r.x = __builtin_amdgcn_cvt_pk_u8_f32(g[3] * 255.f, 3, r.x);
    r.y = __builtin_amdgcn_cvt_pk_u8_f32(g[4] * 255.f, 0, r.y); r.y = __builtin_amdgcn_cvt_pk_u8_f32(g[5] * 255.f, 1, r.y); r.y = __builtin_amdgcn_cvt_pk_u8_f32(g[6] * 255.f, 2, r.y); r.y = __builtin_amdgcn_cvt_pk_u8_f32(g[7] * 255.f, 3, r.y); return r; }
DEVFN void q8unpack(const U2& w, float* g) { const float k = 1.0f / 255.0f;
    g[0] = (float)(w.x & 255u) * k; g[1] = (float)((w.x >> 8) & 255u) * k; g[2] = (float)((w.x >> 16) & 255u) * k; g[3] = (float)(w.x >> 24) * k;
    g[4] = (float)(w.y & 255u) * k; g[5] = (float)((w.y >> 8) & 255u) * k; g[6] = (float)((w.y >> 16) & 255u) * k; g[7] = (float)(w.y >> 24) * k; }
#endif
DEVFN void ld4(const bf16_t* p, float* o) { const U2 v = *(const U2*)p; unsigned t; t = v.x << 16; memcpy(&o[0], &t, 4); t = v.x & 0xffff0000u; memcpy(&o[1], &t, 4); t = v.y << 16; memcpy(&o[2], &t, 4); t = v.y & 0xffff0000u; memcpy(&o[3], &t, 4); }

DEVFN int rotmap(int c, int half) { const int g = c >> 2, e = c & 3; return e < 2 ? 2 * g + e : half + 2 * g + (e - 2); }
DEVFN int src_w1(int n) {
    if (n < V1_SBK) return C_SBQ + n;
    if (n < V1_CQ) return C_SBK + (n - V1_SBK);
    if (n < V1_CKV) return C_CQ + (n - V1_CQ);
    if (n < V1_KR) return C_CKV + (n - V1_CKV);
    if (n < V1_DQ) return C_KR + rotmap(n - V1_KR, 16);
    if (n < V1_DK) { const int c = n - V1_DQ, cc = c & 63; return C_DQ + (c & ~63) + (cc < 16 ? rotmap(cc, 8) : cc); }
    if (n < V1_END) { const int c = n - V1_DK, cc = c & 63; return C_DK + (c & ~63) + (cc < 16 ? rotmap(cc, 8) : cc); }
    return -1;
}
DEVFN int src_wv(int n) { return n < W ? C_SBV + n : C_DV + (n - W); }
DEVFN int src_w3(int n) { return n < W ? C_SBZ + n : n < 2 * W ? C_MZ + (n - W) : n < 3 * W ? C_DZ + (n - 2 * W) : C_G + (n - 3 * W); }
DEVFN int src_uq(int n) { const int h = n / 96, cc = n % 96; return h * 96 + (cc < 64 ? cc : 64 + rotmap(cc - 64, 16)); }
DEVFN int src_uk(int n) { return (n >> 6) * 128 + (n & 63); }
DEVFN int src_uv(int n) { return (n >> 6) * 128 + 64 + (n & 63); }

#ifdef HOST_EMU
DEVFN float quad_sum(float s) { return s; }
#else
template <int CTRL> DEVFN float dpp_get(float s) { return __int_as_float(__builtin_amdgcn_update_dpp(0, __float_as_int(s), CTRL, 0xf, 0xf, true)); }
DEVFN float xor16_sum(float s) { auto r = __builtin_amdgcn_permlane16_swap(__float_as_uint(s), __float_as_uint(s), false, false); return __uint_as_float(r[0]) + __uint_as_float(r[1]); }
DEVFN float xor32_sum(float s) { auto r = __builtin_amdgcn_permlane32_swap(__float_as_uint(s), __float_as_uint(s), false, false); return __uint_as_float(r[0]) + __uint_as_float(r[1]); }
DEVFN float quad_sum(float s) { return xor32_sum(xor16_sum(s)); }
DEVFN float quad4_sum(float s) { s += dpp_get<0xB1>(s); s += dpp_get<0x4E>(s); return s; }
DEVFN float wave_sum(float s) { s = quad4_sum(s); s += dpp_get<0x124>(s); s += dpp_get<0x128>(s); return xor32_sum(xor16_sum(s)); }
#endif
struct NoPre {};
DEVFN float ssq8(const float* v) { return ((v[0] * v[0] + v[1] * v[1]) + (v[2] * v[2] + v[3] * v[3])) + ((v[4] * v[4] + v[5] * v[5]) + (v[6] * v[6] + v[7] * v[7])); }
DEVFN void rope4(bf16_t* o, int half, int g, const float* v, const float* cs, const float* sn, float sc) {
    const float c0 = cs[2 * g], c1 = cs[2 * g + 1], s0 = sn[2 * g], s1 = sn[2 * g + 1];
    st2(o + 2 * g, (v[0] * c0 - v[2] * s0) * sc, (v[1] * c1 - v[3] * s1) * sc); st2(o + half + 2 * g, (v[2] * c0 + v[0] * s0) * sc, (v[3] * c1 + v[1] * s1) * sc);
}
struct F1 {
    const Params& p; int aux; typedef NoPre Pre;
    DEVFN bool swapped(int tag) const { return tag == 1; }
    DEVFN float scale(int tag, int idx) const { return rstd_slots(p.ssx(), idx, NSX, 1.0f / D); }
    DEVFN void preload(int, int, int, Pre&) const {}
    DEVFN float apply(int tag, int row, int vc, const float* a, const float* sc, const Pre&) const {
        if (tag == 1) { const bool sb = UNI(row) < W; bf16_t* const vs = opq(p.VSBT()); bf16_t* const vd = opq(p.VDT()); bf16_t* o = (sb ? vs + (size_t)row * R : vd + (size_t)(row - W) * R) + (vc & ~15);
            const int t0 = vc & 15;
            st4(o + sperm(t0), a[0] * sc[0], a[1] * sc[1], a[2] * sc[2], a[3] * sc[3]); st4(o + sperm(t0 + 4), a[4] * sc[4], a[5] * sc[5], a[6] * sc[6], a[7] * sc[7]); return 0.f; }
        const int vcu = UNI(vc); const float rs = sc[0]; float v[8];
#pragma unroll
        for (int i = 0; i < 8; ++i) v[i] = a[i] * rs;
        const int t = row % TB; const int pos = t >= LEAD ? t - LEAD : 0;
        if (vcu < V1_SBK) {
#pragma unroll
            for (int i = 0; i < 8; ++i) v[i] *= 0.125f * LOG2E;
            st8(p.QSB() + (size_t)row * W + vc, v); }
        else if (vcu < V1_CQ) { st8(p.KSB() + (size_t)row * W + (vc - V1_SBK), v); }
        else if (vcu < V1_CKV) { st8(p.CQ() + (size_t)row * QR + (vc - V1_CQ), v); return ssq8(v); }
        else if (vcu < V1_KR) { st8(p.CKV() + (size_t)row * KVR + (vc - V1_CKV), v); return ssq8(v); }
        else if (vcu < V1_DQ) { const int g = (vc - V1_KR) >> 2; bf16_t* o = p.KR() + (size_t)row * 32; rope4(o, 16, g, v, p.cosm() + pos * 16, p.sinm() + pos * 16, 1.f); rope4(o, 16, g + 1, v + 4, p.cosm() + pos * 16, p.sinm() + pos * 16, 1.f); }
        else if (vcu < V1_END) { const bool isq = vcu < V1_DK; const int c = vc - (isq ? V1_DQ : V1_DK), cc = c & 63; const float sc2 = isq ? 0.125f * LOG2E : 1.0f;
            bf16_t* const qd = opq(p.QD()); bf16_t* const kd = opq(p.KD()); bf16_t* o = (isq ? qd : kd) + (size_t)row * W + (c & ~63);
            if (cc < 16  ) { const int g = cc >> 2; rope4(o, 8, g, v, p.cosd() + pos * 8, p.sind() + pos * 8, sc2); rope4(o, 8, g + 1, v + 4, p.cosd() + pos * 8, p.sind() + pos * 8, sc2); }
            else {
#pragma unroll
                for (int i = 0; i < 8; ++i) v[i] *= sc2;
                st8(o + cc, v); } }
        return 0.f;
    }
    DEVFN void rowslot(int tag, int row, int vc0, int fq, float part) const {
        if (tag != 0 || vc0 < V1_CQ || vc0 >= V1_KR) return;
        const float s = quad_sum(part);
        if (fq == 0) { if (vc0 < V1_CKV) p.ssq()[(size_t)row * NSQ + ((vc0 - V1_CQ) >> 5)] = s; else p.ssk()[(size_t)row * NSK + ((vc0 - V1_CKV) >> 5)] = s; }
    }
};
struct FUQ {
    const Params& p; int aux; typedef NoPre Pre;
    DEVFN bool swapped(int) const { return false; }
    DEVFN float scale(int, int idx) const { return rstd_slots(p.ssq(), idx, NSQ, 1.0f / QR) * (LOG2E * 0.10206207261596577f); }
    DEVFN void preload(int, int, int, Pre&) const {}
    DEVFN float apply(int, int row, int vc, const float* a, const float* sc, const Pre&) const {
        const float rs = sc[0]; float v[8];
#pragma unroll
        for (int i = 0; i < 8; ++i) v[i] = a[i] * rs;
        const int t = row % TB; const int pos = t >= LEAD ? t - LEAD : 0;
        const int h = vc / 96, cc = vc % 96; bf16_t* o = p.QB() + (size_t)row * QBW + h * 96;
        if (UNI(vc) % 96 < 64) st8(o + cc, v);
        else { const int g = (cc - 64) >> 2; rope4(o + 64, 16, g, v, p.cosm() + pos * 16, p.sinm() + pos * 16, 1.f); rope4(o + 64, 16, g + 1, v + 4, p.cosm() + pos * 16, p.sinm() + pos * 16, 1.f); }
        return 0.f;
    }
    DEVFN void rowslot(int, int, int, int, float) const {}
};
struct FUK {
    const Params& p; int aux; typedef NoPre Pre;
    DEVFN bool swapped(int tag) const { return tag == 1; }
    DEVFN float scale(int, int idx) const { return rstd_slots(p.ssk(), idx, NSK, 1.0f / KVR); }
    DEVFN void preload(int, int, int, Pre&) const {}
    DEVFN float apply(int tag, int row, int vc, const float* a, const float* sc, const Pre&) const {
        if (tag == 1) { bf16_t* o = p.VBT() + (size_t)row * R + (vc & ~15); const int t0 = vc & 15;
            st4(o + sperm(t0), a[0] * sc[0], a[1] * sc[1], a[2] * sc[2], a[3] * sc[3]); st4(o + sperm(t0 + 4), a[4] * sc[4], a[5] * sc[5], a[6] * sc[6], a[7] * sc[7]); }
        else { float v[8];
#pragma unroll
            for (int i = 0; i < 8; ++i) v[i] = a[i] * sc[0];
            st8(p.KNOPE() + (size_t)row * W + vc, v); }
        return 0.f;
    }
    DEVFN void rowslot(int, int, int, int, float) const {}
};
struct F3 {
    const Params& p; int layer; typedef U4 Pre;
    DEVFN bool swapped(int) const { return false; }
    DEVFN float scale(int, int idx) const { return rstd_slots(p.ssx(), idx, NSX, 1.0f / D); }
    DEVFN bf16_t* optr(int row, int vc) const { const int vcu = UNI(vc); bf16_t* const o0 = opq(p.QSB()); bf16_t* const o1 = opq(p.OMLA()); bf16_t* const o2 = opq(p.QD()); return (vcu < W ? o0 : vcu < 2 * W ? o1 : o2) + (size_t)row * W + (vc % W); }
    DEVFN void preload(int, int row, int vc, Pre& pre) const { if (UNI(vc) < 3 * W) pre = *(const U4*)optr(row, vc); }
    DEVFN float apply(int, int row, int vc, const float* a, const float* sc, const Pre& pre) const {
        const float rs = sc[0]; float v[8];
        if (UNI(vc) < 3 * W) { float ov[8]; up8(pre, ov);
#pragma unroll
            for (int i = 0; i < 8; ++i) v[i] = ov[i] * silu_f(a[i] * rs);
            st8(optr(row, vc), v); }
        else { const int c = vc - 3 * W, cu = UNI(c), b = cu / D, cc = c - b * D; const F4v b0 = *(const F4v*)(p.b_gate + (size_t)layer * 3 * D + c), b1 = *(const F4v*)(p.b_gate + (size_t)layer * 3 * D + c + 4);
            v[0] = sigm_f(a[0] * rs + b0.x); v[1] = sigm_f(a[1] * rs + b0.y); v[2] = sigm_f(a[2] * rs + b0.z); v[3] = sigm_f(a[3] * rs + b0.w);
            v[4] = sigm_f(a[4] * rs + b1.x); v[5] = sigm_f(a[5] * rs + b1.y); v[6] = sigm_f(a[6] * rs + b1.z); v[7] = sigm_f(a[7] * rs + b1.w);
            *(U2*)g8ptr(p, b, row, cc) = q8pack(v); }
        return 0.f;
    }
    DEVFN void rowslot(int, int, int, int, float) const {}
};
struct F4 {
    const Params& p; int aux; struct Pre { U2 g; U4 m; };
    DEVFN bool swapped(int) const { return false; }
    DEVFN float scale(int, int) const { return 1.f; }
    DEVFN void preload(int tag, int row, int c, Pre& pre) const { pre.g = *(const U2*)g8ptr(p, tag & 3, row, c); if (tag >> 2) pre.m = *(const U4*)(p.G0() + (size_t)row * D + c); }
    DEVFN float apply(int tag, int row, int c, const float* a, const float*, const Pre& pre) const {
        float g[8], m[8], v[8]; q8unpack(pre.g, g);
        if (tag >> 2) up8(pre.m, m); else {
#pragma unroll
            for (int i = 0; i < 8; ++i) m[i] = 0.f; }
#pragma unroll
        for (int i = 0; i < 8; ++i) v[i] = m[i] + g[i] * a[i];
        st8(p.G0() + (size_t)row * D + c, v); return 0.f;
    }
    DEVFN void rowslot(int, int, int, int, float) const {}
};
struct F5 {
    const Params& p; int last; struct Pre { F4v x0, x1; };
    DEVFN bool swapped(int) const { return false; }
    DEVFN float scale(int, int) const { return 1.f; }
    DEVFN void preload(int, int row, int c, Pre& pre) const { const F4v* x = (const F4v*)(p.X() + (size_t)row * D + c); pre.x0 = x[0]; pre.x1 = x[1]; }
    DEVFN float apply(int, int row, int c, const float* a, const float*, const Pre& pre) const {
        float v[8] = {pre.x0.x + a[0], pre.x0.y + a[1], pre.x0.z + a[2], pre.x0.w + a[3], pre.x1.x + a[4], pre.x1.y + a[5], pre.x1.z + a[6], pre.x1.w + a[7]};
        F4v* x = (F4v*)(p.X() + (size_t)row * D + c); x[0] = F4v{v[0], v[1], v[2], v[3]}; x[1] = F4v{v[4], v[5], v[6], v[7]};
        if (!last) st8(p.XB() + (size_t)row * D + c, v);
        return ssq8(v);
    }
    DEVFN void rowslot(int, int row, int vc0, int fq, float part) const { const float s = quad_sum(part); if (fq == 0) p.ssx()[(size_t)row * NSX + (vc0 >> 5)] = s; }
};

#ifdef HOST_EMU
struct dim3e { unsigned x, y, z; };
static dim3e threadIdx, blockIdx, blockDim, gridDim;
#define GLOBAL static
#define LB64
#define LAUNCH(kern, nblk, nthr, ...) do { gridDim.x = (unsigned)(nblk); blockDim.x = (unsigned)(nthr); for (unsigned b_ = 0; b_ < gridDim.x; ++b_) for (unsigned t_ = 0; t_ < blockDim.x; ++t_) { blockIdx.x = b_; threadIdx.x = t_; kern(__VA_ARGS__); } } while (0)
#else
#define GLOBAL __global__
#define LB64 __launch_bounds__(64)
#define LAUNCH(kern, nblk, nthr, ...) kern<<<dim3((unsigned)(nblk)), dim3((unsigned)(nthr)), 0, stream>>>(__VA_ARGS__)
#endif
#define GTID ((long)blockIdx.x * blockDim.x + threadIdx.x)

#ifdef HOST_EMU
template <int MAP> GLOBAL void k_prep_w(bf16_t* dst, int N, int K, const float* src, int src_ld, const float* rowscale) {
    const long i = GTID; if (i >= (long)N * K) return;
    const int n = (int)(i % N), k = (int)(i / N);
    int s;
    if (MAP == 0) s = src_w1(n); else if (MAP == 1) s = src_wv(n); else if (MAP == 2) s = src_w3(n); else if (MAP == 3) s = src_uq(n); else if (MAP == 4) s = src_uk(n); else if (MAP == 5) s = src_uv(n); else s = n;
    float v = 0.f; if (s >= 0) v = src[(size_t)k * src_ld + s] * (rowscale ? rowscale[k] : 1.f);
    dst[(size_t)n * K + k] = f2bf(v);
}
GLOBAL void k_tables(Params p) {
    const long i = GTID;
    if (i < NPOS * 16) { const int pos = (int)(i / 16), j = (int)(i % 16); const float inv = (float)pow(500000.0, -(double)(2 * j) / 32.0); const float ang = (float)pos * inv;
        p.cosm()[i] = (float)cos((double)ang); p.sinm()[i] = (float)sin((double)ang); }
    if (i < NPOS * 8) { const int pos = (int)(i / 8), j = (int)(i % 8); const float inv = (float)pow(500000.0, -(double)(2 * j) / 16.0); const float ang = (float)pos * inv;
        p.cosd()[i] = (float)cos((double)ang); p.sind()[i] = (float)sin((double)ang); }
    if (i < DEPTH) { const float* lm = p.dlam + i * 4 * 64; float s0 = 0.f, s1 = 0.f; for (int d = 0; d < 64; ++d) { s0 += lm[d] * lm[64 + d]; s1 += lm[128 + d] * lm[192 + d]; }
        p.lamv()[i] = expf(s0) - expf(s1) + (0.8f - 0.6f * expf(-0.3f * (float)i)); }
}
GLOBAL void k_init_x(Params p) {
    const long i = GTID; if (i >= (long)R * D) return;
    const int row = (int)(i / D), c = (int)(i % D), b = row / TB, t = row % TB;
    const float v = t < LEAD ? 0.f : t < LEAD + NMETA ? p.meta[(t - LEAD) * D + c] : p.x[((size_t)b * SEQ + (t - LEAD - NMETA)) * D + c];
    p.X()[i] = v; p.XB()[i] = f2bf(v);
}
GLOBAL void k_x2bf(Params p) { const long i = GTID; if (i >= (long)R * D) return; p.XB2()[i] = f2bf(p.X()[i]); }
GLOBAL void k_ssq_f32(const float* X, int n, float* slots, int ns) {
    const long row = GTID; if (row >= R) return; float s = 0.f; for (int c = 0; c < n; ++c) { const float v = X[(size_t)row * n + c]; s += v * v; }
    slots[row * ns] = s; for (int i = 1; i < ns; ++i) slots[row * ns + i] = 0.f;
}
GLOBAL void k_ssq_bf(const bf16_t* X, int n, float* slots, int ns) {
    const long row = GTID; if (row >= R) return; float s = 0.f; for (int c = 0; c < n; ++c) { const float v = bf2f(X[(size_t)row * n + c]); s += v * v; }
    slots[row * ns] = s; for (int i = 1; i < ns; ++i) slots[row * ns + i] = 0.f;
}
GLOBAL void k_final(Params p) {
    const long i = GTID; if (i >= (long)NB * SEQ) return;
    const int b = (int)(i / SEQ), s = (int)(i % SEQ); const float* x = p.X() + ((size_t)b * TB + LEAD + NMETA + s) * D; float ss = 0.f;
    for (int c = 0; c < D; ++c) ss += x[c] * x[c];
    const float rs = rsq(ss / D + EPS); float* o = p.out + (size_t)i * D;
    for (int c = 0; c < D; ++c) o[c] = x[c] * rs * p.final_g[c];
}

template <class Epi> GLOBAL void k_gemm(const bf16_t* A, int lda, const bf16_t* Bt, int ldb, int M, int N, int K, Params pp, int aux, int tag) {
    const Epi epi{pp, aux};
    const long idx = GTID; const int n8 = N / 8; if (idx >= (long)M * n8) return;
    const int m = (int)(idx / n8), n0 = (int)(idx % n8) * 8;
    float acc[8] = {0.f, 0.f, 0.f, 0.f, 0.f, 0.f, 0.f, 0.f};
    const bf16_t* a = A + (size_t)m * lda; const bf16_t* b0 = Bt + (size_t)n0 * ldb;
    for (int k = 0; k < K; k += 8) {
        float av[8]; ld8(a + k, av);
        for (int i = 0; i < 8; ++i) { float bv[8]; ld8(b0 + (size_t)i * ldb + k, bv); float s = 0.f;
            for (int j = 0; j < 8; ++j) s += av[j] * bv[j];
            acc[i] += s; }
    }
    float sc[8]; if (epi.swapped(tag)) { for (int i = 0; i < 8; ++i) sc[i] = epi.scale(tag, n0 + i); } else sc[0] = epi.scale(tag, m);
    typename Epi::Pre pre; epi.preload(tag, m, n0, pre); epi.apply(tag, m, n0, acc, sc, pre);
}

GLOBAL void LB64 k_attn_sb(Params p) {
    const long i = GTID; if (i >= (long)NB * NH * TB) return;
    const int t = (int)(i % TB), h = (int)((i / TB) % NH), b = (int)(i / ((long)TB * NH));
    const size_t row = (size_t)b * TB + t; bf16_t* qo = p.QSB() + row * W + h * 64;
    float q[64], o[64];
#pragma unroll
    for (int d = 0; d < 64; ++d) { q[d] = bf2f(qo[d]); o[d] = 0.f; }
    if (t >= LEAD) {
        float carry = 0.f;
        for (int j = t - 1; j >= LEAD; --j) {
            const size_t kr = (size_t)b * TB + j; const bf16_t* k = p.KSB() + kr * W + h * 64; float z = 0.f;
#pragma unroll
            for (int d = 0; d < 64; ++d) z += q[d] * bf2f(k[d]);
            const float sp = fmaxf(z, 0.f) + log2f(1.f + exp2f(-fabsf(z)));
            const float w = exp2f((z - sp) + carry); carry -= sp;
            const bf16_t* vt = p.VSBT() + (size_t)(h * 64) * R + ((kr & ~(size_t)15) | sperm((int)(kr & 15)));
#pragma unroll
            for (int d = 0; d < 64; ++d) o[d] += w * bf2f(vt[(size_t)d * R]);
        }
    }
#pragma unroll
    for (int d = 0; d < 64; ++d) qo[d] = f2bf(o[d]);
}
GLOBAL void LB64 k_attn_mla(Params p) {
    const long i = GTID; if (i >= (long)NB * NH * TB) return;
    const int t = (int)(i % TB), h = (int)((i / TB) % NH), b = (int)(i / ((long)TB * NH));
    const size_t row = (size_t)b * TB + t; const bf16_t* qp = p.QB() + row * QBW + h * 96;
    float o[64]; float m = -INFINITY, l = 0.f;
#pragma unroll
    for (int d = 0; d < 64; ++d) o[d] = 0.f;
    if (t >= LEAD) {
        const int kend = (t / 64 + 1) * 64 < TB ? (t / 64 + 1) * 64 : TB;
        for (int j = LEAD; j < kend; ++j) {
            const size_t kr = (size_t)b * TB + j; const bf16_t* kn = p.KNOPE() + kr * W + h * 64; const bf16_t* kq = p.KR() + kr * 32; float s = 0.f;
            for (int d = 0; d < 64; ++d) s += bf2f(qp[d]) * bf2f(kn[d]);
            for (int d = 0; d < 32; ++d) s += bf2f(qp[64 + d]) * bf2f(kq[d]);
            const float mn = fmaxf(m, s), f = exp2f(m - mn), w = exp2f(s - mn); m = mn; l = l * f + w;
            const bf16_t* vt = p.VBT() + (size_t)(h * 64) * R + ((kr & ~(size_t)15) | sperm((int)(kr & 15)));
#pragma unroll
            for (int d = 0; d < 64; ++d) o[d] = o[d] * f + w * bf2f(vt[(size_t)d * R]);
        }
    }
    const float il = l > 0.f ? 1.f / l : 0.f; bf16_t* op = p.OMLA() + row * W + h * 64;
#pragma unroll
    for (int d = 0; d < 64; ++d) op[d] = f2bf(o[d] * il);
}
GLOBAL void LB64 k_attn_diff(Params p, int layer) {
    const long i = GTID; if (i >= (long)NB * NHD * TB) return;
    const int t = (int)(i % TB), h = (int)((i / TB) % NHD), b = (int)(i / ((long)TB * NHD));
    const size_t row = (size_t)b * TB + t; bf16_t* qo = p.QD() + row * W + h * 128;
    const float lam = p.lamv()[layer], lam_init = 0.8f - 0.6f * expf(-0.3f * (float)layer);
    float o[128];
#pragma unroll
    for (int d = 0; d < 128; ++d) o[d] = 0.f;
    if (t >= LEAD) {
        const int kend = (t / 64 + 1) * 64 < TB ? (t / 64 + 1) * 64 : TB;
        float m0 = -INFINITY, l0 = 0.f, m1 = -INFINITY, l1 = 0.f;
        for (int j = LEAD; j < kend; ++j) { const bf16_t* k = p.KD() + ((size_t)b * TB + j) * W + h * 128; float s0 = 0.f, s1 = 0.f;
            for (int d = 0; d < 64; ++d) { s0 += bf2f(qo[d]) * bf2f(k[d]); s1 += bf2f(qo[64 + d]) * bf2f(k[64 + d]); }
            float mn = fmaxf(m0, s0); l0 = l0 * exp2f(m0 - mn) + exp2f(s0 - mn); m0 = mn; mn = fmaxf(m1, s1); l1 = l1 * exp2f(m1 - mn) + exp2f(s1 - mn); m1 = mn; }
        const float i0 = 1.f / l0, i1 = lam / l1;
        for (int j = LEAD; j < kend; ++j) { const size_t kr = (size_t)b * TB + j; const bf16_t* k = p.KD() + kr * W + h * 128; float s0 = 0.f, s1 = 0.f;
            for (int d = 0; d < 64; ++d) { s0 += bf2f(qo[d]) * bf2f(k[d]); s1 += bf2f(qo[64 + d]) * bf2f(k[64 + d]); }
            const float w = exp2f(s0 - m0) * i0 - exp2f(s1 - m1) * i1;
            const bf16_t* vt = p.VDT() + (size_t)(h * 128) * R + ((kr & ~(size_t)15) | sperm((int)(kr & 15)));
#pragma unroll
            for (int d = 0; d < 128; ++d) o[d] += w * bf2f(vt[(size_t)d * R]);
        }
    }
    float ss = 0.f;
#pragma unroll
    for (int d = 0; d < 128; ++d) ss += o[d] * o[d];
    const float rs = rsq(ss * (1.f / 128.f) + EPS) * (1.f - lam_init); const float* g = p.dnorm_g + (size_t)layer * 128;
#pragma unroll
    for (int d = 0; d < 128; ++d) qo[d] = f2bf(o[d] * rs * g[d]);
}


#endif
#ifndef HOST_EMU
namespace pg8 {
#define PG8_LAS __attribute__((address_space(3)))
typedef short bf16x8 __attribute__((ext_vector_type(8)));
typedef float f32x4 __attribute__((ext_vector_type(4)));
typedef unsigned u32x4 __attribute__((ext_vector_type(4)));
constexpr int BM = 256, BK = 64, HALF = 128, HTB = HALF * BK * 2  , STAGE_BYTES = 8 * HTB, NXCD = 8, WGM = 8;
__host__ __device__ __forceinline__ int lds_byte(int r, int c) { const int st = (r >> 4) * 2 + (c >> 5), rr = r & 15, cc = c & 31, ob = rr * 64 + cc * 2; return st * 1024 + (ob ^ (((ob >> 9) & 1) << 5)); }
__host__ __device__ __forceinline__ void stage_rc(int b, int& R, int& C) { const int st = b / 1024, sb = b % 1024, swz = sb ^ (((sb >> 9) & 1) << 5); R = (st >> 1) * 16 + swz / 64; C = (st & 1) * 32 + (swz % 64) / 2; }
__host__ __device__ __forceinline__ int perm32(int rho) { const int n = rho >> 4, i = rho & 15; return 8 * (i >> 2) + 4 * n + (i & 3); }
struct Unit { int pm, pn, tag; const char* A; const char* B; };
struct Gemm { int K, lda, ldb; };
__device__ __forceinline__ void order_map(int L, int nM, int nN, int& pm, int& pn) {
    const int nwg = nM * nN; int wgid = L; { const int q = nwg / NXCD, r = nwg % NXCD, xcd = wgid % NXCD, off = wgid / NXCD; wgid = (xcd < r ? xcd * (q + 1) : r * (q + 1) + (xcd - r) * q) + off; }
    const int nig = WGM * nN, gid = wgid / nig, fm = gid * WGM, gsz = (nM - fm) < WGM ? (nM - fm) : WGM;
    pm = fm + ((wgid % nig) % gsz); pn = (wgid % nig) / gsz;
}
template <class F> struct EpiAd {
    static constexpr bool PERM = true, AFTER_DRAIN = false;
    F f;
    __device__ __forceinline__ void operator()(const f32x4 (&acc)[2][2][4][2], const Unit& u, int wr, int wc, int fr, int fq, PG8_LAS unsigned char* scr, int tid) const {
        PG8_LAS float* rs = (PG8_LAS float*)scr;
        const bool sw = f.swapped(u.tag);
        if (tid < 256) rs[tid] = f.scale(u.tag, (sw ? u.pn : u.pm) * BM + tid);
        asm volatile("s_waitcnt lgkmcnt(0)" ::: "memory"); __builtin_amdgcn_s_barrier(); asm volatile("" ::: "memory");
#pragma unroll
        for (int ai = 0; ai < 2; ++ai) {
            int rl0 = ai * HALF + wr * 64 + fr, fqo = fq; asm volatile("" : "+v"(rl0), "+v"(fqo));
            typename F::Pre pre[4][2];
#pragma unroll
            for (int m = 0; m < 4; ++m)
#pragma unroll
                for (int bj = 0; bj < 2; ++bj) f.preload(u.tag, u.pm * BM + rl0 + m * 16, u.pn * BM + bj * HALF + wc * 32 + 8 * fqo, pre[m][bj]);
#pragma unroll
            for (int m = 0; m < 4; ++m) { const int rl = rl0 + m * 16, row = u.pm * BM + rl;
#pragma unroll
                for (int bj = 0; bj < 2; ++bj) { const int cl = bj * HALF + wc * 32 + 8 * fqo; const f32x4 v0 = acc[ai][bj][m][0], v1 = acc[ai][bj][m][1]; const float a8[8] = {v0[0], v0[1], v0[2], v0[3], v1[0], v1[1], v1[2], v1[3]};
                    float sc[8];
                    if (sw) {
#pragma unroll
                        for (int i = 0; i < 8; ++i) sc[i] = rs[cl + i]; }
                    else { sc[0] = rs[rl];
#pragma unroll
                        for (int i = 1; i < 8; ++i) sc[i] = 0.f; }
                    const float part = f.apply(u.tag, row, u.pn * BM + cl, a8, sc, pre[m][bj]);
                    f.rowslot(u.tag, row, u.pn * BM + bj * HALF + wc * 32, fq, part); } }
            asm volatile("" ::: "memory");
        }
    }
};
template <class Epi, class Sched, bool ALIGN_EPI = false, bool SP2 = false>
__device__ __forceinline__ void gemm_phase(PG8_LAS unsigned char* lds, const Gemm g, const Sched& S, const Epi& E, const int wid0  ) {
    int lane_ = lane_id_v();
    const int wid = wid0, lane = lane_, tid = wid * 64 + lane, wr = wid >> 2, wc = wid & 3, fr = lane & 15, fq = lane >> 4;
    const int K = g.K, nt = K / BK, lda = g.lda, ldb = g.ldb;
    unsigned voffA[2], voffB[2];
#pragma unroll
    for (int i = 0; i < 2; ++i) { int R, C; stage_rc(tid * 16 + i * 8192, R, C); const int Rb = Epi::PERM ? ((R & ~31) + perm32(R & 31)) : R;
        voffA[i] = (unsigned)(R * lda + C) * 2u; voffB[i] = (unsigned)(Rb * ldb + C) * 2u; }
    const size_t kstep = (size_t)(BK * 2);
    const size_t hstepA = (size_t)HALF * lda * 2, hstepB = (size_t)HALF * ldb * 2;
    const size_t tstepA = 2 * hstepA, tstepB = 2 * hstepB;
    const unsigned ldsw = (unsigned)wid * 1024u;
    const int aoff = lds_byte(wr * 64 + fr, fq * 8), boff = lds_byte(wc * 32 + fr, fq * 8);
#define PG8_SA(b, h) (((b) * 2 + (h)) * HTB)
#define PG8_SB(b, h) ((4 + (b) * 2 + (h)) * HTB)
#define PG8_STAGE(bufoff, gbase, voff) do { _Pragma("unroll") for (int _i = 0; _i < 2; ++_i) \
        __builtin_amdgcn_global_load_lds((const unsigned*)((const char*)(gbase) + (voff)[_i]), (PG8_LAS unsigned*)(lds + (bufoff) + ldsw + _i * 8192), 16, 0, 0); } while (0)
#define PG8_LDA(dst, b, h) do { _Pragma("unroll") for (int m = 0; m < 4; ++m) _Pragma("unroll") for (int k = 0; k < 2; ++k) dst[m][k] = *(const PG8_LAS bf16x8*)(lds + PG8_SA(b, h) + aoff + m * 2048 + k * 1024); } while (0)
#define PG8_LDB(dst, b, h) do { _Pragma("unroll") for (int n = 0; n < 2; ++n) _Pragma("unroll") for (int k = 0; k < 2; ++k) dst[n][k] = *(const PG8_LAS bf16x8*)(lds + PG8_SB(b, h) + boff + n * 2048 + k * 1024); } while (0)
#define PG8_MMA(ai, bj, At, Bt) do { __builtin_amdgcn_s_setprio(1); _Pragma("unroll") for (int m = 0; m < 4; ++m) _Pragma("unroll") for (int n = 0; n < 2; ++n) _Pragma("unroll") for (int k = 0; k < 2; ++k) \
        acc[ai][bj][m][n] = __builtin_amdgcn_mfma_f32_16x16x32_bf16(Bt[n][k], At[m][k], acc[ai][bj][m][n], 0, 0, 0); __builtin_amdgcn_s_setprio(0); } while (0)
#define PG8_WAIT_V(n) asm volatile("s_waitcnt vmcnt(" #n ")" ::: "memory")
#define PG8_WAIT_L(n) asm volatile("s_waitcnt lgkmcnt(" #n ")" ::: "memory")
#define PG8_BAR __builtin_amdgcn_s_barrier()
#define PG8_SCHED __builtin_amdgcn_sched_barrier(0)
    Unit cur, nxt; int ui = 0;
    if (!S.next(0, cur)) return;
    f32x4 acc[2][2][4][2];
#pragma unroll
    for (int a = 0; a < 2; ++a)
#pragma unroll
        for (int b = 0; b < 2; ++b)
#pragma unroll
            for (int m = 0; m < 4; ++m)
#pragma unroll
                for (int n = 0; n < 2; ++n) acc[a][b][m][n] = (f32x4){0.f, 0.f, 0.f, 0.f};
    bf16x8 At[4][2], B0[2][2], B1[2][2];
    const char* cA = cur.A + (size_t)cur.pm * tstepA; const char* cB = cur.B + (size_t)cur.pn * tstepB;
    S.a_ready(cur);
    if constexpr (SP2) {
        PG8_STAGE(PG8_SB(0, 0), cB, voffB); PG8_STAGE(PG8_SB(0, 1), cB + hstepB, voffB); PG8_STAGE(PG8_SA(0, 0), cA, voffA); PG8_STAGE(PG8_SA(0, 1), cA + hstepA, voffA);
        if (wr == 1) PG8_BAR;
        PG8_WAIT_V(2); PG8_BAR;
        PG8_STAGE(PG8_SB(1, 0), cB + kstep, voffB); PG8_STAGE(PG8_SA(1, 0), cA + kstep, voffA); PG8_STAGE(PG8_SB(1, 1), cB + hstepB + kstep, voffB);
        PG8_WAIT_V(6); PG8_BAR;
    } else {
        PG8_STAGE(PG8_SB(0, 0), cB, voffB); PG8_STAGE(PG8_SA(0, 0), cA, voffA); PG8_STAGE(PG8_SB(0, 1), cB + hstepB, voffB); PG8_STAGE(PG8_SA(0, 1), cA + hstepA, voffA);
        if (wr == 1) PG8_BAR;
        PG8_WAIT_V(4); PG8_BAR;
        PG8_STAGE(PG8_SB(1, 0), cB + kstep, voffB); PG8_STAGE(PG8_SA(1, 0), cA + kstep, voffA); PG8_STAGE(PG8_SB(1, 1), cB + hstepB + kstep, voffB);
        PG8_WAIT_V(6); PG8_BAR;
    }
    for (;;) {
        const bool has_next = S.next(ui + 1, nxt);
        const char* nA = has_next ? nxt.A + (size_t)nxt.pm * tstepA : cA; const char* nB = has_next ? nxt.B + (size_t)nxt.pn * tstepB : cB;
#pragma nounroll
        for (int t = 0; t < nt; t += 2) {
            const bool last = (t == nt - 2);
            const char* a1 = cA + (size_t)(t + 1) * kstep;
            const char* a2 = last ? nA : cA + (size_t)(t + 2) * kstep; const char* b2 = last ? nB : cB + (size_t)(t + 2) * kstep;
            const char* a3 = a2 + kstep; const char* b3 = b2 + kstep;
            if (last && has_next) S.a_ready(nxt);
            if constexpr (SP2) {
            PG8_LDB(B0, 0, 0); PG8_LDB(B1, 0, 1); PG8_SCHED; PG8_LDA(At, 0, 0); PG8_STAGE(PG8_SA(1, 1), a1 + hstepA, voffA);
            PG8_WAIT_V(8); PG8_WAIT_L(0); PG8_BAR; PG8_MMA(0, 0, At, B0); PG8_MMA(0, 1, At, B1); PG8_BAR; PG8_SCHED;
            PG8_LDA(At, 0, 1); PG8_STAGE(PG8_SB(0, 0), b2, voffB); PG8_STAGE(PG8_SB(0, 1), b2 + hstepB, voffB); PG8_STAGE(PG8_SA(0, 0), a2, voffA);
            PG8_WAIT_V(8); PG8_WAIT_L(0); PG8_BAR; PG8_MMA(1, 0, At, B0); PG8_MMA(1, 1, At, B1); PG8_BAR; PG8_SCHED;
            PG8_LDB(B0, 1, 0); PG8_LDB(B1, 1, 1); PG8_SCHED; PG8_LDA(At, 1, 0); PG8_STAGE(PG8_SA(0, 1), a2 + hstepA, voffA);
            PG8_WAIT_V(8); PG8_WAIT_L(0); PG8_BAR; PG8_MMA(0, 0, At, B0); PG8_MMA(0, 1, At, B1); PG8_BAR; PG8_SCHED;
            PG8_LDA(At, 1, 1); PG8_STAGE(PG8_SB(1, 0), b3, voffB); PG8_STAGE(PG8_SB(1, 1), b3 + hstepB, voffB); PG8_STAGE(PG8_SA(1, 0), a3, voffA);
            PG8_WAIT_V(8); PG8_WAIT_L(0); PG8_BAR; PG8_MMA(1, 0, At, B0); PG8_MMA(1, 1, At, B1); PG8_BAR; PG8_SCHED;
            } else {
            PG8_LDB(B0, 0, 0); PG8_SCHED; PG8_LDA(At, 0, 0); PG8_STAGE(PG8_SA(1, 1), a1 + hstepA, voffA);
            PG8_WAIT_L(8); PG8_BAR; PG8_WAIT_L(0); PG8_MMA(0, 0, At, B0); PG8_BAR; PG8_SCHED;
            PG8_LDB(B1, 0, 1); PG8_STAGE(PG8_SB(0, 0), b2, voffB);
            PG8_BAR; PG8_WAIT_L(0); PG8_MMA(0, 1, At, B1); PG8_BAR;
            PG8_LDA(At, 0, 1); PG8_STAGE(PG8_SA(0, 0), a2, voffA);
            PG8_BAR; PG8_WAIT_L(0); PG8_MMA(1, 0, At, B0); PG8_BAR; PG8_SCHED;
            PG8_STAGE(PG8_SB(0, 1), b2 + hstepB, voffB);
            PG8_WAIT_V(6); PG8_BAR; PG8_MMA(1, 1, At, B1); PG8_BAR;
            PG8_LDB(B0, 1, 0); PG8_SCHED; PG8_LDA(At, 1, 0); PG8_STAGE(PG8_SA(0, 1), a2 + hstepA, voffA);
            PG8_WAIT_L(8); PG8_BAR; PG8_WAIT_L(0); PG8_MMA(0, 0, At, B0); PG8_BAR; PG8_SCHED;
            PG8_LDB(B1, 1, 1); PG8_STAGE(PG8_SB(1, 0), b3, voffB);
            PG8_BAR; PG8_WAIT_L(0); PG8_MMA(0, 1, At, B1); PG8_BAR;
            PG8_LDA(At, 1, 1); PG8_STAGE(PG8_SA(1, 0), a3, voffA);
            PG8_BAR; PG8_WAIT_L(0); PG8_MMA(1, 0, At, B0); PG8_BAR; PG8_SCHED;
            PG8_STAGE(PG8_SB(1, 1), b3 + hstepB, voffB);
            PG8_WAIT_V(6); PG8_BAR; PG8_MMA(1, 1, At, B1); PG8_BAR;
            }
        }
        if constexpr (ALIGN_EPI) { if (wr == 0) PG8_BAR; }
        if constexpr (!Epi::AFTER_DRAIN) { E(acc, cur, wr, wc, fr, fq, lds + STAGE_BYTES, tid); S.done(cur); }
        if (!has_next) break;
#pragma unroll
        for (int a = 0; a < 2; ++a)
#pragma unroll
            for (int b = 0; b < 2; ++b)
#pragma unroll
                for (int m = 0; m < 4; ++m)
#pragma unroll
                    for (int n = 0; n < 2; ++n) acc[a][b][m][n] = (f32x4){0.f, 0.f, 0.f, 0.f};
        cur = nxt; cA = nA; cB = nB; ++ui;
        if constexpr (ALIGN_EPI) { if (wr == 1) PG8_BAR; }
    }
    PG8_WAIT_V(0);
    if constexpr (!ALIGN_EPI) { if (wr == 0) PG8_BAR; }
    PG8_BAR;
    if constexpr (Epi::AFTER_DRAIN) { E.fused(acc, cur, wr, wc, fr, fq, lds, wid, lane); S.done(cur); }
#undef PG8_SA
#undef PG8_SB
#undef PG8_STAGE
#undef PG8_LDA
#undef PG8_LDB
#undef PG8_MMA
#undef PG8_WAIT_V
#undef PG8_WAIT_L
#undef PG8_BAR
#undef PG8_SCHED
}

}

struct SchedGrid {
    int nM, nN, G, c, tag; const char* A; const char* B;
    __device__ __forceinline__ bool next(int i, pg8::Unit& u) const { const long L = (long)i * G + c; if (L >= (long)nM * nN) return false; pg8::order_map((int)L, nM, nN, u.pm, u.pn); u.tag = tag; u.A = A; u.B = B; return true; }
    __device__ __forceinline__ void a_ready(const pg8::Unit&) const {}
    __device__ __forceinline__ void done(const pg8::Unit&) const {}
};
struct SchedTwo {
    int nM0, nN0, nM1, nN1, G, c; const char *A0, *B0, *A1, *B1;
    __device__ __forceinline__ bool next(int i, pg8::Unit& u) const { long L = (long)i * G + c; const long n0 = (long)nM0 * nN0;
        if (L < n0) { pg8::order_map((int)L, nM0, nN0, u.pm, u.pn); u.tag = 0; u.A = A0; u.B = B0; return true; }
        L -= n0; if (L >= (long)nM1 * nN1) return false; pg8::order_map((int)L, nM1, nN1, u.pm, u.pn); u.tag = 1; u.A = A1; u.B = B1; return true; }
    __device__ __forceinline__ void a_ready(const pg8::Unit&) const {}
    __device__ __forceinline__ void done(const pg8::Unit&) const {}
};
struct SchedP4 {
    int nM, nN, G, c; const char* A0; size_t astride; const char* B0; size_t bstride;
    __device__ __forceinline__ bool next(int i, pg8::Unit& u) const { const int j = i % 3, b = (2 * j) % 3; const long L = (long)(i / 3) * G + c; if (L >= (long)nM * nN) return false;
        pg8::order_map((int)L, nM, nN, u.pm, u.pn); u.tag = b + (j > 0 ? 4 : 0); u.A = A0 + (size_t)j * astride; u.B = B0 + (size_t)b * bstride; return true; }
    __device__ __forceinline__ void a_ready(const pg8::Unit&) const {}
    __device__ __forceinline__ void done(const pg8::Unit&) const {}
};
constexpr int LDS_SCR = pg8::STAGE_BYTES, LDS_BYTES = 147456;
#define LASP __attribute__((address_space(3)))
enum { PK_P1 = 0, PK_P2 = 1, PK_P3 = 2, PK_P3B = 3, PK_P4 = 4, PK_P5 = 5 };
__device__ __forceinline__ void gemm_part(const Params& p, LASP unsigned char* lds, int kind, int l, int G, int c, int wid0) {
    constexpr int nR = R / 256;
    if (kind == PK_P1) {
        SchedTwo S{nR, N1 / 256, 2 * W / 256, nR, G, c, (const char*)p.XB(), (const char*)wptr(p, l, WL_W1), (const char*)wptr(p, l, WL_WV), (const char*)p.XB()};
        pg8::EpiAd<F1> E{F1{p, 0}}; pg8::gemm_phase<pg8::EpiAd<F1>, SchedTwo, true, true>(lds, pg8::Gemm{D, D, D}, S, E, wid0);
    } else if (kind == PK_P2) {
        { SchedGrid S{nR, QBW / 256, G, c, 0, (const char*)p.CQ(), (const char*)wptr(p, l, WL_UQ)};
          pg8::EpiAd<FUQ> E{FUQ{p, 0}}; pg8::gemm_phase<pg8::EpiAd<FUQ>, SchedGrid, true, true>(lds, pg8::Gemm{QR, QR, QR}, S, E, wid0); }
        { SchedTwo S{nR, W / 256, W / 256, nR, G, c, (const char*)p.CKV(), (const char*)wptr(p, l, WL_UK), (const char*)wptr(p, l, WL_UV), (const char*)p.CKV()};
          pg8::EpiAd<FUK> E{FUK{p, 0}}; pg8::gemm_phase<pg8::EpiAd<FUK>, SchedTwo, true, true>(lds, pg8::Gemm{KVR, KVR, KVR}, S, E, wid0); }
    } else if (kind == PK_P3B) {
        SchedGrid S{nR, N3 / 256, G, c, 0, (const char*)p.XB2(), (const char*)wptr(p, l, WL_W3)};
        pg8::EpiAd<F3> E{F3{p, l}}; pg8::gemm_phase<pg8::EpiAd<F3>, SchedGrid, true, true>(lds, pg8::Gemm{D, D, D}, S, E, wid0);
    } else if (kind == PK_P4) {
        SchedP4 S{nR, D / 256, G, c, (const char*)p.QSB(), (size_t)((const char*)p.QD() - (const char*)p.QSB()), (const char*)wptr(p, l, WL_WO), (size_t)D * W * 2};
        pg8::EpiAd<F4> E{F4{p, 0}}; pg8::gemm_phase<pg8::EpiAd<F4>, SchedP4, true, true>(lds, pg8::Gemm{W, W, W}, S, E, wid0);
    } else if (kind == PK_P5) {
        SchedGrid S{nR, D / 256, G, c, 0, (const char*)p.G0(), (const char*)wptr(p, l, WL_OUT)};
        pg8::EpiAd<F5> E{F5{p, l == DEPTH - 1 ? 1 : 0}}; pg8::gemm_phase<pg8::EpiAd<F5>, SchedGrid, true, true>(lds, pg8::Gemm{D, D, D}, S, E, wid0);
    }
}
template <int KIND> __global__ void __launch_bounds__(512, 2) k_gemm_fast(Params p, int l) {
    extern __shared__ __attribute__((aligned(16))) unsigned char lds_raw[];
    gemm_part(p, (LASP unsigned char*)lds_raw, KIND, l, (int)gridDim.x, (int)blockIdx.x, __builtin_amdgcn_readfirstlane((int)threadIdx.x >> 6));
}

namespace att {
typedef short bf16x8 __attribute__((ext_vector_type(8)));
typedef float f32x16 __attribute__((ext_vector_type(16)));
typedef unsigned u32x4v __attribute__((ext_vector_type(4)));
__device__ __forceinline__ int crow(int r, int h) { return (r & 3) + 8 * (r >> 2) + 4 * h; }
__device__ __forceinline__ bf16x8 ldg8(const bf16_t* p) { return *(const bf16x8*)p; }
__device__ __forceinline__ void halves(float x, float& lo, float& hi) { auto r = __builtin_amdgcn_permlane32_swap(__float_as_uint(x), __float_as_uint(x), false, false); lo = __uint_as_float(r[0]); hi = __uint_as_float(r[1]); }
__device__ __forceinline__ bf16x8 pack8(const f32x16& v, int b) { u32x4v w; w.x = pk2(v[b], v[b + 1]); w.y = pk2(v[b + 2], v[b + 3]); w.z = pk2(v[b + 4], v[b + 5]); w.w = pk2(v[b + 6], v[b + 7]); return __builtin_bit_cast(bf16x8, w); }
constexpr float SB_DEAD = -152.0f;
#define ATT_FENCE() asm volatile("" ::: "memory")
constexpr int RING_SLOTS = 4, RING_D = 3;
__device__ __forceinline__ void dma16(const void* gsrc, LASP unsigned char* ldst) { __builtin_amdgcn_global_load_lds((const unsigned*)gsrc, (LASP unsigned*)ldst, 16, 0, 0); }
template <int NQB, int NKS, int NKSA, int NDB, bool SBM>
__device__ __forceinline__ void tile_step(const LASP unsigned char* kimg, const LASP unsigned char* krimg, const LASP unsigned char* vimg, const bool first, const bool diag, const int qoff, const int cl, const int h,
                                          const bf16x8 (&qf)[NQB][NKS], f32x16 (&o)[NDB][NQB], float (&mrun)[NQB], float (&lrun)[NQB], float (&carry)[NQB]) {
#define ATT_LDK(dst, g_) do { _Pragma("unroll") for (int j_ = 0; j_ < 2; ++j_) { const int key_ = j_ * 32 + cla; \
        dst[j_] = (g_) < NKSA ? *(const LASP bf16x8*)(kimg + key_ * 128 + (((2 * (g_) + ha) ^ (cla & 7)) << 4)) : *(const LASP bf16x8*)(krimg + key_ * 64 + (((2 * ((g_) - NKSA) + ha) ^ ((cla >> 2) & 3)) << 4)); } } while (0)
#define ATT_LDV(dst, j_) do { _Pragma("unroll") for (int d_ = 0; d_ < NDB; ++d_) dst[d_] = *(const LASP bf16x8*)(vimg + (d_ * 32 + cla) * 128 + (((2 * (j_) + ha) ^ (cla & 7)) << 4)); } while (0)
    int cla = cl, ha = h; asm volatile("" : "+v"(cla), "+v"(ha));
    bf16x8 kf0[2], kf1[2], vf0[NDB], vf1[NDB];
    ATT_LDK(kf0, 0);
    f32x16 s[2][NQB];
#pragma unroll
    for (int kb = 0; kb < 2; ++kb)
#pragma unroll
        for (int qb = 0; qb < NQB; ++qb)
#pragma unroll
            for (int r = 0; r < 16; ++r) s[kb][qb][r] = 0.f;
#pragma unroll
    for (int g = 0; g < NKS; ++g) {
        if (g + 1 < NKS) { if (g & 1) ATT_LDK(kf0, g + 1); else ATT_LDK(kf1, g + 1); } else ATT_LDV(vf0, 0);
        ATT_FENCE();
#pragma unroll
        for (int j = 0; j < 2; ++j)
#pragma unroll
            for (int qb = 0; qb < NQB; ++qb) s[j][qb] = __builtin_amdgcn_mfma_f32_32x32x16_bf16((g & 1) ? kf1[j] : kf0[j], qf[qb][g], s[j][qb], 0, 0, 0);
    }
    if (!SBM) {
        if (first) {
#pragma unroll
            for (int qb = 0; qb < NQB; ++qb) {
#pragma unroll
                for (int r = 0; r < 16; ++r) s[0][qb][r] = -INFINITY;
#pragma unroll
                for (int r = 0; r < 8; ++r) s[1][qb][r] = -INFINITY; } }
#pragma unroll
        for (int qb = 0; qb < NQB; ++qb) {
            float mx = s[0][qb][0];
#pragma unroll
            for (int r = 1; r < 16; ++r) mx = fmaxf(mx, s[0][qb][r]);
#pragma unroll
            for (int r = 0; r < 16; ++r) mx = fmaxf(mx, s[1][qb][r]);
            float m0, m1; halves(mx, m0, m1); const float mn = fmaxf(mrun[qb], fmaxf(m0, m1)); const float f = __builtin_amdgcn_exp2f(mrun[qb] - mn); mrun[qb] = mn;
            float ps = 0.f;
#pragma unroll
            for (int kb = 0; kb < 2; ++kb)
#pragma unroll
                for (int r = 0; r < 16; ++r) { const float pv = __builtin_amdgcn_exp2f(s[kb][qb][r] - mn); s[kb][qb][r] = pv; ps += pv; }
            lrun[qb] = lrun[qb] * f + ps;
#pragma unroll
            for (int d = 0; d < NDB; ++d)
#pragma unroll
                for (int r = 0; r < 16; ++r) o[d][qb][r] *= f;
        }
    } else {
#pragma unroll
        for (int qb = 0; qb < NQB; ++qb) {
            float run = carry[qb];
#pragma unroll
            for (int kb = 1; kb >= 0; --kb)
#pragma unroll
                for (int rg = 3; rg >= 0; --rg) {
                    const bool lead = first && (kb == 0 || rg < 2);
                    float y[4], sp[4]; bool ok[4];
#pragma unroll
                    for (int e = 0; e < 4; ++e) { y[e] = s[kb][qb][4 * rg + e]; ok[e] = !lead && !(diag && (kb * 32 + 8 * rg + 4 * h + e >= qoff + qb * 32 + cl));
                        sp[e] = ok[e] ? fmaxf(y[e], 0.f) + __builtin_amdgcn_logf(1.0f + __builtin_amdgcn_exp2f(-fabsf(y[e]))) : 0.f; }
                    const float gs = -((sp[0] + sp[1]) + (sp[2] + sp[3])); float g0, g1; halves(gs, g0, g1);
                    const float t1 = run; run += g1; const float t0 = run; run += g0; float a = h ? t1 : t0;
#pragma unroll
                    for (int e = 3; e >= 0; --e) { const float w = ok[e] ? __builtin_amdgcn_exp2f((y[e] - sp[e]) + a) : 0.f; a -= sp[e]; s[kb][qb][4 * rg + e] = w; }
                    __builtin_amdgcn_sched_barrier(0); }
            carry[qb] = run;
        }
    }
    ATT_FENCE();
#pragma unroll
    for (int j = 0; j < 4; ++j) {
        if (j + 1 < 4) { if (j & 1) ATT_LDV(vf0, j + 1); else ATT_LDV(vf1, j + 1); }
        ATT_FENCE();
        bf16x8 pf[NQB];
#pragma unroll
        for (int qb = 0; qb < NQB; ++qb) pf[qb] = pack8(s[j >> 1][qb], 8 * (j & 1));
#pragma unroll
        for (int d = 0; d < NDB; ++d)
#pragma unroll
            for (int qb = 0; qb < NQB; ++qb) o[d][qb] = __builtin_amdgcn_mfma_f32_32x32x16_bf16((j & 1) ? vf1[d] : vf0[d], pf[qb], o[d][qb], 0, 0, 0);
    }
#undef ATT_LDK
#undef ATT_LDV
}
template <int NQB, int NDB> __device__ __forceinline__ void store_ot(bf16_t* optr, int ldo, const f32x16 (&o)[NDB][NQB], const float (&sc)[NQB]) {
    int lane_ = lane_id_v(); const int lane = lane_, cl = lane & 31, h = lane >> 5;
#pragma unroll
    for (int qb = 0; qb < NQB; ++qb)
#pragma unroll
        for (int d = 0; d < NDB; ++d)
#pragma unroll
            for (int rg = 0; rg < 4; ++rg) st4(optr + (size_t)(qb * 32 + cl) * ldo + d * 32 + 8 * rg + 4 * h, o[d][qb][4 * rg] * sc[qb], o[d][qb][4 * rg + 1] * sc[qb], o[d][qb][4 * rg + 2] * sc[qb], o[d][qb][4 * rg + 3] * sc[qb]);
}
#define ATT_WAIT(n) asm volatile("s_waitcnt vmcnt(" #n ") lgkmcnt(0)" ::: "memory")
#define ATT_BAR() do { __builtin_amdgcn_s_barrier(); asm volatile("" ::: "memory"); } while (0)
template <bool SBM> __device__ __forceinline__ void unit8(const Params& p, LASP unsigned char* lds, const int wid, const int b, const int h, const int c0, const int nq) {
    constexpr int NKS = SBM ? 4 : 6, NQB = SBM ? 1 : 2, SLOTB = 20480, OFF_V = 8192, OFF_KR = 16384;
    const int lane = lane_id_v(), cl = lane & 31, hh = lane >> 5; const size_t r0 = (size_t)b * TB;
    const int ti = SBM ? wid >> 1 : wid, qoff = SBM ? (wid & 1) * 32 : 0;
    const int qt = c0 + ti, nt = c0 + nq; const bool active = ti < nq;
    const int swz = ((lane & 7) ^ ((lane >> 3) & 7)) << 3;
    const bf16_t* kbase = (SBM ? p.KSB() : p.KNOPE()) + (r0 + wid * 8 + (lane >> 3)) * W + h * 64 + swz;
    const bf16_t* vbase = (SBM ? p.VSBT() : p.VBT()) + (size_t)(h * 64 + wid * 8 + (lane >> 3)) * R + r0 + swz;
    const bf16_t* krbase = p.KR() + (r0 + (wid & 3) * 16 + (lane >> 2)) * 32 + (((lane & 3) ^ ((lane >> 4) & 3)) << 3);
#define U8_ISSUE(t_) do { const int kt_ = SBM ? nt - 1 - (t_) : (t_); LASP unsigned char* sl_ = lds + ((t_) & (RING_SLOTS - 1)) * SLOTB; \
        dma16(kbase + (size_t)kt_ * 64 * W, sl_ + wid * 1024); dma16(vbase + kt_ * 64, sl_ + OFF_V + wid * 1024); \
        if (!SBM) dma16(krbase + (size_t)kt_ * 64 * 32, sl_ + OFF_KR + (wid & 3) * 1024); } while (0)
    bf16x8 qf[NQB][NKS]; f32x16 o[2][NQB]; float mrun[NQB], lrun[NQB], carry[NQB];
    { const bf16_t* qp = SBM ? p.QSB() + (r0 + (size_t)qt * 64 + qoff) * W + h * 64 : p.QB() + (r0 + (size_t)qt * 64) * QBW + h * 96; const int ldq = SBM ? W : QBW;
#pragma unroll
      for (int qb = 0; qb < NQB; ++qb)
#pragma unroll
          for (int ks = 0; ks < NKS; ++ks) { if (active) qf[qb][ks] = ldg8(qp + (size_t)(qb * 32 + cl) * ldq + 16 * ks + 8 * hh); else qf[qb][ks] = (bf16x8){0, 0, 0, 0, 0, 0, 0, 0}; } }
#pragma unroll
    for (int qb = 0; qb < NQB; ++qb) { mrun[qb] = -INFINITY; lrun[qb] = 0.f; carry[qb] = 0.f;
#pragma unroll
        for (int d = 0; d < 2; ++d)
#pragma unroll
            for (int r = 0; r < 16; ++r) o[d][qb][r] = 0.f; }
    volatile LASP unsigned* fl = (volatile LASP unsigned*)(lds + LDS_SCR + 3072);
    if (SBM && lane == 0) fl[8 + wid] = active ? 1u : 0u;
#pragma unroll
    for (int t = 0; t < RING_D; ++t) if (t < nt) U8_ISSUE(t);
    bool dead = !active;
    for (int it = 0; it < nt; ++it) {
        const int rem = nt - 1 - it;
        if (SBM) { if (rem >= 2) ATT_WAIT(4); else if (rem == 1) ATT_WAIT(2); else ATT_WAIT(0); }
        else     { if (rem >= 2) ATT_WAIT(6); else if (rem == 1) ATT_WAIT(3); else ATT_WAIT(0); }
        ATT_BAR();
        if (SBM) { const int pb = ((it + 1) & 1) * 8; const unsigned any = (fl[pb] | fl[pb + 1] | fl[pb + 2] | fl[pb + 3]) | (fl[pb + 4] | fl[pb + 5] | fl[pb + 6] | fl[pb + 7]); if (!any) break; }
        if (it + RING_D < nt) U8_ISSUE(it + RING_D);
        const int kt = SBM ? nt - 1 - it : it;
        if (!dead && kt <= qt) {
            const LASP unsigned char* sl = lds + (it & (RING_SLOTS - 1)) * SLOTB;
            tile_step<NQB, NKS, 4, 2, SBM>(sl, sl + OFF_KR, sl + OFF_V, kt == 0, kt == qt, qoff, cl, hh, qf, o, mrun, lrun, carry);
            if (SBM) { bool dd = true;
#pragma unroll
                for (int qb = 0; qb < NQB; ++qb) dd = dd && (carry[qb] < SB_DEAD);
                dead = __all(dd) != 0; }
        }
        if (SBM && lane == 0) fl[(it & 1) * 8 + wid] = (!dead && kt > 0) ? 1u : 0u;
    }
    if (active) {
        if (SBM) { float one[NQB];
#pragma unroll
            for (int qb = 0; qb < NQB; ++qb) one[qb] = 1.f;
            store_ot<NQB, 2>(p.QSB() + (r0 + (size_t)qt * 64 + qoff) * W + h * 64, W, o, one); }
        else { float il[NQB];
#pragma unroll
            for (int qb = 0; qb < NQB; ++qb) { float l0, l1; halves(lrun[qb], l0, l1); il[qb] = 1.0f / (l0 + l1); }
            store_ot<NQB, 2>(p.OMLA() + (r0 + (size_t)qt * 64) * W + h * 64, W, o, il); }
    }
    ATT_WAIT(0); ATT_BAR();
#undef U8_ISSUE
}
__device__ __forceinline__ void unit_diff(const Params& p, LASP unsigned char* lds, const int wid, const int layer, const int b, const int head, const int c0, const int nq) {
    constexpr int SLOTB = 32768, OFF_K1 = 8192, OFF_V = 16384;
    const int lane = lane_id_v(), cl = lane & 31, hh = lane >> 5, g = wid >> 2, mp = (wid >> 1) & 1, qh = wid & 1; const size_t r0 = (size_t)b * TB;
    const int qt = c0 + g, nt = c0 + nq; const bool active = g < nq;
    const int swz = ((lane & 7) ^ ((lane >> 3) & 7)) << 3;
    const bf16_t* kbase = p.KD() + (r0 + wid * 8 + (lane >> 3)) * W + head * 128 + swz;
    const bf16_t* vbase = p.VDT() + (size_t)(head * 128 + wid * 8 + (lane >> 3)) * R + r0 + swz;
#define UD_ISSUE(t_) do { const int kt_ = (t_); LASP unsigned char* sl_ = lds + ((t_) & (RING_SLOTS - 1)) * SLOTB; \
        dma16(kbase + (size_t)kt_ * 64 * W, sl_ + wid * 1024); dma16(kbase + (size_t)kt_ * 64 * W + 64, sl_ + OFF_K1 + wid * 1024); \
        dma16(vbase + kt_ * 64, sl_ + OFF_V + wid * 1024); dma16(vbase + (size_t)64 * R + kt_ * 64, sl_ + OFF_V + (wid + 8) * 1024); } while (0)
    bf16x8 qf[1][4]; f32x16 o[4][1]; float mrun[1], lrun[1], carry[1];
    { const bf16_t* qp = p.QD() + (r0 + (size_t)qt * 64 + qh * 32) * W + head * 128 + mp * 64;
#pragma unroll
      for (int ks = 0; ks < 4; ++ks) { if (active) qf[0][ks] = ldg8(qp + (size_t)cl * W + 16 * ks + 8 * hh); else qf[0][ks] = (bf16x8){0, 0, 0, 0, 0, 0, 0, 0}; } }
    mrun[0] = -INFINITY; lrun[0] = 0.f; carry[0] = 0.f;
#pragma unroll
    for (int d = 0; d < 4; ++d)
#pragma unroll
        for (int r = 0; r < 16; ++r) o[d][0][r] = 0.f;
#pragma unroll
    for (int t = 0; t < RING_D; ++t) if (t < nt) UD_ISSUE(t);
    for (int it = 0; it < nt; ++it) {
        const int rem = nt - 1 - it;
        if (rem >= 2) ATT_WAIT(8); else if (rem == 1) ATT_WAIT(4); else ATT_WAIT(0);
        ATT_BAR();
        if (it + RING_D < nt) UD_ISSUE(it + RING_D);
        if (active && it <= qt) { const LASP unsigned char* sl = lds + (it & (RING_SLOTS - 1)) * SLOTB;
            tile_step<1, 4, 4, 4, false>(sl + mp * OFF_K1, sl, sl + OFF_V, it == 0, false, 0, cl, hh, qf, o, mrun, lrun, carry); }
    }
    ATT_WAIT(0); ATT_BAR();
    if (active) { float l0, l1; halves(lrun[0], l0, l1); const float il = 1.0f / (l0 + l1);
        LASP float* reg = (LASP float*)(lds + wid * 16384);
#pragma unroll
        for (int d = 0; d < 4; ++d)
#pragma unroll
            for (int r = 0; r < 16; ++r) reg[cl * 128 + ((d * 32 + crow(r, hh)) ^ cl)] = o[d][0][r] * il; }
    ATT_WAIT(0); ATT_BAR();
    if (active) { const float lam = p.lamv()[layer], lam_init = __uint_as_float(__builtin_amdgcn_readfirstlane(layer == 0 ? 0x3e4ccccdu : 0x3eb60549u));
      const LASP float* r0p = (const LASP float*)(lds + ((g * 2 + 0) * 2 + qh) * 16384); const LASP float* r1p = (const LASP float*)(lds + ((g * 2 + 1) * 2 + qh) * 16384);
      const int ql = mp * 16 + (lane >> 2), part = lane & 3; float v[32]; float ss = 0.f;
#pragma unroll
      for (int i = 0; i < 32; ++i) { const int ii = (i + 8 * part) & 31; const int a = ql * 128 + ((part * 32 + ii) ^ ql); v[i] = r0p[a] - lam * r1p[a]; ss += v[i] * v[i]; }
      ss = quad4_sum(ss);
      const float rs = rsq(ss * (1.0f / 128.0f) + EPS) * (1.0f - lam_init); const float* gn = p.dnorm_g + (size_t)layer * 128 + part * 32;
      bf16_t* op = p.QD() + (r0 + (size_t)qt * 64 + qh * 32 + ql) * W + head * 128 + part * 32;
#pragma unroll
      for (int i = 0; i < 32; i += 2) { const int ii = (i + 8 * part) & 31;
          st2(op + ii, v[i] * rs * gn[ii], v[i + 1] * rs * gn[ii + 1]); } }
    ATT_WAIT(0); ATT_BAR();
#undef UD_ISSUE
}
enum { AK_P2 = 0, AK_P3 = 1 };
__device__ __forceinline__ void attn_part(const Params& p, LASP unsigned char* lds, int kind, int layer, int wid, int rep = 0) {
    const bool leader = wid == 0 && lane_id_v() == 0;
    volatile LASP int* slot = (volatile LASP int*)(lds + LDS_SCR + 2048);
    unsigned* ctr = p.ctl() + 1024 + 64 * (layer * 2 + kind + 4 * rep);
    constexpr int NT = TB / 64;
    static_assert((NT - 1) % 8 == 0, "query tile grouping");
    constexpr int NG8 = (NT - 1) / 8 + 1, NG4 = (NT - 1) / 4 + 1, NGD = (NT - 1) / 2 + 1;
    constexpr int N8 = NB * NH * NG8, N4 = NB * NH * NG4, ND = NB * NHD * NGD;
    const int nitems = kind == AK_P2 ? ND + N4 : N8;
    for (int n = 0;; ++n) {
        if (leader) slot[n & 1] = (int)atomicAdd(ctr, 1u);
        asm volatile("s_waitcnt vmcnt(0) lgkmcnt(0)" ::: "memory"); __builtin_amdgcn_s_barrier(); asm volatile("" ::: "memory");
        int item = __builtin_amdgcn_readfirstlane(slot[n & 1]);
        if (item >= nitems) break;
        if (kind == AK_P2) {
            if (item < ND) { const int u = item / (NB * NHD), j = item % (NB * NHD); const bool single = u == NGD - 1;
                unit_diff(p, lds, wid, layer, j / NHD, j % NHD, single ? 0 : NT - 2 - 2 * u, single ? 1 : 2); }
            else { item -= ND; const int u = item / (NB * NH), j = item % (NB * NH); const bool single = u == NG4 - 1;
                unit8<true>(p, lds, wid, j / NH, j % NH, single ? 0 : NT - 4 - 4 * u, single ? 1 : 4); }
        } else { const int u = item / (NB * NH), j = item % (NB * NH); const bool single = u == NG8 - 1;
            unit8<false>(p, lds, wid, j / NH, j % NH, single ? 0 : NT - 8 - 8 * u, single ? 1 : 8); }
    }
}
}
template <int KIND> __global__ void __launch_bounds__(512, 2) k_attn_fast(Params p, int l) {
    extern __shared__ __attribute__((aligned(16))) unsigned char lds_raw[];
    att::attn_part(p, (LASP unsigned char*)lds_raw, KIND, l, __builtin_amdgcn_readfirstlane((int)threadIdx.x >> 6));
}

#define XB_TMO      128
#define XB_XCNT(j)  (256  + 64 * (j))
#define XB_XSUB(j)  (1280 + 64 * (j))
#define XB_XGEN(j)  (2304 + 64 * (j))
#define XB_TOP      3328
#define XB_TOPGEN   3392
#define XCD_BAR_WORDS 3456
#define XB_SPIN_CAP (1u << 18)
__device__ __forceinline__ unsigned xb_ld(unsigned* p)              { return __hip_atomic_load(p, __ATOMIC_RELAXED, __HIP_MEMORY_SCOPE_AGENT); }
__device__ __forceinline__ unsigned xb_add(unsigned* p, unsigned v) { return __hip_atomic_fetch_add(p, v, __ATOMIC_RELAXED, __HIP_MEMORY_SCOPE_AGENT); }
__device__ __forceinline__ unsigned xb_xcc_id() { return (unsigned)__builtin_amdgcn_s_getreg((3 << 11) | 20) & 0xFu; }
#define XB_SPIN(cond, bar) do { unsigned _sp = 0; while (cond) { __builtin_amdgcn_s_sleep(1); \
    if ((++_sp & 255u) == 0u) { if (xb_ld(&(bar)[XB_TMO])) break; if (_sp > XB_SPIN_CAP) { atomicAdd(&(bar)[XB_TMO], 1u); break; } } } } while (0)
struct XcdBarrier { unsigned* bar; unsigned x; volatile LASP unsigned* st; };
__device__ __forceinline__ XcdBarrier xcd_barrier_post(unsigned* bar, volatile LASP unsigned* st, bool leader) {
    XcdBarrier b; b.bar = bar; b.x = xb_xcc_id(); b.st = st;
    if (leader) (void)xb_add(&bar[XB_XCNT(b.x)], 1u);
    return b;
}
__device__ __forceinline__ void xcd_barrier_complete(unsigned* bar, unsigned x, unsigned& nloc, unsigned& nx) {
    const unsigned G = gridDim.x * gridDim.y * gridDim.z;
    unsigned sum, cnt, mine, sp = 0u;
    for (;;) {
        sum = 0u; cnt = 0u; mine = 0u;
#pragma unroll
        for (unsigned j = 0; j < 16; ++j) { const unsigned c = xb_ld(&bar[XB_XCNT(j)]); sum += c; cnt += (c > 0u) ? 1u : 0u; mine = (j == x) ? c : mine; }
        if (sum == G) break;
        __builtin_amdgcn_s_sleep(1);
        if ((++sp & 255u) == 0u) { if (xb_ld(&bar[XB_TMO])) break; if (sp > XB_SPIN_CAP) { atomicAdd(&bar[XB_TMO], 1u); break; } }
    }
    nloc = mine > 0u ? mine : 1u; nx = cnt > 0u ? cnt : 1u;
}
__device__ __forceinline__ void xcd_barrier(const XcdBarrier& b, const int wid0) {
    const bool leader = wid0 == 0 && lane_id_v() == 0;
    asm volatile("s_waitcnt vmcnt(0)" ::: "memory");
    __syncthreads();
    if (leader) {
        unsigned* bar = b.bar;
        __builtin_amdgcn_s_waitcnt(0);
        unsigned nloc = b.st[0], nx = b.st[1];
        if (nloc == 0u) { xcd_barrier_complete(bar, b.x, nloc, nx); b.st[0] = nloc; b.st[1] = nx; }
        const unsigned old = xb_add(&bar[XB_XSUB(b.x)], 1u);
        const unsigned gen = old / nloc;
        if (old + 1u == (gen + 1u) * nloc) {
            __builtin_amdgcn_fence(__ATOMIC_RELEASE, "agent");
            asm volatile("s_waitcnt vmcnt(0)" ::: "memory");
            const unsigned og = xb_add(&bar[XB_TOP], 1u);
            const unsigned tg = og / nx;
            if (og + 1u == (tg + 1u) * nx) xb_add(&bar[XB_TOPGEN], 1u);
            else XB_SPIN(xb_ld(&bar[XB_TOPGEN]) == tg, bar);
            __builtin_amdgcn_fence(__ATOMIC_ACQUIRE, "agent");
            xb_add(&bar[XB_XGEN(b.x)], 1u);
            asm volatile("s_waitcnt vmcnt(0)" ::: "memory");
        } else {
            XB_SPIN(xb_ld(&bar[XB_XGEN(b.x)]) == gen, bar);
            __builtin_amdgcn_fence(__ATOMIC_ACQUIRE, "agent");
            asm volatile("s_waitcnt vmcnt(0)" ::: "memory");
        }
    }
    __syncthreads();
}

typedef float f32x4v __attribute__((ext_vector_type(4)));
typedef unsigned u32x4w __attribute__((ext_vector_type(4)));
__device__ __forceinline__ float rope_inv(int e, int dim) { return exp2f(-(float)e / (float)dim * 18.931568569324174f); }
__device__ __forceinline__ void rope_cs(float ang, float& cs, float& sn) { const double t = (double)ang * 0.15915494309189535; const float a = (float)((t - rint(t)) * 6.283185307179586); cs = cosf(a); sn = sinf(a); }
template <int MAP> __device__ __forceinline__ int prep_src(int n) { if (MAP == 0) return src_w1(n); if (MAP == 1) return src_wv(n); if (MAP == 2) return src_w3(n); if (MAP == 3) return src_uq(n); if (MAP == 4) return src_uk(n); if (MAP == 5) return src_uv(n); return n; }
struct alignas(8) F2v { float x, y; };
template <int MAP> __device__ __forceinline__ void prep_item(const float* src, int src_ld, const float* rowscale, bf16_t* dst, int N, int K, int item, int lane, LASP float* scr) {
    const int nblk = N / 32, kb = item / nblk, nb = item % nblk, k0 = 64 * kb, n0 = 32 * nb, g4 = 4 * (lane & 7), kr = lane >> 3;
    const int s0 = prep_src<MAP>(n0 + g4), s2 = prep_src<MAP>(n0 + g4 + 2);
    const bool quad = s0 >= 0 && s2 == s0 + 2 && (s0 & 3) == 0;
#pragma unroll
    for (int i = 0; i < 8; ++i) { const int kk = 8 * i + kr; const float* row = src + (size_t)(k0 + kk) * src_ld; const float sc = rowscale ? rowscale[k0 + kk] : 1.f;
        F4v v = {0.f, 0.f, 0.f, 0.f};
        if (quad) v = *(const F4v*)(row + s0); else if (s0 >= 0) { const F2v a = *(const F2v*)(row + s0), b2 = *(const F2v*)(row + s2); v.x = a.x; v.y = a.y; v.z = b2.x; v.w = b2.y; }
        LASP float* t = scr + kk * 33 + g4; t[0] = v.x * sc; t[1] = v.y * sc; t[2] = v.z * sc; t[3] = v.w * sc; }
    asm volatile("s_waitcnt lgkmcnt(0)" ::: "memory");
    const int c = lane & 7;
#pragma unroll
    for (int j = 0; j < 4; ++j) { const int n = (lane >> 3) + 8 * j; const LASP float* t = scr + (8 * c) * 33 + n;
        u32x4w o; o.x = pk2(t[0 * 33], t[1 * 33]); o.y = pk2(t[2 * 33], t[3 * 33]); o.z = pk2(t[4 * 33], t[5 * 33]); o.w = pk2(t[6 * 33], t[7 * 33]);
        *(u32x4w*)(dst + (size_t)(n0 + n) * K + k0 + 8 * c) = o; }
    asm volatile("s_waitcnt lgkmcnt(0)" ::: "memory");
}
__device__ __forceinline__ void prologue_part(const Params& p, LASP unsigned char* lds, int G, int c, int wave) {
    int lane_ = lane_id_v(); const int lane = lane_;
    const int gw = c * 8 + wave, NGW = G * 8;
    for (int i = gw * 64 + lane; i < NPOS * 16; i += NGW * 64) {
        { const int pos = i / 16, j = i % 16; const float ang = (float)pos * rope_inv(2 * j, 32); float cs, sn; rope_cs(ang, cs, sn); p.cosm()[i] = cs; p.sinm()[i] = sn; }
        if (i < NPOS * 8) { const int pos = i / 8, j = i % 8; const float ang = (float)pos * rope_inv(2 * j, 16); float cs, sn; rope_cs(ang, cs, sn); p.cosd()[i] = cs; p.sind()[i] = sn; }
        if (i < DEPTH) { const float* lm = p.dlam + i * 4 * 64; float s0 = 0.f, s1 = 0.f; for (int d = 0; d < 64; ++d) { s0 += lm[d] * lm[64 + d]; s1 += lm[128 + d] * lm[192 + d]; }
            p.lamv()[i] = expf(s0) - expf(s1) + (i == 0 ? 0.2f : 0.35550906759f); }
    }
    LASP float* scr = (LASP float*)(lds + wave * 16384);
    constexpr int I_W1 = (D / 64) * (N1 / 32), I_WV = (D / 64) * (2 * W / 32), I_W3 = (D / 64) * (N3 / 32), I_UQ = (QR / 64) * (QBW / 32), I_UK = (KVR / 64) * (W / 32), I_WO = (W / 64) * (D / 32), I_OUT = (D / 64) * (D / 32);
    constexpr int I_L = I_W1 + I_WV + I_W3 + I_UQ + 2 * I_UK + 3 * I_WO + I_OUT;
    for (int it = gw; it < 2 * I_L; it += NGW) {
        const int l = it / I_L; int r = it % I_L;
        const float* win = p.w_in + (size_t)l * D * INC; const float* ng = p.norm_g + l * D;
        if (r < I_W1) { prep_item<0>(win, INC, ng, wptr(p, l, WL_W1), N1, D, r, lane, scr); continue; } r -= I_W1;
        if (r < I_WV) { prep_item<1>(win, INC, ng, wptr(p, l, WL_WV), 2 * W, D, r, lane, scr); continue; } r -= I_WV;
        if (r < I_W3) { prep_item<2>(win, INC, ng, wptr(p, l, WL_W3), N3, D, r, lane, scr); continue; } r -= I_W3;
        if (r < I_UQ) { prep_item<3>(p.w_uq + (size_t)l * QR * QBW, QBW, p.cq_g + l * QR, wptr(p, l, WL_UQ), QBW, QR, r, lane, scr); continue; } r -= I_UQ;
        if (r < I_UK) { prep_item<4>(p.w_ukv + (size_t)l * KVR * NH * 128, NH * 128, p.ckv_g + l * KVR, wptr(p, l, WL_UK), W, KVR, r, lane, scr); continue; } r -= I_UK;
        if (r < I_UK) { prep_item<5>(p.w_ukv + (size_t)l * KVR * NH * 128, NH * 128, p.ckv_g + l * KVR, wptr(p, l, WL_UV), W, KVR, r, lane, scr); continue; } r -= I_UK;
        if (r < 3 * I_WO) { const int b = r / I_WO; const float* const w0 = opq(p.w_osb); const float* const w1 = opq(p.w_omla); const float* const w2 = opq(p.w_odiff); const float* wo = (b == 0 ? w0 : b == 1 ? w1 : w2) + (size_t)l * W * D;
            prep_item<6>(wo, D, nullptr, wptr(p, l, WL_WO) + (size_t)b * D * W, D, W, r % I_WO, lane, scr); continue; } r -= 3 * I_WO;
        prep_item<6>(p.w_out + (size_t)l * D * D, D, nullptr, wptr(p, l, WL_OUT), D, D, r, lane, scr);
    }
    for (int row = gw; row < R; row += NGW) {
        const int b = row / TB, t = row % TB; f32x4v v[D / 256]; float ss = 0.f;
#pragma unroll
        for (int j = 0; j < D / 256; ++j) { const int col = 256 * j + 4 * lane;
            if (t < LEAD) v[j] = (f32x4v){0.f, 0.f, 0.f, 0.f}; else if (t < LEAD + NMETA) v[j] = *(const f32x4v*)(p.meta + (size_t)(t - LEAD) * D + col); else v[j] = *(const f32x4v*)(p.x + ((size_t)b * SEQ + (t - LEAD - NMETA)) * D + col);
            ss += (v[j].x * v[j].x + v[j].y * v[j].y) + (v[j].z * v[j].z + v[j].w * v[j].w); }
        ss = wave_sum(ss);
#pragma unroll
        for (int j = 0; j < D / 256; ++j) { const int col = 256 * j + 4 * lane; *(f32x4v*)(p.X() + (size_t)row * D + col) = v[j]; st4(p.XB() + (size_t)row * D + col, v[j].x, v[j].y, v[j].z, v[j].w); }
        if (lane < NSX) p.ssx()[(size_t)row * NSX + lane] = lane == 0 ? ss : 0.f;
    }
}
__device__ __forceinline__ void x2bf_part(const Params& p, int G, int c, int wave) {
    int lane_ = lane_id_v(); const int lane = lane_;
    for (int row = c * 8 + wave; row < R; row += G * 8) {
#pragma unroll
        for (int j = 0; j < D / 256; ++j) { const int col = 256 * j + 4 * lane; const f32x4v v = *(const f32x4v*)(p.X() + (size_t)row * D + col); st4(p.XB2() + (size_t)row * D + col, v.x, v.y, v.z, v.w); } }
}
__device__ __forceinline__ void final_part(const Params& p, int G, int c, int wave) {
    int lane_ = lane_id_v(); const int lane = lane_;
    for (int i = c * 8 + wave; i < NB * SEQ; i += G * 8) {
        const int b = i / SEQ, sq = i % SEQ; const float* x = p.X() + ((size_t)b * TB + LEAD + NMETA + sq) * D; f32x4v v[D / 256]; float ss = 0.f;
#pragma unroll
        for (int j = 0; j < D / 256; ++j) { v[j] = *(const f32x4v*)(x + 256 * j + 4 * lane); ss += (v[j].x * v[j].x + v[j].y * v[j].y) + (v[j].z * v[j].z + v[j].w * v[j].w); }
        const float rs = rsq(wave_sum(ss) * (1.0f / D) + EPS);
#pragma unroll
        for (int j = 0; j < D / 256; ++j) { const f32x4v g = *(const f32x4v*)(p.final_g + 256 * j + 4 * lane); *(f32x4v*)(p.out + (size_t)i * D + 256 * j + 4 * lane) = v[j] * rs * g; }
    }
}
constexpr int N_PHASES = 2 + 6 * DEPTH;
constexpr int CW_QUEUE = 1024, CW_BAR = 4096;
#define MK_SEAM(k) do { if ((k) + 1 < ph_hi) xcd_barrier(bar, wid0); } while (0)
#define MK_IN(k) (ph_lo <= (k) && (k) < ph_hi)
#ifndef PROBE_DUP
#define PROBE_DUP 0
#endif
template <int L> __device__ __forceinline__ void layer_phases(const Params& p, LASP unsigned char* lds, const XcdBarrier& bar, int ph_lo, int ph_hi, int G, int c, int wid0) {
    constexpr int B0 = 1 + 6 * L;
    if (MK_IN(B0 + 0)) { gemm_part(p, lds, PK_P1, L, G, c, wid0); if (PROBE_DUP & 2) gemm_part(p, lds, PK_P1, L, G, c, wid0); MK_SEAM(B0 + 0); }
    if (MK_IN(B0 + 1)) { gemm_part(p, lds, PK_P2, L, G, c, wid0); att::attn_part(p, lds, att::AK_P2, L, wid0); MK_SEAM(B0 + 1); }
    if (MK_IN(B0 + 2)) { x2bf_part(p, G, c, wid0); att::attn_part(p, lds, att::AK_P3, L, wid0); if (PROBE_DUP & 4) { x2bf_part(p, G, c, wid0); att::attn_part(p, lds, att::AK_P3, L, wid0, 1); } MK_SEAM(B0 + 2); }
    if (MK_IN(B0 + 3)) { gemm_part(p, lds, PK_P3B, L, G, c, wid0); MK_SEAM(B0 + 3); }
    if (MK_IN(B0 + 4)) { gemm_part(p, lds, PK_P4, L, G, c, wid0); if (PROBE_DUP & 8) gemm_part(p, lds, PK_P4, L, G, c, wid0); MK_SEAM(B0 + 4); }
    if (MK_IN(B0 + 5)) { gemm_part(p, lds, PK_P5, L, G, c, wid0); MK_SEAM(B0 + 5); }
}
__global__ void __launch_bounds__(512, 2) mk_fwd(Params p, int ph_lo, int ph_hi) {
    extern __shared__ __attribute__((aligned(16))) unsigned char lds_raw[];
    LASP unsigned char* lds = (LASP unsigned char*)lds_raw;
    volatile LASP unsigned* misc = (volatile LASP unsigned*)(lds + LDS_SCR + 4096);
    const int wid0 = __builtin_amdgcn_readfirstlane((int)threadIdx.x >> 6);
    if (threadIdx.x < 64) misc[threadIdx.x] = 0u;
    __syncthreads();
    const int G = (int)gridDim.x, c = (int)blockIdx.x;
    const XcdBarrier bar = xcd_barrier_post(p.ctl() + CW_BAR, misc + 8, threadIdx.x == 0);
    if (MK_IN(0)) { prologue_part(p, lds, G, c, wid0); if (PROBE_DUP & 1) prologue_part(p, lds, G, c, wid0); MK_SEAM(0); }
    layer_phases<0>(p, lds, bar, ph_lo, ph_hi, G, c, wid0);
    layer_phases<1>(p, lds, bar, ph_lo, ph_hi, G, c, wid0);
    if (MK_IN(N_PHASES - 1)) { final_part(p, G, c, wid0); if (PROBE_DUP & 1) final_part(p, G, c, wid0); }
}
#endif

#ifdef HOST_EMU
typedef int hipStream_t;
#endif
#define NBLK(n, t) (((long)(n) + (t) - 1) / (t))
#ifndef HOST_EMU
#ifndef MK_SPLIT
#define MK_SPLIT 0
#endif
extern "C" void kernel_launch(void* const* d_in, const int* in_sizes, int n_in, void* d_out, int out_size, void* d_ws, size_t ws_size, hipStream_t stream) {
    if (n_in != 16 || in_sizes[0] != NB * SEQ * D || out_size != NB * SEQ * D || ws_size < WS_NEED) { fprintf(stderr, "kernel_launch: unexpected shapes / workspace (%d inputs, ws %zu, need %zu)\n", n_in, ws_size, (size_t)WS_NEED); return; }
    static int grid = 0;
    if (grid == 0) { int dev = 0, cus = 0; (void)hipGetDevice(&dev); (void)hipDeviceGetAttribute(&cus, hipDeviceAttributeMultiprocessorCount, dev); grid = cus > 0 ? cus : 256;
        if (hipFuncSetAttribute((const void*)mk_fwd, hipFuncAttributeMaxDynamicSharedMemorySize, LDS_BYTES) != hipSuccess) { fprintf(stderr, "kernel_launch: hipFuncSetAttribute failed\n"); grid = -1; } }
    if (grid < 0) return;
    const Params p = make_params(d_in, d_out, d_ws);
    (void)hipMemsetAsync((char*)d_ws + O_CTL, 0, 65536, stream);
#if MK_SPLIT
    for (int ph = 0; ph < N_PHASES; ++ph) hipLaunchKernelGGL(mk_fwd, dim3(grid), dim3(512), LDS_BYTES, stream, p, ph, ph + 1);
#else
    hipLaunchKernelGGL(mk_fwd, dim3(grid), dim3(512), LDS_BYTES, stream, p, 0, N_PHASES);
#endif
}
#else
extern "C" void kernel_launch(void* const* d_in, const int* in_sizes, int n_in, void* d_out, int out_size, void* d_ws, size_t ws_size, hipStream_t stream) {
    if (n_in != 16 || in_sizes[0] != NB * SEQ * D || out_size != NB * SEQ * D || ws_size < WS_NEED) { fprintf(stderr, "kernel_launch: unexpected shapes / workspace (%d inputs, ws %zu, need %zu)\n", n_in, ws_size, (size_t)WS_NEED); return; }
    const Params p = make_params(d_in, d_out, d_ws);
    const int T = 256;
#if 0
        (void)hipFuncSetAttribute((const void*)k_gemm_fast<PK_P1>, hipFuncAttributeMaxDynamicSharedMemorySize, LDS_BYTES); hipFuncSetAttribute((const void*)k_gemm_fast<PK_P2>, hipFuncAttributeMaxDynamicSharedMemorySize, LDS_BYTES);
        hipFuncSetAttribute((const void*)k_gemm_fast<PK_P3B>, hipFuncAttributeMaxDynamicSharedMemorySize, LDS_BYTES); hipFuncSetAttribute((const void*)k_gemm_fast<PK_P4>, hipFuncAttributeMaxDynamicSharedMemorySize, LDS_BYTES);
        hipFuncSetAttribute((const void*)k_gemm_fast<PK_P5>, hipFuncAttributeMaxDynamicSharedMemorySize, LDS_BYTES);
        hipFuncSetAttribute((const void*)k_attn_fast<att::AK_P2>, hipFuncAttributeMaxDynamicSharedMemorySize, LDS_BYTES); hipFuncSetAttribute((const void*)k_attn_fast<att::AK_P3>, hipFuncAttributeMaxDynamicSharedMemorySize, LDS_BYTES); }
    (void)hipMemsetAsync((char*)d_ws + O_CTL, 0, 65536, stream);
#endif
    LAUNCH(k_tables, NBLK(NPOS * 16, T), T, p);
    for (int l = 0; l < DEPTH; ++l) {
        LAUNCH(k_prep_w<0>, NBLK((long)N1 * D, T), T, wptr(p, l, WL_W1), N1, D, p.w_in + (size_t)l * D * INC, INC, p.norm_g + l * D);
        LAUNCH(k_prep_w<1>, NBLK((long)2 * W * D, T), T, wptr(p, l, WL_WV), 2 * W, D, p.w_in + (size_t)l * D * INC, INC, p.norm_g + l * D);
        LAUNCH(k_prep_w<2>, NBLK((long)N3 * D, T), T, wptr(p, l, WL_W3), N3, D, p.w_in + (size_t)l * D * INC, INC, p.norm_g + l * D);
        LAUNCH(k_prep_w<3>, NBLK((long)QBW * QR, T), T, wptr(p, l, WL_UQ), QBW, QR, p.w_uq + (size_t)l * QR * QBW, QBW, p.cq_g + l * QR);
        LAUNCH(k_prep_w<4>, NBLK((long)W * KVR, T), T, wptr(p, l, WL_UK), W, KVR, p.w_ukv + (size_t)l * KVR * NH * 128, NH * 128, p.ckv_g + l * KVR);
        LAUNCH(k_prep_w<5>, NBLK((long)W * KVR, T), T, wptr(p, l, WL_UV), W, KVR, p.w_ukv + (size_t)l * KVR * NH * 128, NH * 128, p.ckv_g + l * KVR);
        LAUNCH(k_prep_w<6>, NBLK((long)D * W, T), T, wptr(p, l, WL_WO), D, W, p.w_osb + (size_t)l * W * D, D, (const float*)nullptr);
        LAUNCH(k_prep_w<6>, NBLK((long)D * W, T), T, wptr(p, l, WL_WO) + (size_t)D * W, D, W, p.w_omla + (size_t)l * W * D, D, (const float*)nullptr);
        LAUNCH(k_prep_w<6>, NBLK((long)D * W, T), T, wptr(p, l, WL_WO) + (size_t)2 * D * W, D, W, p.w_odiff + (size_t)l * W * D, D, (const float*)nullptr);
        LAUNCH(k_prep_w<6>, NBLK((long)D * D, T), T, wptr(p, l, WL_OUT), D, D, p.w_out + (size_t)l * D * D, D, (const float*)nullptr);
    }
    LAUNCH(k_init_x, NBLK((long)R * D, T), T, p);
    LAUNCH(k_ssq_f32, NBLK(R, 64), 64, (const float*)p.X(), D, p.ssx(), NSX);
    for (int l = 0; l < DEPTH; ++l) {
        const int last = (l == DEPTH - 1) ? 1 : 0; (void)last;
#ifndef HOST_EMU
        FASTG(PK_P1, l);
        FASTG(PK_P2, l);
#else
        LAUNCH(k_gemm<F1>, NBLK((long)R * (V1_END / 8), T), T, (const bf16_t*)p.XB(), D, (const bf16_t*)wptr(p, l, WL_W1), D, R, V1_END, D, p, 0, 0);
        LAUNCH(k_gemm<F1>, NBLK((long)2 * W * (R / 8), T), T, (const bf16_t*)wptr(p, l, WL_WV), D, (const bf16_t*)p.XB(), D, 2 * W, R, D, p, 0, 1);
        LAUNCH(k_ssq_bf, NBLK(R, 64), 64, (const bf16_t*)p.CQ(), QR, p.ssq(), NSQ);
        LAUNCH(k_ssq_bf, NBLK(R, 64), 64, (const bf16_t*)p.CKV(), KVR, p.ssk(), NSK);
        LAUNCH(k_gemm<FUQ>, NBLK((long)R * (QBW / 8), T), T, (const bf16_t*)p.CQ(), QR, (const bf16_t*)wptr(p, l, WL_UQ), QR, R, QBW, QR, p, 0, 0);
        LAUNCH(k_gemm<FUK>, NBLK((long)R * (W / 8), T), T, (const bf16_t*)p.CKV(), KVR, (const bf16_t*)wptr(p, l, WL_UK), KVR, R, W, KVR, p, 0, 0);
        LAUNCH(k_gemm<FUK>, NBLK((long)W * (R / 8), T), T, (const bf16_t*)wptr(p, l, WL_UV), KVR, (const bf16_t*)p.CKV(), KVR, W, R, KVR, p, 0, 1);
#endif
#ifndef HOST_EMU
        hipLaunchKernelGGL(k_attn_fast<att::AK_P2>, dim3(grid), dim3(512), LDS_BYTES, stream, p, l);
        hipLaunchKernelGGL(k_attn_fast<att::AK_P3>, dim3(grid), dim3(512), LDS_BYTES, stream, p, l);
#else
        LAUNCH(k_attn_sb, NBLK((long)NB * NH * TB, 64), 64, p);
        LAUNCH(k_attn_diff, NBLK((long)NB * NHD * TB, 64), 64, p, l);
        LAUNCH(k_attn_mla, NBLK((long)NB * NH * TB, 64), 64, p);
#endif
        LAUNCH(k_x2bf, NBLK((long)R * D, T), T, p);
#ifndef HOST_EMU
        FASTG(PK_P3B, l); FASTG(PK_P4, l); FASTG(PK_P5, l);
#else
        LAUNCH(k_gemm<F3>, NBLK((long)R * (N3 / 8), T), T, (const bf16_t*)p.XB2(), D, (const bf16_t*)wptr(p, l, WL_W3), D, R, N3, D, p, l, 0);
        LAUNCH(k_gemm<F4>, NBLK((long)R * (D / 8), T), T, (const bf16_t*)p.QSB(), W, (const bf16_t*)wptr(p, l, WL_WO), W, R, D, W, p, 0, 0);
        LAUNCH(k_gemm<F4>, NBLK((long)R * (D / 8), T), T, (const bf16_t*)p.OMLA(), W, (const bf16_t*)(wptr(p, l, WL_WO) + (size_t)D * W), W, R, D, W, p, 0, 5);
        LAUNCH(k_gemm<F4>, NBLK((long)R * (D / 8), T), T, (const bf16_t*)p.QD(), W, (const bf16_t*)(wptr(p, l, WL_WO) + (size_t)2 * D * W), W, R, D, W, p, 0, 6);
        LAUNCH(k_gemm<F5>, NBLK((long)R * (D / 8), T), T, (const bf16_t*)p.G0(), D, (const bf16_t*)wptr(p, l, WL_OUT), D, R, D, D, p, last, 0);
        if (!last) LAUNCH(k_ssq_f32, NBLK(R, 64), 64, (const float*)p.X(), D, p.ssx(), NSX);
#endif
    }
    LAUNCH(k_final, NBLK((long)NB * SEQ, 64), 64, p);
}
#endif
```

```cpp
#ifndef HOST_EMU
#include <hip/hip_runtime.h>
#endif
#include <cstdio>
#include <cstdint>
#include <cmath>
#include <cstring>

#ifndef CFG_B
#define CFG_B 8
#endif
#ifndef CFG_S
#define CFG_S 2048
#endif
#ifndef CFG_D
#define CFG_D 1024
#endif

typedef unsigned short bf16_t;

namespace cfg {
constexpr int NB = CFG_B, SEQ = CFG_S, D = CFG_D, DEPTH = 2;
constexpr int NMETA = 16, LEAD = 48, TB = LEAD + NMETA + SEQ, R = NB * TB, NPOS = NMETA + SEQ;
constexpr int W = D / 2;
constexpr int NH = D / 128;
constexpr int NHD = D / 256;
constexpr int QR = 3 * D / 8, KVR = D / 4, QBW = NH * 96;
constexpr int INC = 4 * W + QR + KVR + 32 + W + 4 * W + 3 * D;
constexpr int C_SBQ = 0, C_SBK = W, C_SBV = 2 * W, C_SBZ = 3 * W, C_CQ = 4 * W, C_CKV = C_CQ + QR, C_KR = C_CKV + KVR, C_MZ = C_KR + 32,
              C_DQ = C_MZ + W, C_DK = C_DQ + W, C_DV = C_DK + W, C_DZ = C_DV + W, C_G = C_DZ + W;
static_assert(C_G + 3 * D == INC, "w_in columns");
constexpr int V1_SBQ = 0, V1_SBK = W, V1_CQ = 2 * W, V1_CKV = V1_CQ + QR, V1_KR = V1_CKV + KVR, V1_DQ = V1_KR + 32, V1_DK = V1_DQ + W, V1_END = V1_DK + W;
constexpr int N1 = (V1_END + 255) / 256 * 256;
constexpr int N3 = 3 * W + 3 * D;
constexpr int NSX = D / 32, NSQ = QR / 32, NSK = KVR / 32;
constexpr float EPS = 1e-6f, LOG2E = 1.4426950408889634f;
constexpr int GP = D / 256;
constexpr int LT_ROW0 = (R / 256 - 2) * 256;
}
using namespace cfg;

#ifdef HOST_EMU
#define DEVFN inline
#define HDFN inline
#else
#define DEVFN __device__ __forceinline__
#define HDFN __host__ __device__ __forceinline__
#endif
constexpr size_t MiB = size_t(1) << 20;
constexpr size_t al256(size_t x) { return (x + 255) & ~size_t(255); }
constexpr size_t SZ_W = (size_t)R * W * 2, SZ_D2 = (size_t)R * D * 2, SZ_X = (size_t)R * D * 4, SZ_CQ = (size_t)R * QR * 2, SZ_CKV = (size_t)R * KVR * 2,
                 SZ_KR = (size_t)R * 32 * 2, SZ_QB = (size_t)R * QBW * 2, SZ_GP = (size_t)R * 256 * 2;
constexpr size_t WB_W1 = (size_t)N1 * D * 2, WB_WV = (size_t)2 * W * D * 2, WB_W3 = (size_t)N3 * D * 2, WB_UQ = (size_t)QBW * QR * 2, WB_UK = (size_t)W * KVR * 2,
                 WB_UV = WB_UK, WB_WO = (size_t)3 * D * W * 2, WB_OUT = (size_t)D * D * 2;
constexpr size_t WL_W1 = 0, WL_WV = WL_W1 + WB_W1, WL_W3 = WL_WV + WB_WV, WL_UQ = WL_W3 + WB_W3, WL_UK = WL_UQ + WB_UQ, WL_UV = WL_UK + WB_UK, WL_WO = WL_UV + WB_UV,
                 WL_OUT = WL_WO + WB_WO, WL_BYTES = al256(WL_OUT + WB_OUT);
constexpr bool STDCFG = (NB == 8 && SEQ == 2048 && D == 1024);
#if defined(HOST_EMU)
constexpr bool HANDMAP = false;
#else
constexpr bool HANDMAP = STDCFG;
#endif
constexpr size_t O_CTL = 0, O_TAB = 1 * MiB, O_LAM = O_TAB + 768 * 1024, O_SSX = 2 * MiB, O_SSQ = O_SSX + al256((size_t)R * NSX * 4), O_SSK = O_SSQ + al256((size_t)R * NSQ * 4),
                 O_WTS = al256(O_SSK + (size_t)R * NSK * 4 + MiB) / MiB * MiB;
constexpr size_t O_X = HANDMAP ? 52 * MiB : al256(O_WTS + 2 * WL_BYTES);
static_assert(O_WTS + 2 * WL_BYTES <= O_X, "weights overrun X");
constexpr size_t O_A = O_X + al256(SZ_X);
constexpr size_t Q_QSB = O_A, Q_QD = Q_QSB + al256(SZ_W), Q_OMLA = Q_QD + al256(SZ_W), Q_KSB = Q_OMLA + al256(SZ_W), Q_VSBT = Q_KSB + al256(SZ_W), Q_KD = Q_VSBT + al256(SZ_W),
                 Q_VDT = Q_KD + al256(SZ_W), Q_VBT = Q_VDT + al256(SZ_W), Q_KR = Q_VBT + al256(SZ_W), Q_CKV = Q_KR + al256(SZ_KR), Q_XB2 = Q_CKV + al256(SZ_CKV), Q_G0 = Q_XB2 + al256(SZ_D2),
                 Q_GPC = Q_G0 + al256(SZ_D2), Q_XB = Q_GPC + 2 * GP * al256(SZ_GP), Q_QB = Q_XB + al256(SZ_D2), Q_CQ = Q_QB + al256(SZ_QB), Q_KNOPE = Q_CQ + al256(SZ_CQ), Q_END = Q_KNOPE + al256(SZ_W);
constexpr size_t WS_NEED = HANDMAP ? 256 * MiB : Q_END;

constexpr size_t mibf(double m) { return (size_t)(m * 1048576.0); }
struct Params {
    const float *x, *meta, *norm_g, *w_in, *b_gate, *cq_g, *ckv_g, *w_uq, *w_ukv, *dlam, *dnorm_g, *w_osb, *w_omla, *w_odiff, *w_out, *final_g;
    float* out; char* ws;
#define WS_F32(name, off) HDFN float* name() const { return (float*)(ws + (off)); }
#define WS_B16(name, off) HDFN bf16_t* name() const { return (bf16_t*)(ws + (off)); }
#define OB_B16(name, offh, offq) HDFN bf16_t* name() const { return HANDMAP ? (bf16_t*)((char*)out + (offh)) : (bf16_t*)(ws + (offq)); }
    HDFN unsigned* ctl() const { return (unsigned*)(ws + O_CTL); }
    WS_F32(cosm, O_TAB) WS_F32(sinm, O_TAB + (size_t)NPOS * 16 * 4) WS_F32(cosd, O_TAB + (size_t)NPOS * 32 * 4) WS_F32(sind, O_TAB + (size_t)NPOS * 40 * 4) WS_F32(lamv, O_LAM)
    WS_F32(ssx, O_SSX) WS_F32(ssq, O_SSQ) WS_F32(ssk, O_SSK) WS_F32(X, O_X)
    HDFN char* WTS() const { return ws + O_WTS; }
    WS_B16(QSB, HANDMAP ? mibf(118) : Q_QSB) WS_B16(QD, HANDMAP ? mibf(134.5) : Q_QD) WS_B16(OMLA, HANDMAP ? mibf(151) : Q_OMLA) WS_B16(CKV, HANDMAP ? mibf(151) : Q_CKV) WS_B16(KSB, HANDMAP ? mibf(167.5) : Q_KSB)
    WS_B16(VSBT, HANDMAP ? mibf(184) : Q_VSBT) WS_B16(KD, HANDMAP ? mibf(200.5) : Q_KD) WS_B16(VDT, HANDMAP ? mibf(217) : Q_VDT) WS_B16(VBT, HANDMAP ? mibf(233.5) : Q_VBT) WS_B16(KR, HANDMAP ? mibf(250) : Q_KR)
    WS_B16(XB2, HANDMAP ? mibf(167.5) : Q_XB2) WS_B16(G0, HANDMAP ? mibf(200.5) : Q_G0)
    OB_B16(XB, 0, Q_XB) OB_B16(QB, 0, Q_QB) OB_B16(CQ, mibf(33), Q_CQ) OB_B16(KNOPE, mibf(45.5), Q_KNOPE)
    HDFN unsigned char* G8() const { return HANDMAP ? (unsigned char*)out : (unsigned char*)(ws + Q_GPC); }
};
static Params make_params(void* const* d_in, void* d_out, void* d_ws) {
    Params p{};
    const float* const* in = (const float* const*)d_in;
    p.x = in[0]; p.meta = in[1]; p.norm_g = in[2]; p.w_in = in[3]; p.b_gate = in[4]; p.cq_g = in[5]; p.ckv_g = in[6]; p.w_uq = in[7]; p.w_ukv = in[8]; p.dlam = in[9];
    p.dnorm_g = in[10]; p.w_osb = in[11]; p.w_omla = in[12]; p.w_odiff = in[13]; p.w_out = in[14]; p.final_g = in[15];
    p.out = (float*)d_out; p.ws = (char*)d_ws;
    return p;
}
static_assert(!STDCFG || (SZ_W == (size_t)(16.5 * 1048576) && SZ_D2 == 33 * MiB && SZ_GP == (size_t)(8.25 * 1048576) && SZ_QB == (size_t)(24.75 * 1048576) && SZ_CQ <= (size_t)(12.5 * 1048576) &&
              SZ_KR <= (size_t)(1.1 * 1048576) && SZ_X == 66 * MiB && GP == 4), "hand map sizes");

#ifdef HOST_EMU
template <class T> DEVFN T* opq(T* p) { return p; }
#else
DEVFN int lane_id_v() { int l; asm volatile("v_mbcnt_lo_u32_b32 %0, -1, 0\n\tv_mbcnt_hi_u32_b32 %0, -1, %0" : "=v"(l)); return l; }
template <class T> DEVFN T* opq(T* p) { asm volatile("" : "+s"(p)); return p; }
#endif
DEVFN float bf2f(bf16_t h) { unsigned u = (unsigned)h << 16; float f; memcpy(&f, &u, 4); return f; }
DEVFN bf16_t f2bf(float f) { unsigned u; memcpy(&u, &f, 4); return (bf16_t)((u + 0x7fffu + ((u >> 16) & 1u)) >> 16); }
struct alignas(16) U4 { unsigned x, y, z, w; };
DEVFN void ld8(const bf16_t* p, float* o) {
    const U4 v = *(const U4*)p; const unsigned u[4] = {v.x, v.y, v.z, v.w};
#pragma unroll
    for (int i = 0; i < 4; ++i) { unsigned lo = u[i] << 16, hi = u[i] & 0xffff0000u; memcpy(&o[2 * i], &lo, 4); memcpy(&o[2 * i + 1], &hi, 4); }
}
DEVFN float rsq(float x) { return 1.0f / sqrtf(x); }
DEVFN float rstd_slots(const float* s, int row, int ns, float invn) { float t = 0.f; for (int i = 0; i < ns; ++i) t += s[(size_t)row * ns + i]; return rsq(t * invn + EPS); }
DEVFN int sperm(int r) { return (r & ~12) | ((r & 4) << 1) | ((r & 8) >> 1); }
static_assert((size_t)R * 3 * D <= (HANDMAP ? 64 * MiB : 2 * GP * al256(SZ_GP)), "gate buffer");
DEVFN unsigned char* g8ptr(const Params& p, int b, int row, int c) { return p.G8() + (size_t)row * (3 * D) + b * D + c; }
HDFN bf16_t* wptr(const Params& p, int l, size_t off) { return (bf16_t*)(p.WTS() + (size_t)l * WL_BYTES + off); }
#ifdef HOST_EMU
DEVFN float sigm_f(float z) { return 1.f / (1.f + expf(-z)); }
#define UNI(x) (x)
#else
DEVFN float sigm_f(float z) { return __builtin_amdgcn_rcpf(1.0f + __builtin_amdgcn_exp2f(-1.4426950408889634f * z)); }
#define UNI(x) __builtin_amdgcn_readfirstlane(x)
#endif
DEVFN float silu_f(float z) { return z * sigm_f(z); }
struct alignas(8) U2 { unsigned x, y; };
#ifdef HOST_EMU
DEVFN unsigned pk2(float lo, float hi) { return (unsigned)f2bf(lo) | ((unsigned)f2bf(hi) << 16); }
#else
typedef float f32x2_t __attribute__((ext_vector_type(2))); typedef __bf16 bf16x2_t __attribute__((ext_vector_type(2)));
DEVFN unsigned pk2(float lo, float hi) { f32x2_t v = {lo, hi}; bf16x2_t b = __builtin_convertvector(v, bf16x2_t); return __builtin_bit_cast(unsigned, b); }
#endif
DEVFN void st4(bf16_t* p, float a, float b, float c, float d) { U2 v; v.x = pk2(a, b); v.y = pk2(c, d); *(U2*)p = v; }
DEVFN void st2(bf16_t* p, float a, float b) { *(unsigned*)p = pk2(a, b); }
DEVFN void st8(bf16_t* p, const float* v) { U4 w; w.x = pk2(v[0], v[1]); w.y = pk2(v[2], v[3]); w.z = pk2(v[4], v[5]); w.w = pk2(v[6], v[7]); *(U4*)p = w; }
DEVFN void up8(const U4& v, float* o) { const unsigned u[4] = {v.x, v.y, v.z, v.w};
#pragma unroll
    for (int i = 0; i < 4; ++i) { unsigned lo = u[i] << 16, hi = u[i] & 0xffff0000u; memcpy(&o[2 * i], &lo, 4); memcpy(&o[2 * i + 1], &hi, 4); } }
struct alignas(16) F4v { float x, y, z, w; };
#ifdef HOST_EMU
DEVFN U2 q8pack(const float* g) { unsigned w[2] = {0u, 0u}; for (int i = 0; i < 8; ++i) { float t = g[i] * 255.f + 0.5f; unsigned q = t <= 0.f ? 0u : t >= 255.f ? 255u : (unsigned)t; w[i >> 2] |= q << (8 * (i & 3)); } U2 r; r.x = w[0]; r.y = w[1]; return r; }
DEVFN void q8unpack(const U2& w, float* g) { for (int i = 0; i < 8; ++i) g[i] = (float)(((i < 4 ? w.x : w.y) >> (8 * (i & 3))) & 255u) * (1.0f / 255.0f); }
#else
DEVFN U2 q8pack(const float* g) { U2 r; r.x = 0u; r.y = 0u;
    r.x = __builtin_amdgcn_cvt_pk_u8_f32(g[0] * 255.f, 0, r.x); r.x = __builtin_amdgcn_cvt_pk_u8_f32(g[1] * 255.f, 1, r.x); r.x = __builtin_amdgcn_cvt_pk_u8_f32(g[2] * 255.f, 2, r.x); r.x = __builtin_amdgcn_cvt_pk_u8_f32(g[3] * 255.f, 3, r.x);
    r.y = __builtin_amdgcn_cvt_pk_u8_f32(g[4] * 255.f, 0, r.y); r.y = __builtin_amdgcn_cvt_pk_u8_f32(g[5] * 255.f, 1, r.y); r.y = __builtin_amdgcn_cvt_pk_u8_f32(g[6] * 255.f, 2, r.y); r.y = __builtin_amdgcn_cvt_pk_u8_f32(g[7] * 255.f, 3, r.y); return r; }
DEVFN void q8unpack(const U2& w, float* g) { const float k = 1.0f / 255.0f;
    g[0] = (float)(w.x & 255u) * k; g[1] = (float)((w.x >> 8) & 255u) * k; g[2] = (float)((w.x >> 16) & 255u) * k; g[3] = (float)(w.x >> 24) * k;
    g[4] = (float)(w.y & 255u) * k; g[5] = (float)((w.y >> 8) & 255u) * k; g[6] = (float)((w.y >> 16) & 255u) * k; g[7] = (float)(w.y >> 24) * k; }
#endif
DEVFN void ld4(const bf16_t* p, float* o) { const U2 v = *(const U2*)p; unsigned t; t = v.x << 16; memcpy(&o[0], &t, 4); t = v.x & 0xffff0000u; memcpy(&o[1], &t, 4); t = v.y << 16; memcpy(&o[2], &t, 4); t = v.y & 0xffff0000u; memcpy(&o[3], &t, 4); }

DEVFN int rotmap(int c, int half) { const int g = c >> 2, e = c & 3; return e < 2 ? 2 * g + e : half + 2 * g + (e - 2); }
DEVFN int src_w1(int n) {
    if (n < V1_SBK) return C_SBQ + n;
    if (n < V1_CQ) return C_SBK + (n - V1_SBK);
    if (n < V1_CKV) return C_CQ + (n - V1_CQ);
    if (n < V1_KR) return C_CKV + (n - V1_CKV);
    if (n < V1_DQ) return C_KR + rotmap(n - V1_KR, 16);
    if (n < V1_DK) { const int c = n - V1_DQ, cc = c & 63; return C_DQ + (c & ~63) + (cc < 16 ? rotmap(cc, 8) : cc); }
    if (n < V1_END) { const int c = n - V1_DK, cc = c & 63; return C_DK + (c & ~63) + (cc < 16 ? rotmap(cc, 8) : cc); }
    return -1;
}
DEVFN int src_wv(int n) { return n < W ? C_SBV + n : C_DV + (n - W); }
DEVFN int src_w3(int n) { return n < W ? C_SBZ + n : n < 2 * W ? C_MZ + (n - W) : n < 3 * W ? C_DZ + (n - 2 * W) : C_G + (n - 3 * W); }
DEVFN int src_uq(int n) { const int h = n / 96, cc = n % 96; return h * 96 + (cc < 64 ? cc : 64 + rotmap(cc - 64, 16)); }
DEVFN int src_uk(int n) { return (n >> 6) * 128 + (n & 63); }
DEVFN int src_uv(int n) { return (n >> 6) * 128 + 64 + (n & 63); }

#ifdef HOST_EMU
DEVFN float quad_sum(float s) { return s; }
#else
template <int CTRL> DEVFN float dpp_get(float s) { return __int_as_float(__builtin_amdgcn_update_dpp(0, __float_as_int(s), CTRL, 0xf, 0xf, true)); }
DEVFN float xor16_sum(float s) { auto r = __builtin_amdgcn_permlane16_swap(__float_as_uint(s), __float_as_uint(s), false, false); return __uint_as_float(r[0]) + __uint_as_float(r[1]); }
DEVFN float xor32_sum(float s) { auto r = __builtin_amdgcn_permlane32_swap(__float_as_uint(s), __float_as_uint(s), false, false); return __uint_as_float(r[0]) + __uint_as_float(r[1]); }
DEVFN float quad_sum(float s) { return xor32_sum(xor16_sum(s)); }
DEVFN float quad4_sum(float s) { s += dpp_get<0xB1>(s); s += dpp_get<0x4E>(s); return s; }
DEVFN float wave_sum(float s) { s = quad4_sum(s); s += dpp_get<0x124>(s); s += dpp_get<0x128>(s); return xor32_sum(xor16_sum(s)); }
#endif
struct NoPre {};
DEVFN float ssq8(const float* v) { return ((v[0] * v[0] + v[1] * v[1]) + (v[2] * v[2] + v[3] * v[3])) + ((v[4] * v[4] + v[5] * v[5]) + (v[6] * v[6] + v[7] * v[7])); }
DEVFN void rope4(bf16_t* o, int half, int g, const float* v, const float* cs, const float* sn, float sc) {
    const float c0 = cs[2 * g], c1 = cs[2 * g + 1], s0 = sn[2 * g], s1 = sn[2 * g + 1];
    st2(o + 2 * g, (v[0] * c0 - v[2] * s0) * sc, (v[1] * c1 - v[3] * s1) * sc); st2(o + half + 2 * g, (v[2] * c0 + v[0] * s0) * sc, (v[3] * c1 + v[1] * s1) * sc);
}
struct F1 {
    const Params& p; int aux; typedef NoPre Pre;
    DEVFN bool swapped(int tag) const { return tag == 1; }
    DEVFN float scale(int tag, int idx) const { return rstd_slots(p.ssx(), idx, NSX, 1.0f / D); }
    DEVFN void preload(int, int, int, Pre&) const {}
    DEVFN float apply(int tag, int row, int vc, const float* a, const float* sc, const Pre&) const {
        if (tag == 1) { const bool sb = UNI(row) < W; bf16_t* const vs = opq(p.VSBT()); bf16_t* const vd = opq(p.VDT()); bf16_t* o = (sb ? vs + (size_t)row * R : vd + (size_t)(row - W) * R) + (vc & ~15);
            const int t0 = vc & 15;
            st4(o + sperm(t0), a[0] * sc[0], a[1] * sc[1], a[2] * sc[2], a[3] * sc[3]); st4(o + sperm(t0 + 4), a[4] * sc[4], a[5] * sc[5], a[6] * sc[6], a[7] * sc[7]); return 0.f; }
        const int vcu = UNI(vc); const float rs = sc[0]; float v[8];
#pragma unroll
        for (int i = 0; i < 8; ++i) v[i] = a[i] * rs;
        const int t = row % TB; const int pos = t >= LEAD ? t - LEAD : 0;
        if (vcu < V1_SBK) {
#pragma unroll
            for (int i = 0; i < 8; ++i) v[i] *= 0.125f * LOG2E;
            st8(p.QSB() + (size_t)row * W + vc, v); }
        else if (vcu < V1_CQ) { st8(p.KSB() + (size_t)row * W + (vc - V1_SBK), v); }
        else if (vcu < V1_CKV) { st8(p.CQ() + (size_t)row * QR + (vc - V1_CQ), v); return ssq8(v); }
        else if (vcu < V1_KR) { st8(p.CKV() + (size_t)row * KVR + (vc - V1_CKV), v); return ssq8(v); }
        else if (vcu < V1_DQ) { const int g = (vc - V1_KR) >> 2; bf16_t* o = p.KR() + (size_t)row * 32; rope4(o, 16, g, v, p.cosm() + pos * 16, p.sinm() + pos * 16, 1.f); rope4(o, 16, g + 1, v + 4, p.cosm() + pos * 16, p.sinm() + pos * 16, 1.f); }
        else if (vcu < V1_END) { const bool isq = vcu < V1_DK; const int c = vc - (isq ? V1_DQ : V1_DK), cc = c & 63; const float sc2 = isq ? 0.125f * LOG2E : 1.0f;
            bf16_t* const qd = opq(p.QD()); bf16_t* const kd = opq(p.KD()); bf16_t* o = (isq ? qd : kd) + (size_t)row * W + (c & ~63);
            if (cc < 16  ) { const int g = cc >> 2; rope4(o, 8, g, v, p.cosd() + pos * 8, p.sind() + pos * 8, sc2); rope4(o, 8, g + 1, v + 4, p.cosd() + pos * 8, p.sind() + pos * 8, sc2); }
            else {
#pragma unroll
                for (int i = 0; i < 8; ++i) v[i] *= sc2;
                st8(o + cc, v); } }
        return 0.f;
    }
    DEVFN void rowslot(int tag, int row, int vc0, int fq, float part) const {
        if (tag != 0 || vc0 < V1_CQ || vc0 >= V1_KR) return;
        const float s = quad_sum(part);
        if (fq == 0) { if (vc0 < V1_CKV) p.ssq()[(size_t)row * NSQ + ((vc0 - V1_CQ) >> 5)] = s; else p.ssk()[(size_t)row * NSK + ((vc0 - V1_CKV) >> 5)] = s; }
    }
};
struct FUQ {
    const Params& p; int aux; typedef NoPre Pre;
    DEVFN bool swapped(int) const { return false; }
    DEVFN float scale(int, int idx) const { return rstd_slots(p.ssq(), idx, NSQ, 1.0f / QR) * (LOG2E * 0.10206207261596577f); }
    DEVFN void preload(int, int, int, Pre&) const {}
    DEVFN float apply(int, int row, int vc, const float* a, const float* sc, const Pre&) const {
        const float rs = sc[0]; float v[8];
#pragma unroll
        for (int i = 0; i < 8; ++i) v[i] = a[i] * rs;
        const int t = row % TB; const int pos = t >= LEAD ? t - LEAD : 0;
        const int h = vc / 96, cc = vc % 96; bf16_t* o = p.QB() + (size_t)row * QBW + h * 96;
        if (UNI(vc) % 96 < 64) st8(o + cc, v);
        else { const int g = (cc - 64) >> 2; rope4(o + 64, 16, g, v, p.cosm() + pos * 16, p.sinm() + pos * 16, 1.f); rope4(o + 64, 16, g + 1, v + 4, p.cosm() + pos * 16, p.sinm() + pos * 16, 1.f); }
        return 0.f;
    }
    DEVFN void rowslot(int, int, int, int, float) const {}
};
struct FUK {
    const Params& p; int aux; typedef NoPre Pre;
    DEVFN bool swapped(int tag) const { return tag == 1; }
    DEVFN float scale(int, int idx) const { return rstd_slots(p.ssk(), idx, NSK, 1.0f / KVR); }
    DEVFN void preload(int, int, int, Pre&) const {}
    DEVFN float apply(int tag, int row, int vc, const float* a, const float* sc, const Pre&) const {
        if (tag == 1) { bf16_t* o = p.VBT() + (size_t)row * R + (vc & ~15); const int t0 = vc & 15;
            st4(o + sperm(t0), a[0] * sc[0], a[1] * sc[1], a[2] * sc[2], a[3] * sc[3]); st4(o + sperm(t0 + 4), a[4] * sc[4], a[5] * sc[5], a[6] * sc[6], a[7] * sc[7]); }
        else { float v[8];
#pragma unroll
            for (int i = 0; i < 8; ++i) v[i] = a[i] * sc[0];
            st8(p.KNOPE() + (size_t)row * W + vc, v); }
        return 0.f;
    }
    DEVFN void rowslot(int, int, int, int, float) const {}
};
struct F3 {
    const Params& p; int layer; typedef U4 Pre;
    DEVFN bool swapped(int) const { return false; }
    DEVFN float scale(int, int idx) const { return rstd_slots(p.ssx(), idx, NSX, 1.0f / D); }
    DEVFN bf16_t* optr(int row, int vc) const { const int vcu = UNI(vc); bf16_t* const o0 = opq(p.QSB()); bf16_t* const o1 = opq(p.OMLA()); bf16_t* const o2 = opq(p.QD()); return (vcu < W ? o0 : vcu < 2 * W ? o1 : o2) + (size_t)row * W + (vc % W); }
    DEVFN void preload(int, int row, int vc, Pre& pre) const { if (UNI(vc) < 3 * W) pre = *(const U4*)optr(row, vc); }
    DEVFN float apply(int, int row, int vc, const float* a, const float* sc, const Pre& pre) const {
        const float rs = sc[0]; float v[8];
        if (UNI(vc) < 3 * W) { float ov[8]; up8(pre, ov);
#pragma unroll
            for (int i = 0; i < 8; ++i) v[i] = ov[i] * silu_f(a[i] * rs);
            st8(optr(row, vc), v); }
        else { const int c = vc - 3 * W, cu = UNI(c), b = cu / D, cc = c - b * D; const F4v b0 = *(const F4v*)(p.b_gate + (size_t)layer * 3 * D + c), b1 = *(const F4v*)(p.b_gate + (size_t)layer * 3 * D + c + 4);
            v[0] = sigm_f(a[0] * rs + b0.x); v[1] = sigm_f(a[1] * rs + b0.y); v[2] = sigm_f(a[2] * rs + b0.z); v[3] = sigm_f(a[3] * rs + b0.w);
            v[4] = sigm_f(a[4] * rs + b1.x); v[5] = sigm_f(a[5] * rs + b1.y); v[6] = sigm_f(a[6] * rs + b1.z); v[7] = sigm_f(a[7] * rs + b1.w);
            *(U2*)g8ptr(p, b, row, cc) = q8pack(v); }
        return 0.f;
    }
    DEVFN void rowslot(int, int, int, int, float) const {}
};
struct F4 {
    const Params& p; int aux; struct Pre { U2 g; U4 m; };
    DEVFN bool swapped(int) const { return false; }
    DEVFN float scale(int, int) const { return 1.f; }
    DEVFN bf16_t* tptr(int b, int row, int c) const { return p.XB2() + ((size_t)b * (R - LT_ROW0) + (row - LT_ROW0)) * D + c; }
    DEVFN void preload(int tag, int row, int c, Pre& pre) const { pre.g = *(const U2*)g8ptr(p, tag & 3, row, c); if (tag & 4) pre.m = *(const U4*)(p.G0() + (size_t)row * D + c); }
    DEVFN float apply(int tag, int row, int c, const float* a, const float*, const Pre& pre) const {
        float g[8], m[8], v[8]; q8unpack(pre.g, g);
        if (tag & 4) up8(pre.m, m); else {
#pragma unroll
            for (int i = 0; i < 8; ++i) m[i] = 0.f; }
#pragma unroll
        for (int i = 0; i < 8; ++i) v[i] = m[i] + g[i] * a[i];
        st8((tag & 8) ? tptr(tag & 3, row, c) : p.G0() + (size_t)row * D + c, v); return 0.f;
    }
    DEVFN void rowslot(int, int, int, int, float) const {}
};
struct F5 {
    const Params& p; int last; struct Pre { F4v x0, x1; };
    DEVFN bool swapped(int) const { return false; }
    DEVFN float scale(int, int) const { return 1.f; }
    DEVFN void preload(int, int row, int c, Pre& pre) const { const F4v* x = (const F4v*)(p.X() + (size_t)row * D + c); pre.x0 = x[0]; pre.x1 = x[1]; }
    DEVFN float apply(int, int row, int c, const float* a, const float*, const Pre& pre) const {
        float v[8] = {pre.x0.x + a[0], pre.x0.y + a[1], pre.x0.z + a[2], pre.x0.w + a[3], pre.x1.x + a[4], pre.x1.y + a[5], pre.x1.z + a[6], pre.x1.w + a[7]};
        F4v* x = (F4v*)(p.X() + (size_t)row * D + c); x[0] = F4v{v[0], v[1], v[2], v[3]}; x[1] = F4v{v[4], v[5], v[6], v[7]};
        if (!last) st8(p.XB() + (size_t)row * D + c, v);
        return ssq8(v);
    }
    DEVFN void rowslot(int, int row, int vc0, int fq, float part) const { const float s = quad_sum(part); if (fq == 0) p.ssx()[(size_t)row * NSX + (vc0 >> 5)] = s; }
};

#ifdef HOST_EMU
struct dim3e { unsigned x, y, z; };
static dim3e threadIdx, blockIdx, blockDim, gridDim;
#define GLOBAL static
#define LB64
#define LAUNCH(kern, nblk, nthr, ...) do { gridDim.x = (unsigned)(nblk); blockDim.x = (unsigned)(nthr); for (unsigned b_ = 0; b_ < gridDim.x; ++b_) for (unsigned t_ = 0; t_ < blockDim.x; ++t_) { blockIdx.x = b_; threadIdx.x = t_; kern(__VA_ARGS__); } } while (0)
#else
#define GLOBAL __global__
#define LB64 __launch_bounds__(64)
#define LAUNCH(kern, nblk, nthr, ...) kern<<<dim3((unsigned)(nblk)), dim3((unsigned)(nthr)), 0, stream>>>(__VA_ARGS__)
#endif
#define GTID ((long)blockIdx.x * blockDim.x + threadIdx.x)

#ifdef HOST_EMU
template <int MAP> GLOBAL void k_prep_w(bf16_t* dst, int N, int K, const float* src, int src_ld, const float* rowscale) {
    const long i = GTID; if (i >= (long)N * K) return;
    const int n = (int)(i % N), k = (int)(i / N);
    int s;
    if (MAP == 0) s = src_w1(n); else if (MAP == 1) s = src_wv(n); else if (MAP == 2) s = src_w3(n); else if (MAP == 3) s = src_uq(n); else if (MAP == 4) s = src_uk(n); else if (MAP == 5) s = src_uv(n); else s = n;
    float v = 0.f; if (s >= 0) v = src[(size_t)k * src_ld + s] * (rowscale ? rowscale[k] : 1.f);
    dst[(size_t)n * K + k] = f2bf(v);
}
GLOBAL void k_tables(Params p) {
    const long i = GTID;
    if (i < NPOS * 16) { const int pos = (int)(i / 16), j = (int)(i % 16); const float inv = (float)pow(500000.0, -(double)(2 * j) / 32.0); const float ang = (float)pos * inv;
        p.cosm()[i] = (float)cos((double)ang); p.sinm()[i] = (float)sin((double)ang); }
    if (i < NPOS * 8) { const int pos = (int)(i / 8), j = (int)(i % 8); const float inv = (float)pow(500000.0, -(double)(2 * j) / 16.0); const float ang = (float)pos * inv;
        p.cosd()[i] = (float)cos((double)ang); p.sind()[i] = (float)sin((double)ang); }
    if (i < DEPTH) { const float* lm = p.dlam + i * 4 * 64; float s0 = 0.f, s1 = 0.f; for (int d = 0; d < 64; ++d) { s0 += lm[d] * lm[64 + d]; s1 += lm[128 + d] * lm[192 + d]; }
        p.lamv()[i] = expf(s0) - expf(s1) + (0.8f - 0.6f * expf(-0.3f * (float)i)); }
}
GLOBAL void k_init_x(Params p) {
    const long i = GTID; if (i >= (long)R * D) return;
    const int row = (int)(i / D), c = (int)(i % D), b = row / TB, t = row % TB;
    const float v = t < LEAD ? 0.f : t < LEAD + NMETA ? p.meta[(t - LEAD) * D + c] : p.x[((size_t)b * SEQ + (t - LEAD - NMETA)) * D + c];
    p.X()[i] = v; p.XB()[i] = f2bf(v);
}
GLOBAL void k_x2bf(Params p) { const long i = GTID; if (i >= (long)R * D) return; p.XB2()[i] = f2bf(p.X()[i]); }
GLOBAL void k_ssq_f32(const float* X, int n, float* slots, int ns) {
    const long row = GTID; if (row >= R) return; float s = 0.f; for (int c = 0; c < n; ++c) { const float v = X[(size_t)row * n + c]; s += v * v; }
    slots[row * ns] = s; for (int i = 1; i < ns; ++i) slots[row * ns + i] = 0.f;
}
GLOBAL void k_ssq_bf(const bf16_t* X, int n, float* slots, int ns) {
    const long row = GTID; if (row >= R) return; float s = 0.f; for (int c = 0; c < n; ++c) { const float v = bf2f(X[(size_t)row * n + c]); s += v * v; }
    slots[row * ns] = s; for (int i = 1; i < ns; ++i) slots[row * ns + i] = 0.f;
}
GLOBAL void k_final(Params p) {
    const long i = GTID; if (i >= (long)NB * SEQ) return;
    const int b = (int)(i / SEQ), s = (int)(i % SEQ); const float* x = p.X() + ((size_t)b * TB + LEAD + NMETA + s) * D; float ss = 0.f;
    for (int c = 0; c < D; ++c) ss += x[c] * x[c];
    const float rs = rsq(ss / D + EPS); float* o = p.out + (size_t)i * D;
    for (int c = 0; c < D; ++c) o[c] = x[c] * rs * p.final_g[c];
}

template <class Epi> GLOBAL void k_gemm(const bf16_t* A, int lda, const bf16_t* Bt, int ldb, int M, int N, int K, Params pp, int aux, int tag) {
    const Epi epi{pp, aux};
    const long idx = GTID; const int n8 = N / 8; if (idx >= (long)M * n8) return;
    const int m = (int)(idx / n8), n0 = (int)(idx % n8) * 8;
    float acc[8] = {0.f, 0.f, 0.f, 0.f, 0.f, 0.f, 0.f, 0.f};
    const bf16_t* a = A + (size_t)m * lda; const bf16_t* b0 = Bt + (size_t)n0 * ldb;
    for (int k = 0; k < K; k += 8) {
        float av[8]; ld8(a + k, av);
        for (int i = 0; i < 8; ++i) { float bv[8]; ld8(b0 + (size_t)i * ldb + k, bv); float s = 0.f;
            for (int j = 0; j < 8; ++j) s += av[j] * bv[j];
            acc[i] += s; }
    }
    float sc[8]; if (epi.swapped(tag)) { for (int i = 0; i < 8; ++i) sc[i] = epi.scale(tag, n0 + i); } else sc[0] = epi.scale(tag, m);
    typename Epi::Pre pre; epi.preload(tag, m, n0, pre); epi.apply(tag, m, n0, acc, sc, pre);
}

GLOBAL void LB64 k_attn_sb(Params p) {
    const long i = GTID; if (i >= (long)NB * NH * TB) return;
    const int t = (int)(i % TB), h = (int)((i / TB) % NH), b = (int)(i / ((long)TB * NH));
    const size_t row = (size_t)b * TB + t; bf16_t* qo = p.QSB() + row * W + h * 64;
    float q[64], o[64];
#pragma unroll
    for (int d = 0; d < 64; ++d) { q[d] = bf2f(qo[d]); o[d] = 0.f; }
    if (t >= LEAD) {
        float carry = 0.f;
        for (int j = t - 1; j >= LEAD; --j) {
            const size_t kr = (size_t)b * TB + j; const bf16_t* k = p.KSB() + kr * W + h * 64; float z = 0.f;
#pragma unroll
            for (int d = 0; d < 64; ++d) z += q[d] * bf2f(k[d]);
            const float sp = fmaxf(z, 0.f) + log2f(1.f + exp2f(-fabsf(z)));
            const float w = exp2f((z - sp) + carry); carry -= sp;
            const bf16_t* vt = p.VSBT() + (size_t)(h * 64) * R + ((kr & ~(size_t)15) | sperm((int)(kr & 15)));
#pragma unroll
            for (int d = 0; d < 64; ++d) o[d] += w * bf2f(vt[(size_t)d * R]);
        }
    }
#pragma unroll
    for (int d = 0; d < 64; ++d) qo[d] = f2bf(o[d]);
}
GLOBAL void LB64 k_attn_mla(Params p) {
    const long i = GTID; if (i >= (long)NB * NH * TB) return;
    const int t = (int)(i % TB), h = (int)((i / TB) % NH), b = (int)(i / ((long)TB * NH));
    const size_t row = (size_t)b * TB + t; const bf16_t* qp = p.QB() + row * QBW + h * 96;
    float o[64]; float m = -INFINITY, l = 0.f;
#pragma unroll
    for (int d = 0; d < 64; ++d) o[d] = 0.f;
    if (t >= LEAD) {
        const int kend = (t / 64 + 1) * 64 < TB ? (t / 64 + 1) * 64 : TB;
        for (int j = LEAD; j < kend; ++j) {
            const size_t kr = (size_t)b * TB + j; const bf16_t* kn = p.KNOPE() + kr * W + h * 64; const bf16_t* kq = p.KR() + kr * 32; float s = 0.f;
            for (int d = 0; d < 64; ++d) s += bf2f(qp[d]) * bf2f(kn[d]);
            for (int d = 0; d < 32; ++d) s += bf2f(qp[64 + d]) * bf2f(kq[d]);
            const float mn = fmaxf(m, s), f = exp2f(m - mn), w = exp2f(s - mn); m = mn; l = l * f + w;
            const bf16_t* vt = p.VBT() + (size_t)(h * 64) * R + ((kr & ~(size_t)15) | sperm((int)(kr & 15)));
#pragma unroll
            for (int d = 0; d < 64; ++d) o[d] = o[d] * f + w * bf2f(vt[(size_t)d * R]);
        }
    }
    const float il = l > 0.f ? 1.f / l : 0.f; bf16_t* op = p.OMLA() + row * W + h * 64;
#pragma unroll
    for (int d = 0; d < 64; ++d) op[d] = f2bf(o[d] * il);
}
GLOBAL void LB64 k_attn_diff(Params p, int layer) {
    const long i = GTID; if (i >= (long)NB * NHD * TB) return;
    const int t = (int)(i % TB), h = (int)((i / TB) % NHD), b = (int)(i / ((long)TB * NHD));
    const size_t row = (size_t)b * TB + t; bf16_t* qo = p.QD() + row * W + h * 128;
    const float lam = p.lamv()[layer], lam_init = 0.8f - 0.6f * expf(-0.3f * (float)layer);
    float o[128];
#pragma unroll
    for (int d = 0; d < 128; ++d) o[d] = 0.f;
    if (t >= LEAD) {
        const int kend = (t / 64 + 1) * 64 < TB ? (t / 64 + 1) * 64 : TB;
        float m0 = -INFINITY, l0 = 0.f, m1 = -INFINITY, l1 = 0.f;
        for (int j = LEAD; j < kend; ++j) { const bf16_t* k = p.KD() + ((size_t)b * TB + j) * W + h * 128; float s0 = 0.f, s1 = 0.f;
            for (int d = 0; d < 64; ++d) { s0 += bf2f(qo[d]) * bf2f(k[d]); s1 += bf2f(qo[64 + d]) * bf2f(k[64 + d]); }
            float mn = fmaxf(m0, s0); l0 = l0 * exp2f(m0 - mn) + exp2f(s0 - mn); m0 = mn; mn = fmaxf(m1, s1); l1 = l1 * exp2f(m1 - mn) + exp2f(s1 - mn); m1 = mn; }
        const float i0 = 1.f / l0, i1 = lam / l1;
        for (int j = LEAD; j < kend; ++j) { const size_t kr = (size_t)b * TB + j; const bf16_t* k = p.KD() + kr * W + h * 128; float s0 = 0.f, s1 = 0.f;
            for (int d = 0; d < 64; ++d) { s0 += bf2f(qo[d]) * bf2f(k[d]); s1 += bf2f(qo[64 + d]) * bf2f(k[64 + d]); }
            const float w = exp2f(s0 - m0) * i0 - exp2f(s1 - m1) * i1;
            const bf16_t* vt = p.VDT() + (size_t)(h * 128) * R + ((kr & ~(size_t)15) | sperm((int)(kr & 15)));
#pragma unroll
            for (int d = 0; d < 128; ++d) o[d] += w * bf2f(vt[(size_t)d * R]);
        }
    }
    float ss = 0.f;
#pragma unroll
    for (int d = 0; d < 128; ++d) ss += o[d] * o[d];
    const float rs = rsq(ss * (1.f / 128.f) + EPS) * (1.f - lam_init); const float* g = p.dnorm_g + (size_t)layer * 128;
#pragma unroll
    for (int d = 0; d < 128; ++d) qo[d] = f2bf(o[d] * rs * g[d]);
}


#endif
#ifndef HOST_EMU
namespace pg8 {
#define PG8_LAS __attribute__((address_space(3)))
typedef short bf16x8 __attribute__((ext_vector_type(8)));
typedef float f32x4 __attribute__((ext_vector_type(4)));
typedef unsigned u32x4 __attribute__((ext_vector_type(4)));
constexpr int BM = 256, BK = 64, HALF = 128, HTB = HALF * BK * 2  , STAGE_BYTES = 8 * HTB, NXCD = 8, WGM = 8;
__host__ __device__ __forceinline__ int lds_byte(int r, int c) { const int st = (r >> 4) * 2 + (c >> 5), rr = r & 15, cc = c & 31, ob = rr * 64 + cc * 2; return st * 1024 + (ob ^ (((ob >> 9) & 1) << 5)); }
__host__ __device__ __forceinline__ void stage_rc(int b, int& R, int& C) { const int st = b / 1024, sb = b % 1024, swz = sb ^ (((sb >> 9) & 1) << 5); R = (st >> 1) * 16 + swz / 64; C = (st & 1) * 32 + (swz % 64) / 2; }
__host__ __device__ __forceinline__ int perm32(int rho) { const int n = rho >> 4, i = rho & 15; return 8 * (i >> 2) + 4 * n + (i & 3); }
struct Unit { int pm, pn, tag; const char* A; const char* B; };
struct Gemm { int K, lda, ldb; };
__device__ __forceinline__ void order_map(int L, int nM, int nN, int& pm, int& pn) {
    const int nwg = nM * nN; int wgid = L; { const int q = nwg / NXCD, r = nwg % NXCD, xcd = wgid % NXCD, off = wgid / NXCD; wgid = (xcd < r ? xcd * (q + 1) : r * (q + 1) + (xcd - r) * q) + off; }
    const int nig = WGM * nN, gid = wgid / nig, fm = gid * WGM, gsz = (nM - fm) < WGM ? (nM - fm) : WGM;
    pm = fm + ((wgid % nig) % gsz); pn = (wgid % nig) / gsz;
}
template <class F> struct EpiAd {
    static constexpr bool PERM = true, AFTER_DRAIN = false;
    F f;
    __device__ __forceinline__ void operator()(const f32x4 (&acc)[2][2][4][2], const Unit& u, int wr, int wc, int fr, int fq, PG8_LAS unsigned char* scr, int tid) const {
        PG8_LAS float* rs = (PG8_LAS float*)scr;
        const bool sw = f.swapped(u.tag);
        if (tid < 256) rs[tid] = f.scale(u.tag, (sw ? u.pn : u.pm) * BM + tid);
        asm volatile("s_waitcnt lgkmcnt(0)" ::: "memory"); __builtin_amdgcn_s_barrier(); asm volatile("" ::: "memory");
#pragma unroll
        for (int ai = 0; ai < 2; ++ai) {
            int rl0 = ai * HALF + wr * 64 + fr, fqo = fq; asm volatile("" : "+v"(rl0), "+v"(fqo));
            typename F::Pre pre[4][2];
#pragma unroll
            for (int m = 0; m < 4; ++m)
#pragma unroll
                for (int bj = 0; bj < 2; ++bj) f.preload(u.tag, u.pm * BM + rl0 + m * 16, u.pn * BM + bj * HALF + wc * 32 + 8 * fqo, pre[m][bj]);
#pragma unroll
            for (int m = 0; m < 4; ++m) { const int rl = rl0 + m * 16, row = u.pm * BM + rl;
#pragma unroll
                for (int bj = 0; bj < 2; ++bj) { const int cl = bj * HALF + wc * 32 + 8 * fqo; const f32x4 v0 = acc[ai][bj][m][0], v1 = acc[ai][bj][m][1]; const float a8[8] = {v0[0], v0[1], v0[2], v0[3], v1[0], v1[1], v1[2], v1[3]};
                    float sc[8];
                    if (sw) {
#pragma unroll
                        for (int i = 0; i < 8; ++i) sc[i] = rs[cl + i]; }
                    else { sc[0] = rs[rl];
#pragma unroll
                        for (int i = 1; i < 8; ++i) sc[i] = 0.f; }
                    const float part = f.apply(u.tag, row, u.pn * BM + cl, a8, sc, pre[m][bj]);
                    f.rowslot(u.tag, row, u.pn * BM + bj * HALF + wc * 32, fq, part); } }
            asm volatile("" ::: "memory");
        }
    }
};
template <class Epi, class Sched, bool ALIGN_EPI = false, bool SP2 = false>
__device__ __forceinline__ void gemm_phase(PG8_LAS unsigned char* lds, const Gemm g, const Sched& S, const Epi& E, const int wid0  ) {
    int lane_ = lane_id_v();
    const int wid = wid0, lane = lane_, tid = wid * 64 + lane, wr = wid >> 2, wc = wid & 3, fr = lane & 15, fq = lane >> 4;
    const int K = g.K, nt = K / BK, lda = g.lda, ldb = g.ldb;
    unsigned voffA[2], voffB[2];
#pragma unroll
    for (int i = 0; i < 2; ++i) { int R, C; stage_rc(tid * 16 + i * 8192, R, C); const int Rb = Epi::PERM ? ((R & ~31) + perm32(R & 31)) : R;
        voffA[i] = (unsigned)(R * lda + C) * 2u; voffB[i] = (unsigned)(Rb * ldb + C) * 2u; }
    const size_t kstep = (size_t)(BK * 2);
    const size_t hstepA = (size_t)HALF * lda * 2, hstepB = (size_t)HALF * ldb * 2;
    const size_t tstepA = 2 * hstepA, tstepB = 2 * hstepB;
    const unsigned ldsw = (unsigned)wid * 1024u;
    const int aoff = lds_byte(wr * 64 + fr, fq * 8), boff = lds_byte(wc * 32 + fr, fq * 8);
#define PG8_SA(b, h) (((b) * 2 + (h)) * HTB)
#define PG8_SB(b, h) ((4 + (b) * 2 + (h)) * HTB)
#define PG8_STAGE(bufoff, gbase, voff) do { _Pragma("unroll") for (int _i = 0; _i < 2; ++_i) \
        __builtin_amdgcn_global_load_lds((const unsigned*)((const char*)(gbase) + (voff)[_i]), (PG8_LAS unsigned*)(lds + (bufoff) + ldsw + _i * 8192), 16, 0, 0); } while (0)
#define PG8_LDA(dst, b, h) do { _Pragma("unroll") for (int m = 0; m < 4; ++m) _Pragma("unroll") for (int k = 0; k < 2; ++k) dst[m][k] = *(const PG8_LAS bf16x8*)(lds + PG8_SA(b, h) + aoff + m * 2048 + k * 1024); } while (0)
#define PG8_LDB(dst, b, h) do { _Pragma("unroll") for (int n = 0; n < 2; ++n) _Pragma("unroll") for (int k = 0; k < 2; ++k) dst[n][k] = *(const PG8_LAS bf16x8*)(lds + PG8_SB(b, h) + boff + n * 2048 + k * 1024); } while (0)
#define PG8_MMA(ai, bj, At, Bt) do { __builtin_amdgcn_s_setprio(1); _Pragma("unroll") for (int m = 0; m < 4; ++m) _Pragma("unroll") for (int n = 0; n < 2; ++n) _Pragma("unroll") for (int k = 0; k < 2; ++k) \
        acc[ai][bj][m][n] = __builtin_amdgcn_mfma_f32_16x16x32_bf16(Bt[n][k], At[m][k], acc[ai][bj][m][n], 0, 0, 0); __builtin_amdgcn_s_setprio(0); } while (0)
#define PG8_WAIT_V(n) asm volatile("s_waitcnt vmcnt(" #n ")" ::: "memory")
#define PG8_WAIT_L(n) asm volatile("s_waitcnt lgkmcnt(" #n ")" ::: "memory")
#define PG8_BAR __builtin_amdgcn_s_barrier()
#define PG8_SCHED __builtin_amdgcn_sched_barrier(0)
    Unit cur, nxt; int ui = 0;
    if (!S.next(0, cur)) return;
    f32x4 acc[2][2][4][2];
#pragma unroll
    for (int a = 0; a < 2; ++a)
#pragma unroll
        for (int b = 0; b < 2; ++b)
#pragma unroll
            for (int m = 0; m < 4; ++m)
#pragma unroll
                for (int n = 0; n < 2; ++n) acc[a][b][m][n] = (f32x4){0.f, 0.f, 0.f, 0.f};
    bf16x8 At[4][2], B0[2][2], B1[2][2];
    const char* cA = cur.A + (size_t)cur.pm * tstepA; const char* cB = cur.B + (size_t)cur.pn * tstepB;
    S.a_ready(cur);
    if constexpr (SP2) {
        PG8_STAGE(PG8_SB(0, 0), cB, voffB); PG8_STAGE(PG8_SB(0, 1), cB + hstepB, voffB); PG8_STAGE(PG8_SA(0, 0), cA, voffA); PG8_STAGE(PG8_SA(0, 1), cA + hstepA, voffA);
        if (wr == 1) PG8_BAR;
        PG8_WAIT_V(2); PG8_BAR;
        PG8_STAGE(PG8_SB(1, 0), cB + kstep, voffB); PG8_STAGE(PG8_SA(1, 0), cA + kstep, voffA); PG8_STAGE(PG8_SB(1, 1), cB + hstepB + kstep, voffB);
        PG8_WAIT_V(6); PG8_BAR;
    } else {
        PG8_STAGE(PG8_SB(0, 0), cB, voffB); PG8_STAGE(PG8_SA(0, 0), cA, voffA); PG8_STAGE(PG8_SB(0, 1), cB + hstepB, voffB); PG8_STAGE(PG8_SA(0, 1), cA + hstepA, voffA);
        if (wr == 1) PG8_BAR;
        PG8_WAIT_V(4); PG8_BAR;
        PG8_STAGE(PG8_SB(1, 0), cB + kstep, voffB); PG8_STAGE(PG8_SA(1, 0), cA + kstep, voffA); PG8_STAGE(PG8_SB(1, 1), cB + hstepB + kstep, voffB);
        PG8_WAIT_V(6); PG8_BAR;
    }
    for (;;) {
        const bool has_next = S.next(ui + 1, nxt);
        const char* nA = has_next ? nxt.A + (size_t)nxt.pm * tstepA : cA; const char* nB = has_next ? nxt.B + (size_t)nxt.pn * tstepB : cB;
#pragma nounroll
        for (int t = 0; t < nt; t += 2) {
            const bool last = (t == nt - 2);
            const char* a1 = cA + (size_t)(t + 1) * kstep;
            const char* a2 = last ? nA : cA + (size_t)(t + 2) * kstep; const char* b2 = last ? nB : cB + (size_t)(t + 2) * kstep;
            const char* a3 = a2 + kstep; const char* b3 = b2 + kstep;
            if (last && has_next) S.a_ready(nxt);
            if constexpr (SP2) {
            PG8_LDB(B0, 0, 0); PG8_LDB(B1, 0, 1); PG8_SCHED; PG8_LDA(At, 0, 0); PG8_STAGE(PG8_SA(1, 1), a1 + hstepA, voffA);
            PG8_WAIT_V(8); PG8_WAIT_L(0); PG8_BAR; PG8_MMA(0, 0, At, B0); PG8_MMA(0, 1, At, B1); PG8_BAR; PG8_SCHED;
            PG8_LDA(At, 0, 1); PG8_STAGE(PG8_SB(0, 0), b2, voffB); PG8_STAGE(PG8_SB(0, 1), b2 + hstepB, voffB); PG8_STAGE(PG8_SA(0, 0), a2, voffA);
            PG8_WAIT_V(8); PG8_WAIT_L(0); PG8_BAR; PG8_MMA(1, 0, At, B0); PG8_MMA(1, 1, At, B1); PG8_BAR; PG8_SCHED;
            PG8_LDB(B0, 1, 0); PG8_LDB(B1, 1, 1); PG8_SCHED; PG8_LDA(At, 1, 0); PG8_STAGE(PG8_SA(0, 1), a2 + hstepA, voffA);
            PG8_WAIT_V(8); PG8_WAIT_L(0); PG8_BAR; PG8_MMA(0, 0, At, B0); PG8_MMA(0, 1, At, B1); PG8_BAR; PG8_SCHED;
            PG8_LDA(At, 1, 1); PG8_STAGE(PG8_SB(1, 0), b3, voffB); PG8_STAGE(PG8_SB(1, 1), b3 + hstepB, voffB); PG8_STAGE(PG8_SA(1, 0), a3, voffA);
            PG8_WAIT_V(8); PG8_WAIT_L(0); PG8_BAR; PG8_MMA(1, 0, At, B0); PG8_MMA(1, 1, At, B1); PG8_BAR; PG8_SCHED;
            } else {
            PG8_LDB(B0, 0, 0); PG8_SCHED; PG8_LDA(At, 0, 0); PG8_STAGE(PG8_SA(1, 1), a1 + hstepA, voffA);
            PG8_WAIT_L(8); PG8_BAR; PG8_WAIT_L(0); PG8_MMA(0, 0, At, B0); PG8_BAR; PG8_SCHED;
            PG8_LDB(B1, 0, 1); PG8_STAGE(PG8_SB(0, 0), b2, voffB);
            PG8_BAR; PG8_WAIT_L(0); PG8_MMA(0, 1, At, B1); PG8_BAR;
            PG8_LDA(At, 0, 1); PG8_STAGE(PG8_SA(0, 0), a2, voffA);
            PG8_BAR; PG8_WAIT_L(0); PG8_MMA(1, 0, At, B0); PG8_BAR; PG8_SCHED;
            PG8_STAGE(PG8_SB(0, 1), b2 + hstepB, voffB);
            PG8_WAIT_V(6); PG8_BAR; PG8_MMA(1, 1, At, B1); PG8_BAR;
            PG8_LDB(B0, 1, 0); PG8_SCHED; PG8_LDA(At, 1, 0); PG8_STAGE(PG8_SA(0, 1), a2 + hstepA, voffA);
            PG8_WAIT_L(8); PG8_BAR; PG8_WAIT_L(0); PG8_MMA(0, 0, At, B0); PG8_BAR; PG8_SCHED;
            PG8_LDB(B1, 1, 1); PG8_STAGE(PG8_SB(1, 0), b3, voffB);
            PG8_BAR; PG8_WAIT_L(0); PG8_MMA(0, 1, At, B1); PG8_BAR;
            PG8_LDA(At, 1, 1); PG8_STAGE(PG8_SA(1, 0), a3, voffA);
            PG8_BAR; PG8_WAIT_L(0); PG8_MMA(1, 0, At, B0); PG8_BAR; PG8_SCHED;
            PG8_STAGE(PG8_SB(1, 1), b3 + hstepB, voffB);
            PG8_WAIT_V(6); PG8_BAR; PG8_MMA(1, 1, At, B1); PG8_BAR;
            }
        }
        if constexpr (ALIGN_EPI) { if (wr == 0) PG8_BAR; }
        if constexpr (!Epi::AFTER_DRAIN) { E(acc, cur, wr, wc, fr, fq, lds + STAGE_BYTES, tid); S.done(cur); }
        if (!has_next) break;
#pragma unroll
        for (int a = 0; a < 2; ++a)
#pragma unroll
            for (int b = 0; b < 2; ++b)
#pragma unroll
                for (int m = 0; m < 4; ++m)
#pragma unroll
                    for (int n = 0; n < 2; ++n) acc[a][b][m][n] = (f32x4){0.f, 0.f, 0.f, 0.f};
        cur = nxt; cA = nA; cB = nB; ++ui;
        if constexpr (ALIGN_EPI) { if (wr == 1) PG8_BAR; }
    }
    PG8_WAIT_V(0);
    if constexpr (!ALIGN_EPI) { if (wr == 0) PG8_BAR; }
    PG8_BAR;
    if constexpr (Epi::AFTER_DRAIN) { E.fused(acc, cur, wr, wc, fr, fq, lds, wid, lane); S.done(cur); }
#undef PG8_SA
#undef PG8_SB
#undef PG8_STAGE
#undef PG8_LDA
#undef PG8_LDB
#undef PG8_MMA
#undef PG8_WAIT_V
#undef PG8_WAIT_L
#undef PG8_BAR
#undef PG8_SCHED
}

}

struct SchedGrid {
    int nM, nN, G, c, tag; const char* A; const char* B;
    __device__ __forceinline__ bool next(int i, pg8::Unit& u) const { const long L = (long)i * G + c; if (L >= (long)nM * nN) return false; pg8::order_map((int)L, nM, nN, u.pm, u.pn); u.tag = tag; u.A = A; u.B = B; return true; }
    __device__ __forceinline__ void a_ready(const pg8::Unit&) const {}
    __device__ __forceinline__ void done(const pg8::Unit&) const {}
};
struct SchedTwo {
    int nM0, nN0, nM1, nN1, G, c; const char *A0, *B0, *A1, *B1;
    __device__ __forceinline__ bool next(int i, pg8::Unit& u) const { long L = (long)i * G + c; const long n0 = (long)nM0 * nN0;
        if (L < n0) { pg8::order_map((int)L, nM0, nN0, u.pm, u.pn); u.tag = 0; u.A = A0; u.B = B0; return true; }
        L -= n0; if (L >= (long)nM1 * nN1) return false; pg8::order_map((int)L, nM1, nN1, u.pm, u.pn); u.tag = 1; u.A = A1; u.B = B1; return true; }
    __device__ __forceinline__ void a_ready(const pg8::Unit&) const {}
    __device__ __forceinline__ void done(const pg8::Unit&) const {}
};
struct SchedP4 {
    int nM, nN, G, c; const char* A0; size_t astride; const char* B0; size_t bstride;
    __device__ __forceinline__ bool next(int i, pg8::Unit& u) const {
        const int nmain = (nM - 2) * nN;
        if (i < 3) { if (c >= nmain) return false; const int j = i, b = (2 * j) % 3; pg8::order_map(c, nM - 2, nN, u.pm, u.pn); u.tag = b + (j > 0 ? 4 : 0); u.A = A0 + (size_t)j * astride; u.B = B0 + (size_t)b * bstride; return true; }
        if (i == 3 && c < 6 * nN) { const int lt = c / 3, j = c % 3, b = (2 * j) % 3; u.pm = nM - 2 + lt / nN; u.pn = lt % nN; u.tag = b + 8; u.A = A0 + (size_t)j * astride; u.B = B0 + (size_t)b * bstride; return true; }
        return false; }
    __device__ __forceinline__ void a_ready(const pg8::Unit&) const {}
    __device__ __forceinline__ void done(const pg8::Unit&) const {}
};
struct SchedP5 {
    int nM, nN, G, c; const char* A; const char* B; unsigned* flags;
    __device__ __forceinline__ bool next(int i, pg8::Unit& u) const {
        const int nmain = (nM - 2) * nN; u.tag = 0; u.A = A; u.B = B;
        if (i == 0) { if (c >= nmain) return false; pg8::order_map(c, nM - 2, nN, u.pm, u.pn); return true; }
        if (i == 1 && c < 2 * nN) { u.pm = nM - 2 + c / nN; u.pn = c % nN; return true; }
        return false; }
    __device__ __forceinline__ void a_ready(const pg8::Unit& u) const {
        if (u.pm < nM - 2) return;
        for (unsigned sp = 0; sp < (1u << 22); ++sp) { unsigned n = 0;
#pragma unroll
            for (int k = 0; k < 8; ++k) n += __hip_atomic_load(flags + 16 * k, __ATOMIC_RELAXED, __HIP_MEMORY_SCOPE_AGENT);
            if (n >= 8u) break; __builtin_amdgcn_s_sleep(2); }
        __builtin_amdgcn_fence(__ATOMIC_ACQUIRE, "agent"); asm volatile("s_waitcnt vmcnt(0)" ::: "memory");
    }
    __device__ __forceinline__ void done(const pg8::Unit&) const {}
};
constexpr int CW_LTFLAG = 2048;
constexpr int LDS_SCR = pg8::STAGE_BYTES, LDS_BYTES = 147456;
#define LASP __attribute__((address_space(3)))
enum { PK_P1 = 0, PK_P2 = 1, PK_P3 = 2, PK_P3B = 3, PK_P4 = 4, PK_P5 = 5 };
__device__ __forceinline__ void gemm_part(const Params& p, LASP unsigned char* lds, int kind, int l, int G, int c, int wid0) {
    constexpr int nR = R / 256;
    if (kind == PK_P1) {
        SchedTwo S{nR, N1 / 256, 2 * W / 256, nR, G, c, (const char*)p.XB(), (const char*)wptr(p, l, WL_W1), (const char*)wptr(p, l, WL_WV), (const char*)p.XB()};
        pg8::EpiAd<F1> E{F1{p, 0}}; pg8::gemm_phase<pg8::EpiAd<F1>, SchedTwo, true, true>(lds, pg8::Gemm{D, D, D}, S, E, wid0);
    } else if (kind == PK_P2) {
        { SchedGrid S{nR, QBW / 256, G, c, 0, (const char*)p.CQ(), (const char*)wptr(p, l, WL_UQ)};
          pg8::EpiAd<FUQ> E{FUQ{p, 0}}; pg8::gemm_phase<pg8::EpiAd<FUQ>, SchedGrid, true, true>(lds, pg8::Gemm{QR, QR, QR}, S, E, wid0); }
        { SchedTwo S{nR, W / 256, W / 256, nR, G, c, (const char*)p.CKV(), (const char*)wptr(p, l, WL_UK), (const char*)wptr(p, l, WL_UV), (const char*)p.CKV()};
          pg8::EpiAd<FUK> E{FUK{p, 0}}; pg8::gemm_phase<pg8::EpiAd<FUK>, SchedTwo, true, true>(lds, pg8::Gemm{KVR, KVR, KVR}, S, E, wid0); }
    } else if (kind == PK_P3B) {
        SchedGrid S{nR, N3 / 256, G, c, 0, (const char*)p.XB2(), (const char*)wptr(p, l, WL_W3)};
        pg8::EpiAd<F3> E{F3{p, l}}; pg8::gemm_phase<pg8::EpiAd<F3>, SchedGrid, true, true>(lds, pg8::Gemm{D, D, D}, S, E, wid0);
    } else if (kind == PK_P4) {
        SchedP4 S{nR, D / 256, G, c, (const char*)p.QSB(), (size_t)((const char*)p.QD() - (const char*)p.QSB()), (const char*)wptr(p, l, WL_WO), (size_t)D * W * 2};
        pg8::EpiAd<F4> E{F4{p, 0}}; pg8::gemm_phase<pg8::EpiAd<F4>, SchedP4, true, true>(lds, pg8::Gemm{W, W, W}, S, E, wid0);
    } else if (kind == PK_P5) {
        SchedP5 S{nR, D / 256, G, c, (const char*)p.G0(), (const char*)wptr(p, l, WL_OUT), p.ctl() + CW_LTFLAG + 256 * l};
        pg8::EpiAd<F5> E{F5{p, l == DEPTH - 1 ? 1 : 0}}; pg8::gemm_phase<pg8::EpiAd<F5>, SchedP5, true, true>(lds, pg8::Gemm{D, D, D}, S, E, wid0);
    }
}
__device__ __forceinline__ void lt_merge(const Params& p, int l, int G, int c, int wid0) {
    if (c < G - 8) return;
    const int k = c - (G - 8), lane = lane_id_v(), tid = wid0 * 64 + lane; constexpr int NR = (R - LT_ROW0) / 8;
    const bf16_t* T = p.XB2(); bf16_t* M = p.G0() + (size_t)LT_ROW0 * D;
    for (int e = tid; e < NR * D / 8; e += 512) { const size_t off = ((size_t)k * NR) * D + (size_t)e * 8; float a[8], b[8], cc[8], v[8];
        up8(*(const U4*)(T + off), a); up8(*(const U4*)(T + (size_t)(R - LT_ROW0) * D + off), b); up8(*(const U4*)(T + 2 * (size_t)(R - LT_ROW0) * D + off), cc);
#pragma unroll
        for (int i = 0; i < 8; ++i) v[i] = (a[i] + cc[i]) + b[i];
        st8(M + off, v); }
    asm volatile("s_waitcnt vmcnt(0)" ::: "memory"); __syncthreads();
    if (tid == 0) { __builtin_amdgcn_fence(__ATOMIC_RELEASE, "agent"); asm volatile("s_waitcnt vmcnt(0)" ::: "memory"); __hip_atomic_store(p.ctl() + CW_LTFLAG + 256 * l + 16 * k, 1u, __ATOMIC_RELAXED, __HIP_MEMORY_SCOPE_AGENT); }
}
template <int KIND> __global__ void __launch_bounds__(512, 2) k_gemm_fast(Params p, int l) {
    extern __shared__ __attribute__((aligned(16))) unsigned char lds_raw[];
    gemm_part(p, (LASP unsigned char*)lds_raw, KIND, l, (int)gridDim.x, (int)blockIdx.x, __builtin_amdgcn_readfirstlane((int)threadIdx.x >> 6));
}

namespace att {
typedef short bf16x8 __attribute__((ext_vector_type(8)));
typedef float f32x16 __attribute__((ext_vector_type(16)));
typedef unsigned u32x4v __attribute__((ext_vector_type(4)));
__device__ __forceinline__ int crow(int r, int h) { return (r & 3) + 8 * (r >> 2) + 4 * h; }
__device__ __forceinline__ bf16x8 ldg8(const bf16_t* p) { return *(const bf16x8*)p; }
__device__ __forceinline__ void halves(float x, float& lo, float& hi) { auto r = __builtin_amdgcn_permlane32_swap(__float_as_uint(x), __float_as_uint(x), false, false); lo = __uint_as_float(r[0]); hi = __uint_as_float(r[1]); }
__device__ __forceinline__ bf16x8 pack8(const f32x16& v, int b) { u32x4v w; w.x = pk2(v[b], v[b + 1]); w.y = pk2(v[b + 2], v[b + 3]); w.z = pk2(v[b + 4], v[b + 5]); w.w = pk2(v[b + 6], v[b + 7]); return __builtin_bit_cast(bf16x8, w); }
constexpr float SB_DEAD = -152.0f;
#define ATT_FENCE() asm volatile("" ::: "memory")
constexpr int RING_SLOTS = 4, RING_D = 3;
__device__ __forceinline__ void dma16(const void* gsrc, LASP unsigned char* ldst) { __builtin_amdgcn_global_load_lds((const unsigned*)gsrc, (LASP unsigned*)ldst, 16, 0, 0); }
template <int NQB, int NKS, int NKSA, int NDB, bool SBM>
__device__ __forceinline__ void tile_step(const LASP unsigned char* kimg, const LASP unsigned char* krimg, const LASP unsigned char* vimg, const bool first, const bool diag, const int qoff, const int cl, const int h,
                                          const bf16x8 (&qf)[NQB][NKS], f32x16 (&o)[NDB][NQB], float (&mrun)[NQB], float (&lrun)[NQB], float (&carry)[NQB]) {
#define ATT_LDK(dst, g_) do { _Pragma("unroll") for (int j_ = 0; j_ < 2; ++j_) { const int key_ = j_ * 32 + cla; \
        dst[j_] = (g_) < NKSA ? *(const LASP bf16x8*)(kimg + key_ * 128 + (((2 * (g_) + ha) ^ (cla & 7)) << 4)) : *(const LASP bf16x8*)(krimg + key_ * 64 + (((2 * ((g_) - NKSA) + ha) ^ ((cla >> 2) & 3)) << 4)); } } while (0)
#define ATT_LDV(dst, j_) do { _Pragma("unroll") for (int d_ = 0; d_ < NDB; ++d_) dst[d_] = *(const LASP bf16x8*)(vimg + (d_ * 32 + cla) * 128 + (((2 * (j_) + ha) ^ (cla & 7)) << 4)); } while (0)
    int cla = cl, ha = h; asm volatile("" : "+v"(cla), "+v"(ha));
    bf16x8 kf0[2], kf1[2], vf0[NDB], vf1[NDB];
    ATT_LDK(kf0, 0);
    f32x16 s[2][NQB];
#pragma unroll
    for (int kb = 0; kb < 2; ++kb)
#pragma unroll
        for (int qb = 0; qb < NQB; ++qb)
#pragma unroll
            for (int r = 0; r < 16; ++r) s[kb][qb][r] = 0.f;
#pragma unroll
    for (int g = 0; g < NKS; ++g) {
        if (g + 1 < NKS) { if (g & 1) ATT_LDK(kf0, g + 1); else ATT_LDK(kf1, g + 1); } else ATT_LDV(vf0, 0);
        ATT_FENCE();
#pragma unroll
        for (int j = 0; j < 2; ++j)
#pragma unroll
            for (int qb = 0; qb < NQB; ++qb) s[j][qb] = __builtin_amdgcn_mfma_f32_32x32x16_bf16((g & 1) ? kf1[j] : kf0[j], qf[qb][g], s[j][qb], 0, 0, 0);
    }
    if (!SBM) {
        if (first) {
#pragma unroll
            for (int qb = 0; qb < NQB; ++qb) {
#pragma unroll
                for (int r = 0; r < 16; ++r) s[0][qb][r] = -INFINITY;
#pragma unroll
                for (int r = 0; r < 8; ++r) s[1][qb][r] = -INFINITY; } }
#pragma unroll
        for (int qb = 0; qb < NQB; ++qb) {
            float mx = s[0][qb][0];
#pragma unroll
            for (int r = 1; r < 16; ++r) mx = fmaxf(mx, s[0][qb][r]);
#pragma unroll
            for (int r = 0; r < 16; ++r) mx = fmaxf(mx, s[1][qb][r]);
            float m0, m1; halves(mx, m0, m1); const float cand = fmaxf(m0, m1);
            if (__any(cand > mrun[qb] + 8.0f)) { const float mn = fmaxf(mrun[qb], cand); const float f = __builtin_amdgcn_exp2f(mrun[qb] - mn); mrun[qb] = mn; lrun[qb] *= f;
#pragma unroll
                for (int d = 0; d < NDB; ++d)
#pragma unroll
                    for (int r = 0; r < 16; ++r) o[d][qb][r] *= f; }
            float ps = 0.f;
#pragma unroll
            for (int kb = 0; kb < 2; ++kb)
#pragma unroll
                for (int r = 0; r < 16; ++r) { const float pv = __builtin_amdgcn_exp2f(s[kb][qb][r] - mrun[qb]); s[kb][qb][r] = pv; ps += pv; }
            lrun[qb] += ps;
        }
    } else {
#pragma unroll
        for (int qb = 0; qb < NQB; ++qb) {
            float run = carry[qb];
#pragma unroll
            for (int kb = 1; kb >= 0; --kb)
#pragma unroll
                for (int rg = 3; rg >= 0; --rg) {
                    const bool lead = first && (kb == 0 || rg < 2);
                    float y[4], sp[4]; bool ok[4];
#pragma unroll
                    for (int e = 0; e < 4; ++e) { y[e] = s[kb][qb][4 * rg + e]; ok[e] = !lead && !(diag && (kb * 32 + 8 * rg + 4 * h + e >= qoff + qb * 32 + cl));
                        sp[e] = ok[e] ? fmaxf(y[e], 0.f) + __builtin_amdgcn_logf(1.0f + __builtin_amdgcn_exp2f(-fabsf(y[e]))) : 0.f; }
                    const float gs = -((sp[0] + sp[1]) + (sp[2] + sp[3])); float g0, g1; halves(gs, g0, g1);
                    const float t1 = run; run += g1; const float t0 = run; run += g0; float a = h ? t1 : t0;
#pragma unroll
                    for (int e = 3; e >= 0; --e) { const float w = ok[e] ? __builtin_amdgcn_exp2f((y[e] - sp[e]) + a) : 0.f; a -= sp[e]; s[kb][qb][4 * rg + e] = w; }
                    __builtin_amdgcn_sched_barrier(0); }
            carry[qb] = run;
        }
    }
    ATT_FENCE();
#pragma unroll
    for (int j = 0; j < 4; ++j) {
        if (j + 1 < 4) { if (j & 1) ATT_LDV(vf0, j + 1); else ATT_LDV(vf1, j + 1); }
        ATT_FENCE();
        bf16x8 pf[NQB];
#pragma unroll
        for (int qb = 0; qb < NQB; ++qb) pf[qb] = pack8(s[j >> 1][qb], 8 * (j & 1));
#pragma unroll
        for (int d = 0; d < NDB; ++d)
#pragma unroll
            for (int qb = 0; qb < NQB; ++qb) o[d][qb] = __builtin_amdgcn_mfma_f32_32x32x16_bf16((j & 1) ? vf1[d] : vf0[d], pf[qb], o[d][qb], 0, 0, 0);
    }
#undef ATT_LDK
#undef ATT_LDV
}
template <int NQB, int NDB> __device__ __forceinline__ void store_ot(bf16_t* optr, int ldo, const f32x16 (&o)[NDB][NQB], const float (&sc)[NQB]) {
    int lane_ = lane_id_v(); const int lane = lane_, cl = lane & 31, h = lane >> 5;
#pragma unroll
    for (int qb = 0; qb < NQB; ++qb)
#pragma unroll
        for (int d = 0; d < NDB; ++d)
#pragma unroll
            for (int rg = 0; rg < 4; ++rg) st4(optr + (size_t)(qb * 32 + cl) * ldo + d * 32 + 8 * rg + 4 * h, o[d][qb][4 * rg] * sc[qb], o[d][qb][4 * rg + 1] * sc[qb], o[d][qb][4 * rg + 2] * sc[qb], o[d][qb][4 * rg + 3] * sc[qb]);
}
#define ATT_WAIT(n) asm volatile("s_waitcnt vmcnt(" #n ") lgkmcnt(0)" ::: "memory")
#define ATT_BAR() do { __builtin_amdgcn_s_barrier(); asm volatile("" ::: "memory"); } while (0)
template <bool SBM> __device__ __forceinline__ void unit8(const Params& p, LASP unsigned char* lds, const int wid, const int b, const int h, const int c0, const int nq) {
    constexpr int NKS = SBM ? 4 : 6, NQB = SBM ? 1 : 2, SLOTB = 20480, OFF_V = 8192, OFF_KR = 16384;
    const int lane = lane_id_v(), cl = lane & 31, hh = lane >> 5; const size_t r0 = (size_t)b * TB;
    const int ti = SBM ? wid >> 1 : wid, qoff = SBM ? (wid & 1) * 32 : 0;
    const int qt = c0 + ti, nt = c0 + nq; const bool active = ti < nq;
    const int swz = ((lane & 7) ^ ((lane >> 3) & 7)) << 3;
    const bf16_t* kbase = (SBM ? p.KSB() : p.KNOPE()) + (r0 + wid * 8 + (lane >> 3)) * W + h * 64 + swz;
    const bf16_t* vbase = (SBM ? p.VSBT() : p.VBT()) + (size_t)(h * 64 + wid * 8 + (lane >> 3)) * R + r0 + swz;
    const bf16_t* krbase = p.KR() + (r0 + (wid & 3) * 16 + (lane >> 2)) * 32 + (((lane & 3) ^ ((lane >> 4) & 3)) << 3);
#define U8_ISSUE(t_) do { const int kt_ = SBM ? nt - 1 - (t_) : (t_); LASP unsigned char* sl_ = lds + ((t_) & (RING_SLOTS - 1)) * SLOTB; \
        dma16(kbase + (size_t)kt_ * 64 * W, sl_ + wid * 1024); dma16(vbase + kt_ * 64, sl_ + OFF_V + wid * 1024); \
        if (!SBM) dma16(krbase + (size_t)kt_ * 64 * 32, sl_ + OFF_KR + (wid & 3) * 1024); } while (0)
    bf16x8 qf[NQB][NKS]; f32x16 o[2][NQB]; float mrun[NQB], lrun[NQB], carry[NQB];
    { const bf16_t* qp = SBM ? p.QSB() + (r0 + (size_t)qt * 64 + qoff) * W + h * 64 : p.QB() + (r0 + (size_t)qt * 64) * QBW + h * 96; const int ldq = SBM ? W : QBW;
#pragma unroll
      for (int qb = 0; qb < NQB; ++qb)
#pragma unroll
          for (int ks = 0; ks < NKS; ++ks) { if (active) qf[qb][ks] = ldg8(qp + (size_t)(qb * 32 + cl) * ldq + 16 * ks + 8 * hh); else qf[qb][ks] = (bf16x8){0, 0, 0, 0, 0, 0, 0, 0}; } }
#pragma unroll
    for (int qb = 0; qb < NQB; ++qb) { mrun[qb] = -INFINITY; lrun[qb] = 0.f; carry[qb] = 0.f;
#pragma unroll
        for (int d = 0; d < 2; ++d)
#pragma unroll
            for (int r = 0; r < 16; ++r) o[d][qb][r] = 0.f; }
    volatile LASP unsigned* fl = (volatile LASP unsigned*)(lds + LDS_SCR + 3072);
    if (SBM && lane == 0) fl[8 + wid] = active ? 1u : 0u;
#pragma unroll
    for (int t = 0; t < RING_D; ++t) if (t < nt) U8_ISSUE(t);
    bool dead = !active;
    for (int it = 0; it < nt; ++it) {
        const int rem = nt - 1 - it;
        if (SBM) { if (rem >= 2) ATT_WAIT(4); else if (rem == 1) ATT_WAIT(2); else ATT_WAIT(0); }
        else     { if (rem >= 2) ATT_WAIT(6); else if (rem == 1) ATT_WAIT(3); else ATT_WAIT(0); }
        ATT_BAR();
        if (SBM) { const int pb = ((it + 1) & 1) * 8; const unsigned any = (fl[pb] | fl[pb + 1] | fl[pb + 2] | fl[pb + 3]) | (fl[pb + 4] | fl[pb + 5] | fl[pb + 6] | fl[pb + 7]); if (!any) break; }
        if (it + RING_D < nt) U8_ISSUE(it + RING_D);
        const int kt = SBM ? nt - 1 - it : it;
        if (!dead && kt <= qt) {
            const LASP unsigned char* sl = lds + (it & (RING_SLOTS - 1)) * SLOTB;
            tile_step<NQB, NKS, 4, 2, SBM>(sl, sl + OFF_KR, sl + OFF_V, kt == 0, kt == qt, qoff, cl, hh, qf, o, mrun, lrun, carry);
            if (SBM) { bool dd = true;
#pragma unroll
                for (int qb = 0; qb < NQB; ++qb) dd = dd && (carry[qb] < SB_DEAD);
                dead = __all(dd) != 0; }
        }
        if (SBM && lane == 0) fl[(it & 1) * 8 + wid] = (!dead && kt > 0) ? 1u : 0u;
    }
    if (active) {
        if (SBM) { float one[NQB];
#pragma unroll
            for (int qb = 0; qb < NQB; ++qb) one[qb] = 1.f;
            store_ot<NQB, 2>(p.QSB() + (r0 + (size_t)qt * 64 + qoff) * W + h * 64, W, o, one); }
        else { float il[NQB];
#pragma unroll
            for (int qb = 0; qb < NQB; ++qb) { float l0, l1; halves(lrun[qb], l0, l1); il[qb] = 1.0f / (l0 + l1); }
            store_ot<NQB, 2>(p.OMLA() + (r0 + (size_t)qt * 64) * W + h * 64, W, o, il); }
    }
    ATT_WAIT(0); ATT_BAR();
#undef U8_ISSUE
}
__device__ __forceinline__ void unit_diff(const Params& p, LASP unsigned char* lds, const int wid, const int layer, const int b, const int head, const int c0, const int nq) {
    constexpr int SLOTB = 32768, OFF_K1 = 8192, OFF_V = 16384;
    const int lane = lane_id_v(), cl = lane & 31, hh = lane >> 5, g = wid >> 2, mp = (wid >> 1) & 1, qh = wid & 1; const size_t r0 = (size_t)b * TB;
    const int qt = c0 + g, nt = c0 + nq; const bool active = g < nq;
    const int swz = ((lane & 7) ^ ((lane >> 3) & 7)) << 3;
    const bf16_t* kbase = p.KD() + (r0 + wid * 8 + (lane >> 3)) * W + head * 128 + swz;
    const bf16_t* vbase = p.VDT() + (size_t)(head * 128 + wid * 8 + (lane >> 3)) * R + r0 + swz;
#define UD_ISSUE(t_) do { const int kt_ = (t_); LASP unsigned char* sl_ = lds + ((t_) & (RING_SLOTS - 1)) * SLOTB; \
        dma16(kbase + (size_t)kt_ * 64 * W, sl_ + wid * 1024); dma16(kbase + (size_t)kt_ * 64 * W + 64, sl_ + OFF_K1 + wid * 1024); \
        dma16(vbase + kt_ * 64, sl_ + OFF_V + wid * 1024); dma16(vbase + (size_t)64 * R + kt_ * 64, sl_ + OFF_V + (wid + 8) * 1024); } while (0)
    bf16x8 qf[1][4]; f32x16 o[4][1]; float mrun[1], lrun[1], carry[1];
    { const bf16_t* qp = p.QD() + (r0 + (size_t)qt * 64 + qh * 32) * W + head * 128 + mp * 64;
#pragma unroll
      for (int ks = 0; ks < 4; ++ks) { if (active) qf[0][ks] = ldg8(qp + (size_t)cl * W + 16 * ks + 8 * hh); else qf[0][ks] = (bf16x8){0, 0, 0, 0, 0, 0, 0, 0}; } }
    mrun[0] = -INFINITY; lrun[0] = 0.f; carry[0] = 0.f;
#pragma unroll
    for (int d = 0; d < 4; ++d)
#pragma unroll
        for (int r = 0; r < 16; ++r) o[d][0][r] = 0.f;
#pragma unroll
    for (int t = 0; t < RING_D; ++t) if (t < nt) UD_ISSUE(t);
    for (int it = 0; it < nt; ++it) {
        const int rem = nt - 1 - it;
        if (rem >= 2) ATT_WAIT(8); else if (rem == 1) ATT_WAIT(4); else ATT_WAIT(0);
        ATT_BAR();
        if (it + RING_D < nt) UD_ISSUE(it + RING_D);
        if (active && it <= qt) { const LASP unsigned char* sl = lds + (it & (RING_SLOTS - 1)) * SLOTB;
            tile_step<1, 4, 4, 4, false>(sl + mp * OFF_K1, sl, sl + OFF_V, it == 0, false, 0, cl, hh, qf, o, mrun, lrun, carry); }
    }
    ATT_WAIT(0); ATT_BAR();
    if (active) { float l0, l1; halves(lrun[0], l0, l1); const float il = 1.0f / (l0 + l1);
        LASP float* reg = (LASP float*)(lds + wid * 16384);
#pragma unroll
        for (int d = 0; d < 4; ++d)
#pragma unroll
            for (int r = 0; r < 16; ++r) reg[cl * 128 + ((d * 32 + crow(r, hh)) ^ cl)] = o[d][0][r] * il; }
    ATT_WAIT(0); ATT_BAR();
    if (active) { const float lam = p.lamv()[layer], lam_init = __uint_as_float(__builtin_amdgcn_readfirstlane(layer == 0 ? 0x3e4ccccdu : 0x3eb60549u));
      const LASP float* r0p = (const LASP float*)(lds + ((g * 2 + 0) * 2 + qh) * 16384); const LASP float* r1p = (const LASP float*)(lds + ((g * 2 + 1) * 2 + qh) * 16384);
      const int ql = mp * 16 + (lane >> 2), part = lane & 3; float v[32]; float ss = 0.f;
#pragma unroll
      for (int i = 0; i < 32; ++i) { const int ii = (i + 8 * part) & 31; const int a = ql * 128 + ((part * 32 + ii) ^ ql); v[i] = r0p[a] - lam * r1p[a]; ss += v[i] * v[i]; }
      ss = quad4_sum(ss);
      const float rs = rsq(ss * (1.0f / 128.0f) + EPS) * (1.0f - lam_init); const float* gn = p.dnorm_g + (size_t)layer * 128 + part * 32;
      bf16_t* op = p.QD() + (r0 + (size_t)qt * 64 + qh * 32 + ql) * W + head * 128 + part * 32;
#pragma unroll
      for (int i = 0; i < 32; i += 2) { const int ii = (i + 8 * part) & 31;
          st2(op + ii, v[i] * rs * gn[ii], v[i + 1] * rs * gn[ii + 1]); } }
    ATT_WAIT(0); ATT_BAR();
#undef UD_ISSUE
}
enum { AK_P2 = 0, AK_P3 = 1 };
__device__ __forceinline__ void attn_part(const Params& p, LASP unsigned char* lds, int kind, int layer, int wid, int rep = 0) {
    const bool leader = wid == 0 && lane_id_v() == 0;
    volatile LASP int* slot = (volatile LASP int*)(lds + LDS_SCR + 2048);
    unsigned* ctr = p.ctl() + 1024 + 64 * (layer * 2 + kind + 4 * rep);
    constexpr int NT = TB / 64;
    static_assert((NT - 1) % 8 == 0, "query tile grouping");
    constexpr int NG8 = (NT - 1) / 8 + 1, NG4 = (NT - 1) / 4 + 1, NGD = (NT - 1) / 2 + 1;
    constexpr int N8 = NB * NH * NG8, N4 = NB * NH * NG4, ND = NB * NHD * NGD;
    const int nitems = kind == AK_P2 ? ND + N4 : N8;
    for (int n = 0;; ++n) {
        if (leader) slot[n & 1] = (int)atomicAdd(ctr, 1u);
        asm volatile("s_waitcnt vmcnt(0) lgkmcnt(0)" ::: "memory"); __builtin_amdgcn_s_barrier(); asm volatile("" ::: "memory");
        int item = __builtin_amdgcn_readfirstlane(slot[n & 1]);
        if (item >= nitems) break;
        if (kind == AK_P2) {
            if (item < ND) { const int u = item / (NB * NHD), j = item % (NB * NHD); const bool single = u == NGD - 1;
                unit_diff(p, lds, wid, layer, j / NHD, j % NHD, single ? 0 : NT - 2 - 2 * u, single ? 1 : 2); }
            else { item -= ND; const int u = item / (NB * NH), j = item % (NB * NH); const bool single = u == NG4 - 1;
                unit8<true>(p, lds, wid, j / NH, j % NH, single ? 0 : NT - 4 - 4 * u, single ? 1 : 4); }
        } else { const int u = item / (NB * NH), j = item % (NB * NH); const bool single = u == NG8 - 1;
            unit8<false>(p, lds, wid, j / NH, j % NH, single ? 0 : NT - 8 - 8 * u, single ? 1 : 8); }
    }
}
}
template <int KIND> __global__ void __launch_bounds__(512, 2) k_attn_fast(Params p, int l) {
    extern __shared__ __attribute__((aligned(16))) unsigned char lds_raw[];
    att::attn_part(p, (LASP unsigned char*)lds_raw, KIND, l, __builtin_amdgcn_readfirstlane((int)threadIdx.x >> 6));
}

#define XB_TMO      128
#define XB_XCNT(j)  (256  + 64 * (j))
#define XB_XSUB(j)  (1280 + 64 * (j))
#define XB_XGEN(j)  (2304 + 64 * (j))
#define XB_TOP      3328
#define XB_TOPGEN   3392
#define XCD_BAR_WORDS 3456
#define XB_SPIN_CAP (1u << 18)
__device__ __forceinline__ unsigned xb_ld(unsigned* p)              { return __hip_atomic_load(p, __ATOMIC_RELAXED, __HIP_MEMORY_SCOPE_AGENT); }
__device__ __forceinline__ unsigned xb_add(unsigned* p, unsigned v) { return __hip_atomic_fetch_add(p, v, __ATOMIC_RELAXED, __HIP_MEMORY_SCOPE_AGENT); }
__device__ __forceinline__ unsigned xb_xcc_id() { return (unsigned)__builtin_amdgcn_s_getreg((3 << 11) | 20) & 0xFu; }
#define XB_SPIN(cond, bar) do { unsigned _sp = 0; while (cond) { __builtin_amdgcn_s_sleep(1); \
    if ((++_sp & 255u) == 0u) { if (xb_ld(&(bar)[XB_TMO])) break; if (_sp > XB_SPIN_CAP) { atomicAdd(&(bar)[XB_TMO], 1u); break; } } } } while (0)
struct XcdBarrier { unsigned* bar; unsigned x; volatile LASP unsigned* st; };
__device__ __forceinline__ XcdBarrier xcd_barrier_post(unsigned* bar, volatile LASP unsigned* st, bool leader) {
    XcdBarrier b; b.bar = bar; b.x = xb_xcc_id(); b.st = st;
    if (leader) (void)xb_add(&bar[XB_XCNT(b.x)], 1u);
    return b;
}
__device__ __forceinline__ void xcd_barrier_complete(unsigned* bar, unsigned x, unsigned& nloc, unsigned& nx) {
    const unsigned G = gridDim.x * gridDim.y * gridDim.z;
    unsigned sum, cnt, mine, sp = 0u;
    for (;;) {
        sum = 0u; cnt = 0u; mine = 0u;
#pragma unroll
        for (unsigned j = 0; j < 16; ++j) { const unsigned c = xb_ld(&bar[XB_XCNT(j)]); sum += c; cnt += (c > 0u) ? 1u : 0u; mine = (j == x) ? c : mine; }
        if (sum == G) break;
        __builtin_amdgcn_s_sleep(1);
        if ((++sp & 255u) == 0u) { if (xb_ld(&bar[XB_TMO])) break; if (sp > XB_SPIN_CAP) { atomicAdd(&bar[XB_TMO], 1u); break; } }
    }
    nloc = mine > 0u ? mine : 1u; nx = cnt > 0u ? cnt : 1u;
}
__device__ __forceinline__ void xcd_barrier(const XcdBarrier& b, const int wid0) {
    const bool leader = wid0 == 0 && lane_id_v() == 0;
    asm volatile("s_waitcnt vmcnt(0)" ::: "memory");
    __syncthreads();
    if (leader) {
        unsigned* bar = b.bar;
        __builtin_amdgcn_s_waitcnt(0);
        unsigned nloc = b.st[0], nx = b.st[1];
        if (nloc == 0u) { xcd_barrier_complete(bar, b.x, nloc, nx); b.st[0] = nloc; b.st[1] = nx; }
        const unsigned old = xb_add(&bar[XB_XSUB(b.x)], 1u);
        const unsigned gen = old / nloc;
        if (old + 1u == (gen + 1u) * nloc) {
            __builtin_amdgcn_fence(__ATOMIC_RELEASE, "agent");
            asm volatile("s_waitcnt vmcnt(0)" ::: "memory");
            const unsigned og = xb_add(&bar[XB_TOP], 1u);
            const unsigned tg = og / nx;
            if (og + 1u == (tg + 1u) * nx) xb_add(&bar[XB_TOPGEN], 1u);
            else XB_SPIN(xb_ld(&bar[XB_TOPGEN]) == tg, bar);
            __builtin_amdgcn_fence(__ATOMIC_ACQUIRE, "agent");
            xb_add(&bar[XB_XGEN(b.x)], 1u);
            asm volatile("s_waitcnt vmcnt(0)" ::: "memory");
        } else {
            XB_SPIN(xb_ld(&bar[XB_XGEN(b.x)]) == gen, bar);
            __builtin_amdgcn_fence(__ATOMIC_ACQUIRE, "agent");
            asm volatile("s_waitcnt vmcnt(0)" ::: "memory");
        }
    }
    __syncthreads();
}

typedef float f32x4v __attribute__((ext_vector_type(4)));
typedef unsigned u32x4w __attribute__((ext_vector_type(4)));
__device__ __forceinline__ float rope_inv(int e, int dim) { return exp2f(-(float)e / (float)dim * 18.931568569324174f); }
__device__ __forceinline__ void rope_cs(float ang, float& cs, float& sn) { const double t = (double)ang * 0.15915494309189535; const float a = (float)((t - rint(t)) * 6.283185307179586); cs = cosf(a); sn = sinf(a); }
template <int MAP> __device__ __forceinline__ int prep_src(int n) { if (MAP == 0) return src_w1(n); if (MAP == 1) return src_wv(n); if (MAP == 2) return src_w3(n); if (MAP == 3) return src_uq(n); if (MAP == 4) return src_uk(n); if (MAP == 5) return src_uv(n); return n; }
struct alignas(8) F2v { float x, y; };
template <int MAP> __device__ __forceinline__ void prep_item(const float* src, int src_ld, const float* rowscale, bf16_t* dst, int N, int K, int item, int lane, LASP float* scr) {
    const int nblk = N / 32, kb = item / nblk, nb = item % nblk, k0 = 64 * kb, n0 = 32 * nb, g4 = 4 * (lane & 7), kr = lane >> 3;
    const int s0 = prep_src<MAP>(n0 + g4), s2 = prep_src<MAP>(n0 + g4 + 2);
    const bool quad = s0 >= 0 && s2 == s0 + 2 && (s0 & 3) == 0;
#pragma unroll
    for (int i = 0; i < 8; ++i) { const int kk = 8 * i + kr; const float* row = src + (size_t)(k0 + kk) * src_ld; const float sc = rowscale ? rowscale[k0 + kk] : 1.f;
        F4v v = {0.f, 0.f, 0.f, 0.f};
        if (quad) v = *(const F4v*)(row + s0); else if (s0 >= 0) { const F2v a = *(const F2v*)(row + s0), b2 = *(const F2v*)(row + s2); v.x = a.x; v.y = a.y; v.z = b2.x; v.w = b2.y; }
        LASP float* t = scr + kk * 33 + g4; t[0] = v.x * sc; t[1] = v.y * sc; t[2] = v.z * sc; t[3] = v.w * sc; }
    asm volatile("s_waitcnt lgkmcnt(0)" ::: "memory");
    const int c = lane & 7;
#pragma unroll
    for (int j = 0; j < 4; ++j) { const int n = (lane >> 3) + 8 * j; const LASP float* t = scr + (8 * c) * 33 + n;
        u32x4w o; o.x = pk2(t[0 * 33], t[1 * 33]); o.y = pk2(t[2 * 33], t[3 * 33]); o.z = pk2(t[4 * 33], t[5 * 33]); o.w = pk2(t[6 * 33], t[7 * 33]);
        *(u32x4w*)(dst + (size_t)(n0 + n) * K + k0 + 8 * c) = o; }
    asm volatile("s_waitcnt lgkmcnt(0)" ::: "memory");
}
__device__ __forceinline__ void prologue_part(const Params& p, LASP unsigned char* lds, int G, int c, int wave) {
    int lane_ = lane_id_v(); const int lane = lane_;
    const int gw = c * 8 + wave, NGW = G * 8;
    for (int i = gw * 64 + lane; i < NPOS * 16; i += NGW * 64) {
        { const int pos = i / 16, j = i % 16; const float ang = (float)pos * rope_inv(2 * j, 32); float cs, sn; rope_cs(ang, cs, sn); p.cosm()[i] = cs; p.sinm()[i] = sn; }
        if (i < NPOS * 8) { const int pos = i / 8, j = i % 8; const float ang = (float)pos * rope_inv(2 * j, 16); float cs, sn; rope_cs(ang, cs, sn); p.cosd()[i] = cs; p.sind()[i] = sn; }
        if (i < DEPTH) { const float* lm = p.dlam + i * 4 * 64; float s0 = 0.f, s1 = 0.f; for (int d = 0; d < 64; ++d) { s0 += lm[d] * lm[64 + d]; s1 += lm[128 + d] * lm[192 + d]; }
            p.lamv()[i] = expf(s0) - expf(s1) + (i == 0 ? 0.2f : 0.35550906759f); }
    }
    LASP float* scr = (LASP float*)(lds + wave * 16384);
    constexpr int I_W1 = (D / 64) * (N1 / 32), I_WV = (D / 64) * (2 * W / 32), I_W3 = (D / 64) * (N3 / 32), I_UQ = (QR / 64) * (QBW / 32), I_UK = (KVR / 64) * (W / 32), I_WO = (W / 64) * (D / 32), I_OUT = (D / 64) * (D / 32);
    constexpr int I_L = I_W1 + I_WV + I_W3 + I_UQ + 2 * I_UK + 3 * I_WO + I_OUT;
    for (int it = gw; it < 2 * I_L; it += NGW) {
        const int l = it / I_L; int r = it % I_L;
        const float* win = p.w_in + (size_t)l * D * INC; const float* ng = p.norm_g + l * D;
        if (r < I_W1) { prep_item<0>(win, INC, ng, wptr(p, l, WL_W1), N1, D, r, lane, scr); continue; } r -= I_W1;
        if (r < I_WV) { prep_item<1>(win, INC, ng, wptr(p, l, WL_WV), 2 * W, D, r, lane, scr); continue; } r -= I_WV;
        if (r < I_W3) { prep_item<2>(win, INC, ng, wptr(p, l, WL_W3), N3, D, r, lane, scr); continue; } r -= I_W3;
        if (r < I_UQ) { prep_item<3>(p.w_uq + (size_t)l * QR * QBW, QBW, p.cq_g + l * QR, wptr(p, l, WL_UQ), QBW, QR, r, lane, scr); continue; } r -= I_UQ;
        if (r < I_UK) { prep_item<4>(p.w_ukv + (size_t)l * KVR * NH * 128, NH * 128, p.ckv_g + l * KVR, wptr(p, l, WL_UK), W, KVR, r, lane, scr); continue; } r -= I_UK;
        if (r < I_UK) { prep_item<5>(p.w_ukv + (size_t)l * KVR * NH * 128, NH * 128, p.ckv_g + l * KVR, wptr(p, l, WL_UV), W, KVR, r, lane, scr); continue; } r -= I_UK;
        if (r < 3 * I_WO) { const int b = r / I_WO; const float* const w0 = opq(p.w_osb); const float* const w1 = opq(p.w_omla); const float* const w2 = opq(p.w_odiff); const float* wo = (b == 0 ? w0 : b == 1 ? w1 : w2) + (size_t)l * W * D;
            prep_item<6>(wo, D, nullptr, wptr(p, l, WL_WO) + (size_t)b * D * W, D, W, r % I_WO, lane, scr); continue; } r -= 3 * I_WO;
        prep_item<6>(p.w_out + (size_t)l * D * D, D, nullptr, wptr(p, l, WL_OUT), D, D, r, lane, scr);
    }
    for (int row = gw; row < R; row += NGW) {
        const int b = row / TB, t = row % TB; f32x4v v[D / 256]; float ss = 0.f;
#pragma unroll
        for (int j = 0; j < D / 256; ++j) { const int col = 256 * j + 4 * lane;
            if (t < LEAD) v[j] = (f32x4v){0.f, 0.f, 0.f, 0.f}; else if (t < LEAD + NMETA) v[j] = *(const f32x4v*)(p.meta + (size_t)(t - LEAD) * D + col); else v[j] = *(const f32x4v*)(p.x + ((size_t)b * SEQ + (t - LEAD - NMETA)) * D + col);
            ss += (v[j].x * v[j].x + v[j].y * v[j].y) + (v[j].z * v[j].z + v[j].w * v[j].w); }
        ss = wave_sum(ss);
#pragma unroll
        for (int j = 0; j < D / 256; ++j) { const int col = 256 * j + 4 * lane; *(f32x4v*)(p.X() + (size_t)row * D + col) = v[j]; st4(p.XB() + (size_t)row * D + col, v[j].x, v[j].y, v[j].z, v[j].w); }
        if (lane < NSX) p.ssx()[(size_t)row * NSX + lane] = lane == 0 ? ss : 0.f;
    }
}
__device__ __forceinline__ void x2bf_part(const Params& p, int G, int c, int wave) {
    int lane_ = lane_id_v(); const int lane = lane_;
    for (int row = c * 8 + wave; row < R; row += G * 8) {
#pragma unroll
        for (int j = 0; j < D / 256; ++j) { const int col = 256 * j + 4 * lane; const f32x4v v = *(const f32x4v*)(p.X() + (size_t)row * D + col); st4(p.XB2() + (size_t)row * D + col, v.x, v.y, v.z, v.w); } }
}
__device__ __forceinline__ void final_part(const Params& p, int G, int c, int wave) {
    int lane_ = lane_id_v(); const int lane = lane_;
    for (int i = c * 8 + wave; i < NB * SEQ; i += G * 8) {
        const int b = i / SEQ, sq = i % SEQ; const float* x = p.X() + ((size_t)b * TB + LEAD + NMETA + sq) * D; f32x4v v[D / 256]; float ss = 0.f;
#pragma unroll
        for (int j = 0; j < D / 256; ++j) { v[j] = *(const f32x4v*)(x + 256 * j + 4 * lane); ss += (v[j].x * v[j].x + v[j].y * v[j].y) + (v[j].z * v[j].z + v[j].w * v[j].w); }
        const float rs = rsq(wave_sum(ss) * (1.0f / D) + EPS);
#pragma unroll
        for (int j = 0; j < D / 256; ++j) { const f32x4v g = *(const f32x4v*)(p.final_g + 256 * j + 4 * lane); *(f32x4v*)(p.out + (size_t)i * D + 256 * j + 4 * lane) = v[j] * rs * g; }
    }
}
constexpr int N_PHASES = 2 + 6 * DEPTH;
constexpr int CW_QUEUE = 1024, CW_BAR = 4096;
#define MK_SEAM(k) do { if ((k) + 1 < ph_hi) xcd_barrier(bar, wid0); } while (0)
#define MK_IN(k) (ph_lo <= (k) && (k) < ph_hi)
#ifndef PROBE_DUP
#define PROBE_DUP 0
#endif
template <int L> __device__ __forceinline__ void layer_phases(const Params& p, LASP unsigned char* lds, const XcdBarrier& bar, int ph_lo, int ph_hi, int G, int c, int wid0) {
    constexpr int B0 = 1 + 6 * L;
    if (MK_IN(B0 + 0)) { gemm_part(p, lds, PK_P1, L, G, c, wid0); if (PROBE_DUP & 2) gemm_part(p, lds, PK_P1, L, G, c, wid0); MK_SEAM(B0 + 0); }
    if (MK_IN(B0 + 1)) { gemm_part(p, lds, PK_P2, L, G, c, wid0); att::attn_part(p, lds, att::AK_P2, L, wid0); MK_SEAM(B0 + 1); }
    if (MK_IN(B0 + 2)) { x2bf_part(p, G, c, wid0); att::attn_part(p, lds, att::AK_P3, L, wid0); if (PROBE_DUP & 4) { x2bf_part(p, G, c, wid0); att::attn_part(p, lds, att::AK_P3, L, wid0, 1); } MK_SEAM(B0 + 2); }
    if (MK_IN(B0 + 3)) { gemm_part(p, lds, PK_P3B, L, G, c, wid0); MK_SEAM(B0 + 3); }
    if (MK_IN(B0 + 4)) { gemm_part(p, lds, PK_P4, L, G, c, wid0); if (PROBE_DUP & 8) gemm_part(p, lds, PK_P4, L, G, c, wid0); MK_SEAM(B0 + 4); }
    if (MK_IN(B0 + 5)) { lt_merge(p, L, G, c, wid0); gemm_part(p, lds, PK_P5, L, G, c, wid0); MK_SEAM(B0 + 5); }
}
__global__ void __launch_bounds__(512, 2) mk_fwd(Params p, int ph_lo, int ph_hi) {
    extern __shared__ __attribute__((aligned(16))) unsigned char lds_raw[];
    LASP unsigned char* lds = (LASP unsigned char*)lds_raw;
    volatile LASP unsigned* misc = (volatile LASP unsigned*)(lds + LDS_SCR + 4096);
    const int wid0 = __builtin_amdgcn_readfirstlane((int)threadIdx.x >> 6);
    if (threadIdx.x < 64) misc[threadIdx.x] = 0u;
    __syncthreads();
    const int G = (int)gridDim.x, c = (int)blockIdx.x;
    const XcdBarrier bar = xcd_barrier_post(p.ctl() + CW_BAR, misc + 8, threadIdx.x == 0);
    if (MK_IN(0)) { prologue_part(p, lds, G, c, wid0); if (PROBE_DUP & 1) prologue_part(p, lds, G, c, wid0); MK_SEAM(0); }
    layer_phases<0>(p, lds, bar, ph_lo, ph_hi, G, c, wid0);
    layer_phases<1>(p, lds, bar, ph_lo, ph_hi, G, c, wid0);
    if (MK_IN(N_PHASES - 1)) { final_part(p, G, c, wid0); if (PROBE_DUP & 1) final_part(p, G, c, wid0); }
}
#endif

#ifdef HOST_EMU
typedef int hipStream_t;
#endif
#define NBLK(n, t) (((long)(n) + (t) - 1) / (t))
#ifndef HOST_EMU
#ifndef MK_SPLIT
#define MK_SPLIT 0
#endif
extern "C" void kernel_launch(void* const* d_in, const int* in_sizes, int n_in, void* d_out, int out_size, void* d_ws, size_t ws_size, hipStream_t stream) {
    if (n_in != 16 || in_sizes[0] != NB * SEQ * D || out_size != NB * SEQ * D || ws_size < WS_NEED) { fprintf(stderr, "kernel_launch: unexpected shapes / workspace (%d inputs, ws %zu, need %zu)\n", n_in, ws_size, (size_t)WS_NEED); return; }
    static int grid = 0;
    if (grid == 0) { int dev = 0, cus = 0; (void)hipGetDevice(&dev); (void)hipDeviceGetAttribute(&cus, hipDeviceAttributeMultiprocessorCount, dev); grid = cus > 0 ? cus : 256;
        if (hipFuncSetAttribute((const void*)mk_fwd, hipFuncAttributeMaxDynamicSharedMemorySize, LDS_BYTES) != hipSuccess) { fprintf(stderr, "kernel_launch: hipFuncSetAttribute failed\n"); grid = -1; } }
    if (grid < 0) return;
    const Params p = make_params(d_in, d_out, d_ws);
    (void)hipMemsetAsync((char*)d_ws + O_CTL, 0, 65536, stream);
#if MK_SPLIT
    for (int ph = 0; ph < N_PHASES; ++ph) hipLaunchKernelGGL(mk_fwd, dim3(grid), dim3(512), LDS_BYTES, stream, p, ph, ph + 1);
#else
    hipLaunchKernelGGL(mk_fwd, dim3(grid), dim3(512), LDS_BYTES, stream, p, 0, N_PHASES);
#endif
}
#else
extern "C" void kernel_launch(void* const* d_in, const int* in_sizes, int n_in, void* d_out, int out_size, void* d_ws, size_t ws_size, hipStream_t stream) {
    if (n_in != 16 || in_sizes[0] != NB * SEQ * D || out_size != NB * SEQ * D || ws_size < WS_NEED) { fprintf(stderr, "kernel_launch: unexpected shapes / workspace (%d inputs, ws %zu, need %zu)\n", n_in, ws_size, (size_t)WS_NEED); return; }
    const Params p = make_params(d_in, d_out, d_ws);
    const int T = 256;
#if 0
        (void)hipFuncSetAttribute((const void*)k_gemm_fast<PK_P1>, hipFuncAttributeMaxDynamicSharedMemorySize, LDS_BYTES); hipFuncSetAttribute((const void*)k_gemm_fast<PK_P2>, hipFuncAttributeMaxDynamicSharedMemorySize, LDS_BYTES);
        hipFuncSetAttribute((const void*)k_gemm_fast<PK_P3B>, hipFuncAttributeMaxDynamicSharedMemorySize, LDS_BYTES); hipFuncSetAttribute((const void*)k_gemm_fast<PK_P4>, hipFuncAttributeMaxDynamicSharedMemorySize, LDS_BYTES);
        hipFuncSetAttribute((const void*)k_gemm_fast<PK_P5>, hipFuncAttributeMaxDynamicSharedMemorySize, LDS_BYTES);
        hipFuncSetAttribute((const void*)k_attn_fast<att::AK_P2>, hipFuncAttributeMaxDynamicSharedMemorySize, LDS_BYTES); hipFuncSetAttribute((const void*)k_attn_fast<att::AK_P3>, hipFuncAttributeMaxDynamicSharedMemorySize, LDS_BYTES); }
    (void)hipMemsetAsync((char*)d_ws + O_CTL, 0, 65536, stream);
#endif
    LAUNCH(k_tables, NBLK(NPOS * 16, T), T, p);
    for (int l = 0; l < DEPTH; ++l) {
        LAUNCH(k_prep_w<0>, NBLK((long)N1 * D, T), T, wptr(p, l, WL_W1), N1, D, p.w_in + (size_t)l * D * INC, INC, p.norm_g + l * D);
        LAUNCH(k_prep_w<1>, NBLK((long)2 * W * D, T), T, wptr(p, l, WL_WV), 2 * W, D, p.w_in + (size_t)l * D * INC, INC, p.norm_g + l * D);
        LAUNCH(k_prep_w<2>, NBLK((long)N3 * D, T), T, wptr(p, l, WL_W3), N3, D, p.w_in + (size_t)l * D * INC, INC, p.norm_g + l * D);
        LAUNCH(k_prep_w<3>, NBLK((long)QBW * QR, T), T, wptr(p, l, WL_UQ), QBW, QR, p.w_uq + (size_t)l * QR * QBW, QBW, p.cq_g + l * QR);
        LAUNCH(k_prep_w<4>, NBLK((long)W * KVR, T), T, wptr(p, l, WL_UK), W, KVR, p.w_ukv + (size_t)l * KVR * NH * 128, NH * 128, p.ckv_g + l * KVR);
        LAUNCH(k_prep_w<5>, NBLK((long)W * KVR, T), T, wptr(p, l, WL_UV), W, KVR, p.w_ukv + (size_t)l * KVR * NH * 128, NH * 128, p.ckv_g + l * KVR);
        LAUNCH(k_prep_w<6>, NBLK((long)D * W, T), T, wptr(p, l, WL_WO), D, W, p.w_osb + (size_t)l * W * D, D, (const float*)nullptr);
        LAUNCH(k_prep_w<6>, NBLK((long)D * W, T), T, wptr(p, l, WL_WO) + (size_t)D * W, D, W, p.w_omla + (size_t)l * W * D, D, (const float*)nullptr);
        LAUNCH(k_prep_w<6>, NBLK((long)D * W, T), T, wptr(p, l, WL_WO) + (size_t)2 * D * W, D, W, p.w_odiff + (size_t)l * W * D, D, (const float*)nullptr);
        LAUNCH(k_prep_w<6>, NBLK((long)D * D, T), T, wptr(p, l, WL_OUT), D, D, p.w_out + (size_t)l * D * D, D, (const float*)nullptr);
    }
    LAUNCH(k_init_x, NBLK((long)R * D, T), T, p);
    LAUNCH(k_ssq_f32, NBLK(R, 64), 64, (const float*)p.X(), D, p.ssx(), NSX);
    for (int l = 0; l < DEPTH; ++l) {
        const int last = (l == DEPTH - 1) ? 1 : 0; (void)last;
#ifndef HOST_EMU
        FASTG(PK_P1, l);
        FASTG(PK_P2, l);
#else
        LAUNCH(k_gemm<F1>, NBLK((long)R * (V1_END / 8), T), T, (const bf16_t*)p.XB(), D, (const bf16_t*)wptr(p, l, WL_W1), D, R, V1_END, D, p, 0, 0);
        LAUNCH(k_gemm<F1>, NBLK((long)2 * W * (R / 8), T), T, (const bf16_t*)wptr(p, l, WL_WV), D, (const bf16_t*)p.XB(), D, 2 * W, R, D, p, 0, 1);
        LAUNCH(k_ssq_bf, NBLK(R, 64), 64, (const bf16_t*)p.CQ(), QR, p.ssq(), NSQ);
        LAUNCH(k_ssq_bf, NBLK(R, 64), 64, (const bf16_t*)p.CKV(), KVR, p.ssk(), NSK);
        LAUNCH(k_gemm<FUQ>, NBLK((long)R * (QBW / 8), T), T, (const bf16_t*)p.CQ(), QR, (const bf16_t*)wptr(p, l, WL_UQ), QR, R, QBW, QR, p, 0, 0);
        LAUNCH(k_gemm<FUK>, NBLK((long)R * (W / 8), T), T, (const bf16_t*)p.CKV(), KVR, (const bf16_t*)wptr(p, l, WL_UK), KVR, R, W, KVR, p, 0, 0);
        LAUNCH(k_gemm<FUK>, NBLK((long)W * (R / 8), T), T, (const bf16_t*)wptr(p, l, WL_UV), KVR, (const bf16_t*)p.CKV(), KVR, W, R, KVR, p, 0, 1);
#endif
#ifndef HOST_EMU
        hipLaunchKernelGGL(k_attn_fast<att::AK_P2>, dim3(grid), dim3(512), LDS_BYTES, stream, p, l);
        hipLaunchKernelGGL(k_attn_fast<att::AK_P3>, dim3(grid), dim3(512), LDS_BYTES, stream, p, l);
#else
        LAUNCH(k_attn_sb, NBLK((long)NB * NH * TB, 64), 64, p);
        LAUNCH(k_attn_diff, NBLK((long)NB * NHD * TB, 64), 64, p, l);
        LAUNCH(k_attn_mla, NBLK((long)NB * NH * TB, 64), 64, p);
#endif
        LAUNCH(k_x2bf, NBLK((long)R * D, T), T, p);
#ifndef HOST_EMU
        FASTG(PK_P3B, l); FASTG(PK_P4, l); FASTG(PK_P5, l);
#else
        LAUNCH(k_gemm<F3>, NBLK((long)R * (N3 / 8), T), T, (const bf16_t*)p.XB2(), D, (const bf16_t*)wptr(p, l, WL_W3), D, R, N3, D, p, l, 0);
        LAUNCH(k_gemm<F4>, NBLK((long)R * (D / 8), T), T, (const bf16_t*)p.QSB(), W, (const bf16_t*)wptr(p, l, WL_WO), W, R, D, W, p, 0, 0);
        LAUNCH(k_gemm<F4>, NBLK((long)R * (D / 8), T), T, (const bf16_t*)p.OMLA(), W, (const bf16_t*)(wptr(p, l, WL_WO) + (size_t)D * W), W, R, D, W, p, 0, 5);
        LAUNCH(k_gemm<F4>, NBLK((long)R * (D / 8), T), T, (const bf16_t*)p.QD(), W, (const bf16_t*)(wptr(p, l, WL_WO) + (size_t)2 * D * W), W, R, D, W, p, 0, 6);
        LAUNCH(k_gemm<F5>, NBLK((long)R * (D / 8), T), T, (const bf16_t*)p.G0(), D, (const bf16_t*)wptr(p, l, WL_OUT), D, R, D, D, p, last, 0);
        if (!last) LAUNCH(k_ssq_f32, NBLK(R, 64), 64, (const float*)p.X(), D, p.ssx(), NSX);
#endif
    }
    LAUNCH(k_final, NBLK((long)NB * SEQ, 64), 64, p);
}
#endif
```

```cpp
#ifndef HOST_EMU
#include <hip/hip_runtime.h>
#endif
#include <cstdio>
#include <cstdint>
#include <cmath>
#include <cstring>

#ifndef CFG_B
#define CFG_B 8
#endif
#ifndef CFG_S
#define CFG_S 2048
#endif
#ifndef CFG_D
#define CFG_D 1024
#endif

typedef unsigned short bf16_t;

namespace cfg {
constexpr int NB = CFG_B, SEQ = CFG_S, D = CFG_D, DEPTH = 2;
constexpr int NMETA = 16, LEAD = 48, TB = LEAD + NMETA + SEQ, R = NB * TB, NPOS = NMETA + SEQ;
constexpr int W = D / 2;
constexpr int NH = D / 128;
constexpr int NHD = D / 256;
constexpr int QR = 3 * D / 8, KVR = D / 4, QBW = NH * 96;
constexpr int INC = 4 * W + QR + KVR + 32 + W + 4 * W + 3 * D;
constexpr int C_SBQ = 0, C_SBK = W, C_SBV = 2 * W, C_SBZ = 3 * W, C_CQ = 4 * W, C_CKV = C_CQ + QR, C_KR = C_CKV + KVR, C_MZ = C_KR + 32,
              C_DQ = C_MZ + W, C_DK = C_DQ + W, C_DV = C_DK + W, C_DZ = C_DV + W, C_G = C_DZ + W;
static_assert(C_G + 3 * D == INC, "w_in columns");
constexpr int V1_SBQ = 0, V1_SBK = W, V1_CQ = 2 * W, V1_CKV = V1_CQ + QR, V1_KR = V1_CKV + KVR, V1_DQ = V1_KR + 32, V1_DK = V1_DQ + W, V1_END = V1_DK + W;
constexpr int N1 = (V1_END + 255) / 256 * 256;
constexpr int N3 = 3 * W + 3 * D;
constexpr int NSX = D / 32, NSQ = QR / 32, NSK = KVR / 32;
constexpr float EPS = 1e-6f, LOG2E = 1.4426950408889634f;
constexpr int GP = D / 256;
constexpr int LT_ROW0 = (R / 256 - 2) * 256;
}
using namespace cfg;

#ifdef HOST_EMU
#define DEVFN inline
#define HDFN inline
#else
#define DEVFN __device__ __forceinline__
#define HDFN __host__ __device__ __forceinline__
#endif
constexpr size_t MiB = size_t(1) << 20;
constexpr size_t al256(size_t x) { return (x + 255) & ~size_t(255); }
constexpr size_t SZ_W = (size_t)R * W * 2, SZ_D2 = (size_t)R * D * 2, SZ_X = (size_t)R * D * 4, SZ_CQ = (size_t)R * QR * 2, SZ_CKV = (size_t)R * KVR * 2,
                 SZ_KR = (size_t)R * 32 * 2, SZ_QB = (size_t)R * QBW * 2, SZ_GP = (size_t)R * 256 * 2;
constexpr size_t WB_W1 = (size_t)N1 * D * 2, WB_WV = (size_t)2 * W * D * 2, WB_W3 = (size_t)N3 * D * 2, WB_UQ = (size_t)QBW * QR * 2, WB_UK = (size_t)W * KVR * 2,
                 WB_UV = WB_UK, WB_WO = (size_t)3 * D * W * 2, WB_OUT = (size_t)D * D * 2;
constexpr size_t WL_W1 = 0, WL_WV = WL_W1 + WB_W1, WL_W3 = WL_WV + WB_WV, WL_UQ = WL_W3 + WB_W3, WL_UK = WL_UQ + WB_UQ, WL_UV = WL_UK + WB_UK, WL_WO = WL_UV + WB_UV,
                 WL_OUT = WL_WO + WB_WO, WL_BYTES = al256(WL_OUT + WB_OUT);
constexpr bool STDCFG = (NB == 8 && SEQ == 2048 && D == 1024);
#if defined(HOST_EMU)
constexpr bool HANDMAP = false;
#else
constexpr bool HANDMAP = STDCFG;
#endif
constexpr size_t O_CTL = 0, O_TAB = 1 * MiB, O_LAM = O_TAB + 768 * 1024, O_SSX = 2 * MiB, O_SSQ = O_SSX + al256((size_t)R * NSX * 4), O_SSK = O_SSQ + al256((size_t)R * NSQ * 4),
                 O_WTS = al256(O_SSK + (size_t)R * NSK * 4 + MiB) / MiB * MiB;
constexpr size_t O_X = HANDMAP ? 52 * MiB : al256(O_WTS + 2 * WL_BYTES);
static_assert(O_WTS + 2 * WL_BYTES <= O_X, "weights overrun X");
constexpr size_t O_A = O_X + al256(SZ_X);
constexpr size_t Q_QSB = O_A, Q_QD = Q_QSB + al256(SZ_W), Q_OMLA = Q_QD + al256(SZ_W), Q_KSB = Q_OMLA + al256(SZ_W), Q_VSBT = Q_KSB + al256(SZ_W), Q_KD = Q_VSBT + al256(SZ_W),
                 Q_VDT = Q_KD + al256(SZ_W), Q_VBT = Q_VDT + al256(SZ_W), Q_KR = Q_VBT + al256(SZ_W), Q_CKV = Q_KR + al256(SZ_KR), Q_XB2 = Q_CKV + al256(SZ_CKV), Q_G0 = Q_XB2 + al256(SZ_D2),
                 Q_GPC = Q_G0 + al256(SZ_D2), Q_XB = Q_GPC + 2 * GP * al256(SZ_GP), Q_QB = Q_XB + al256(SZ_D2), Q_CQ = Q_QB + al256(SZ_QB), Q_KNOPE = Q_CQ + al256(SZ_CQ), Q_END = Q_KNOPE + al256(SZ_W);
constexpr size_t WS_NEED = HANDMAP ? 256 * MiB : Q_END;

constexpr size_t mibf(double m) { return (size_t)(m * 1048576.0); }
struct Params {
    const float *x, *meta, *norm_g, *w_in, *b_gate, *cq_g, *ckv_g, *w_uq, *w_ukv, *dlam, *dnorm_g, *w_osb, *w_omla, *w_odiff, *w_out, *final_g;
    float* out; char* ws;
#define WS_F32(name, off) HDFN float* name() const { return (float*)(ws + (off)); }
#define WS_B16(name, off) HDFN bf16_t* name() const { return (bf16_t*)(ws + (off)); }
#define OB_B16(name, offh, offq) HDFN bf16_t* name() const { return HANDMAP ? (bf16_t*)((char*)out + (offh)) : (bf16_t*)(ws + (offq)); }
    HDFN unsigned* ctl() const { return (unsigned*)(ws + O_CTL); }
    WS_F32(cosm, O_TAB) WS_F32(sinm, O_TAB + (size_t)NPOS * 16 * 4) WS_F32(cosd, O_TAB + (size_t)NPOS * 32 * 4) WS_F32(sind, O_TAB + (size_t)NPOS * 40 * 4) WS_F32(lamv, O_LAM)
    WS_F32(ssx, O_SSX) WS_F32(ssq, O_SSQ) WS_F32(ssk, O_SSK) WS_F32(X, O_X)
    HDFN char* WTS() const { return ws + O_WTS; }
    WS_B16(QSB, HANDMAP ? mibf(118) : Q_QSB) WS_B16(QD, HANDMAP ? mibf(134.5) : Q_QD) WS_B16(OMLA, HANDMAP ? mibf(151) : Q_OMLA) WS_B16(CKV, HANDMAP ? mibf(151) : Q_CKV) WS_B16(KSB, HANDMAP ? mibf(167.5) : Q_KSB)
    WS_B16(VSBT, HANDMAP ? mibf(184) : Q_VSBT) WS_B16(KD, HANDMAP ? mibf(200.5) : Q_KD) WS_B16(VDT, HANDMAP ? mibf(217) : Q_VDT) WS_B16(VBT, HANDMAP ? mibf(233.5) : Q_VBT) WS_B16(KR, HANDMAP ? mibf(250) : Q_KR)
    WS_B16(XB2, HANDMAP ? mibf(167.5) : Q_XB2) WS_B16(G0, HANDMAP ? mibf(200.5) : Q_G0)
    OB_B16(XB, 0, Q_XB) OB_B16(QB, 0, Q_QB) OB_B16(CQ, mibf(33), Q_CQ) OB_B16(KNOPE, mibf(45.5), Q_KNOPE)
    HDFN unsigned char* G8() const { return HANDMAP ? (unsigned char*)out : (unsigned char*)(ws + Q_GPC); }
};
static Params make_params(void* const* d_in, void* d_out, void* d_ws) {
    Params p{};
    const float* const* in = (const float* const*)d_in;
    p.x = in[0]; p.meta = in[1]; p.norm_g = in[2]; p.w_in = in[3]; p.b_gate = in[4]; p.cq_g = in[5]; p.ckv_g = in[6]; p.w_uq = in[7]; p.w_ukv = in[8]; p.dlam = in[9];
    p.dnorm_g = in[10]; p.w_osb = in[11]; p.w_omla = in[12]; p.w_odiff = in[13]; p.w_out = in[14]; p.final_g = in[15];
    p.out = (float*)d_out; p.ws = (char*)d_ws;
    return p;
}
static_assert(!STDCFG || (SZ_W == (size_t)(16.5 * 1048576) && SZ_D2 == 33 * MiB && SZ_GP == (size_t)(8.25 * 1048576) && SZ_QB == (size_t)(24.75 * 1048576) && SZ_CQ <= (size_t)(12.5 * 1048576) &&
              SZ_KR <= (size_t)(1.1 * 1048576) && SZ_X == 66 * MiB && GP == 4), "hand map sizes");

#ifdef HOST_EMU
template <class T> DEVFN T* opq(T* p) { return p; }
#else
DEVFN int lane_id_v() { int l; asm volatile("v_mbcnt_lo_u32_b32 %0, -1, 0\n\tv_mbcnt_hi_u32_b32 %0, -1, %0" : "=v"(l)); return l; }
template <class T> DEVFN T* opq(T* p) { asm volatile("" : "+s"(p)); return p; }
#endif
DEVFN float bf2f(bf16_t h) { unsigned u = (unsigned)h << 16; float f; memcpy(&f, &u, 4); return f; }
DEVFN bf16_t f2bf(float f) { unsigned u; memcpy(&u, &f, 4); return (bf16_t)((u + 0x7fffu + ((u >> 16) & 1u)) >> 16); }
struct alignas(16) U4 { unsigned x, y, z, w; };
DEVFN void ld8(const bf16_t* p, float* o) {
    const U4 v = *(const U4*)p; const unsigned u[4] = {v.x, v.y, v.z, v.w};
#pragma unroll
    for (int i = 0; i < 4; ++i) { unsigned lo = u[i] << 16, hi = u[i] & 0xffff0000u; memcpy(&o[2 * i], &lo, 4); memcpy(&o[2 * i + 1], &hi, 4); }
}
DEVFN float rsq(float x) { return 1.0f / sqrtf(x); }
DEVFN float rstd_slots(const float* s, int row, int ns, float invn) { float t = 0.f; for (int i = 0; i < ns; ++i) t += s[(size_t)row * ns + i]; return rsq(t * invn + EPS); }
DEVFN int sperm(int r) { return (r & ~12) | ((r & 4) << 1) | ((r & 8) >> 1); }
static_assert((size_t)R * 3 * D <= (HANDMAP ? 64 * MiB : 2 * GP * al256(SZ_GP)), "gate buffer");
DEVFN unsigned char* g8ptr(const Params& p, int b, int row, int c) { return p.G8() + (size_t)row * (3 * D) + b * D + c; }
HDFN bf16_t* wptr(const Params& p, int l, size_t off) { return (bf16_t*)(p.WTS() + (size_t)l * WL_BYTES + off); }
#ifdef HOST_EMU
DEVFN float sigm_f(float z) { return 1.f / (1.f + expf(-z)); }
#define UNI(x) (x)
#else
DEVFN float sigm_f(float z) { return __builtin_amdgcn_rcpf(1.0f + __builtin_amdgcn_exp2f(-1.4426950408889634f * z)); }
#define UNI(x) __builtin_amdgcn_readfirstlane(x)
#endif
DEVFN float silu_f(float z) { return z * sigm_f(z); }
struct alignas(8) U2 { unsigned x, y; };
#ifdef HOST_EMU
DEVFN unsigned pk2(float lo, float hi) { return (unsigned)f2bf(lo) | ((unsigned)f2bf(hi) << 16); }
#else
typedef float f32x2_t __attribute__((ext_vector_type(2))); typedef __bf16 bf16x2_t __attribute__((ext_vector_type(2)));
DEVFN unsigned pk2(float lo, float hi) { f32x2_t v = {lo, hi}; bf16x2_t b = __builtin_convertvector(v, bf16x2_t); return __builtin_bit_cast(unsigned, b); }
#endif
DEVFN void st4(bf16_t* p, float a, float b, float c, float d) { U2 v; v.x = pk2(a, b); v.y = pk2(c, d); *(U2*)p = v; }
DEVFN void st2(bf16_t* p, float a, float b) { *(unsigned*)p = pk2(a, b); }
DEVFN void st8(bf16_t* p, const float* v) { U4 w; w.x = pk2(v[0], v[1]); w.y = pk2(v[2], v[3]); w.z = pk2(v[4], v[5]); w.w = pk2(v[6], v[7]); *(U4*)p = w; }
DEVFN void up8(const U4& v, float* o) { const unsigned u[4] = {v.x, v.y, v.z, v.w};
#pragma unroll
    for (int i = 0; i < 4; ++i) { unsigned lo = u[i] << 16, hi = u[i] & 0xffff0000u; memcpy(&o[2 * i], &lo, 4); memcpy(&o[2 * i + 1], &hi, 4); } }
struct alignas(16) F4v { float x, y, z, w; };
#ifdef HOST_EMU
DEVFN U2 q8pack(const float* g) { unsigned w[2] = {0u, 0u}; for (int i = 0; i < 8; ++i) { float t = g[i] * 255.f + 0.5f; unsigned q = t <= 0.f ? 0u : t >= 255.f ? 255u : (unsigned)t; w[i >> 2] |= q << (8 * (i & 3)); } U2 r; r.x = w[0]; r.y = w[1]; return r; }
DEVFN void q8unpack(const U2& w, float* g) { for (int i = 0; i < 8; ++i) g[i] = (float)(((i < 4 ? w.x : w.y) >> (8 * (i & 3))) & 255u) * (1.0f / 255.0f); }
#else
DEVFN U2 q8pack(const float* g) { U2 r; r.x = 0u; r.y = 0u;
    r.x = __builtin_amdgcn_cvt_pk_u8_f32(g[0] * 255.f, 0, r.x); r.x = __builtin_amdgcn_cvt_pk_u8_f32(g[1] * 255.f, 1, r.x); r.x = __builtin_amdgcn_cvt_pk_u8_f32(g[2] * 255.f, 2, r.x); r.x = __builtin_amdgcn_cvt_pk_u8_f32(g[3] * 255.f, 3, r.x);
    r.y = __builtin_amdgcn_cvt_pk_u8_f32(g[4] * 255.f, 0, r.y); r.y = __builtin_amdgcn_cvt_pk_u8_f32(g[5] * 255.f, 1, r.y); r.y = __builtin_amdgcn_cvt_pk_u8_f32(g[6] * 255.f, 2, r.y); r.y = __builtin_amdgcn_cvt_pk_u8_f32(g[7] * 255.f, 3, r.y); return r; }
DEVFN void q8unpack(const U2& w, float* g) { const float k = 1.0f / 255.0f;
    g[0] = (float)(w.x & 255u) * k; g[1] = (float)((w.x >> 8) & 255u) * k; g[2] = (float)((w.x >> 16) & 255u) * k; g[3] = (float)(w.x >> 24) * k;
    g[4] = (float)(w.y & 255u) * k; g[5] = (float)((w.y >> 8) & 255u) * k; g[6] = (float)((w.y >> 16) & 255u) * k; g[7] = (float)(w.y >> 24) * k; }
#endif
DEVFN void ld4(const bf16_t* p, float* o) { const U2 v = *(const U2*)p; unsigned t; t = v.x << 16; memcpy(&o[0], &t, 4); t = v.x & 0xffff0000u; memcpy(&o[1], &t, 4); t = v.y << 16; memcpy(&o[2], &t, 4); t = v.y & 0xffff0000u; memcpy(&o[3], &t, 4); }

DEVFN int rotmap(int c, int half) { const int g = c >> 2, e = c & 3; return e < 2 ? 2 * g + e : half + 2 * g + (e - 2); }
DEVFN int src_w1(int n) {
    if (n < V1_SBK) return C_SBQ + n;
    if (n < V1_CQ) return C_SBK + (n - V1_SBK);
    if (n < V1_CKV) return C_CQ + (n - V1_CQ);
    if (n < V1_KR) return C_CKV + (n - V1_CKV);
    if (n < V1_DQ) return C_KR + rotmap(n - V1_KR, 16);
    if (n < V1_DK) { const int c = n - V1_DQ, cc = c & 63; return C_DQ + (c & ~63) + (cc < 16 ? rotmap(cc, 8) : cc); }
    if (n < V1_END) { const int c = n - V1_DK, cc = c & 63; return C_DK + (c & ~63) + (cc < 16 ? rotmap(cc, 8) : cc); }
    return -1;
}
DEVFN int src_wv(int n) { return n < W ? C_SBV + n : C_DV + (n - W); }
DEVFN int src_w3(int n) { return n < W ? C_SBZ + n : n < 2 * W ? C_MZ + (n - W) : n < 3 * W ? C_DZ + (n - 2 * W) : C_G + (n - 3 * W); }
DEVFN int src_uq(int n) { const int h = n / 96, cc = n % 96; return h * 96 + (cc < 64 ? cc : 64 + rotmap(cc - 64, 16)); }
DEVFN int src_uk(int n) { return (n >> 6) * 128 + (n & 63); }
DEVFN int src_uv(int n) { return (n >> 6) * 128 + 64 + (n & 63); }

#ifdef HOST_EMU
DEVFN float quad_sum(float s) { return s; }
#else
template <int CTRL> DEVFN float dpp_get(float s) { return __int_as_float(__builtin_amdgcn_update_dpp(0, __float_as_int(s), CTRL, 0xf, 0xf, true)); }
DEVFN float xor16_sum(float s) { auto r = __builtin_amdgcn_permlane16_swap(__float_as_uint(s), __float_as_uint(s), false, false); return __uint_as_float(r[0]) + __uint_as_float(r[1]); }
DEVFN float xor32_sum(float s) { auto r = __builtin_amdgcn_permlane32_swap(__float_as_uint(s), __float_as_uint(s), false, false); return __uint_as_float(r[0]) + __uint_as_float(r[1]); }
DEVFN float quad_sum(float s) { return xor32_sum(xor16_sum(s)); }
DEVFN float quad4_sum(float s) { s += dpp_get<0xB1>(s); s += dpp_get<0x4E>(s); return s; }
DEVFN float wave_sum(float s) { s = quad4_sum(s); s += dpp_get<0x124>(s); s += dpp_get<0x128>(s); return xor32_sum(xor16_sum(s)); }
#endif
struct NoPre {};
DEVFN float ssq8(const float* v) { return ((v[0] * v[0] + v[1] * v[1]) + (v[2] * v[2] + v[3] * v[3])) + ((v[4] * v[4] + v[5] * v[5]) + (v[6] * v[6] + v[7] * v[7])); }
DEVFN void rope4(bf16_t* o, int half, int g, const float* v, const float* cs, const float* sn, float sc) {
    const float c0 = cs[2 * g], c1 = cs[2 * g + 1], s0 = sn[2 * g], s1 = sn[2 * g + 1];
    st2(o + 2 * g, (v[0] * c0 - v[2] * s0) * sc, (v[1] * c1 - v[3] * s1) * sc); st2(o + half + 2 * g, (v[2] * c0 + v[0] * s0) * sc, (v[3] * c1 + v[1] * s1) * sc);
}
struct F1 {
    const Params& p; int aux; typedef NoPre Pre;
    DEVFN bool swapped(int tag) const { return tag == 1; }
    DEVFN float scale(int tag, int idx) const { return rstd_slots(p.ssx(), idx, NSX, 1.0f / D); }
    DEVFN void preload(int, int, int, Pre&) const {}
    DEVFN float apply(int tag, int row, int vc, const float* a, const float* sc, const Pre&) const {
        if (tag == 1) { const bool sb = UNI(row) < W; bf16_t* const vs = opq(p.VSBT()); bf16_t* const vd = opq(p.VDT()); bf16_t* o = (sb ? vs + (size_t)row * R : vd + (size_t)(row - W) * R) + (vc & ~15);
            const int t0 = vc & 15;
            st4(o + sperm(t0), a[0] * sc[0], a[1] * sc[1], a[2] * sc[2], a[3] * sc[3]); st4(o + sperm(t0 + 4), a[4] * sc[4], a[5] * sc[5], a[6] * sc[6], a[7] * sc[7]); return 0.f; }
        const int vcu = UNI(vc); const float rs = sc[0]; float v[8];
#pragma unroll
        for (int i = 0; i < 8; ++i) v[i] = a[i] * rs;
        const int t = row % TB; const int pos = t >= LEAD ? t - LEAD : 0;
        if (vcu < V1_SBK) {
#pragma unroll
            for (int i = 0; i < 8; ++i) v[i] *= 0.125f * LOG2E;
            st8(p.QSB() + (size_t)row * W + vc, v); }
        else if (vcu < V1_CQ) { st8(p.KSB() + (size_t)row * W + (vc - V1_SBK), v); }
        else if (vcu < V1_CKV) { st8(p.CQ() + (size_t)row * QR + (vc - V1_CQ), v); return ssq8(v); }
        else if (vcu < V1_KR) { st8(p.CKV() + (size_t)row * KVR + (vc - V1_CKV), v); return ssq8(v); }
        else if (vcu < V1_DQ) { const int g = (vc - V1_KR) >> 2; bf16_t* o = p.KR() + (size_t)row * 32; rope4(o, 16, g, v, p.cosm() + pos * 16, p.sinm() + pos * 16, 1.f); rope4(o, 16, g + 1, v + 4, p.cosm() + pos * 16, p.sinm() + pos * 16, 1.f); }
        else if (vcu < V1_END) { const bool isq = vcu < V1_DK; const int c = vc - (isq ? V1_DQ : V1_DK), cc = c & 63; const float sc2 = isq ? 0.125f * LOG2E : 1.0f;
            bf16_t* const qd = opq(p.QD()); bf16_t* const kd = opq(p.KD()); bf16_t* o = (isq ? qd : kd) + (size_t)row * W + (c & ~63);
            if (cc < 16  ) { const int g = cc >> 2; rope4(o, 8, g, v, p.cosd() + pos * 8, p.sind() + pos * 8, sc2); rope4(o, 8, g + 1, v + 4, p.cosd() + pos * 8, p.sind() + pos * 8, sc2); }
            else {
#pragma unroll
                for (int i = 0; i < 8; ++i) v[i] *= sc2;
                st8(o + cc, v); } }
        return 0.f;
    }
    DEVFN void rowslot(int tag, int row, int vc0, int fq, float part) const {
        if (tag != 0 || vc0 < V1_CQ || vc0 >= V1_KR) return;
        const float s = quad_sum(part);
        if (fq == 0) { if (vc0 < V1_CKV) p.ssq()[(size_t)row * NSQ + ((vc0 - V1_CQ) >> 5)] = s; else p.ssk()[(size_t)row * NSK + ((vc0 - V1_CKV) >> 5)] = s; }
    }
};
struct FUQ {
    const Params& p; int aux; typedef NoPre Pre;
    DEVFN bool swapped(int) const { return false; }
    DEVFN float scale(int, int idx) const { return rstd_slots(p.ssq(), idx, NSQ, 1.0f / QR) * (LOG2E * 0.10206207261596577f); }
    DEVFN void preload(int, int, int, Pre&) const {}
    DEVFN float apply(int, int row, int vc, const float* a, const float* sc, const Pre&) const {
        const float rs = sc[0]; float v[8];
#pragma unroll
        for (int i = 0; i < 8; ++i) v[i] = a[i] * rs;
        const int t = row % TB; const int pos = t >= LEAD ? t - LEAD : 0;
        const int h = vc / 96, cc = vc % 96; bf16_t* o = p.QB() + (size_t)row * QBW + h * 96;
        if (UNI(vc) % 96 < 64) st8(o + cc, v);
        else { const int g = (cc - 64) >> 2; rope4(o + 64, 16, g, v, p.cosm() + pos * 16, p.sinm() + pos * 16, 1.f); rope4(o + 64, 16, g + 1, v + 4, p.cosm() + pos * 16, p.sinm() + pos * 16, 1.f); }
        return 0.f;
    }
    DEVFN void rowslot(int, int, int, int, float) const {}
};
struct FUK {
    const Params& p; int aux; typedef NoPre Pre;
    DEVFN bool swapped(int tag) const { return tag == 1; }
    DEVFN float scale(int, int idx) const { return rstd_slots(p.ssk(), idx, NSK, 1.0f / KVR); }
    DEVFN void preload(int, int, int, Pre&) const {}
    DEVFN float apply(int tag, int row, int vc, const float* a, const float* sc, const Pre&) const {
        if (tag == 1) { bf16_t* o = p.VBT() + (size_t)row * R + (vc & ~15); const int t0 = vc & 15;
            st4(o + sperm(t0), a[0] * sc[0], a[1] * sc[1], a[2] * sc[2], a[3] * sc[3]); st4(o + sperm(t0 + 4), a[4] * sc[4], a[5] * sc[5], a[6] * sc[6], a[7] * sc[7]); }
        else { float v[8];
#pragma unroll
            for (int i = 0; i < 8; ++i) v[i] = a[i] * sc[0];
            st8(p.KNOPE() + (size_t)row * W + vc, v); }
        return 0.f;
    }
    DEVFN void rowslot(int, int, int, int, float) const {}
};
struct F3 {
    const Params& p; int layer; typedef U4 Pre;
    DEVFN bool swapped(int) const { return false; }
    DEVFN float scale(int, int idx) const { return rstd_slots(p.ssx(), idx, NSX, 1.0f / D); }
    DEVFN bf16_t* optr(int row, int vc) const { const int vcu = UNI(vc); bf16_t* const o0 = opq(p.QSB()); bf16_t* const o1 = opq(p.OMLA()); bf16_t* const o2 = opq(p.QD()); return (vcu < W ? o0 : vcu < 2 * W ? o1 : o2) + (size_t)row * W + (vc % W); }
    DEVFN void preload(int, int row, int vc, Pre& pre) const { if (UNI(vc) < 3 * W) pre = *(const U4*)optr(row, vc); }
    DEVFN float apply(int, int row, int vc, const float* a, const float* sc, const Pre& pre) const {
        const float rs = sc[0]; float v[8];
        if (UNI(vc) < 3 * W) { float ov[8]; up8(pre, ov);
#pragma unroll
            for (int i = 0; i < 8; ++i) v[i] = ov[i] * silu_f(a[i] * rs);
            st8(optr(row, vc), v); }
        else { const int c = vc - 3 * W, cu = UNI(c), b = cu / D, cc = c - b * D; const F4v b0 = *(const F4v*)(p.b_gate + (size_t)layer * 3 * D + c), b1 = *(const F4v*)(p.b_gate + (size_t)layer * 3 * D + c + 4);
            v[0] = sigm_f(a[0] * rs + b0.x); v[1] = sigm_f(a[1] * rs + b0.y); v[2] = sigm_f(a[2] * rs + b0.z); v[3] = sigm_f(a[3] * rs + b0.w);
            v[4] = sigm_f(a[4] * rs + b1.x); v[5] = sigm_f(a[5] * rs + b1.y); v[6] = sigm_f(a[6] * rs + b1.z); v[7] = sigm_f(a[7] * rs + b1.w);
            *(U2*)g8ptr(p, b, row, cc) = q8pack(v); }
        return 0.f;
    }
    DEVFN void rowslot(int, int, int, int, float) const {}
};
struct F4 {
    const Params& p; int aux; struct Pre { U2 g; U4 m; };
    DEVFN bool swapped(int) const { return false; }
    DEVFN float scale(int, int) const { return 1.f; }
    DEVFN bf16_t* tptr(int b, int row, int c) const { return p.XB2() + ((size_t)b * (R - LT_ROW0) + (row - LT_ROW0)) * D + c; }
    DEVFN void preload(int tag, int row, int c, Pre& pre) const { pre.g = *(const U2*)g8ptr(p, tag & 3, row, c); if (tag & 4) pre.m = *(const U4*)(p.G0() + (size_t)row * D + c); }
    DEVFN float apply(int tag, int row, int c, const float* a, const float*, const Pre& pre) const {
        float g[8], m[8], v[8]; q8unpack(pre.g, g);
        if (tag & 4) up8(pre.m, m); else {
#pragma unroll
            for (int i = 0; i < 8; ++i) m[i] = 0.f; }
#pragma unroll
        for (int i = 0; i < 8; ++i) v[i] = m[i] + g[i] * a[i];
        st8((tag & 8) ? tptr(tag & 3, row, c) : p.G0() + (size_t)row * D + c, v); return 0.f;
    }
    DEVFN void rowslot(int, int, int, int, float) const {}
};
struct F5 {
    const Params& p; int last; struct Pre { F4v x0, x1; };
    DEVFN bool swapped(int) const { return false; }
    DEVFN float scale(int, int) const { return 1.f; }
    DEVFN void preload(int, int row, int c, Pre& pre) const { const F4v* x = (const F4v*)(p.X() + (size_t)row * D + c); pre.x0 = x[0]; pre.x1 = x[1]; }
    DEVFN float apply(int, int row, int c, const float* a, const float*, const Pre& pre) const {
        float v[8] = {pre.x0.x + a[0], pre.x0.y + a[1], pre.x0.z + a[2], pre.x0.w + a[3], pre.x1.x + a[4], pre.x1.y + a[5], pre.x1.z + a[6], pre.x1.w + a[7]};
        F4v* x = (F4v*)(p.X() + (size_t)row * D + c); x[0] = F4v{v[0], v[1], v[2], v[3]}; x[1] = F4v{v[4], v[5], v[6], v[7]};
        if (!last) st8(p.XB() + (size_t)row * D + c, v);
        return ssq8(v);
    }
    DEVFN void rowslot(int, int row, int vc0, int fq, float part) const { const float s = quad_sum(part); if (fq == 0) p.ssx()[(size_t)row * NSX + (vc0 >> 5)] = s; }
};

#ifdef HOST_EMU
struct dim3e { unsigned x, y, z; };
static dim3e threadIdx, blockIdx, blockDim, gridDim;
#define GLOBAL static
#define LB64
#define LAUNCH(kern, nblk, nthr, ...) do { gridDim.x = (unsigned)(nblk); blockDim.x = (unsigned)(nthr); for (unsigned b_ = 0; b_ < gridDim.x; ++b_) for (unsigned t_ = 0; t_ < blockDim.x; ++t_) { blockIdx.x = b_; threadIdx.x = t_; kern(__VA_ARGS__); } } while (0)
#else
#define GLOBAL __global__
#define LB64 __launch_bounds__(64)
#define LAUNCH(kern, nblk, nthr, ...) kern<<<dim3((unsigned)(nblk)), dim3((unsigned)(nthr)), 0, stream>>>(__VA_ARGS__)
#endif
#define GTID ((long)blockIdx.x * blockDim.x + threadIdx.x)

#ifdef HOST_EMU
template <int MAP> GLOBAL void k_prep_w(bf16_t* dst, int N, int K, const float* src, int src_ld, const float* rowscale) {
    const long i = GTID; if (i >= (long)N * K) return;
    const int n = (int)(i % N), k = (int)(i / N);
    int s;
    if (MAP == 0) s = src_w1(n); else if (MAP == 1) s = src_wv(n); else if (MAP == 2) s = src_w3(n); else if (MAP == 3) s = src_uq(n); else if (MAP == 4) s = src_uk(n); else if (MAP == 5) s = src_uv(n); else s = n;
    float v = 0.f; if (s >= 0) v = src[(size_t)k * src_ld + s] * (rowscale ? rowscale[k] : 1.f);
    dst[(size_t)n * K + k] = f2bf(v);
}
GLOBAL void k_tables(Params p) {
    const long i = GTID;
    if (i < NPOS * 16) { const int pos = (int)(i / 16), j = (int)(i % 16); const float inv = (float)pow(500000.0, -(double)(2 * j) / 32.0); const float ang = (float)pos * inv;
        p.cosm()[i] = (float)cos((double)ang); p.sinm()[i] = (float)sin((double)ang); }
    if (i < NPOS * 8) { const int pos = (int)(i / 8), j = (int)(i % 8); const float inv = (float)pow(500000.0, -(double)(2 * j) / 16.0); const float ang = (float)pos * inv;
        p.cosd()[i] = (float)cos((double)ang); p.sind()[i] = (float)sin((double)ang); }
    if (i < DEPTH) { const float* lm = p.dlam + i * 4 * 64; float s0 = 0.f, s1 = 0.f; for (int d = 0; d < 64; ++d) { s0 += lm[d] * lm[64 + d]; s1 += lm[128 + d] * lm[192 + d]; }
        p.lamv()[i] = expf(s0) - expf(s1) + (0.8f - 0.6f * expf(-0.3f * (float)i)); }
}
GLOBAL void k_init_x(Params p) {
    const long i = GTID; if (i >= (long)R * D) return;
    const int row = (int)(i / D), c = (int)(i % D), b = row / TB, t = row % TB;
    const float v = t < LEAD ? 0.f : t < LEAD + NMETA ? p.meta[(t - LEAD) * D + c] : p.x[((size_t)b * SEQ + (t - LEAD - NMETA)) * D + c];
    p.X()[i] = v; p.XB()[i] = f2bf(v);
}
GLOBAL void k_x2bf(Params p) { const long i = GTID; if (i >= (long)R * D) return; p.XB2()[i] = f2bf(p.X()[i]); }
GLOBAL void k_ssq_f32(const float* X, int n, float* slots, int ns) {
    const long row = GTID; if (row >= R) return; float s = 0.f; for (int c = 0; c < n; ++c) { const float v = X[(size_t)row * n + c]; s += v * v; }
    slots[row * ns] = s; for (int i = 1; i < ns; ++i) slots[row * ns + i] = 0.f;
}
GLOBAL void k_ssq_bf(const bf16_t* X, int n, float* slots, int ns) {
    const long row = GTID; if (row >= R) return; float s = 0.f; for (int c = 0; c < n; ++c) { const float v = bf2f(X[(size_t)row * n + c]); s += v * v; }
    slots[row * ns] = s; for (int i = 1; i < ns; ++i) slots[row * ns + i] = 0.f;
}
GLOBAL void k_final(Params p) {
    const long i = GTID; if (i >= (long)NB * SEQ) return;
    const int b = (int)(i / SEQ), s = (int)(i % SEQ); const float* x = p.X() + ((size_t)b * TB + LEAD + NMETA + s) * D; float ss = 0.f;
    for (int c = 0; c < D; ++c) ss += x[c] * x[c];
    const float rs = rsq(ss / D + EPS); float* o = p.out + (size_t)i * D;
    for (int c = 0; c < D; ++c) o[c] = x[c] * rs * p.final_g[c];
}

template <class Epi> GLOBAL void k_gemm(const bf16_t* A, int lda, const bf16_t* Bt, int ldb, int M, int N, int K, Params pp, int aux, int tag) {
    const Epi epi{pp, aux};
    const long idx = GTID; const int n8 = N / 8; if (idx >= (long)M * n8) return;
    const int m = (int)(idx / n8), n0 = (int)(idx % n8) * 8;
    float acc[8] = {0.f, 0.f, 0.f, 0.f, 0.f, 0.f, 0.f, 0.f};
    const bf16_t* a = A + (size_t)m * lda; const bf16_t* b0 = Bt + (size_t)n0 * ldb;
    for (int k = 0; k < K; k += 8) {
        float av[8]; ld8(a + k, av);
        for (int i = 0; i < 8; ++i) { float bv[8]; ld8(b0 + (size_t)i * ldb + k, bv); float s = 0.f;
            for (int j = 0; j < 8; ++j) s += av[j] * bv[j];
            acc[i] += s; }
    }
    float sc[8]; if (epi.swapped(tag)) { for (int i = 0; i < 8; ++i) sc[i] = epi.scale(tag, n0 + i); } else sc[0] = epi.scale(tag, m);
    typename Epi::Pre pre; epi.preload(tag, m, n0, pre); epi.apply(tag, m, n0, acc, sc, pre);
}

GLOBAL void LB64 k_attn_sb(Params p) {
    const long i = GTID; if (i >= (long)NB * NH * TB) return;
    const int t = (int)(i % TB), h = (int)((i / TB) % NH), b = (int)(i / ((long)TB * NH));
    const size_t row = (size_t)b * TB + t; bf16_t* qo = p.QSB() + row * W + h * 64;
    float q[64], o[64];
#pragma unroll
    for (int d = 0; d < 64; ++d) { q[d] = bf2f(qo[d]); o[d] = 0.f; }
    if (t >= LEAD) {
        float carry = 0.f;
        for (int j = t - 1; j >= LEAD; --j) {
            const size_t kr = (size_t)b * TB + j; const bf16_t* k = p.KSB() + kr * W + h * 64; float z = 0.f;
#pragma unroll
            for (int d = 0; d < 64; ++d) z += q[d] * bf2f(k[d]);
            const float sp = fmaxf(z, 0.f) + log2f(1.f + exp2f(-fabsf(z)));
            const float w = exp2f((z - sp) + carry); carry -= sp;
            const bf16_t* vt = p.VSBT() + (size_t)(h * 64) * R + ((kr & ~(size_t)15) | sperm((int)(kr & 15)));
#pragma unroll
            for (int d = 0; d < 64; ++d) o[d] += w * bf2f(vt[(size_t)d * R]);
        }
    }
#pragma unroll
    for (int d = 0; d < 64; ++d) qo[d] = f2bf(o[d]);
}
GLOBAL void LB64 k_attn_mla(Params p) {
    const long i = GTID; if (i >= (long)NB * NH * TB) return;
    const int t = (int)(i % TB), h = (int)((i / TB) % NH), b = (int)(i / ((long)TB * NH));
    const size_t row = (size_t)b * TB + t; const bf16_t* qp = p.QB() + row * QBW + h * 96;
    float o[64]; float m = -INFINITY, l = 0.f;
#pragma unroll
    for (int d = 0; d < 64; ++d) o[d] = 0.f;
    if (t >= LEAD) {
        const int kend = (t / 64 + 1) * 64 < TB ? (t / 64 + 1) * 64 : TB;
        for (int j = LEAD; j < kend; ++j) {
            const size_t kr = (size_t)b * TB + j; const bf16_t* kn = p.KNOPE() + kr * W + h * 64; const bf16_t* kq = p.KR() + kr * 32; float s = 0.f;
            for (int d = 0; d < 64; ++d) s += bf2f(qp[d]) * bf2f(kn[d]);
            for (int d = 0; d < 32; ++d) s += bf2f(qp[64 + d]) * bf2f(kq[d]);
            const float mn = fmaxf(m, s), f = exp2f(m - mn), w = exp2f(s - mn); m = mn; l = l * f + w;
            const bf16_t* vt = p.VBT() + (size_t)(h * 64) * R + ((kr & ~(size_t)15) | sperm((int)(kr & 15)));
#pragma unroll
            for (int d = 0; d < 64; ++d) o[d] = o[d] * f + w * bf2f(vt[(size_t)d * R]);
        }
    }
    const float il = l > 0.f ? 1.f / l : 0.f; bf16_t* op = p.OMLA() + row * W + h * 64;
#pragma unroll
    for (int d = 0; d < 64; ++d) op[d] = f2bf(o[d] * il);
}
GLOBAL void LB64 k_attn_diff(Params p, int layer) {
    const long i = GTID; if (i >= (long)NB * NHD * TB) return;
    const int t = (int)(i % TB), h = (int)((i / TB) % NHD), b = (int)(i / ((long)TB * NHD));
    const size_t row = (size_t)b * TB + t; bf16_t* qo = p.QD() + row * W + h * 128;
    const float lam = p.lamv()[layer], lam_init = 0.8f - 0.6f * expf(-0.3f * (float)layer);
    float o[128];
#pragma unroll
    for (int d = 0; d < 128; ++d) o[d] = 0.f;
    if (t >= LEAD) {
        const int kend = (t / 64 + 1) * 64 < TB ? (t / 64 + 1) * 64 : TB;
        float m0 = -INFINITY, l0 = 0.f, m1 = -INFINITY, l1 = 0.f;
        for (int j = LEAD; j < kend; ++j) { const bf16_t* k = p.KD() + ((size_t)b * TB + j) * W + h * 128; float s0 = 0.f, s1 = 0.f;
            for (int d = 0; d < 64; ++d) { s0 += bf2f(qo[d]) * bf2f(k[d]); s1 += bf2f(qo[64 + d]) * bf2f(k[64 + d]); }
            float mn = fmaxf(m0, s0); l0 = l0 * exp2f(m0 - mn) + exp2f(s0 - mn); m0 = mn; mn = fmaxf(m1, s1); l1 = l1 * exp2f(m1 - mn) + exp2f(s1 - mn); m1 = mn; }
        const float i0 = 1.f / l0, i1 = lam / l1;
        for (int j = LEAD; j < kend; ++j) { const size_t kr = (size_t)b * TB + j; const bf16_t* k = p.KD() + kr * W + h * 128; float s0 = 0.f, s1 = 0.f;
            for (int d = 0; d < 64; ++d) { s0 += bf2f(qo[d]) * bf2f(k[d]); s1 += bf2f(qo[64 + d]) * bf2f(k[64 + d]); }
            const float w = exp2f(s0 - m0) * i0 - exp2f(s1 - m1) * i1;
            const bf16_t* vt = p.VDT() + (size_t)(h * 128) * R + ((kr & ~(size_t)15) | sperm((int)(kr & 15)));
#pragma unroll
            for (int d = 0; d < 128; ++d) o[d] += w * bf2f(vt[(size_t)d * R]);
        }
    }
    float ss = 0.f;
#pragma unroll
    for (int d = 0; d < 128; ++d) ss += o[d] * o[d];
    const float rs = rsq(ss * (1.f / 128.f) + EPS) * (1.f - lam_init); const float* g = p.dnorm_g + (size_t)layer * 128;
#pragma unroll
    for (int d = 0; d < 128; ++d) qo[d] = f2bf(o[d] * rs * g[d]);
}


#endif
#ifndef HOST_EMU
namespace pg8 {
#define PG8_LAS __attribute__((address_space(3)))
typedef short bf16x8 __attribute__((ext_vector_type(8)));
typedef float f32x4 __attribute__((ext_vector_type(4)));
typedef unsigned u32x4 __attribute__((ext_vector_type(4)));
constexpr int BM = 256, BK = 64, HALF = 128, HTB = HALF * BK * 2  , STAGE_BYTES = 8 * HTB, NXCD = 8, WGM = 8;
__host__ __device__ __forceinline__ int lds_byte(int r, int c) { const int st = (r >> 4) * 2 + (c >> 5), rr = r & 15, cc = c & 31, ob = rr * 64 + cc * 2; return st * 1024 + (ob ^ (((ob >> 9) & 1) << 5)); }
__host__ __device__ __forceinline__ void stage_rc(int b, int& R, int& C) { const int st = b / 1024, sb = b % 1024, swz = sb ^ (((sb >> 9) & 1) << 5); R = (st >> 1) * 16 + swz / 64; C = (st & 1) * 32 + (swz % 64) / 2; }
__host__ __device__ __forceinline__ int perm32(int rho) { const int n = rho >> 4, i = rho & 15; return 8 * (i >> 2) + 4 * n + (i & 3); }
struct Unit { int pm, pn, tag; const char* A; const char* B; };
struct Gemm { int K, lda, ldb; };
__device__ __forceinline__ void order_map(int L, int nM, int nN, int& pm, int& pn) {
    const int nwg = nM * nN; int wgid = L; { const int q = nwg / NXCD, r = nwg % NXCD, xcd = wgid % NXCD, off = wgid / NXCD; wgid = (xcd < r ? xcd * (q + 1) : r * (q + 1) + (xcd - r) * q) + off; }
    const int nig = WGM * nN, gid = wgid / nig, fm = gid * WGM, gsz = (nM - fm) < WGM ? (nM - fm) : WGM;
    pm = fm + ((wgid % nig) % gsz); pn = (wgid % nig) / gsz;
}
template <class F> struct EpiAd {
    static constexpr bool PERM = true, AFTER_DRAIN = false;
    F f;
    __device__ __forceinline__ void operator()(const f32x4 (&acc)[2][2][4][2], const Unit& u, int wr, int wc, int fr, int fq, PG8_LAS unsigned char* scr, int tid) const {
        PG8_LAS float* rs = (PG8_LAS float*)scr;
        const bool sw = f.swapped(u.tag);
        if (tid < 256) rs[tid] = f.scale(u.tag, (sw ? u.pn : u.pm) * BM + tid);
        asm volatile("s_waitcnt lgkmcnt(0)" ::: "memory"); __builtin_amdgcn_s_barrier(); asm volatile("" ::: "memory");
#pragma unroll
        for (int ai = 0; ai < 2; ++ai) {
            int rl0 = ai * HALF + wr * 64 + fr, fqo = fq; asm volatile("" : "+v"(rl0), "+v"(fqo));
            typename F::Pre pre[4][2];
#pragma unroll
            for (int m = 0; m < 4; ++m)
#pragma unroll
                for (int bj = 0; bj < 2; ++bj) f.preload(u.tag, u.pm * BM + rl0 + m * 16, u.pn * BM + bj * HALF + wc * 32 + 8 * fqo, pre[m][bj]);
#pragma unroll
            for (int m = 0; m < 4; ++m) { const int rl = rl0 + m * 16, row = u.pm * BM + rl;
#pragma unroll
                for (int bj = 0; bj < 2; ++bj) { const int cl = bj * HALF + wc * 32 + 8 * fqo; const f32x4 v0 = acc[ai][bj][m][0], v1 = acc[ai][bj][m][1]; const float a8[8] = {v0[0], v0[1], v0[2], v0[3], v1[0], v1[1], v1[2], v1[3]};
                    float sc[8];
                    if (sw) {
#pragma unroll
                        for (int i = 0; i < 8; ++i) sc[i] = rs[cl + i]; }
                    else { sc[0] = rs[rl];
#pragma unroll
                        for (int i = 1; i < 8; ++i) sc[i] = 0.f; }
                    const float part = f.apply(u.tag, row, u.pn * BM + cl, a8, sc, pre[m][bj]);
                    f.rowslot(u.tag, row, u.pn * BM + bj * HALF + wc * 32, fq, part); } }
            asm volatile("" ::: "memory");
        }
    }
};
template <class Epi, class Sched, bool ALIGN_EPI = false, bool SP2 = false>
__device__ __forceinline__ void gemm_phase(PG8_LAS unsigned char* lds, const Gemm g, const Sched& S, const Epi& E, const int wid0  ) {
    int lane_ = lane_id_v();
    const int wid = wid0, lane = lane_, tid = wid * 64 + lane, wr = wid >> 2, wc = wid & 3, fr = lane & 15, fq = lane >> 4;
    const int K = g.K, nt = K / BK, lda = g.lda, ldb = g.ldb;
    unsigned voffA[2], voffB[2];
#pragma unroll
    for (int i = 0; i < 2; ++i) { int R, C; stage_rc(tid * 16 + i * 8192, R, C); const int Rb = Epi::PERM ? ((R & ~31) + perm32(R & 31)) : R;
        voffA[i] = (unsigned)(R * lda + C) * 2u; voffB[i] = (unsigned)(Rb * ldb + C) * 2u; }
    const size_t kstep = (size_t)(BK * 2);
    const size_t hstepA = (size_t)HALF * lda * 2, hstepB = (size_t)HALF * ldb * 2;
    const size_t tstepA = 2 * hstepA, tstepB = 2 * hstepB;
    const unsigned ldsw = (unsigned)wid * 1024u;
    const int aoff = lds_byte(wr * 64 + fr, fq * 8), boff = lds_byte(wc * 32 + fr, fq * 8);
#define PG8_SA(b, h) (((b) * 2 + (h)) * HTB)
#define PG8_SB(b, h) ((4 + (b) * 2 + (h)) * HTB)
#define PG8_STAGE(bufoff, gbase, voff) do { _Pragma("unroll") for (int _i = 0; _i < 2; ++_i) \
        __builtin_amdgcn_global_load_lds((const unsigned*)((const char*)(gbase) + (voff)[_i]), (PG8_LAS unsigned*)(lds + (bufoff) + ldsw + _i * 8192), 16, 0, 0); } while (0)
#define PG8_LDA(dst, b, h) do { _Pragma("unroll") for (int m = 0; m < 4; ++m) _Pragma("unroll") for (int k = 0; k < 2; ++k) dst[m][k] = *(const PG8_LAS bf16x8*)(lds + PG8_SA(b, h) + aoff + m * 2048 + k * 1024); } while (0)
#define PG8_LDB(dst, b, h) do { _Pragma("unroll") for (int n = 0; n < 2; ++n) _Pragma("unroll") for (int k = 0; k < 2; ++k) dst[n][k] = *(const PG8_LAS bf16x8*)(lds + PG8_SB(b, h) + boff + n * 2048 + k * 1024); } while (0)
#define PG8_MMA(ai, bj, At, Bt) do { __builtin_amdgcn_s_setprio(1); _Pragma("unroll") for (int m = 0; m < 4; ++m) _Pragma("unroll") for (int n = 0; n < 2; ++n) _Pragma("unroll") for (int k = 0; k < 2; ++k) \
        acc[ai][bj][m][n] = __builtin_amdgcn_mfma_f32_16x16x32_bf16(Bt[n][k], At[m][k], acc[ai][bj][m][n], 0, 0, 0); __builtin_amdgcn_s_setprio(0); } while (0)
#define PG8_WAIT_V(n) asm volatile("s_waitcnt vmcnt(" #n ")" ::: "memory")
#define PG8_WAIT_L(n) asm volatile("s_waitcnt lgkmcnt(" #n ")" ::: "memory")
#define PG8_BAR __builtin_amdgcn_s_barrier()
#define PG8_SCHED __builtin_amdgcn_sched_barrier(0)
    Unit cur, nxt; int ui = 0;
    if (!S.next(0, cur)) return;
    f32x4 acc[2][2][4][2];
#pragma unroll
    for (int a = 0; a < 2; ++a)
#pragma unroll
        for (int b = 0; b < 2; ++b)
#pragma unroll
            for (int m = 0; m < 4; ++m)
#pragma unroll
                for (int n = 0; n < 2; ++n) acc[a][b][m][n] = (f32x4){0.f, 0.f, 0.f, 0.f};
    bf16x8 At[4][2], B0[2][2], B1[2][2];
    const char* cA = cur.A + (size_t)cur.pm * tstepA; const char* cB = cur.B + (size_t)cur.pn * tstepB;
    S.a_ready(cur);
    if constexpr (SP2) {
        PG8_STAGE(PG8_SB(0, 0), cB, voffB); PG8_STAGE(PG8_SB(0, 1), cB + hstepB, voffB); PG8_STAGE(PG8_SA(0, 0), cA, voffA); PG8_STAGE(PG8_SA(0, 1), cA + hstepA, voffA);
        if (wr == 1) PG8_BAR;
        PG8_WAIT_V(2); PG8_BAR;
        PG8_STAGE(PG8_SB(1, 0), cB + kstep, voffB); PG8_STAGE(PG8_SA(1, 0), cA + kstep, voffA); PG8_STAGE(PG8_SB(1, 1), cB + hstepB + kstep, voffB);
        PG8_WAIT_V(6); PG8_BAR;
    } else {
        PG8_STAGE(PG8_SB(0, 0), cB, voffB); PG8_STAGE(PG8_SA(0, 0), cA, voffA); PG8_STAGE(PG8_SB(0, 1), cB + hstepB, voffB); PG8_STAGE(PG8_SA(0, 1), cA + hstepA, voffA);
        if (wr == 1) PG8_BAR;
        PG8_WAIT_V(4); PG8_BAR;
        PG8_STAGE(PG8_SB(1, 0), cB + kstep, voffB); PG8_STAGE(PG8_SA(1, 0), cA + kstep, voffA); PG8_STAGE(PG8_SB(1, 1), cB + hstepB + kstep, voffB);
        PG8_WAIT_V(6); PG8_BAR;
    }
    for (;;) {
        const bool has_next = S.next(ui + 1, nxt);
        const char* nA = has_next ? nxt.A + (size_t)nxt.pm * tstepA : cA; const char* nB = has_next ? nxt.B + (size_t)nxt.pn * tstepB : cB;
#pragma nounroll
        for (int t = 0; t < nt; t += 2) {
            const bool last = (t == nt - 2);
            const char* a1 = cA + (size_t)(t + 1) * kstep;
            const char* a2 = last ? nA : cA + (size_t)(t + 2) * kstep; const char* b2 = last ? nB : cB + (size_t)(t + 2) * kstep;
            const char* a3 = a2 + kstep; const char* b3 = b2 + kstep;
            if (last && has_next) S.a_ready(nxt);
            if constexpr (SP2) {
            PG8_LDB(B0, 0, 0); PG8_LDB(B1, 0, 1); PG8_SCHED; PG8_LDA(At, 0, 0); PG8_STAGE(PG8_SA(1, 1), a1 + hstepA, voffA);
            PG8_WAIT_V(8); PG8_WAIT_L(0); PG8_BAR; PG8_MMA(0, 0, At, B0); PG8_MMA(0, 1, At, B1); PG8_BAR; PG8_SCHED;
            PG8_LDA(At, 0, 1); PG8_STAGE(PG8_SB(0, 0), b2, voffB); PG8_STAGE(PG8_SB(0, 1), b2 + hstepB, voffB); PG8_STAGE(PG8_SA(0, 0), a2, voffA);
            PG8_WAIT_V(8); PG8_WAIT_L(0); PG8_BAR; PG8_MMA(1, 0, At, B0); PG8_MMA(1, 1, At, B1); PG8_BAR; PG8_SCHED;
            PG8_LDB(B0, 1, 0); PG8_LDB(B1, 1, 1); PG8_SCHED; PG8_LDA(At, 1, 0); PG8_STAGE(PG8_SA(0, 1), a2 + hstepA, voffA);
            PG8_WAIT_V(8); PG8_WAIT_L(0); PG8_BAR; PG8_MMA(0, 0, At, B0); PG8_MMA(0, 1, At, B1); PG8_BAR; PG8_SCHED;
            PG8_LDA(At, 1, 1); PG8_STAGE(PG8_SB(1, 0), b3, voffB); PG8_STAGE(PG8_SB(1, 1), b3 + hstepB, voffB); PG8_STAGE(PG8_SA(1, 0), a3, voffA);
            PG8_WAIT_V(8); PG8_WAIT_L(0); PG8_BAR; PG8_MMA(1, 0, At, B0); PG8_MMA(1, 1, At, B1); PG8_BAR; PG8_SCHED;
            } else {
            PG8_LDB(B0, 0, 0); PG8_SCHED; PG8_LDA(At, 0, 0); PG8_STAGE(PG8_SA(1, 1), a1 + hstepA, voffA);
            PG8_WAIT_L(8); PG8_BAR; PG8_WAIT_L(0); PG8_MMA(0, 0, At, B0); PG8_BAR; PG8_SCHED;
            PG8_LDB(B1, 0, 1); PG8_STAGE(PG8_SB(0, 0), b2, voffB);
            PG8_BAR; PG8_WAIT_L(0); PG8_MMA(0, 1, At, B1); PG8_BAR;
            PG8_LDA(At, 0, 1); PG8_STAGE(PG8_SA(0, 0), a2, voffA);
            PG8_BAR; PG8_WAIT_L(0); PG8_MMA(1, 0, At, B0); PG8_BAR; PG8_SCHED;
            PG8_STAGE(PG8_SB(0, 1), b2 + hstepB, voffB);
            PG8_WAIT_V(6); PG8_BAR; PG8_MMA(1, 1, At, B1); PG8_BAR;
            PG8_LDB(B0, 1, 0); PG8_SCHED; PG8_LDA(At, 1, 0); PG8_STAGE(PG8_SA(0, 1), a2 + hstepA, voffA);
            PG8_WAIT_L(8); PG8_BAR; PG8_WAIT_L(0); PG8_MMA(0, 0, At, B0); PG8_BAR; PG8_SCHED;
            PG8_LDB(B1, 1, 1); PG8_STAGE(PG8_SB(1, 0), b3, voffB);
            PG8_BAR; PG8_WAIT_L(0); PG8_MMA(0, 1, At, B1); PG8_BAR;
            PG8_LDA(At, 1, 1); PG8_STAGE(PG8_SA(1, 0), a3, voffA);
            PG8_BAR; PG8_WAIT_L(0); PG8_MMA(1, 0, At, B0); PG8_BAR; PG8_SCHED;
            PG8_STAGE(PG8_SB(1, 1), b3 + hstepB, voffB);
            PG8_WAIT_V(6); PG8_BAR; PG8_MMA(1, 1, At, B1); PG8_BAR;
            }
        }
        if constexpr (ALIGN_EPI) { if (wr == 0) PG8_BAR; }
        if constexpr (!Epi::AFTER_DRAIN) { E(acc, cur, wr, wc, fr, fq, lds + STAGE_BYTES, tid); S.done(cur); }
        if (!has_next) break;
#pragma unroll
        for (int a = 0; a < 2; ++a)
#pragma unroll
            for (int b = 0; b < 2; ++b)
#pragma unroll
                for (int m = 0; m < 4; ++m)
#pragma unroll
                    for (int n = 0; n < 2; ++n) acc[a][b][m][n] = (f32x4){0.f, 0.f, 0.f, 0.f};
        cur = nxt; cA = nA; cB = nB; ++ui;
        if constexpr (ALIGN_EPI) { if (wr == 1) PG8_BAR; }
    }
    PG8_WAIT_V(0);
    if constexpr (!ALIGN_EPI) { if (wr == 0) PG8_BAR; }
    PG8_BAR;
    if constexpr (Epi::AFTER_DRAIN) { E.fused(acc, cur, wr, wc, fr, fq, lds, wid, lane); S.done(cur); }
#undef PG8_SA
#undef PG8_SB
#undef PG8_STAGE
#undef PG8_LDA
#undef PG8_LDB
#undef PG8_MMA
#undef PG8_WAIT_V
#undef PG8_WAIT_L
#undef PG8_BAR
#undef PG8_SCHED
}

}

struct SchedGrid {
    int nM, nN, G, c, tag; const char* A; const char* B;
    __device__ __forceinline__ bool next(int i, pg8::Unit& u) const { const long L = (long)i * G + c; if (L >= (long)nM * nN) return false; pg8::order_map((int)L, nM, nN, u.pm, u.pn); u.tag = tag; u.A = A; u.B = B; return true; }
    __device__ __forceinline__ void a_ready(const pg8::Unit&) const {}
    __device__ __forceinline__ void done(const pg8::Unit&) const {}
};
__device__ __forceinline__ void lt_wait(unsigned* flags) {
    for (unsigned sp = 0; sp < (1u << 22); ++sp) { unsigned n = 0;
#pragma unroll
        for (int k = 0; k < 8; ++k) n += __hip_atomic_load(flags + 16 * k, __ATOMIC_RELAXED, __HIP_MEMORY_SCOPE_AGENT);
        if (n >= 8u) break; __builtin_amdgcn_s_sleep(2); }
    __builtin_amdgcn_fence(__ATOMIC_ACQUIRE, "agent"); asm volatile("s_waitcnt vmcnt(0)" ::: "memory");
}
struct SchedTwo {
    int nM0, nN0, nM1, nN1, G, c; const char *A0, *B0, *A1, *B1; unsigned* gate; int gate_panel;
    __device__ __forceinline__ bool next(int i, pg8::Unit& u) const { long L = (long)i * G + c; const long n0 = (long)nM0 * nN0;
        if (L < n0) { pg8::order_map((int)L, nM0, nN0, u.pm, u.pn); u.tag = 0; u.A = A0; u.B = B0; return true; }
        L -= n0; if (L >= (long)nM1 * nN1) return false; pg8::order_map((int)L, nM1, nN1, u.pm, u.pn); u.tag = 1; u.A = A1; u.B = B1; return true; }
    __device__ __forceinline__ void a_ready(const pg8::Unit& u) const { if (gate && (u.tag == 0 ? u.pm : u.pn) >= gate_panel) lt_wait(gate); }
    __device__ __forceinline__ void done(const pg8::Unit&) const {}
};
struct SchedP4 {
    int nM, nN, G, c; const char* A0; size_t astride; const char* B0; size_t bstride;
    __device__ __forceinline__ bool next(int i, pg8::Unit& u) const {
        const int nmain = (nM - 2) * nN;
        if (i < 3) { if (c >= nmain) return false; const int j = i, b = (2 * j) % 3; pg8::order_map(c, nM - 2, nN, u.pm, u.pn); u.tag = b + (j > 0 ? 4 : 0); u.A = A0 + (size_t)j * astride; u.B = B0 + (size_t)b * bstride; return true; }
        if (i == 3 && c < 6 * nN) { const int lt = c / 3, j = c % 3, b = (2 * j) % 3; u.pm = nM - 2 + lt / nN; u.pn = lt % nN; u.tag = b + 8; u.A = A0 + (size_t)j * astride; u.B = B0 + (size_t)b * bstride; return true; }
        return false; }
    __device__ __forceinline__ void a_ready(const pg8::Unit&) const {}
    __device__ __forceinline__ void done(const pg8::Unit&) const {}
};
struct SchedP5 {
    int nM, nN, G, c; const char* A; const char* B;
    __device__ __forceinline__ bool next(int i, pg8::Unit& u) const { if (i != 0 || c >= (nM - 2) * nN) return false; u.tag = 0; u.A = A; u.B = B; pg8::order_map(c, nM - 2, nN, u.pm, u.pn); return true; }
    __device__ __forceinline__ void a_ready(const pg8::Unit&) const {}
    __device__ __forceinline__ void done(const pg8::Unit&) const {}
};
struct SchedLeft {
    int nM, nN, k; const char* A; const char* B;
    __device__ __forceinline__ bool next(int i, pg8::Unit& u) const { if (i != 0) return false; u.tag = 0; u.A = A; u.B = B; u.pm = nM - 2 + k / nN; u.pn = k % nN; return true; }
    __device__ __forceinline__ void a_ready(const pg8::Unit&) const {}
    __device__ __forceinline__ void done(const pg8::Unit&) const {}
};
constexpr int CW_LTFLAG = 2048;
constexpr int LDS_SCR = pg8::STAGE_BYTES, LDS_BYTES = 147456;
#define LASP __attribute__((address_space(3)))
enum { PK_P1 = 0, PK_P2 = 1, PK_P3 = 2, PK_P3B = 3, PK_P4 = 4, PK_P5 = 5 };
__device__ __forceinline__ void gemm_part(const Params& p, LASP unsigned char* lds, int kind, int l, int G, int c, int wid0) {
    constexpr int nR = R / 256;
    if (kind == PK_P1) {
        SchedTwo S{nR, N1 / 256, 2 * W / 256, nR, G, c, (const char*)p.XB(), (const char*)wptr(p, l, WL_W1), (const char*)wptr(p, l, WL_WV), (const char*)p.XB(), l > 0 ? p.ctl() + CW_LTFLAG + 128 + 256 * (l - 1) : nullptr, nR - 2};
        pg8::EpiAd<F1> E{F1{p, 0}}; pg8::gemm_phase<pg8::EpiAd<F1>, SchedTwo, true, true>(lds, pg8::Gemm{D, D, D}, S, E, wid0);
    } else if (kind == PK_P2) {
        { SchedGrid S{nR, QBW / 256, G, c, 0, (const char*)p.CQ(), (const char*)wptr(p, l, WL_UQ)};
          pg8::EpiAd<FUQ> E{FUQ{p, 0}}; pg8::gemm_phase<pg8::EpiAd<FUQ>, SchedGrid, true, true>(lds, pg8::Gemm{QR, QR, QR}, S, E, wid0); }
        { SchedTwo S{nR, W / 256, W / 256, nR, G, c, (const char*)p.CKV(), (const char*)wptr(p, l, WL_UK), (const char*)wptr(p, l, WL_UV), (const char*)p.CKV()};
          pg8::EpiAd<FUK> E{FUK{p, 0}}; pg8::gemm_phase<pg8::EpiAd<FUK>, SchedTwo, true, true>(lds, pg8::Gemm{KVR, KVR, KVR}, S, E, wid0); }
    } else if (kind == PK_P3B) {
        SchedGrid S{nR, N3 / 256, G, c, 0, (const char*)p.XB2(), (const char*)wptr(p, l, WL_W3)};
        pg8::EpiAd<F3> E{F3{p, l}}; pg8::gemm_phase<pg8::EpiAd<F3>, SchedGrid, true, true>(lds, pg8::Gemm{D, D, D}, S, E, wid0);
    } else if (kind == PK_P4) {
        SchedP4 S{nR, D / 256, G, c, (const char*)p.QSB(), (size_t)((const char*)p.QD() - (const char*)p.QSB()), (const char*)wptr(p, l, WL_WO), (size_t)D * W * 2};
        pg8::EpiAd<F4> E{F4{p, 0}}; pg8::gemm_phase<pg8::EpiAd<F4>, SchedP4, true, true>(lds, pg8::Gemm{W, W, W}, S, E, wid0);
    } else if (kind == PK_P5) {
        SchedP5 S{nR, D / 256, G, c, (const char*)p.G0(), (const char*)wptr(p, l, WL_OUT)};
        pg8::EpiAd<F5> E{F5{p, l == DEPTH - 1 ? 1 : 0}}; pg8::gemm_phase<pg8::EpiAd<F5>, SchedP5, true, true>(lds, pg8::Gemm{D, D, D}, S, E, wid0);
    }
}
__device__ __forceinline__ void p5_leftover(const Params& p, LASP unsigned char* lds, int l, int G, int c, int wid0) {
    if (c < G - 8) return;
    constexpr int nR = R / 256; const int k = c - (G - 8);
    SchedLeft S{nR, D / 256, k, (const char*)p.G0(), (const char*)wptr(p, l, WL_OUT)};
    pg8::EpiAd<F5> E{F5{p, l == DEPTH - 1 ? 1 : 0}}; pg8::gemm_phase<pg8::EpiAd<F5>, SchedLeft, true, true>(lds, pg8::Gemm{D, D, D}, S, E, wid0);
    if (wid0 == 0 && lane_id_v() == 0) { __builtin_amdgcn_fence(__ATOMIC_RELEASE, "agent"); asm volatile("s_waitcnt vmcnt(0)" ::: "memory");
        __hip_atomic_store(p.ctl() + CW_LTFLAG + 128 + 256 * l + 16 * k, 1u, __ATOMIC_RELAXED, __HIP_MEMORY_SCOPE_AGENT); }
}
__device__ __forceinline__ void lt_merge(const Params& p, int l, int G, int c, int wid0) {
    if (c < G - 8) return;
    const int k = c - (G - 8), lane = lane_id_v(), tid = wid0 * 64 + lane; constexpr int NR = (R - LT_ROW0) / 8;
    const bf16_t* T = p.XB2(); bf16_t* M = p.G0() + (size_t)LT_ROW0 * D;
    for (int e = tid; e < NR * D / 8; e += 512) { const size_t off = ((size_t)k * NR) * D + (size_t)e * 8; float a[8], b[8], cc[8], v[8];
        up8(*(const U4*)(T + off), a); up8(*(const U4*)(T + (size_t)(R - LT_ROW0) * D + off), b); up8(*(const U4*)(T + 2 * (size_t)(R - LT_ROW0) * D + off), cc);
#pragma unroll
        for (int i = 0; i < 8; ++i) v[i] = (a[i] + cc[i]) + b[i];
        st8(M + off, v); }
    asm volatile("s_waitcnt vmcnt(0)" ::: "memory"); __syncthreads();
    if (tid == 0) { __builtin_amdgcn_fence(__ATOMIC_RELEASE, "agent"); asm volatile("s_waitcnt vmcnt(0)" ::: "memory"); __hip_atomic_store(p.ctl() + CW_LTFLAG + 256 * l + 16 * k, 1u, __ATOMIC_RELAXED, __HIP_MEMORY_SCOPE_AGENT); }
}
template <int KIND> __global__ void __launch_bounds__(512, 2) k_gemm_fast(Params p, int l) {
    extern __shared__ __attribute__((aligned(16))) unsigned char lds_raw[];
    gemm_part(p, (LASP unsigned char*)lds_raw, KIND, l, (int)gridDim.x, (int)blockIdx.x, __builtin_amdgcn_readfirstlane((int)threadIdx.x >> 6));
}

namespace att {
typedef short bf16x8 __attribute__((ext_vector_type(8)));
typedef float f32x16 __attribute__((ext_vector_type(16)));
typedef unsigned u32x4v __attribute__((ext_vector_type(4)));
__device__ __forceinline__ int crow(int r, int h) { return (r & 3) + 8 * (r >> 2) + 4 * h; }
__device__ __forceinline__ bf16x8 ldg8(const bf16_t* p) { return *(const bf16x8*)p; }
__device__ __forceinline__ void halves(float x, float& lo, float& hi) { auto r = __builtin_amdgcn_permlane32_swap(__float_as_uint(x), __float_as_uint(x), false, false); lo = __uint_as_float(r[0]); hi = __uint_as_float(r[1]); }
__device__ __forceinline__ bf16x8 pack8(const f32x16& v, int b) { u32x4v w; w.x = pk2(v[b], v[b + 1]); w.y = pk2(v[b + 2], v[b + 3]); w.z = pk2(v[b + 4], v[b + 5]); w.w = pk2(v[b + 6], v[b + 7]); return __builtin_bit_cast(bf16x8, w); }
constexpr float SB_DEAD = -152.0f;
#define ATT_FENCE() asm volatile("" ::: "memory")
constexpr int RING_SLOTS = 4, RING_D = 3;
__device__ __forceinline__ void dma16(const void* gsrc, LASP unsigned char* ldst) { __builtin_amdgcn_global_load_lds((const unsigned*)gsrc, (LASP unsigned*)ldst, 16, 0, 0); }
template <int NQB, int NKS, int NKSA, int NDB, bool SBM>
__device__ __forceinline__ void tile_step(const LASP unsigned char* kimg, const LASP unsigned char* krimg, const LASP unsigned char* vimg, const bool first, const bool diag, const int qoff, const int cl, const int h,
                                          const bf16x8 (&qf)[NQB][NKS], f32x16 (&o)[NDB][NQB], float (&mrun)[NQB], float (&lrun)[NQB], float (&carry)[NQB]) {
#define ATT_LDK(dst, g_) do { _Pragma("unroll") for (int j_ = 0; j_ < 2; ++j_) { const int key_ = j_ * 32 + cla; \
        dst[j_] = (g_) < NKSA ? *(const LASP bf16x8*)(kimg + key_ * 128 + (((2 * (g_) + ha) ^ (cla & 7)) << 4)) : *(const LASP bf16x8*)(krimg + key_ * 64 + (((2 * ((g_) - NKSA) + ha) ^ ((cla >> 2) & 3)) << 4)); } } while (0)
#define ATT_LDV(dst, j_) do { _Pragma("unroll") for (int d_ = 0; d_ < NDB; ++d_) dst[d_] = *(const LASP bf16x8*)(vimg + (d_ * 32 + cla) * 128 + (((2 * (j_) + ha) ^ (cla & 7)) << 4)); } while (0)
    int cla = cl, ha = h; asm volatile("" : "+v"(cla), "+v"(ha));
    bf16x8 kf0[2], kf1[2], vf0[NDB], vf1[NDB];
    ATT_LDK(kf0, 0);
    f32x16 s[2][NQB];
#pragma unroll
    for (int kb = 0; kb < 2; ++kb)
#pragma unroll
        for (int qb = 0; qb < NQB; ++qb)
#pragma unroll
            for (int r = 0; r < 16; ++r) s[kb][qb][r] = 0.f;
#pragma unroll
    for (int g = 0; g < NKS; ++g) {
        if (g + 1 < NKS) { if (g & 1) ATT_LDK(kf0, g + 1); else ATT_LDK(kf1, g + 1); } else ATT_LDV(vf0, 0);
        ATT_FENCE();
#pragma unroll
        for (int j = 0; j < 2; ++j)
#pragma unroll
            for (int qb = 0; qb < NQB; ++qb) s[j][qb] = __builtin_amdgcn_mfma_f32_32x32x16_bf16((g & 1) ? kf1[j] : kf0[j], qf[qb][g], s[j][qb], 0, 0, 0);
    }
    if (!SBM) {
        if (first) {
#pragma unroll
            for (int qb = 0; qb < NQB; ++qb) {
#pragma unroll
                for (int r = 0; r < 16; ++r) s[0][qb][r] = -INFINITY;
#pragma unroll
                for (int r = 0; r < 8; ++r) s[1][qb][r] = -INFINITY; } }
#pragma unroll
        for (int qb = 0; qb < NQB; ++qb) {
            float mx = s[0][qb][0];
#pragma unroll
            for (int r = 1; r < 16; ++r) mx = fmaxf(mx, s[0][qb][r]);
#pragma unroll
            for (int r = 0; r < 16; ++r) mx = fmaxf(mx, s[1][qb][r]);
            float m0, m1; halves(mx, m0, m1); const float cand = fmaxf(m0, m1);
            if (__any(cand > mrun[qb] + 8.0f)) { const float mn = fmaxf(mrun[qb], cand); const float f = __builtin_amdgcn_exp2f(mrun[qb] - mn); mrun[qb] = mn; lrun[qb] *= f;
#pragma unroll
                for (int d = 0; d < NDB; ++d)
#pragma unroll
                    for (int r = 0; r < 16; ++r) o[d][qb][r] *= f; }
            float ps = 0.f;
#pragma unroll
            for (int kb = 0; kb < 2; ++kb)
#pragma unroll
                for (int r = 0; r < 16; ++r) { const float pv = __builtin_amdgcn_exp2f(s[kb][qb][r] - mrun[qb]); s[kb][qb][r] = pv; ps += pv; }
            lrun[qb] += ps;
        }
    } else {
#pragma unroll
        for (int qb = 0; qb < NQB; ++qb) {
            float run = carry[qb];
#pragma unroll
            for (int kb = 1; kb >= 0; --kb)
#pragma unroll
                for (int rg = 3; rg >= 0; --rg) {
                    const bool lead = first && (kb == 0 || rg < 2);
                    float y[4], sp[4]; bool ok[4];
#pragma unroll
                    for (int e = 0; e < 4; ++e) { y[e] = s[kb][qb][4 * rg + e]; ok[e] = !lead && !(diag && (kb * 32 + 8 * rg + 4 * h + e >= qoff + qb * 32 + cl));
                        sp[e] = ok[e] ? fmaxf(y[e], 0.f) + __builtin_amdgcn_logf(1.0f + __builtin_amdgcn_exp2f(-fabsf(y[e]))) : 0.f; }
                    const float gs = -((sp[0] + sp[1]) + (sp[2] + sp[3])); float g0, g1; halves(gs, g0, g1);
                    const float t1 = run; run += g1; const float t0 = run; run += g0; float a = h ? t1 : t0;
#pragma unroll
                    for (int e = 3; e >= 0; --e) { const float w = ok[e] ? __builtin_amdgcn_exp2f((y[e] - sp[e]) + a) : 0.f; a -= sp[e]; s[kb][qb][4 * rg + e] = w; }
                    __builtin_amdgcn_sched_barrier(0); }
            carry[qb] = run;
        }
    }
    ATT_FENCE();
#pragma unroll
    for (int j = 0; j < 4; ++j) {
        if (j + 1 < 4) { if (j & 1) ATT_LDV(vf0, j + 1); else ATT_LDV(vf1, j + 1); }
        ATT_FENCE();
        bf16x8 pf[NQB];
#pragma unroll
        for (int qb = 0; qb < NQB; ++qb) pf[qb] = pack8(s[j >> 1][qb], 8 * (j & 1));
#pragma unroll
        for (int d = 0; d < NDB; ++d)
#pragma unroll
            for (int qb = 0; qb < NQB; ++qb) o[d][qb] = __builtin_amdgcn_mfma_f32_32x32x16_bf16((j & 1) ? vf1[d] : vf0[d], pf[qb], o[d][qb], 0, 0, 0);
    }
#undef ATT_LDK
#undef ATT_LDV
}
template <int NQB, int NDB> __device__ __forceinline__ void store_ot(bf16_t* optr, int ldo, const f32x16 (&o)[NDB][NQB], const float (&sc)[NQB]) {
    int lane_ = lane_id_v(); const int lane = lane_, cl = lane & 31, h = lane >> 5;
#pragma unroll
    for (int qb = 0; qb < NQB; ++qb)
#pragma unroll
        for (int d = 0; d < NDB; ++d)
#pragma unroll
            for (int rg = 0; rg < 4; ++rg) st4(optr + (size_t)(qb * 32 + cl) * ldo + d * 32 + 8 * rg + 4 * h, o[d][qb][4 * rg] * sc[qb], o[d][qb][4 * rg + 1] * sc[qb], o[d][qb][4 * rg + 2] * sc[qb], o[d][qb][4 * rg + 3] * sc[qb]);
}
#define ATT_WAIT(n) asm volatile("s_waitcnt vmcnt(" #n ") lgkmcnt(0)" ::: "memory")
#define ATT_BAR() do { __builtin_amdgcn_s_barrier(); asm volatile("" ::: "memory"); } while (0)
template <bool SBM> __device__ __forceinline__ void unit8(const Params& p, LASP unsigned char* lds, const int wid, const int b, const int h, const int c0, const int nq) {
    constexpr int NKS = SBM ? 4 : 6, NQB = SBM ? 1 : 2, SLOTB = 20480, OFF_V = 8192, OFF_KR = 16384;
    const int lane = lane_id_v(), cl = lane & 31, hh = lane >> 5; const size_t r0 = (size_t)b * TB;
    const int ti = SBM ? wid >> 1 : wid, qoff = SBM ? (wid & 1) * 32 : 0;
    const int qt = c0 + ti, nt = c0 + nq; const bool active = ti < nq;
    const int swz = ((lane & 7) ^ ((lane >> 3) & 7)) << 3;
    const bf16_t* kbase = (SBM ? p.KSB() : p.KNOPE()) + (r0 + wid * 8 + (lane >> 3)) * W + h * 64 + swz;
    const bf16_t* vbase = (SBM ? p.VSBT() : p.VBT()) + (size_t)(h * 64 + wid * 8 + (lane >> 3)) * R + r0 + swz;
    const bf16_t* krbase = p.KR() + (r0 + (wid & 3) * 16 + (lane >> 2)) * 32 + (((lane & 3) ^ ((lane >> 4) & 3)) << 3);
#define U8_ISSUE(t_) do { const int kt_ = SBM ? nt - 1 - (t_) : (t_); LASP unsigned char* sl_ = lds + ((t_) & (RING_SLOTS - 1)) * SLOTB; \
        dma16(kbase + (size_t)kt_ * 64 * W, sl_ + wid * 1024); dma16(vbase + kt_ * 64, sl_ + OFF_V + wid * 1024); \
        if (!SBM) dma16(krbase + (size_t)kt_ * 64 * 32, sl_ + OFF_KR + (wid & 3) * 1024); } while (0)
    bf16x8 qf[NQB][NKS]; f32x16 o[2][NQB]; float mrun[NQB], lrun[NQB], carry[NQB];
    { const bf16_t* qp = SBM ? p.QSB() + (r0 + (size_t)qt * 64 + qoff) * W + h * 64 : p.QB() + (r0 + (size_t)qt * 64) * QBW + h * 96; const int ldq = SBM ? W : QBW;
#pragma unroll
      for (int qb = 0; qb < NQB; ++qb)
#pragma unroll
          for (int ks = 0; ks < NKS; ++ks) { if (active) qf[qb][ks] = ldg8(qp + (size_t)(qb * 32 + cl) * ldq + 16 * ks + 8 * hh); else qf[qb][ks] = (bf16x8){0, 0, 0, 0, 0, 0, 0, 0}; } }
#pragma unroll
    for (int qb = 0; qb < NQB; ++qb) { mrun[qb] = -INFINITY; lrun[qb] = 0.f; carry[qb] = 0.f;
#pragma unroll
        for (int d = 0; d < 2; ++d)
#pragma unroll
            for (int r = 0; r < 16; ++r) o[d][qb][r] = 0.f; }
    volatile LASP unsigned* fl = (volatile LASP unsigned*)(lds + LDS_SCR + 3072);
    if (SBM && lane == 0) fl[8 + wid] = active ? 1u : 0u;
#pragma unroll
    for (int t = 0; t < RING_D; ++t) if (t < nt) U8_ISSUE(t);
    bool dead = !active;
    for (int it = 0; it < nt; ++it) {
        const int rem = nt - 1 - it;
        if (SBM) { if (rem >= 2) ATT_WAIT(4); else if (rem == 1) ATT_WAIT(2); else ATT_WAIT(0); }
        else     { if (rem >= 2) ATT_WAIT(6); else if (rem == 1) ATT_WAIT(3); else ATT_WAIT(0); }
        ATT_BAR();
        if (SBM) { const int pb = ((it + 1) & 1) * 8; const unsigned any = (fl[pb] | fl[pb + 1] | fl[pb + 2] | fl[pb + 3]) | (fl[pb + 4] | fl[pb + 5] | fl[pb + 6] | fl[pb + 7]); if (!any) break; }
        if (it + RING_D < nt) U8_ISSUE(it + RING_D);
        const int kt = SBM ? nt - 1 - it : it;
        if (!dead && kt <= qt) {
            const LASP unsigned char* sl = lds + (it & (RING_SLOTS - 1)) * SLOTB;
            tile_step<NQB, NKS, 4, 2, SBM>(sl, sl + OFF_KR, sl + OFF_V, kt == 0, kt == qt, qoff, cl, hh, qf, o, mrun, lrun, carry);
            if (SBM) { bool dd = true;
#pragma unroll
                for (int qb = 0; qb < NQB; ++qb) dd = dd && (carry[qb] < SB_DEAD);
                dead = __all(dd) != 0; }
        }
        if (SBM && lane == 0) fl[(it & 1) * 8 + wid] = (!dead && kt > 0) ? 1u : 0u;
    }
    if (active) {
        if (SBM) { float one[NQB];
#pragma unroll
            for (int qb = 0; qb < NQB; ++qb) one[qb] = 1.f;
            store_ot<NQB, 2>(p.QSB() + (r0 + (size_t)qt * 64 + qoff) * W + h * 64, W, o, one); }
        else { float il[NQB];
#pragma unroll
            for (int qb = 0; qb < NQB; ++qb) { float l0, l1; halves(lrun[qb], l0, l1); il[qb] = 1.0f / (l0 + l1); }
            store_ot<NQB, 2>(p.OMLA() + (r0 + (size_t)qt * 64) * W + h * 64, W, o, il); }
    }
    ATT_WAIT(0); ATT_BAR();
#undef U8_ISSUE
}
__device__ __forceinline__ void unit_diff(const Params& p, LASP unsigned char* lds, const int wid, const int layer, const int b, const int head, const int c0, const int nq) {
    constexpr int SLOTB = 32768, OFF_K1 = 8192, OFF_V = 16384;
    const int lane = lane_id_v(), cl = lane & 31, hh = lane >> 5, g = wid >> 2, mp = (wid >> 1) & 1, qh = wid & 1; const size_t r0 = (size_t)b * TB;
    const int qt = c0 + g, nt = c0 + nq; const bool active = g < nq;
    const int swz = ((lane & 7) ^ ((lane >> 3) & 7)) << 3;
    const bf16_t* kbase = p.KD() + (r0 + wid * 8 + (lane >> 3)) * W + head * 128 + swz;
    const bf16_t* vbase = p.VDT() + (size_t)(head * 128 + wid * 8 + (lane >> 3)) * R + r0 + swz;
#define UD_ISSUE(t_) do { const int kt_ = (t_); LASP unsigned char* sl_ = lds + ((t_) & (RING_SLOTS - 1)) * SLOTB; \
        dma16(kbase + (size_t)kt_ * 64 * W, sl_ + wid * 1024); dma16(kbase + (size_t)kt_ * 64 * W + 64, sl_ + OFF_K1 + wid * 1024); \
        dma16(vbase + kt_ * 64, sl_ + OFF_V + wid * 1024); dma16(vbase + (size_t)64 * R + kt_ * 64, sl_ + OFF_V + (wid + 8) * 1024); } while (0)
    bf16x8 qf[1][4]; f32x16 o[4][1]; float mrun[1], lrun[1], carry[1];
    { const bf16_t* qp = p.QD() + (r0 + (size_t)qt * 64 + qh * 32) * W + head * 128 + mp * 64;
#pragma unroll
      for (int ks = 0; ks < 4; ++ks) { if (active) qf[0][ks] = ldg8(qp + (size_t)cl * W + 16 * ks + 8 * hh); else qf[0][ks] = (bf16x8){0, 0, 0, 0, 0, 0, 0, 0}; } }
    mrun[0] = -INFINITY; lrun[0] = 0.f; carry[0] = 0.f;
#pragma unroll
    for (int d = 0; d < 4; ++d)
#pragma unroll
        for (int r = 0; r < 16; ++r) o[d][0][r] = 0.f;
#pragma unroll
    for (int t = 0; t < RING_D; ++t) if (t < nt) UD_ISSUE(t);
    for (int it = 0; it < nt; ++it) {
        const int rem = nt - 1 - it;
        if (rem >= 2) ATT_WAIT(8); else if (rem == 1) ATT_WAIT(4); else ATT_WAIT(0);
        ATT_BAR();
        if (it + RING_D < nt) UD_ISSUE(it + RING_D);
        if (active && it <= qt) { const LASP unsigned char* sl = lds + (it & (RING_SLOTS - 1)) * SLOTB;
            tile_step<1, 4, 4, 4, false>(sl + mp * OFF_K1, sl, sl + OFF_V, it == 0, false, 0, cl, hh, qf, o, mrun, lrun, carry); }
    }
    ATT_WAIT(0); ATT_BAR();
    if (active) { float l0, l1; halves(lrun[0], l0, l1); const float il = 1.0f / (l0 + l1);
        LASP float* reg = (LASP float*)(lds + wid * 16384);
#pragma unroll
        for (int d = 0; d < 4; ++d)
#pragma unroll
            for (int r = 0; r < 16; ++r) reg[cl * 128 + ((d * 32 + crow(r, hh)) ^ cl)] = o[d][0][r] * il; }
    ATT_WAIT(0); ATT_BAR();
    if (active) { const float lam = p.lamv()[layer], lam_init = __uint_as_float(__builtin_amdgcn_readfirstlane(layer == 0 ? 0x3e4ccccdu : 0x3eb60549u));
      const LASP float* r0p = (const LASP float*)(lds + ((g * 2 + 0) * 2 + qh) * 16384); const LASP float* r1p = (const LASP float*)(lds + ((g * 2 + 1) * 2 + qh) * 16384);
      const int ql = mp * 16 + (lane >> 2), part = lane & 3; float v[32]; float ss = 0.f;
#pragma unroll
      for (int i = 0; i < 32; ++i) { const int ii = (i + 8 * part) & 31; const int a = ql * 128 + ((part * 32 + ii) ^ ql); v[i] = r0p[a] - lam * r1p[a]; ss += v[i] * v[i]; }
      ss = quad4_sum(ss);
      const float rs = rsq(ss * (1.0f / 128.0f) + EPS) * (1.0f - lam_init); const float* gn = p.dnorm_g + (size_t)layer * 128 + part * 32;
      bf16_t* op = p.QD() + (r0 + (size_t)qt * 64 + qh * 32 + ql) * W + head * 128 + part * 32;
#pragma unroll
      for (int i = 0; i < 32; i += 2) { const int ii = (i + 8 * part) & 31;
          st2(op + ii, v[i] * rs * gn[ii], v[i + 1] * rs * gn[ii + 1]); } }
    ATT_WAIT(0); ATT_BAR();
#undef UD_ISSUE
}
enum { AK_P2 = 0, AK_P3 = 1 };
__device__ __forceinline__ void attn_part(const Params& p, LASP unsigned char* lds, int kind, int layer, int wid, int rep = 0) {
    const bool leader = wid == 0 && lane_id_v() == 0;
    volatile LASP int* slot = (volatile LASP int*)(lds + LDS_SCR + 2048);
    unsigned* ctr = p.ctl() + 1024 + 64 * (layer * 2 + kind + 4 * rep);
    constexpr int NT = TB / 64;
    static_assert((NT - 1) % 8 == 0, "query tile grouping");
    constexpr int NG8 = (NT - 1) / 8 + 1, NG4 = (NT - 1) / 4 + 1, NGD = (NT - 1) / 2 + 1;
    constexpr int N8 = NB * NH * NG8, N4 = NB * NH * NG4, ND = NB * NHD * NGD;
    const int nitems = kind == AK_P2 ? ND + N4 : N8;
    for (int n = 0;; ++n) {
        if (leader) slot[n & 1] = (int)atomicAdd(ctr, 1u);
        asm volatile("s_waitcnt vmcnt(0) lgkmcnt(0)" ::: "memory"); __builtin_amdgcn_s_barrier(); asm volatile("" ::: "memory");
        int item = __builtin_amdgcn_readfirstlane(slot[n & 1]);
        if (item >= nitems) break;
        if (kind == AK_P2) {
            if (item < ND) { const int u = item / (NB * NHD), j = item % (NB * NHD); const bool single = u == NGD - 1;
                unit_diff(p, lds, wid, layer, j / NHD, j % NHD, single ? 0 : NT - 2 - 2 * u, single ? 1 : 2); }
            else { item -= ND; const int u = item / (NB * NH), j = item % (NB * NH); const bool single = u == NG4 - 1;
                unit8<true>(p, lds, wid, j / NH, j % NH, single ? 0 : NT - 4 - 4 * u, single ? 1 : 4); }
        } else { const int u = item / (NB * NH), j = item % (NB * NH); const bool single = u == NG8 - 1;
            unit8<false>(p, lds, wid, j / NH, j % NH, single ? 0 : NT - 8 - 8 * u, single ? 1 : 8); }
    }
}
}
template <int KIND> __global__ void __launch_bounds__(512, 2) k_attn_fast(Params p, int l) {
    extern __shared__ __attribute__((aligned(16))) unsigned char lds_raw[];
    att::attn_part(p, (LASP unsigned char*)lds_raw, KIND, l, __builtin_amdgcn_readfirstlane((int)threadIdx.x >> 6));
}

#define XB_TMO      128
#define XB_XCNT(j)  (256  + 64 * (j))
#define XB_XSUB(j)  (1280 + 64 * (j))
#define XB_XGEN(j)  (2304 + 64 * (j))
#define XB_TOP      3328
#define XB_TOPGEN   3392
#define XCD_BAR_WORDS 3456
#define XB_SPIN_CAP (1u << 18)
__device__ __forceinline__ unsigned xb_ld(unsigned* p)              { return __hip_atomic_load(p, __ATOMIC_RELAXED, __HIP_MEMORY_SCOPE_AGENT); }
__device__ __forceinline__ unsigned xb_add(unsigned* p, unsigned v) { return __hip_atomic_fetch_add(p, v, __ATOMIC_RELAXED, __HIP_MEMORY_SCOPE_AGENT); }
__device__ __forceinline__ unsigned xb_xcc_id() { return (unsigned)__builtin_amdgcn_s_getreg((3 << 11) | 20) & 0xFu; }
#define XB_SPIN(cond, bar) do { unsigned _sp = 0; while (cond) { __builtin_amdgcn_s_sleep(1); \
    if ((++_sp & 255u) == 0u) { if (xb_ld(&(bar)[XB_TMO])) break; if (_sp > XB_SPIN_CAP) { atomicAdd(&(bar)[XB_TMO], 1u); break; } } } } while (0)
struct XcdBarrier { unsigned* bar; unsigned x; volatile LASP unsigned* st; };
__device__ __forceinline__ XcdBarrier xcd_barrier_post(unsigned* bar, volatile LASP unsigned* st, bool leader) {
    XcdBarrier b; b.bar = bar; b.x = xb_xcc_id(); b.st = st;
    if (leader) (void)xb_add(&bar[XB_XCNT(b.x)], 1u);
    return b;
}
__device__ __forceinline__ void xcd_barrier_complete(unsigned* bar, unsigned x, unsigned& nloc, unsigned& nx) {
    const unsigned G = gridDim.x * gridDim.y * gridDim.z;
    unsigned sum, cnt, mine, sp = 0u;
    for (;;) {
        sum = 0u; cnt = 0u; mine = 0u;
#pragma unroll
        for (unsigned j = 0; j < 16; ++j) { const unsigned c = xb_ld(&bar[XB_XCNT(j)]); sum += c; cnt += (c > 0u) ? 1u : 0u; mine = (j == x) ? c : mine; }
        if (sum == G) break;
        __builtin_amdgcn_s_sleep(1);
        if ((++sp & 255u) == 0u) { if (xb_ld(&bar[XB_TMO])) break; if (sp > XB_SPIN_CAP) { atomicAdd(&bar[XB_TMO], 1u); break; } }
    }
    nloc = mine > 0u ? mine : 1u; nx = cnt > 0u ? cnt : 1u;
}
__device__ __forceinline__ void xcd_barrier(const XcdBarrier& b, const int wid0) {
    const bool leader = wid0 == 0 && lane_id_v() == 0;
    asm volatile("s_waitcnt vmcnt(0)" ::: "memory");
    __syncthreads();
    if (leader) {
        unsigned* bar = b.bar;
        __builtin_amdgcn_s_waitcnt(0);
        unsigned nloc = b.st[0], nx = b.st[1];
        if (nloc == 0u) { xcd_barrier_complete(bar, b.x, nloc, nx); b.st[0] = nloc; b.st[1] = nx; }
        const unsigned old = xb_add(&bar[XB_XSUB(b.x)], 1u);
        const unsigned gen = old / nloc;
        if (old + 1u == (gen + 1u) * nloc) {
            __builtin_amdgcn_fence(__ATOMIC_RELEASE, "agent");
            asm volatile("s_waitcnt vmcnt(0)" ::: "memory");
            const unsigned og = xb_add(&bar[XB_TOP], 1u);
            const unsigned tg = og / nx;
            if (og + 1u == (tg + 1u) * nx) xb_add(&bar[XB_TOPGEN], 1u);
            else XB_SPIN(xb_ld(&bar[XB_TOPGEN]) == tg, bar);
            __builtin_amdgcn_fence(__ATOMIC_ACQUIRE, "agent");
            xb_add(&bar[XB_XGEN(b.x)], 1u);
            asm volatile("s_waitcnt vmcnt(0)" ::: "memory");
        } else {
            XB_SPIN(xb_ld(&bar[XB_XGEN(b.x)]) == gen, bar);
            __builtin_amdgcn_fence(__ATOMIC_ACQUIRE, "agent");
            asm volatile("s_waitcnt vmcnt(0)" ::: "memory");
        }
    }
    __syncthreads();
}

typedef float f32x4v __attribute__((ext_vector_type(4)));
typedef unsigned u32x4w __attribute__((ext_vector_type(4)));
__device__ __forceinline__ float rope_inv(int e, int dim) { return exp2f(-(float)e / (float)dim * 18.931568569324174f); }
__device__ __forceinline__ void rope_cs(float ang, float& cs, float& sn) { const double t = (double)ang * 0.15915494309189535; const float a = (float)((t - rint(t)) * 6.283185307179586); cs = cosf(a); sn = sinf(a); }
template <int MAP> __device__ __forceinline__ int prep_src(int n) { if (MAP == 0) return src_w1(n); if (MAP == 1) return src_wv(n); if (MAP == 2) return src_w3(n); if (MAP == 3) return src_uq(n); if (MAP == 4) return src_uk(n); if (MAP == 5) return src_uv(n); return n; }
struct alignas(8) F2v { float x, y; };
template <int MAP> __device__ __forceinline__ void prep_item(const float* src, int src_ld, const float* rowscale, bf16_t* dst, int N, int K, int item, int lane, LASP float* scr) {
    const int nblk = N / 32, kb = item / nblk, nb = item % nblk, k0 = 64 * kb, n0 = 32 * nb, g4 = 4 * (lane & 7), kr = lane >> 3;
    const int s0 = prep_src<MAP>(n0 + g4), s2 = prep_src<MAP>(n0 + g4 + 2);
    const bool quad = s0 >= 0 && s2 == s0 + 2 && (s0 & 3) == 0;
#pragma unroll
    for (int i = 0; i < 8; ++i) { const int kk = 8 * i + kr; const float* row = src + (size_t)(k0 + kk) * src_ld; const float sc = rowscale ? rowscale[k0 + kk] : 1.f;
        F4v v = {0.f, 0.f, 0.f, 0.f};
        if (quad) v = *(const F4v*)(row + s0); else if (s0 >= 0) { const F2v a = *(const F2v*)(row + s0), b2 = *(const F2v*)(row + s2); v.x = a.x; v.y = a.y; v.z = b2.x; v.w = b2.y; }
        LASP float* t = scr + kk * 33 + g4; t[0] = v.x * sc; t[1] = v.y * sc; t[2] = v.z * sc; t[3] = v.w * sc; }
    asm volatile("s_waitcnt lgkmcnt(0)" ::: "memory");
    const int c = lane & 7;
#pragma unroll
    for (int j = 0; j < 4; ++j) { const int n = (lane >> 3) + 8 * j; const LASP float* t = scr + (8 * c) * 33 + n;
        u32x4w o; o.x = pk2(t[0 * 33], t[1 * 33]); o.y = pk2(t[2 * 33], t[3 * 33]); o.z = pk2(t[4 * 33], t[5 * 33]); o.w = pk2(t[6 * 33], t[7 * 33]);
        *(u32x4w*)(dst + (size_t)(n0 + n) * K + k0 + 8 * c) = o; }
    asm volatile("s_waitcnt lgkmcnt(0)" ::: "memory");
}
__device__ __forceinline__ void prologue_part(const Params& p, LASP unsigned char* lds, int G, int c, int wave) {
    int lane_ = lane_id_v(); const int lane = lane_;
    const int gw = c * 8 + wave, NGW = G * 8;
    for (int i = gw * 64 + lane; i < NPOS * 16; i += NGW * 64) {
        { const int pos = i / 16, j = i % 16; const float ang = (float)pos * rope_inv(2 * j, 32); float cs, sn; rope_cs(ang, cs, sn); p.cosm()[i] = cs; p.sinm()[i] = sn; }
        if (i < NPOS * 8) { const int pos = i / 8, j = i % 8; const float ang = (float)pos * rope_inv(2 * j, 16); float cs, sn; rope_cs(ang, cs, sn); p.cosd()[i] = cs; p.sind()[i] = sn; }
        if (i < DEPTH) { const float* lm = p.dlam + i * 4 * 64; float s0 = 0.f, s1 = 0.f; for (int d = 0; d < 64; ++d) { s0 += lm[d] * lm[64 + d]; s1 += lm[128 + d] * lm[192 + d]; }
            p.lamv()[i] = expf(s0) - expf(s1) + (i == 0 ? 0.2f : 0.35550906759f); }
    }
    LASP float* scr = (LASP float*)(lds + wave * 16384);
    constexpr int I_W1 = (D / 64) * (N1 / 32), I_WV = (D / 64) * (2 * W / 32), I_W3 = (D / 64) * (N3 / 32), I_UQ = (QR / 64) * (QBW / 32), I_UK = (KVR / 64) * (W / 32), I_WO = (W / 64) * (D / 32), I_OUT = (D / 64) * (D / 32);
    constexpr int I_L = I_W1 + I_WV + I_W3 + I_UQ + 2 * I_UK + 3 * I_WO + I_OUT;
    for (int it = gw; it < 2 * I_L; it += NGW) {
        const int l = it / I_L; int r = it % I_L;
        const float* win = p.w_in + (size_t)l * D * INC; const float* ng = p.norm_g + l * D;
        if (r < I_W1) { prep_item<0>(win, INC, ng, wptr(p, l, WL_W1), N1, D, r, lane, scr); continue; } r -= I_W1;
        if (r < I_WV) { prep_item<1>(win, INC, ng, wptr(p, l, WL_WV), 2 * W, D, r, lane, scr); continue; } r -= I_WV;
        if (r < I_W3) { prep_item<2>(win, INC, ng, wptr(p, l, WL_W3), N3, D, r, lane, scr); continue; } r -= I_W3;
        if (r < I_UQ) { prep_item<3>(p.w_uq + (size_t)l * QR * QBW, QBW, p.cq_g + l * QR, wptr(p, l, WL_UQ), QBW, QR, r, lane, scr); continue; } r -= I_UQ;
        if (r < I_UK) { prep_item<4>(p.w_ukv + (size_t)l * KVR * NH * 128, NH * 128, p.ckv_g + l * KVR, wptr(p, l, WL_UK), W, KVR, r, lane, scr); continue; } r -= I_UK;
        if (r < I_UK) { prep_item<5>(p.w_ukv + (size_t)l * KVR * NH * 128, NH * 128, p.ckv_g + l * KVR, wptr(p, l, WL_UV), W, KVR, r, lane, scr); continue; } r -= I_UK;
        if (r < 3 * I_WO) { const int b = r / I_WO; const float* const w0 = opq(p.w_osb); const float* const w1 = opq(p.w_omla); const float* const w2 = opq(p.w_odiff); const float* wo = (b == 0 ? w0 : b == 1 ? w1 : w2) + (size_t)l * W * D;
            prep_item<6>(wo, D, nullptr, wptr(p, l, WL_WO) + (size_t)b * D * W, D, W, r % I_WO, lane, scr); continue; } r -= 3 * I_WO;
        prep_item<6>(p.w_out + (size_t)l * D * D, D, nullptr, wptr(p, l, WL_OUT), D, D, r, lane, scr);
    }
    for (int row = gw; row < R; row += NGW) {
        const int b = row / TB, t = row % TB; f32x4v v[D / 256]; float ss = 0.f;
#pragma unroll
        for (int j = 0; j < D / 256; ++j) { const int col = 256 * j + 4 * lane;
            if (t < LEAD) v[j] = (f32x4v){0.f, 0.f, 0.f, 0.f}; else if (t < LEAD + NMETA) v[j] = *(const f32x4v*)(p.meta + (size_t)(t - LEAD) * D + col); else v[j] = *(const f32x4v*)(p.x + ((size_t)b * SEQ + (t - LEAD - NMETA)) * D + col);
            ss += (v[j].x * v[j].x + v[j].y * v[j].y) + (v[j].z * v[j].z + v[j].w * v[j].w); }
        ss = wave_sum(ss);
#pragma unroll
        for (int j = 0; j < D / 256; ++j) { const int col = 256 * j + 4 * lane; *(f32x4v*)(p.X() + (size_t)row * D + col) = v[j]; st4(p.XB() + (size_t)row * D + col, v[j].x, v[j].y, v[j].z, v[j].w); }
        if (lane < NSX) p.ssx()[(size_t)row * NSX + lane] = lane == 0 ? ss : 0.f;
    }
}
__device__ __forceinline__ void x2bf_part(const Params& p, int G, int c, int wave) {
    int lane_ = lane_id_v(); const int lane = lane_;
    for (int row = c * 8 + wave; row < R; row += G * 8) {
#pragma unroll
        for (int j = 0; j < D / 256; ++j) { const int col = 256 * j + 4 * lane; const f32x4v v = *(const f32x4v*)(p.X() + (size_t)row * D + col); st4(p.XB2() + (size_t)row * D + col, v.x, v.y, v.z, v.w); } }
}
__device__ __forceinline__ void final_part(const Params& p, int G, int c, int wave) {
    if (c >= G - 8) return;
    int lane_ = lane_id_v(); const int lane = lane_; bool waited = false;
    for (int i = c * 8 + wave; i < NB * SEQ; i += (G - 8) * 8) {
        const int b = i / SEQ, sq = i % SEQ; const size_t xr = (size_t)b * TB + LEAD + NMETA + sq;
        if (!waited && xr >= (size_t)LT_ROW0) { lt_wait(p.ctl() + CW_LTFLAG + 128 + 256 * (DEPTH - 1)); waited = true; }
        const float* x = p.X() + xr * D; f32x4v v[D / 256]; float ss = 0.f;
#pragma unroll
        for (int j = 0; j < D / 256; ++j) { v[j] = *(const f32x4v*)(x + 256 * j + 4 * lane); ss += (v[j].x * v[j].x + v[j].y * v[j].y) + (v[j].z * v[j].z + v[j].w * v[j].w); }
        const float rs = rsq(wave_sum(ss) * (1.0f / D) + EPS);
#pragma unroll
        for (int j = 0; j < D / 256; ++j) { const f32x4v g = *(const f32x4v*)(p.final_g + 256 * j + 4 * lane); *(f32x4v*)(p.out + (size_t)i * D + 256 * j + 4 * lane) = v[j] * rs * g; }
    }
}
constexpr int N_PHASES = 2 + 6 * DEPTH;
constexpr int CW_QUEUE = 1024, CW_BAR = 4096;
#define MK_SEAM(k) do { if ((k) + 1 < ph_hi) xcd_barrier(bar, wid0); } while (0)
#define MK_IN(k) (ph_lo <= (k) && (k) < ph_hi)
#ifndef PROBE_DUP
#define PROBE_DUP 0
#endif
template <int L> __device__ __forceinline__ void layer_phases(const Params& p, LASP unsigned char* lds, const XcdBarrier& bar, int ph_lo, int ph_hi, int G, int c, int wid0) {
    constexpr int B0 = 1 + 6 * L;
    if (MK_IN(B0 + 0)) { if (L > 0) p5_leftover(p, lds, L - 1, G, c, wid0); gemm_part(p, lds, PK_P1, L, G, c, wid0); MK_SEAM(B0 + 0); }
    if (MK_IN(B0 + 1)) { gemm_part(p, lds, PK_P2, L, G, c, wid0); att::attn_part(p, lds, att::AK_P2, L, wid0); MK_SEAM(B0 + 1); }
    if (MK_IN(B0 + 2)) { x2bf_part(p, G, c, wid0); att::attn_part(p, lds, att::AK_P3, L, wid0); if (PROBE_DUP & 4) { x2bf_part(p, G, c, wid0); att::attn_part(p, lds, att::AK_P3, L, wid0, 1); } MK_SEAM(B0 + 2); }
    if (MK_IN(B0 + 3)) { gemm_part(p, lds, PK_P3B, L, G, c, wid0); MK_SEAM(B0 + 3); }
    if (MK_IN(B0 + 4)) { gemm_part(p, lds, PK_P4, L, G, c, wid0); if (PROBE_DUP & 8) gemm_part(p, lds, PK_P4, L, G, c, wid0); MK_SEAM(B0 + 4); }
    if (MK_IN(B0 + 5)) { lt_merge(p, L, G, c, wid0); gemm_part(p, lds, PK_P5, L, G, c, wid0); MK_SEAM(B0 + 5); }
}
__global__ void __launch_bounds__(512, 2) mk_fwd(Params p, int ph_lo, int ph_hi) {
    extern __shared__ __attribute__((aligned(16))) unsigned char lds_raw[];
    LASP unsigned char* lds = (LASP unsigned char*)lds_raw;
    volatile LASP unsigned* misc = (volatile LASP unsigned*)(lds + LDS_SCR + 4096);
    const int wid0 = __builtin_amdgcn_readfirstlane((int)threadIdx.x >> 6);
    if (threadIdx.x < 64) misc[threadIdx.x] = 0u;
    __syncthreads();
    const int G = (int)gridDim.x, c = (int)blockIdx.x;
    const XcdBarrier bar = xcd_barrier_post(p.ctl() + CW_BAR, misc + 8, threadIdx.x == 0);
    if (MK_IN(0)) { prologue_part(p, lds, G, c, wid0); if (PROBE_DUP & 1) prologue_part(p, lds, G, c, wid0); MK_SEAM(0); }
    layer_phases<0>(p, lds, bar, ph_lo, ph_hi, G, c, wid0);
    layer_phases<1>(p, lds, bar, ph_lo, ph_hi, G, c, wid0);
    if (MK_IN(N_PHASES - 1)) { p5_leftover(p, lds, DEPTH - 1, G, c, wid0); final_part(p, G, c, wid0); }
}
#endif

#ifdef HOST_EMU
typedef int hipStream_t;
#endif
#define NBLK(n, t) (((long)(n) + (t) - 1) / (t))
#ifndef HOST_EMU
#ifndef MK_SPLIT
#define MK_SPLIT 0
#endif
extern "C" void kernel_launch(void* const* d_in, const int* in_sizes, int n_in, void* d_out, int out_size, void* d_ws, size_t ws_size, hipStream_t stream) {
    if (n_in != 16 || in_sizes[0] != NB * SEQ * D || out_size != NB * SEQ * D || ws_size < WS_NEED) { fprintf(stderr, "kernel_launch: unexpected shapes / workspace (%d inputs, ws %zu, need %zu)\n", n_in, ws_size, (size_t)WS_NEED); return; }
    static int grid = 0;
    if (grid == 0) { int dev = 0, cus = 0; (void)hipGetDevice(&dev); (void)hipDeviceGetAttribute(&cus, hipDeviceAttributeMultiprocessorCount, dev); grid = cus > 0 ? cus : 256;
        if (hipFuncSetAttribute((const void*)mk_fwd, hipFuncAttributeMaxDynamicSharedMemorySize, LDS_BYTES) != hipSuccess) { fprintf(stderr, "kernel_launch: hipFuncSetAttribute failed\n"); grid = -1; } }
    if (grid < 0) return;
    const Params p = make_params(d_in, d_out, d_ws);
    (void)hipMemsetAsync((char*)d_ws + O_CTL, 0, 65536, stream);
#if MK_SPLIT
    for (int ph = 0; ph < N_PHASES; ++ph) hipLaunchKernelGGL(mk_fwd, dim3(grid), dim3(512), LDS_BYTES, stream, p, ph, ph + 1);
#else
    hipLaunchKernelGGL(mk_fwd, dim3(grid), dim3(512), LDS_BYTES, stream, p, 0, N_PHASES);
#endif
}
#else
extern "C" void kernel_launch(void* const* d_in, const int* in_sizes, int n_in, void* d_out, int out_size, void* d_ws, size_t ws_size, hipStream_t stream) {
    if (n_in != 16 || in_sizes[0] != NB * SEQ * D || out_size != NB * SEQ * D || ws_size < WS_NEED) { fprintf(stderr, "kernel_launch: unexpected shapes / workspace (%d inputs, ws %zu, need %zu)\n", n_in, ws_size, (size_t)WS_NEED); return; }
    const Params p = make_params(d_in, d_out, d_ws);
    const int T = 256;
#if 0
        (void)hipFuncSetAttribute((const void*)k_gemm_fast<PK_P1>, hipFuncAttributeMaxDynamicSharedMemorySize, LDS_BYTES); hipFuncSetAttribute((const void*)k_gemm_fast<PK_P2>, hipFuncAttributeMaxDynamicSharedMemorySize, LDS_BYTES);
        hipFuncSetAttribute((const void*)k_gemm_fast<PK_P3B>, hipFuncAttributeMaxDynamicSharedMemorySize, LDS_BYTES); hipFuncSetAttribute((const void*)k_gemm_fast<PK_P4>, hipFuncAttributeMaxDynamicSharedMemorySize, LDS_BYTES);
        hipFuncSetAttribute((const void*)k_gemm_fast<PK_P5>, hipFuncAttributeMaxDynamicSharedMemorySize, LDS_BYTES);
        hipFuncSetAttribute((const void*)k_attn_fast<att::AK_P2>, hipFuncAttributeMaxDynamicSharedMemorySize, LDS_BYTES); hipFuncSetAttribute((const void*)k_attn_fast<att::AK_P3>, hipFuncAttributeMaxDynamicSharedMemorySize, LDS_BYTES); }
    (void)hipMemsetAsync((char*)d_ws + O_CTL, 0, 65536, stream);
#endif
    LAUNCH(k_tables, NBLK(NPOS * 16, T), T, p);
    for (int l = 0; l < DEPTH; ++l) {
        LAUNCH(k_prep_w<0>, NBLK((long)N1 * D, T), T, wptr(p, l, WL_W1), N1, D, p.w_in + (size_t)l * D * INC, INC, p.norm_g + l * D);
        LAUNCH(k_prep_w<1>, NBLK((long)2 * W * D, T), T, wptr(p, l, WL_WV), 2 * W, D, p.w_in + (size_t)l * D * INC, INC, p.norm_g + l * D);
        LAUNCH(k_prep_w<2>, NBLK((long)N3 * D, T), T, wptr(p, l, WL_W3), N3, D, p.w_in + (size_t)l * D * INC, INC, p.norm_g + l * D);
        LAUNCH(k_prep_w<3>, NBLK((long)QBW * QR, T), T, wptr(p, l, WL_UQ), QBW, QR, p.w_uq + (size_t)l * QR * QBW, QBW, p.cq_g + l * QR);
        LAUNCH(k_prep_w<4>, NBLK((long)W * KVR, T), T, wptr(p, l, WL_UK), W, KVR, p.w_ukv + (size_t)l * KVR * NH * 128, NH * 128, p.ckv_g + l * KVR);
        LAUNCH(k_prep_w<5>, NBLK((long)W * KVR, T), T, wptr(p, l, WL_UV), W, KVR, p.w_ukv + (size_t)l * KVR * NH * 128, NH * 128, p.ckv_g + l * KVR);
        LAUNCH(k_prep_w<6>, NBLK((long)D * W, T), T, wptr(p, l, WL_WO), D, W, p.w_osb + (size_t)l * W * D, D, (const float*)nullptr);
        LAUNCH(k_prep_w<6>, NBLK((long)D * W, T), T, wptr(p, l, WL_WO) + (size_t)D * W, D, W, p.w_omla + (size_t)l * W * D, D, (const float*)nullptr);
        LAUNCH(k_prep_w<6>, NBLK((long)D * W, T), T, wptr(p, l, WL_WO) + (size_t)2 * D * W, D, W, p.w_odiff + (size_t)l * W * D, D, (const float*)nullptr);
        LAUNCH(k_prep_w<6>, NBLK((long)D * D, T), T, wptr(p, l, WL_OUT), D, D, p.w_out + (size_t)l * D * D, D, (const float*)nullptr);
    }
    LAUNCH(k_init_x, NBLK((long)R * D, T), T, p);
    LAUNCH(k_ssq_f32, NBLK(R, 64), 64, (const float*)p.X(), D, p.ssx(), NSX);
    for (int l = 0; l < DEPTH; ++l) {
        const int last = (l == DEPTH - 1) ? 1 : 0; (void)last;
#ifndef HOST_EMU
        FASTG(PK_P1, l);
        FASTG(PK_P2, l);
#else
        LAUNCH(k_gemm<F1>, NBLK((long)R * (V1_END / 8), T), T, (const bf16_t*)p.XB(), D, (const bf16_t*)wptr(p, l, WL_W1), D, R, V1_END, D, p, 0, 0);
        LAUNCH(k_gemm<F1>, NBLK((long)2 * W * (R / 8), T), T, (const bf16_t*)wptr(p, l, WL_WV), D, (const bf16_t*)p.XB(), D, 2 * W, R, D, p, 0, 1);
        LAUNCH(k_ssq_bf, NBLK(R, 64), 64, (const bf16_t*)p.CQ(), QR, p.ssq(), NSQ);
        LAUNCH(k_ssq_bf, NBLK(R, 64), 64, (const bf16_t*)p.CKV(), KVR, p.ssk(), NSK);
        LAUNCH(k_gemm<FUQ>, NBLK((long)R * (QBW / 8), T), T, (const bf16_t*)p.CQ(), QR, (const bf16_t*)wptr(p, l, WL_UQ), QR, R, QBW, QR, p, 0, 0);
        LAUNCH(k_gemm<FUK>, NBLK((long)R * (W / 8), T), T, (const bf16_t*)p.CKV(), KVR, (const bf16_t*)wptr(p, l, WL_UK), KVR, R, W, KVR, p, 0, 0);
        LAUNCH(k_gemm<FUK>, NBLK((long)W * (R / 8), T), T, (const bf16_t*)wptr(p, l, WL_UV), KVR, (const bf16_t*)p.CKV(), KVR, W, R, KVR, p, 0, 1);
#endif
#ifndef HOST_EMU
        hipLaunchKernelGGL(k_attn_fast<att::AK_P2>, dim3(grid), dim3(512), LDS_BYTES, stream, p, l);
        hipLaunchKernelGGL(k_attn_fast<att::AK_P3>, dim3(grid), dim3(512), LDS_BYTES, stream, p, l);
#else
        LAUNCH(k_attn_sb, NBLK((long)NB * NH * TB, 64), 64, p);
        LAUNCH(k_attn_diff, NBLK((long)NB * NHD * TB, 64), 64, p, l);
        LAUNCH(k_attn_mla, NBLK((long)NB * NH * TB, 64), 64, p);
#endif
        LAUNCH(k_x2bf, NBLK((long)R * D, T), T, p);
#ifndef HOST_EMU
        FASTG(PK_P3B, l); FASTG(PK_P4, l); FASTG(PK_P5, l);
#else
        LAUNCH(k_gemm<F3>, NBLK((long)R * (N3 / 8), T), T, (const bf16_t*)p.XB2(), D, (const bf16_t*)wptr(p, l, WL_W3), D, R, N3, D, p, l, 0);
        LAUNCH(k_gemm<F4>, NBLK((long)R * (D / 8), T), T, (const bf16_t*)p.QSB(), W, (const bf16_t*)wptr(p, l, WL_WO), W, R, D, W, p, 0, 0);
        LAUNCH(k_gemm<F4>, NBLK((long)R * (D / 8), T), T, (const bf16_t*)p.OMLA(), W, (const bf16_t*)(wptr(p, l, WL_WO) + (size_t)D * W), W, R, D, W, p, 0, 5);
        LAUNCH(k_gemm<F4>, NBLK((long)R * (D / 8), T), T, (const bf16_t*)p.QD(), W, (const bf16_t*)(wptr(p, l, WL_WO) + (size_t)2 * D * W), W, R, D, W, p, 0, 6);
        LAUNCH(k_gemm<F5>, NBLK((long)R * (D / 8), T), T, (const bf16_t*)p.G0(), D, (const bf16_t*)wptr(p, l, WL_OUT), D, R, D, D, p, last, 0);
        if (!last) LAUNCH(k_ssq_f32, NBLK(R, 64), 64, (const float*)p.X(), D, p.ssx(), NSX);
#endif
    }
    LAUNCH(k_final, NBLK((long)NB * SEQ, 64), 64, p);
}
#endif
```
